# Optimizing an MI355X kernel written in HIP

```python
import math
import jax
import jax.numpy as jnp
from jax import lax
import numpy as np

D_MODEL = 2048
BATCH = 2
SEQ = 16384
DEPTH = 2

HEAD_DIM = 64
NSA_HEADS = 16
NSA_KV_HEADS = 2
NSA_HPG = NSA_HEADS // NSA_KV_HEADS
CMP_LEN = 32
CMP_STRIDE = 16
CMP_HIDDEN = 128
SLC_BLOCK = 64
N_SELECT = 16
NSA_WINDOW = 512
FORCE_BONUS = 1e4
SWA_HEADS = 16
SWA_KV_HEADS = 2
SWA_HPG = SWA_HEADS // SWA_KV_HEADS
SWA_WINDOW = 128
REL_BUCKETS = 32
REL_EXACT = 16
REL_MAX_DIST = 2048
PEER_HEADS = 8
PEER_NKEYS = 128
PEER_EXPERTS = PEER_NKEYS * PEER_NKEYS
PEER_QDIM = 256
PEER_TOPK = 16
PEER_CHUNK = 128

Q_BLOCK = 128
NEG = -1e30
RMS_EPS = 1e-6
NSA_Q_W = NSA_HEADS * HEAD_DIM
NSA_KV_W = NSA_KV_HEADS * HEAD_DIM
NSA_GATE_W = NSA_HEADS * 3
SWA_Q_W = SWA_HEADS * HEAD_DIM
SWA_KV_W = SWA_KV_HEADS * HEAD_DIM
MIX_WIDTH = NSA_Q_W + SWA_Q_W
PROJ_SPLITS = (NSA_Q_W, NSA_KV_W, NSA_KV_W, NSA_KV_W, NSA_KV_W, NSA_KV_W, NSA_KV_W, NSA_GATE_W, SWA_Q_W, SWA_KV_W, SWA_KV_W)
PROJ_WIDTH = sum(PROJ_SPLITS)
SLC_OFFSETS = (-1, 0, 1, 2, 3)
SLC_WEIGHTS = (1.0, 2.0, 2.0, 2.0, 1.0)

kernel_name = 'nsa_swa_sink_peer_hybrid'


def rmsnorm(x, g):
    xf = x.astype(jnp.float32)
    y = xf * lax.rsqrt(jnp.mean(xf * xf, axis=-1, keepdims=True) + RMS_EPS)
    return (y * g.astype(jnp.float32)).astype(x.dtype)


def rel_bucket(dist):
    d = jnp.maximum(dist, 0)
    n_log = REL_BUCKETS - REL_EXACT
    large = REL_EXACT + (jnp.log(jnp.maximum(d, 1).astype(jnp.float32) / REL_EXACT)
                         / math.log(REL_MAX_DIST / REL_EXACT) * n_log).astype(jnp.int32)
    large = jnp.minimum(large, REL_BUCKETS - 1)
    return jnp.where(d < REL_EXACT, d, large)


def masked_softmax(logits, valid):
    p = jax.nn.softmax(jnp.where(valid, logits, NEG), axis=-1)
    return jnp.where(valid, p, 0.0)


def compress(k, pos, w1, w2):
    B, S, G, Dh = k.shape
    chunks = k.reshape(B, S // CMP_STRIDE, CMP_STRIDE, G, Dh)
    blocks = jnp.concatenate([chunks[:, :-1], chunks[:, 1:]], axis=2)
    blocks = blocks + pos[None, None, :, None, :]
    flat = jnp.moveaxis(blocks, 3, 2).reshape(B, blocks.shape[1], G, CMP_LEN * Dh)
    return jax.nn.gelu(flat @ w1) @ w2


def hybrid_mixer(xn, w_in, cmp_pos_k, cmp_w1_k, cmp_w2_k, cmp_pos_v, cmp_w1_v, cmp_w2_v,
                 sinks, rel_bias, w_out):
    B, S, _ = xn.shape
    f32 = jnp.float32
    GA, GB = NSA_KV_HEADS, SWA_KV_HEADS
    NS = S // SLC_BLOCK
    n_sel = min(N_SELECT, NS)
    scale = HEAD_DIM ** -0.5
    offs = [int(c) for c in np.cumsum(PROJ_SPLITS)[:-1]]
    (q_a, kc, vc, ks, vs, kw, vw, gate_a, q_b, k_b, v_b) = jnp.split(xn @ w_in, offs, axis=-1)

    q_a = q_a.reshape(B, S, GA, NSA_HPG, HEAD_DIM)
    q_b = q_b.reshape(B, S, GB, SWA_HPG, HEAD_DIM)
    gate_a = jax.nn.sigmoid(gate_a).reshape(B, S, GA, NSA_HPG, 3)
    kc_c = compress(kc.reshape(B, S, GA, HEAD_DIM), cmp_pos_k, cmp_w1_k, cmp_w2_k)
    vc_c = compress(vc.reshape(B, S, GA, HEAD_DIM), cmp_pos_v, cmp_w1_v, cmp_w2_v)
    n_cmp = kc_c.shape[1]
    cmp_end = jnp.arange(n_cmp) * CMP_STRIDE + CMP_LEN - 1
    ks_blk = ks.reshape(B, NS, SLC_BLOCK, GA, HEAD_DIM).transpose(0, 3, 1, 2, 4)
    vs_blk = vs.reshape(B, NS, SLC_BLOCK, GA, HEAD_DIM).transpose(0, 3, 1, 2, 4)
    pad_a = ((0, 0), (NSA_WINDOW, 0), (0, 0), (0, 0))
    kw_pad = jnp.pad(kw.reshape(B, S, GA, HEAD_DIM), pad_a)
    vw_pad = jnp.pad(vw.reshape(B, S, GA, HEAD_DIM), pad_a)
    pad_b = ((0, 0), (SWA_WINDOW, 0), (0, 0), (0, 0))
    kb_pad = jnp.pad(k_b.reshape(B, S, GB, HEAD_DIM), pad_b)
    vb_pad = jnp.pad(v_b.reshape(B, S, GB, HEAD_DIM), pad_b)

    bias_a = rel_bias[:, :NSA_HEADS].reshape(REL_BUCKETS, GA, NSA_HPG).astype(f32)
    bias_b = rel_bias[:, NSA_HEADS:].reshape(REL_BUCKETS, GB, SWA_HPG).astype(f32)
    sink = sinks.astype(f32).reshape(1, GB, SWA_HPG, 1, 1)
    b_idx = jnp.arange(B)[:, None, None, None]
    g_idx = jnp.arange(GA)[None, :, None, None]
    blk_ids = jnp.arange(NS)
    slc_tok = jnp.arange(SLC_BLOCK)

    def token_bias(table, dist):
        return table[rel_bucket(dist)].transpose(2, 3, 0, 1)

    def query_block(i):
        q0 = i * Q_BLOCK
        pos_q = q0 + jnp.arange(Q_BLOCK)
        qa = lax.dynamic_slice_in_dim(q_a, q0, Q_BLOCK, axis=1)
        dt = qa.dtype

        dist_c = pos_q[:, None] - cmp_end[None, :]
        lg_c = jnp.einsum('bqghd,bcgd->bghqc', qa, kc_c, preferred_element_type=f32) * scale
        p_cmp = masked_softmax(lg_c + token_bias(bias_a, dist_c), dist_c >= 0)
        o_cmp = jnp.einsum('bghqc,bcgd->bqghd', p_cmp.astype(dt), vc_c)

        imp = jnp.pad(p_cmp.sum(axis=2), ((0, 0), (0, 0), (0, 0), (1, 1)))
        imp_s = jnp.zeros(imp.shape[:-1] + (NS,), f32)
        for r, w in zip(SLC_OFFSETS, SLC_WEIGHTS):
            imp_s = imp_s + w * imp[..., r + 1: r + 2 + 4 * (NS - 1): 4]
        cb = pos_q[:, None] // SLC_BLOCK
        j = blk_ids[None, :]
        forced = (j == 0) | (j == cb) | (j == cb - 1)
        score = jnp.where(j > cb, NEG, imp_s + jnp.where(forced, FORCE_BONUS, 0.0))
        _, sel = lax.top_k(score, n_sel)
        ks_g = ks_blk[b_idx, g_idx, sel].reshape(B, GA, Q_BLOCK, n_sel * SLC_BLOCK, HEAD_DIM)
        vs_g = vs_blk[b_idx, g_idx, sel].reshape(B, GA, Q_BLOCK, n_sel * SLC_BLOCK, HEAD_DIM)
        kpos = (sel[..., None] * SLC_BLOCK + slc_tok).reshape(B, GA, Q_BLOCK, n_sel * SLC_BLOCK)
        dist_s = pos_q[:, None] - kpos
        bias_s = jnp.moveaxis(bias_a[rel_bucket(dist_s), g_idx], -1, 2)
        lg_s = jnp.einsum('bqghd,bgqkd->bghqk', qa, ks_g, preferred_element_type=f32) * scale
        p_s = masked_softmax(lg_s + bias_s, (dist_s >= 0)[:, :, None])
        o_slc = jnp.einsum('bghqk,bgqkd->bqghd', p_s.astype(dt), vs_g)

        La = Q_BLOCK + NSA_WINDOW
        kwin = lax.dynamic_slice_in_dim(kw_pad, q0, La, axis=1)
        vwin = lax.dynamic_slice_in_dim(vw_pad, q0, La, axis=1)
        kpos_w = q0 - NSA_WINDOW + jnp.arange(La)
        dist_w = pos_q[:, None] - kpos_w[None, :]
        valid_w = (dist_w >= 0) & (dist_w < NSA_WINDOW) & (kpos_w[None, :] >= 0)
        lg_w = jnp.einsum('bqghd,blgd->bghql', qa, kwin, preferred_element_type=f32) * scale
        p_w = masked_softmax(lg_w + token_bias(bias_a, dist_w), valid_w)
        o_win = jnp.einsum('bghql,blgd->bqghd', p_w.astype(dt), vwin)

        g = lax.dynamic_slice_in_dim(gate_a, q0, Q_BLOCK, axis=1)
        o_a = g[..., 0:1] * o_cmp + g[..., 1:2] * o_slc + g[..., 2:3] * o_win

        qb = lax.dynamic_slice_in_dim(q_b, q0, Q_BLOCK, axis=1)
        Lb = Q_BLOCK + SWA_WINDOW
        kbw = lax.dynamic_slice_in_dim(kb_pad, q0, Lb, axis=1)
        vbw = lax.dynamic_slice_in_dim(vb_pad, q0, Lb, axis=1)
        kpos_b = q0 - SWA_WINDOW + jnp.arange(Lb)
        dist_b = pos_q[:, None] - kpos_b[None, :]
        valid_b = (dist_b >= 0) & (dist_b < SWA_WINDOW) & (kpos_b[None, :] >= 0)
        lg_b = jnp.einsum('bqghd,blgd->bghql', qb, kbw, preferred_element_type=f32) * scale
        lg_b = jnp.where(valid_b, lg_b + token_bias(bias_b, dist_b), NEG)
        m = jnp.maximum(lg_b.max(axis=-1, keepdims=True), sink)
        e = jnp.exp(lg_b - m)
        p_b = e / (e.sum(axis=-1, keepdims=True) + jnp.exp(sink - m))
        o_b = jnp.einsum('bghql,blgd->bqghd', p_b.astype(dt), vbw)

        return jnp.concatenate([o_a.reshape(B, Q_BLOCK, NSA_Q_W),
                                o_b.reshape(B, Q_BLOCK, SWA_Q_W)], axis=-1)

    out = lax.map(query_block, jnp.arange(S // Q_BLOCK))
    out = out.transpose(1, 0, 2, 3).reshape(B, S, MIX_WIDTH)
    return out @ w_out


def peer(xn, wq, subkeys, u, v):
    B, S, D = xn.shape
    T = B * S
    xt = xn.reshape(T, D)
    q = (xt @ wq).reshape(T, PEER_HEADS, 2, PEER_QDIM // 2).astype(jnp.float32)
    s1 = jnp.einsum('thd,nd->thn', q[:, :, 0], subkeys[0].astype(jnp.float32))
    s2 = jnp.einsum('thd,nd->thn', q[:, :, 1], subkeys[1].astype(jnp.float32))
    v1, i1 = lax.top_k(s1, PEER_TOPK)
    v2, i2 = lax.top_k(s2, PEER_TOPK)
    cand = (v1[..., :, None] + v2[..., None, :]).reshape(T, PEER_HEADS, PEER_TOPK * PEER_TOPK)
    sc, ci = lax.top_k(cand, PEER_TOPK)
    e1 = jnp.take_along_axis(i1, ci // PEER_TOPK, axis=-1)
    e2 = jnp.take_along_axis(i2, ci % PEER_TOPK, axis=-1)
    idx = e1 * PEER_NKEYS + e2
    gate = jax.nn.softmax(sc, axis=-1).astype(xn.dtype)
    n_ch = T // PEER_CHUNK

    def chunk(args):
        xc, ic, gc = args
        h = jax.nn.gelu(jnp.einsum('cd,chkd->chk', xc, u[ic]))
        return jnp.einsum('chk,chkd->cd', gc * h, v[ic])

    out = lax.map(chunk, (xt.reshape(n_ch, PEER_CHUNK, D),
                          idx.reshape(n_ch, PEER_CHUNK, PEER_HEADS, PEER_TOPK),
                          gate.reshape(n_ch, PEER_CHUNK, PEER_HEADS, PEER_TOPK)))
    return out.reshape(B, S, D)


def setup_inputs(seed: int = 0) -> dict:
    key = jax.random.key(seed)
    ks = jax.random.split(key, 18)

    def nrm(k, shape, s):
        return jax.random.normal(k, shape, jnp.float32) * s

    return {
        'x': nrm(ks[0], (BATCH, SEQ, D_MODEL), 1.0),
        'attn_norm': 1.0 + nrm(ks[1], (DEPTH, D_MODEL), 0.02),
        'w_in': nrm(ks[2], (DEPTH, D_MODEL, PROJ_WIDTH), D_MODEL ** -0.5),
        'cmp_pos_k': nrm(ks[3], (DEPTH, CMP_LEN, HEAD_DIM), 0.1),
        'cmp_w1_k': nrm(ks[4], (DEPTH, CMP_LEN * HEAD_DIM, CMP_HIDDEN), (CMP_LEN * HEAD_DIM) ** -0.5),
        'cmp_w2_k': nrm(ks[5], (DEPTH, CMP_HIDDEN, HEAD_DIM), CMP_HIDDEN ** -0.5),
        'cmp_pos_v': nrm(ks[6], (DEPTH, CMP_LEN, HEAD_DIM), 0.1),
        'cmp_w1_v': nrm(ks[7], (DEPTH, CMP_LEN * HEAD_DIM, CMP_HIDDEN), (CMP_LEN * HEAD_DIM) ** -0.5),
        'cmp_w2_v': nrm(ks[8], (DEPTH, CMP_HIDDEN, HEAD_DIM), CMP_HIDDEN ** -0.5),
        'sinks': nrm(ks[9], (DEPTH, SWA_HEADS), 0.5),
        'w_out': nrm(ks[10], (DEPTH, MIX_WIDTH, D_MODEL), MIX_WIDTH ** -0.5),
        'ffn_norm': 1.0 + nrm(ks[11], (DEPTH, D_MODEL), 0.02),
        'peer_wq': nrm(ks[12], (DEPTH, D_MODEL, PEER_HEADS * PEER_QDIM), D_MODEL ** -0.5),
        'peer_subkeys': nrm(ks[13], (DEPTH, 2, PEER_NKEYS, PEER_QDIM // 2), (PEER_QDIM // 2) ** -0.5),
        'peer_u': nrm(ks[14], (DEPTH, PEER_EXPERTS, D_MODEL), D_MODEL ** -0.5),
        'peer_v': nrm(ks[15], (DEPTH, PEER_EXPERTS, D_MODEL), (PEER_HEADS * PEER_TOPK) ** -0.5),
        'rel_bias': nrm(ks[16], (REL_BUCKETS, NSA_HEADS + SWA_HEADS), 0.5),
        'final_norm': 1.0 + nrm(ks[17], (D_MODEL,), 0.02),
    }


def reference(x, attn_norm, w_in, cmp_pos_k, cmp_w1_k, cmp_w2_k, cmp_pos_v, cmp_w1_v, cmp_w2_v,
              sinks, w_out, ffn_norm, peer_wq, peer_subkeys, peer_u, peer_v, rel_bias, final_norm):
    h = x
    for l in range(DEPTH):
        h = h + hybrid_mixer(rmsnorm(h, attn_norm[l]), w_in[l],
                             cmp_pos_k[l], cmp_w1_k[l], cmp_w2_k[l],
                             cmp_pos_v[l], cmp_w1_v[l], cmp_w2_v[l],
                             sinks[l], rel_bias, w_out[l])
        h = h + peer(rmsnorm(h, ffn_norm[l]), peer_wq[l], peer_subkeys[l], peer_u[l], peer_v[l])
    return rmsnorm(h, final_norm)
```

```cpp
#include <hip/hip_runtime.h>
#include <cstdio>
#include <cstdint>
__device__ __forceinline__ int opaque_tid() { int t = threadIdx.x; asm volatile("" : "+v"(t)); return t; }
namespace pg8 {
#define PG8_LAS __attribute__((address_space(3)))
typedef unsigned short bf16_t;
typedef short bf16x8 __attribute__((ext_vector_type(8)));
typedef float f32x4 __attribute__((ext_vector_type(4)));
typedef unsigned u32x4 __attribute__((ext_vector_type(4)));
constexpr int BM = 256, BK = 64, HALF = 128, HTB = HALF * BK * 2  , STAGE_BYTES = 8 * HTB, NXCD = 8, WGM = 8;

__host__ __device__ __forceinline__ int lds_byte(int r, int c) { const int st = (r >> 4) * 2 + (c >> 5), rr = r & 15, cc = c & 31, ob = rr * 64 + cc * 2; return st * 1024 + (ob ^ (((ob >> 9) & 1) << 5)); }
__host__ __device__ __forceinline__ void stage_rc(int b, int& R, int& C) { const int st = b / 1024, sb = b % 1024, swz = sb ^ (((sb >> 9) & 1) << 5); R = (st >> 1) * 16 + swz / 64; C = (st & 1) * 32 + (swz % 64) / 2; }
__host__ __device__ __forceinline__ int perm32(int rho) { const int n = rho >> 4, i = rho & 15; return 8 * (i >> 2) + 4 * n + (i & 3); }

struct Unit { int pm, pn; };
struct Gemm { const bf16_t* A; const bf16_t* Bt; int M, N, K; };

struct StaticOrder {
    int nM, nN, nwg, G, c;
    __host__ __device__ void init(int M, int N, int G_, int c_) { nM = M / BM; nN = N / BM; nwg = nM * nN; G = G_; c = c_; }
    __host__ __device__ bool next(int i, Unit& u) const {
        const long L = (long)i * G + c; if (L >= nwg) return false;
        int wgid = (int)L; { const int q = nwg / NXCD, r = nwg % NXCD, xcd = wgid % NXCD, off = wgid / NXCD; wgid = (xcd < r ? xcd * (q + 1) : r * (q + 1) + (xcd - r) * q) + off; }
        const int nig = WGM * nN, gid = wgid / nig, fm = gid * WGM, gsz = (nM - fm) < WGM ? (nM - fm) : WGM;
        u.pm = fm + ((wgid % nig) % gsz); u.pn = (wgid % nig) / gsz; return true;
    }
    __device__ __forceinline__ void a_ready(const Unit&) const {}
    __device__ __forceinline__ void done(const Unit&) const {}
};

__device__ __forceinline__ unsigned cvt_pk_bf16(float lo, float hi) { unsigned r; asm volatile("v_cvt_pk_bf16_f32 %0, %1, %2" : "=v"(r) : "v"(lo), "v"(hi)); return r; }
typedef float f32x2 __attribute__((ext_vector_type(2)));
__device__ __forceinline__ f32x2 gelu_pk(f32x2 v) {
    const f32x2 av = __builtin_elementwise_abs(v), d = av * 0.2316418882f + 1.0f;
    f32x2 t; t.x = __builtin_amdgcn_rcpf(d.x); t.y = __builtin_amdgcn_rcpf(d.y);
    f32x2 q = t * 0.5307027145f + (-0.7265760135f); q = q * t + 0.7107068705f; q = q * t + (-0.142248368f); q = q * t + 0.127414796f; q = q * t;
    const f32x2 s = (v * v) * (-0.72134752044f);
    f32x2 e; e.x = __builtin_amdgcn_exp2f(s.x); e.y = __builtin_amdgcn_exp2f(s.y);
    const f32x2 m = v * (q * e), r = v - m;
    f32x2 o; o.x = v.x < 0.f ? m.x : r.x; o.y = v.y < 0.f ? m.y : r.y; return o;
}

template <int ACT  > struct EpiBf16 {
    static constexpr bool PERM = true, AFTER_DRAIN = false; static_assert(ACT == 0 || ACT == 1, "EpiBf16: ACT is 0 (none) or 1 (gelu_pk)");
    bf16_t* O; int ldc; const float* bias; int split_cols; size_t split_stride; float scale0;
    __device__ __forceinline__ void operator()(const f32x4 (&acc)[2][2][4][2], const Unit& u, int wr, int wc, int fr, int fq) const {
        const int row0 = u.pm * BM + wr * 64 + fr; int colt = u.pn * BM; bf16_t* base = O;
        float sc = 1.f; if (split_cols) { const int t = colt / split_cols; base += (size_t)t * split_stride; colt -= t * split_cols; if (t == 0) sc = scale0; }
        const int col0 = colt + wc * 32 + 8 * fq, bcol0 = u.pn * BM + wc * 32 + 8 * fq;
        f32x4 bv[2][2];
#pragma unroll
        for (int bj = 0; bj < 2; ++bj)
#pragma unroll
            for (int n = 0; n < 2; ++n) bv[bj][n] = bias ? *(const f32x4*)(bias + bcol0 + bj * HALF + 4 * n) : (f32x4){0.f, 0.f, 0.f, 0.f};
#pragma unroll
        for (int ai = 0; ai < 2; ++ai)
#pragma unroll
            for (int m = 0; m < 4; ++m) { bf16_t* rowp = base + (size_t)(row0 + ai * HALF + m * 16) * ldc + col0;
#pragma unroll
                for (int bj = 0; bj < 2; ++bj) { f32x4 v0 = acc[ai][bj][m][0] + bv[bj][0], v1 = acc[ai][bj][m][1] + bv[bj][1];
                    if (ACT == 1) { f32x2 a = gelu_pk((f32x2){v0[0], v0[1]}), b = gelu_pk((f32x2){v0[2], v0[3]}), c = gelu_pk((f32x2){v1[0], v1[1]}), d = gelu_pk((f32x2){v1[2], v1[3]});
                        v0 = (f32x4){a.x, a.y, b.x, b.y}; v1 = (f32x4){c.x, c.y, d.x, d.y}; }
                    v0 = v0 * sc; v1 = v1 * sc; u32x4 w; w.x = cvt_pk_bf16(v0[0], v0[1]); w.y = cvt_pk_bf16(v0[2], v0[3]); w.z = cvt_pk_bf16(v1[0], v1[1]); w.w = cvt_pk_bf16(v1[2], v1[3]);
                    *(u32x4*)(rowp + bj * HALF) = w; } }
    }
};
template <class Epi, class Sched, bool ALIGN_EPI = false, bool SP2 = false>
__device__ __forceinline__ void gemm_phase(PG8_LAS unsigned char* lds, const Gemm g, const Sched& S, const Epi& E) {
    const int tid = opaque_tid(), wid = __builtin_amdgcn_readfirstlane(tid >> 6), lane = tid & 63, wr = wid >> 2, wc = wid & 3, fr = lane & 15, fq = lane >> 4;
    const int K = g.K, nt = K / BK;
    unsigned voffA[2], voffB[2];
#pragma unroll
    for (int i = 0; i < 2; ++i) { int R, C; stage_rc(tid * 16 + i * 8192, R, C); const int Rb = Epi::PERM ? ((R & ~31) + perm32(R & 31)) : R;
        voffA[i] = (unsigned)(R * K + C) * 2u; voffB[i] = (unsigned)(Rb * K + C) * 2u; }
    const size_t kstep = (size_t)(BK * 2);
    const size_t hstep = (size_t)HALF * K * 2;
    const size_t tstep = 2 * hstep;
    const unsigned ldsw = (unsigned)wid * 1024u;
    const int aoff = lds_byte(wr * 64 + fr, fq * 8), boff = lds_byte(wc * 32 + fr, fq * 8);
#define PG8_SA(b, h) (((b) * 2 + (h)) * HTB)
#define PG8_SB(b, h) ((4 + (b) * 2 + (h)) * HTB)
#define PG8_STAGE(bufoff, gbase, voff) do { _Pragma("unroll") for (int _i = 0; _i < 2; ++_i) \
        __builtin_amdgcn_global_load_lds((const unsigned*)((const char*)(gbase) + (voff)[_i]), (PG8_LAS unsigned*)(lds + (bufoff) + ldsw + _i * 8192), 16, 0, 0); } while (0)
#define PG8_LDA(dst, b, h) do { _Pragma("unroll") for (int m = 0; m < 4; ++m) _Pragma("unroll") for (int k = 0; k < 2; ++k) dst[m][k] = *(const PG8_LAS bf16x8*)(lds + PG8_SA(b, h) + aoff + m * 2048 + k * 1024); } while (0)
#define PG8_LDB(dst, b, h) do { _Pragma("unroll") for (int n = 0; n < 2; ++n) _Pragma("unroll") for (int k = 0; k < 2; ++k) dst[n][k] = *(const PG8_LAS bf16x8*)(lds + PG8_SB(b, h) + boff + n * 2048 + k * 1024); } while (0)
#define PG8_MMA(ai, bj, At, Bt) do { __builtin_amdgcn_s_setprio(1); _Pragma("unroll") for (int m = 0; m < 4; ++m) _Pragma("unroll") for (int n = 0; n < 2; ++n) _Pragma("unroll") for (int k = 0; k < 2; ++k) \
        acc[ai][bj][m][n] = __builtin_amdgcn_mfma_f32_16x16x32_bf16(Bt[n][k], At[m][k], acc[ai][bj][m][n], 0, 0, 0); __builtin_amdgcn_s_setprio(0); } while (0)
#define PG8_WAIT_V(n) asm volatile("s_waitcnt vmcnt(" #n ")" ::: "memory")
#define PG8_WAIT_L(n) asm volatile("s_waitcnt lgkmcnt(" #n ")" ::: "memory")
#define PG8_BAR __builtin_amdgcn_s_barrier()
#define PG8_SCHED __builtin_amdgcn_sched_barrier(0)
    Unit cur, nxt; int ui = 0;
    if (!S.next(0, cur)) return;
    f32x4 acc[2][2][4][2];
#pragma unroll
    for (int a = 0; a < 2; ++a)
#pragma unroll
        for (int b = 0; b < 2; ++b)
#pragma unroll
            for (int m = 0; m < 4; ++m)
#pragma unroll
                for (int n = 0; n < 2; ++n) acc[a][b][m][n] = (f32x4){0.f, 0.f, 0.f, 0.f};
    bf16x8 At[4][2], B0[2][2], B1[2][2];
    const char* cA = (const char*)g.A + (size_t)cur.pm * tstep; const char* cB = (const char*)g.Bt + (size_t)cur.pn * tstep;
    S.a_ready(cur);
    if constexpr (SP2) {
        PG8_STAGE(PG8_SB(0, 0), cB, voffB); PG8_STAGE(PG8_SB(0, 1), cB + hstep, voffB); PG8_STAGE(PG8_SA(0, 0), cA, voffA); PG8_STAGE(PG8_SA(0, 1), cA + hstep, voffA);
        if (wr == 1) PG8_BAR;
        PG8_WAIT_V(2); PG8_BAR;
        PG8_STAGE(PG8_SB(1, 0), cB + kstep, voffB); PG8_STAGE(PG8_SA(1, 0), cA + kstep, voffA); PG8_STAGE(PG8_SB(1, 1), cB + hstep + kstep, voffB);
        PG8_WAIT_V(6); PG8_BAR;
    } else {
        PG8_STAGE(PG8_SB(0, 0), cB, voffB); PG8_STAGE(PG8_SA(0, 0), cA, voffA); PG8_STAGE(PG8_SB(0, 1), cB + hstep, voffB); PG8_STAGE(PG8_SA(0, 1), cA + hstep, voffA);
        if (wr == 1) PG8_BAR;
        PG8_WAIT_V(4); PG8_BAR;
        PG8_STAGE(PG8_SB(1, 0), cB + kstep, voffB); PG8_STAGE(PG8_SA(1, 0), cA + kstep, voffA); PG8_STAGE(PG8_SB(1, 1), cB + hstep + kstep, voffB);
        PG8_WAIT_V(6); PG8_BAR;
    }
    for (;;) {
        const bool has_next = S.next(ui + 1, nxt);
        const char* nA = has_next ? (const char*)g.A + (size_t)nxt.pm * tstep : cA; const char* nB = has_next ? (const char*)g.Bt + (size_t)nxt.pn * tstep : cB;
        for (int t = 0; t < nt; t += 2) {
            const bool last = (t == nt - 2);
            const char* a1 = cA + (size_t)(t + 1) * kstep;
            const char* a2 = last ? nA : cA + (size_t)(t + 2) * kstep; const char* b2 = last ? nB : cB + (size_t)(t + 2) * kstep;
            const char* a3 = a2 + kstep; const char* b3 = b2 + kstep;
            if (last && has_next) S.a_ready(nxt);
            if constexpr (SP2) {
            PG8_LDB(B0, 0, 0); PG8_LDB(B1, 0, 1); PG8_SCHED; PG8_LDA(At, 0, 0); PG8_STAGE(PG8_SA(1, 1), a1 + hstep, voffA);
            PG8_WAIT_V(8); PG8_WAIT_L(0); PG8_BAR; PG8_MMA(0, 0, At, B0); PG8_MMA(0, 1, At, B1); PG8_BAR; PG8_SCHED;
            PG8_LDA(At, 0, 1); PG8_STAGE(PG8_SB(0, 0), b2, voffB); PG8_STAGE(PG8_SB(0, 1), b2 + hstep, voffB); PG8_STAGE(PG8_SA(0, 0), a2, voffA);
            PG8_WAIT_V(8); PG8_WAIT_L(0); PG8_BAR; PG8_MMA(1, 0, At, B0); PG8_MMA(1, 1, At, B1); PG8_BAR; PG8_SCHED;
            PG8_LDB(B0, 1, 0); PG8_LDB(B1, 1, 1); PG8_SCHED; PG8_LDA(At, 1, 0); PG8_STAGE(PG8_SA(0, 1), a2 + hstep, voffA);
            PG8_WAIT_V(8); PG8_WAIT_L(0); PG8_BAR; PG8_MMA(0, 0, At, B0); PG8_MMA(0, 1, At, B1); PG8_BAR; PG8_SCHED;
            PG8_LDA(At, 1, 1); PG8_STAGE(PG8_SB(1, 0), b3, voffB); PG8_STAGE(PG8_SB(1, 1), b3 + hstep, voffB); PG8_STAGE(PG8_SA(1, 0), a3, voffA);
            PG8_WAIT_V(8); PG8_WAIT_L(0); PG8_BAR; PG8_MMA(1, 0, At, B0); PG8_MMA(1, 1, At, B1); PG8_BAR; PG8_SCHED;
            } else {
            PG8_LDB(B0, 0, 0); PG8_SCHED; PG8_LDA(At, 0, 0); PG8_STAGE(PG8_SA(1, 1), a1 + hstep, voffA);
            PG8_WAIT_L(8); PG8_BAR; PG8_WAIT_L(0); PG8_MMA(0, 0, At, B0); PG8_BAR; PG8_SCHED;
            PG8_LDB(B1, 0, 1); PG8_STAGE(PG8_SB(0, 0), b2, voffB);
            PG8_BAR; PG8_WAIT_L(0); PG8_MMA(0, 1, At, B1); PG8_BAR;
            PG8_LDA(At, 0, 1); PG8_STAGE(PG8_SA(0, 0), a2, voffA);
            PG8_BAR; PG8_WAIT_L(0); PG8_MMA(1, 0, At, B0); PG8_BAR; PG8_SCHED;
            PG8_STAGE(PG8_SB(0, 1), b2 + hstep, voffB);
            PG8_WAIT_V(6); PG8_BAR; PG8_MMA(1, 1, At, B1); PG8_BAR;
            PG8_LDB(B0, 1, 0); PG8_SCHED; PG8_LDA(At, 1, 0); PG8_STAGE(PG8_SA(0, 1), a2 + hstep, voffA);
            PG8_WAIT_L(8); PG8_BAR; PG8_WAIT_L(0); PG8_MMA(0, 0, At, B0); PG8_BAR; PG8_SCHED;
            PG8_LDB(B1, 1, 1); PG8_STAGE(PG8_SB(1, 0), b3, voffB);
            PG8_BAR; PG8_WAIT_L(0); PG8_MMA(0, 1, At, B1); PG8_BAR;
            PG8_LDA(At, 1, 1); PG8_STAGE(PG8_SA(1, 0), a3, voffA);
            PG8_BAR; PG8_WAIT_L(0); PG8_MMA(1, 0, At, B0); PG8_BAR; PG8_SCHED;
            PG8_STAGE(PG8_SB(1, 1), b3 + hstep, voffB);
            PG8_WAIT_V(6); PG8_BAR; PG8_MMA(1, 1, At, B1); PG8_BAR;
            }
        }
        if constexpr (ALIGN_EPI) { if (wr == 0) PG8_BAR; }
        if constexpr (!Epi::AFTER_DRAIN) { E(acc, cur, wr, wc, fr, fq); S.done(cur); }
        if (!has_next) break;
#pragma unroll
        for (int a = 0; a < 2; ++a)
#pragma unroll
            for (int b = 0; b < 2; ++b)
#pragma unroll
                for (int m = 0; m < 4; ++m)
#pragma unroll
                    for (int n = 0; n < 2; ++n) acc[a][b][m][n] = (f32x4){0.f, 0.f, 0.f, 0.f};
        cur = nxt; cA = nA; cB = nB; ++ui;
        if constexpr (ALIGN_EPI) { if (wr == 1) PG8_BAR; }
    }
    PG8_WAIT_V(0);
    if constexpr (!ALIGN_EPI) { if (wr == 0) PG8_BAR; }
    PG8_BAR;
    if constexpr (Epi::AFTER_DRAIN) { E.fused(acc, cur, wr, wc, fr, fq, lds, wid, lane); S.done(cur); }
#undef PG8_SA
#undef PG8_SB
#undef PG8_STAGE
#undef PG8_LDA
#undef PG8_LDB
#undef PG8_MMA
#undef PG8_WAIT_V
#undef PG8_WAIT_L
#undef PG8_BAR
#undef PG8_SCHED
}
}

#include <hip/hip_cooperative_groups.h>
namespace cg = cooperative_groups;

#define DI __device__ __forceinline__
#define LAS __attribute__((address_space(3)))
typedef unsigned short bf16_t;
typedef short bf16x8 __attribute__((ext_vector_type(8)));
typedef float f32x4 __attribute__((ext_vector_type(4)));
typedef float f32x2 __attribute__((ext_vector_type(2)));
typedef float f32x16 __attribute__((ext_vector_type(16)));
typedef unsigned u32x4 __attribute__((ext_vector_type(4)));
typedef unsigned u32x2 __attribute__((ext_vector_type(2)));
typedef __bf16 bf16v2 __attribute__((ext_vector_type(2)));

#define MFMA32(a, b, c) __builtin_amdgcn_mfma_f32_32x32x16_bf16((a), (b), (c), 0, 0, 0)
#define MFMA16(a, b, c) __builtin_amdgcn_mfma_f32_16x16x32_bf16((a), (b), (c), 0, 0, 0)
#define LDS_WAIT() asm volatile("s_waitcnt lgkmcnt(0)" ::: "memory")

constexpr int NB = 2, S = 16384, D = 2048, M = NB * S, NLAYER = 2;
constexpr int NPROJ = 3120, NP = 3328;
constexpr int C_QA = 0, C_QB = 1024, C_KC = 2048, C_VC = 2176, C_KS = 2304, C_VS = 2432, C_KW = 2560, C_VW = 2688, C_KB = 2816, C_VB = 2944, C_GATE = 3072;
constexpr int NCP = 1024;
constexpr int NEXP = 16384;
constexpr float NEGF = -1e30f;

constexpr size_t MiB = 1u << 20;
constexpr size_t WS_WIN = 0;
constexpr size_t WS_WOUT = 28 * MiB;
constexpr size_t WS_WQ = 46 * MiB;
constexpr size_t WS_CW1 = 64 * MiB;
constexpr size_t WS_SUBK = 67 * MiB;
constexpr size_t WS_KC = 68 * MiB;
constexpr size_t WS_VCT = 69 * MiB;
constexpr size_t WS_VST = 70 * MiB;
constexpr size_t WS_VWT = 78 * MiB;
constexpr size_t WS_VBT = 86 * MiB;
constexpr size_t WS_IDX = 96 * MiB;
constexpr size_t WS_GATE = 112 * MiB;
constexpr size_t WS_GSUM = 94 * MiB;
constexpr size_t WS_U = 128 * MiB;
constexpr size_t WS_V = 256 * MiB;
constexpr size_t WS_KSF = 192 * MiB, WS_KWF = 200 * MiB, WS_KBF = 208 * MiB;
constexpr size_t WS_KMAX = 95 * MiB + 65536;
constexpr size_t WS_XN = 384 * MiB;
constexpr size_t WS_O = 512 * MiB;
constexpr size_t WS_Q2 = 640 * MiB;
constexpr size_t WS_P = 768 * MiB;
constexpr size_t WS_END = 1000 * MiB;

constexpr int LDS_BYTES = 139264;
constexpr int NTHREADS = 512;

struct Args {
    const float* x; const float* attn_norm; const float* w_in; const float* cmp_pos_k; const float* cmp_w1_k; const float* cmp_w2_k;
    const float* cmp_pos_v; const float* cmp_w1_v; const float* cmp_w2_v; const float* sinks; const float* w_out; const float* ffn_norm;
    const float* peer_wq; const float* peer_subkeys; const float* peer_u; const float* peer_v; const float* rel_bias; const float* final_norm;
    float* out; unsigned char* ws; int ph_lo, ph_hi;
};

DI unsigned f2bf(float f) { unsigned u = __builtin_bit_cast(unsigned, f); return (u + 0x7fffu + ((u >> 16) & 1u)) >> 16; }
DI unsigned pk2(float lo, float hi) { const f32x2 v = {lo, hi}; return __builtin_bit_cast(unsigned, __builtin_convertvector(v, bf16v2)); }
DI float bflo(unsigned w) { return __builtin_bit_cast(float, w << 16); }
DI float bfhi(unsigned w) { return __builtin_bit_cast(float, w & 0xffff0000u); }
DI float bf2f(bf16_t v) { return __builtin_bit_cast(float, (unsigned)v << 16); }
DI float wave_sum(float v) {
#pragma unroll
    for (int o = 1; o < 64; o <<= 1) v += __shfl_xor(v, o);
    return v;
}
DI float gelu_tanh(float x) {
    const float y = 0.7978845608028654f * (x + 0.044715f * x * x * x);
    const float t = __expf(2.f * y);
    const float th = 1.f - 2.f / (t + 1.f);
    return 0.5f * x * (1.f + th);
}
DI float sigmoidf_(float x) { return 1.f / (1.f + __expf(-x)); }
DI int crow(int r, int hi) { return (r & 3) + 8 * (r >> 2) + 4 * hi; }
DI int rel_bucket(int d) {
    const float lf = __log2f((float)(d < 1 ? 1 : d));
    int b = 16 + (int)((lf - 4.0f) * (16.0f / 7.0f));
    b = b > 31 ? 31 : b;
    return d < 16 ? d : b;
}
DI bf16x8 pack8(float a0, float a1, float a2, float a3, float a4, float a5, float a6, float a7) {
    u32x4 p; p.x = pk2(a0, a1); p.y = pk2(a2, a3); p.z = pk2(a4, a5); p.w = pk2(a6, a7);
    return __builtin_bit_cast(bf16x8, p);
}

DI int win_srccol(int n) {
    if (n < 1024) return n;
    if (n < 2048) return 1840 + (n - 1024);
    if (n < 2816) return 1024 + (n - 2048);
    if (n < 3072) return 2864 + (n - 2816);
    if (n < 3120) return 1792 + (n - 3072);
    return -1;
}
template <bool WIN>
DI void transpose_item(const float* W, int K, int Nsrc, bf16_t* WT, int k0, int n0, LAS float* scr, int lane) {
    const int nd = n0 + (lane & 31);
    const int ns = WIN ? win_srccol(nd) : nd;
#pragma unroll 8
    for (int i = 0; i < 32; ++i) { const int kk = 2 * i + (lane >> 5); scr[kk * 33 + (lane & 31)] = ns >= 0 ? W[(size_t)(k0 + kk) * Nsrc + ns] : 0.f; }
    LDS_WAIT();
    const int c = lane & 7;
#pragma unroll
    for (int j = 0; j < 4; ++j) { const int n = (lane >> 3) + 8 * j; const LAS float* s = scr + (8 * c) * 33 + n;
        u32x4 o; o.x = pk2(s[0 * 33], s[1 * 33]); o.y = pk2(s[2 * 33], s[3 * 33]); o.z = pk2(s[4 * 33], s[5 * 33]); o.w = pk2(s[6 * 33], s[7 * 33]);
        *(u32x4*)(WT + (size_t)(n0 + n) * K + k0 + 8 * c) = o; }
    LDS_WAIT();
}
template <bool WIN>
DI void transpose_matrix(const float* W, int K, int Nsrc, int Ndst, bf16_t* WT, LAS float* scr, int lane, int gw, int NGW) {
    const int nblk = Ndst / 32, nitems = (K / 64) * nblk;
    for (int it = gw; it < nitems; it += NGW) transpose_item<WIN>(W, K, Nsrc, WT, 64 * (it / nblk), 32 * (it % nblk), scr, lane);
}
DI void convert_rows(const float* src, bf16_t* dst, size_t n8, size_t gt, size_t ngt) {
    for (size_t i = gt; i < n8; i += ngt) {
        const f32x4 a = ((const f32x4*)src)[2 * i], b = ((const f32x4*)src)[2 * i + 1];
        u32x4 o; o.x = pk2(a.x, a.y); o.y = pk2(a.z, a.w); o.z = pk2(b.x, b.y); o.w = pk2(b.z, b.w);
        ((u32x4*)dst)[i] = o;
    }
}
constexpr float U_SCALE = 512.f, V_SCALE = 64.f;
DI void convert_rows_fp8(const float* src, unsigned char* dst, size_t n16, float scale, size_t gt, size_t ngt) {
    for (size_t i = gt; i < n16; i += ngt) {
        const f32x4 a = ((const f32x4*)src)[4 * i] * scale, b = ((const f32x4*)src)[4 * i + 1] * scale, c = ((const f32x4*)src)[4 * i + 2] * scale, d = ((const f32x4*)src)[4 * i + 3] * scale;
        u32x4 o;
        o.x = (unsigned)__builtin_amdgcn_cvt_pk_fp8_f32(a.z, a.w, __builtin_amdgcn_cvt_pk_fp8_f32(a.x, a.y, 0, false), true);
        o.y = (unsigned)__builtin_amdgcn_cvt_pk_fp8_f32(b.z, b.w, __builtin_amdgcn_cvt_pk_fp8_f32(b.x, b.y, 0, false), true);
        o.z = (unsigned)__builtin_amdgcn_cvt_pk_fp8_f32(c.z, c.w, __builtin_amdgcn_cvt_pk_fp8_f32(c.x, c.y, 0, false), true);
        o.w = (unsigned)__builtin_amdgcn_cvt_pk_fp8_f32(d.z, d.w, __builtin_amdgcn_cvt_pk_fp8_f32(d.x, d.y, 0, false), true);
        ((u32x4*)dst)[i] = o;
    }
}
DI void phase_prologue(const Args& a, LAS unsigned char* lds) {
    const int tid = opaque_tid(), lane = tid & 63, wave = tid >> 6;
    if (blockIdx.x == 0 && tid < 32) ((unsigned*)(a.ws + WS_KMAX))[tid] = 0u;
    const int gw = blockIdx.x * 8 + wave, NGW = gridDim.x * 8;
    LAS float* scr = (LAS float*)(lds + wave * 8448);
    unsigned char* ws = a.ws;
    for (int l = 0; l < NLAYER; ++l) {
        transpose_matrix<true>(a.w_in + (size_t)l * D * NPROJ, D, NPROJ, NP, (bf16_t*)(ws + WS_WIN) + (size_t)l * NP * D, scr, lane, gw, NGW);
        transpose_matrix<false>(a.w_out + (size_t)l * D * D, D, D, D, (bf16_t*)(ws + WS_WOUT) + (size_t)l * D * D, scr, lane, gw, NGW);
        transpose_matrix<false>(a.peer_wq + (size_t)l * D * D, D, D, D, (bf16_t*)(ws + WS_WQ) + (size_t)l * D * D, scr, lane, gw, NGW);
        transpose_matrix<false>(a.cmp_w1_k + (size_t)l * 2048 * 128, 2048, 128, 128, (bf16_t*)(ws + WS_CW1) + (size_t)(l * 2 + 0) * 128 * 2048, scr, lane, gw, NGW);
        transpose_matrix<false>(a.cmp_w1_v + (size_t)l * 2048 * 128, 2048, 128, 128, (bf16_t*)(ws + WS_CW1) + (size_t)(l * 2 + 1) * 128 * 2048, scr, lane, gw, NGW);
    }
    const size_t gt = (size_t)blockIdx.x * NTHREADS + tid, ngt = (size_t)gridDim.x * NTHREADS;
    convert_rows_fp8(a.peer_u, ws + WS_U, (size_t)NLAYER * NEXP * D / 16, U_SCALE, gt, ngt);
    convert_rows_fp8(a.peer_v, ws + WS_V, (size_t)NLAYER * NEXP * D / 16, V_SCALE, gt, ngt);
    convert_rows(a.peer_subkeys, (bf16_t*)(ws + WS_SUBK), (size_t)NLAYER * 2 * 128 * 128 / 8, gt, ngt);
}

DI void phase_rms_bf16(const float* X, const float* g, bf16_t* XN) {
    const int tid = opaque_tid(), lane = tid & 63, wave = tid >> 6;
    const int gw = blockIdx.x * 8 + wave, NGW = gridDim.x * 8;
    f32x4 gv[8];
#pragma unroll
    for (int j = 0; j < 8; ++j) gv[j] = ((const f32x4*)g)[lane + 64 * j];
    for (int m = gw; m < M; m += NGW) {
        const f32x4* xr = (const f32x4*)(X + (size_t)m * D);
        f32x4 v[8]; float s = 0.f;
#pragma unroll
        for (int j = 0; j < 8; ++j) { v[j] = xr[lane + 64 * j]; s += (v[j].x * v[j].x + v[j].y * v[j].y) + (v[j].z * v[j].z + v[j].w * v[j].w); }
        const float rstd = rsqrtf(wave_sum(s) * (1.f / D) + 1e-6f);
        u32x2* o8 = (u32x2*)(XN + (size_t)m * D);
#pragma unroll
        for (int j = 0; j < 8; ++j) { const f32x4 y = v[j] * rstd * gv[j]; u32x2 w; w.x = pk2(y.x, y.y); w.y = pk2(y.z, y.w); o8[lane + 64 * j] = w; }
    }
}
DI void phase_rms_final(float* X, const float* g) {
    const int tid = opaque_tid(), lane = tid & 63, wave = tid >> 6;
    const int gw = blockIdx.x * 8 + wave, NGW = gridDim.x * 8;
    f32x4 gv[8];
#pragma unroll
    for (int j = 0; j < 8; ++j) gv[j] = ((const f32x4*)g)[lane + 64 * j];
    for (int m = gw; m < M; m += NGW) {
        f32x4* xr = (f32x4*)(X + (size_t)m * D);
        f32x4 v[8]; float s = 0.f;
#pragma unroll
        for (int j = 0; j < 8; ++j) { v[j] = xr[lane + 64 * j]; s += (v[j].x * v[j].x + v[j].y * v[j].y) + (v[j].z * v[j].z + v[j].w * v[j].w); }
        const float rstd = rsqrtf(wave_sum(s) * (1.f / D) + 1e-6f);
#pragma unroll
        for (int j = 0; j < 8; ++j) xr[lane + 64 * j] = v[j] * rstd * gv[j];
    }
}

struct EpiResid {
    static constexpr bool PERM = false, AFTER_DRAIN = false;
    const float* base; float* out; int ldc;
    DI void operator()(const pg8::f32x4 (&acc)[2][2][4][2], const pg8::Unit& u, int wr, int wc, int fr, int fq) const {
        const int col0 = u.pn * pg8::BM + wc * 32 + 4 * fq;
#pragma unroll
        for (int ai = 0; ai < 2; ++ai)
#pragma unroll
            for (int m = 0; m < 4; ++m) {
                const size_t off = (size_t)(u.pm * pg8::BM + ai * pg8::HALF + wr * 64 + m * 16 + fr) * ldc + col0;
#pragma unroll
                for (int bj = 0; bj < 2; ++bj)
#pragma unroll
                    for (int n = 0; n < 2; ++n) { const size_t o = off + bj * pg8::HALF + n * 16; const pg8::f32x4 bs = *(const pg8::f32x4*)(base + o); *(pg8::f32x4*)(out + o) = bs + acc[ai][bj][m][n]; }
                asm volatile("" ::: "memory");
            }
    }
};

DI void phase_prep(const Args& a, int layer, LAS unsigned char* lds) {
    const int tid = opaque_tid(), lane = tid & 63, wave = tid >> 6;
    const int gw = blockIdx.x * 8 + wave, NGW = gridDim.x * 8;
    unsigned char* ws = a.ws;
    const bf16_t* P = (const bf16_t*)(ws + WS_P);
    {
        LAS bf16_t* scr = (LAS bf16_t*)(lds + wave * 9216);
        for (int it = gw; it < 6 * 4 * 256; it += NGW) {
            const int which = it / 1024, bg = (it / 256) & 3, st = it & 255, b = bg >> 1, g = bg & 1;
            if (which >= 3) {
                const int srccol = (which == 3 ? C_KS : which == 4 ? C_KW : C_KB) + g * 64;
                bf16_t* dst = (bf16_t*)(ws + (which == 3 ? WS_KSF : which == 4 ? WS_KWF : WS_KBF)) + (size_t)bg * 64 * S + (size_t)st * 4096;
                float rmax = 0.f;
#pragma unroll
                for (int i = 0; i < 8; ++i) { const int tok = i * 8 + (lane >> 3), q = lane & 7;
                    const u32x4 v = *(const u32x4*)(P + (size_t)(b * S + st * 64 + tok) * NP + srccol + q * 8);
                    const int pos = which == 3 ? (((tok >> 4) * 2 + (q >> 2)) * 64 + (q & 3) * 16 + (tok & 15))
                                               : ((tok >> 5) * 256 + (q >> 1) * 64 + (q & 1) * 32 + (tok & 31));
                    *(u32x4*)(dst + pos * 8) = v;
                    float ss = bflo(v.x) * bflo(v.x) + bfhi(v.x) * bfhi(v.x) + bflo(v.y) * bflo(v.y) + bfhi(v.y) * bfhi(v.y)
                             + bflo(v.z) * bflo(v.z) + bfhi(v.z) * bfhi(v.z) + bflo(v.w) * bflo(v.w) + bfhi(v.w) * bfhi(v.w);
                    ss += __shfl_xor(ss, 1); ss += __shfl_xor(ss, 2); ss += __shfl_xor(ss, 4);
                    rmax = fmaxf(rmax, ss); }
                rmax = fmaxf(rmax, __shfl_xor(rmax, 8)); rmax = fmaxf(rmax, __shfl_xor(rmax, 16)); rmax = fmaxf(rmax, __shfl_xor(rmax, 32));
                if (lane == 0) atomicMax((unsigned*)(ws + WS_KMAX) + (layer * 4 + (which - 3)) * 4 + bg, __builtin_bit_cast(unsigned, rmax));
                continue;
            }
            const int srccol = (which == 0 ? C_VS : which == 1 ? C_VW : C_VB) + g * 64;
            bf16_t* dst = (bf16_t*)(ws + (which == 0 ? WS_VST : which == 1 ? WS_VWT : WS_VBT)) + (size_t)bg * 64 * S + (size_t)st * 4096;
#pragma unroll
            for (int i = 0; i < 8; ++i) { const int tok = i * 8 + (lane >> 3), ch = lane & 7;
                const u32x4 v = *(const u32x4*)(P + (size_t)(b * S + st * 64 + tok) * NP + srccol + ch * 8);
                *(LAS u32x4*)(scr + tok * 72 + ch * 8) = v; }
            LDS_WAIT();
#pragma unroll
            for (int f = 0; f < 8; ++f) {
                int d, kb0, kstep;
                if (which == 0) { const int j = f >> 2, dt = f & 3, hh = lane & 15, qd = lane >> 4; d = 16 * dt + hh; kb0 = 32 * j + 4 * qd; kstep = 16; }
                else { const int tl = f >> 2, j = (f >> 1) & 1, dt = f & 1, c = lane & 31, hi = lane >> 5; d = dt * 32 + c; kb0 = tl * 32 + 16 * j + 4 * hi; kstep = 8; }
                unsigned e[8];
#pragma unroll
                for (int i = 0; i < 8; ++i) e[i] = scr[(kb0 + (i & 3) + kstep * (i >> 2)) * 72 + d];
                u32x4 o; o.x = e[0] | (e[1] << 16); o.y = e[2] | (e[3] << 16); o.z = e[4] | (e[5] << 16); o.w = e[6] | (e[7] << 16);
                *(u32x4*)(dst + (f * 64 + lane) * 8) = o;
            }
            LDS_WAIT();
        }
    }
    {
        const bf16_t* XN = (const bf16_t*)(ws + WS_XN);
        const bf16_t* wg = (const bf16_t*)(ws + WS_WIN) + (size_t)layer * NP * D + (size_t)C_GATE * D;
        bf16_t* Pw = (bf16_t*)(ws + WS_P);
        const int c = lane & 31, hi = lane >> 5;
        for (int it = NGW - 1 - gw; it < M / 32; it += NGW) {
            const bf16_t* ar = XN + (size_t)(it * 32 + c) * D + hi * 8;
            const bf16_t* b0 = wg + (size_t)c * D + hi * 8, *b1 = wg + (size_t)(32 + c) * D + hi * 8;
            f32x16 a0, a1;
#pragma unroll
            for (int r = 0; r < 16; ++r) { a0[r] = 0.f; a1[r] = 0.f; }
#pragma unroll 8
            for (int kk = 0; kk < 128; ++kk) {
                const bf16x8 af = *(const bf16x8*)(ar + kk * 16);
                a0 = MFMA32(af, *(const bf16x8*)(b0 + kk * 16), a0);
                a1 = MFMA32(af, *(const bf16x8*)(b1 + kk * 16), a1);
            }
#pragma unroll
            for (int r = 0; r < 16; ++r) {
                bf16_t* pr = Pw + (size_t)(it * 32 + crow(r, hi)) * NP + C_GATE;
                pr[c] = (bf16_t)f2bf(a0[r]);
                if (c < 16) pr[32 + c] = (bf16_t)f2bf(a1[r]);
            }
        }
    }
    __syncthreads();
    {
        LAS float* H = (LAS float*)lds;
        const int c = lane & 31, hi = lane >> 5, rg = wave >> 2, nt = wave & 3;
        for (int it = blockIdx.x; it < 128; it += gridDim.x) {
            const int kv = it >> 6, bg = (it >> 4) & 3, rt = it & 15, b = bg >> 1, g = bg & 1;
            const float* pos = (kv ? a.cmp_pos_v : a.cmp_pos_k) + (size_t)layer * 32 * 64;
            const bf16_t* w1t = (const bf16_t*)(ws + WS_CW1) + (size_t)(layer * 2 + kv) * 128 * 2048;
            const float* w2 = (kv ? a.cmp_w2_v : a.cmp_w2_k) + (size_t)layer * 128 * 64;
            int irow = rt * 64 + rg * 32 + c; irow = irow > 1022 ? 1022 : irow;
            const bf16_t* src = P + (size_t)(b * S + 16 * irow) * NP + (kv ? C_VC : C_KC) + g * 64;
            const bf16_t* bsrc = w1t + (size_t)(nt * 32 + c) * 2048 + hi * 8;
            f32x16 acc;
#pragma unroll
            for (int r = 0; r < 16; ++r) acc[r] = 0.f;
#pragma unroll 4
            for (int kk = 0; kk < 128; ++kk) {
                const int tok = kk >> 2, d = (kk & 3) * 16 + hi * 8;
                const u32x4 sv = *(const u32x4*)(src + (size_t)tok * NP + d);
                const f32x4 p0 = *(const f32x4*)(pos + tok * 64 + d), p1 = *(const f32x4*)(pos + tok * 64 + d + 4);
                const bf16x8 af = pack8(bflo(sv.x) + p0.x, bfhi(sv.x) + p0.y, bflo(sv.y) + p0.z, bfhi(sv.y) + p0.w,
                                        bflo(sv.z) + p1.x, bfhi(sv.z) + p1.y, bflo(sv.w) + p1.z, bfhi(sv.w) + p1.w);
                const bf16x8 bf = *(const bf16x8*)(bsrc + kk * 16);
                acc = MFMA32(af, bf, acc);
            }
#pragma unroll
            for (int r = 0; r < 16; ++r) H[(rg * 32 + crow(r, hi)) * 129 + nt * 32 + c] = gelu_tanh(acc[r]);
            __syncthreads();
            {
                const int i = tid >> 3, dc = (tid & 7) * 8;
                float o[8];
#pragma unroll
                for (int e = 0; e < 8; ++e) o[e] = 0.f;
                for (int n = 0; n < 128; ++n) {
                    const float hv = H[i * 129 + n];
                    const f32x4 wa = *(const f32x4*)(w2 + n * 64 + dc), wb = *(const f32x4*)(w2 + n * 64 + dc + 4);
                    o[0] += hv * wa.x; o[1] += hv * wa.y; o[2] += hv * wa.z; o[3] += hv * wa.w;
                    o[4] += hv * wb.x; o[5] += hv * wb.y; o[6] += hv * wb.z; o[7] += hv * wb.w;
                }
                const int ig = rt * 64 + i;
                if (ig > 1022) {
#pragma unroll
                    for (int e = 0; e < 8; ++e) o[e] = 0.f;
                }
                if (kv == 0) {
                    u32x4 w; w.x = pk2(o[0], o[1]); w.y = pk2(o[2], o[3]); w.z = pk2(o[4], o[5]); w.w = pk2(o[6], o[7]);
                    float ss = bflo(w.x) * bflo(w.x) + bfhi(w.x) * bfhi(w.x) + bflo(w.y) * bflo(w.y) + bfhi(w.y) * bfhi(w.y)
                             + bflo(w.z) * bflo(w.z) + bfhi(w.z) * bfhi(w.z) + bflo(w.w) * bflo(w.w) + bfhi(w.w) * bfhi(w.w);
                    ss += __shfl_xor(ss, 1); ss += __shfl_xor(ss, 2); ss += __shfl_xor(ss, 4);
                    ss = fmaxf(ss, __shfl_xor(ss, 8)); ss = fmaxf(ss, __shfl_xor(ss, 16)); ss = fmaxf(ss, __shfl_xor(ss, 32));
                    if (lane == 0) atomicMax((unsigned*)(ws + WS_KMAX) + (layer * 4 + 3) * 4 + bg, __builtin_bit_cast(unsigned, ss));
                    const int q = dc >> 3;
                    *(u32x4*)((bf16_t*)(ws + WS_KC) + (size_t)bg * NCP * 64 + (size_t)(ig >> 5) * 2048 + ((q >> 1) * 64 + (q & 1) * 32 + (ig & 31)) * 8) = w;
                } else {
                    const int kk5 = ig & 31, jj = kk5 >> 4, rem = kk5 & 15, hh1 = (rem >> 2) & 1, ii = (rem >> 3) * 4 + (rem & 3);
                    bf16_t* vt = (bf16_t*)(ws + WS_VCT) + (size_t)bg * 64 * NCP + (size_t)(ig >> 5) * 2048 + ii;
#pragma unroll
                    for (int e = 0; e < 8; ++e) { const int dd = dc + e; vt[((jj * 2 + (dd >> 5)) * 64 + hh1 * 32 + (dd & 31)) * 8] = (bf16_t)f2bf(o[e]); }
                }
            }
            __syncthreads();
        }
    }
}

constexpr float LOG2E = 1.4426950408889634f, SC2 = 0.125f * 1.4426950408889634f;
DI float ex2(float x) { return __builtin_amdgcn_exp2f(x); }
DI void loadK32(const bf16_t* kt, int lane, bf16x8 (&k)[4]) {
#pragma unroll
    for (int kk = 0; kk < 4; ++kk) k[kk] = *(const bf16x8*)(kt + (kk * 64 + lane) * 8);
}
DI f32x16 qk32r(const bf16x8 (&k)[4], const bf16x8 (&q)[4]) {
    f32x16 s;
#pragma unroll
    for (int r = 0; r < 16; ++r) s[r] = 0.f;
#pragma unroll
    for (int kk = 0; kk < 4; ++kk) s = MFMA32(k[kk], q[kk], s);
    return s;
}
DI void loadV32(const bf16_t* vt, int lane, bf16x8 (&v)[2][2]) {
#pragma unroll
    for (int j = 0; j < 2; ++j)
#pragma unroll
        for (int dt = 0; dt < 2; ++dt) v[j][dt] = *(const bf16x8*)(vt + ((j * 2 + dt) * 64 + lane) * 8);
}
DI void pv32r(const f32x16& p, const bf16x8 (&v)[2][2], f32x16& o0, f32x16& o1) {
#pragma unroll
    for (int j = 0; j < 2; ++j) {
        const bf16x8 pb = pack8(p[8 * j], p[8 * j + 1], p[8 * j + 2], p[8 * j + 3], p[8 * j + 4], p[8 * j + 5], p[8 * j + 6], p[8 * j + 7]);
        o0 = MFMA32(v[j][0], pb, o0);
        o1 = MFMA32(v[j][1], pb, o1);
    }
}
template <bool MASKED>
DI bool softmax32(f32x16& s, unsigned vm, float& m, float& l, float& alpha) {
    float sum = 0.f;
#pragma unroll
    for (int r = 0; r < 16; ++r) { float p = ex2(s[r] - m); if (MASKED) p = ((vm >> r) & 1u) ? p : 0.f; s[r] = p; sum += p; }
    l += sum; alpha = 1.f;
    return false;
}
DI float sumsq8(const bf16x8 v) { const u32x4 w = __builtin_bit_cast(u32x4, v);
    return bflo(w.x) * bflo(w.x) + bfhi(w.x) * bfhi(w.x) + bflo(w.y) * bflo(w.y) + bfhi(w.y) * bfhi(w.y) + bflo(w.z) * bflo(w.z) + bfhi(w.z) * bfhi(w.z) + bflo(w.w) * bflo(w.w) + bfhi(w.w) * bfhi(w.w); }
DI unsigned logits_cmp(f32x16& s, int key0, int qpos, int hi, const LAS float* bias_h) {
    unsigned vm = 0u;
#pragma unroll
    for (int r = 0; r < 16; ++r) {
        const int dist = qpos - (16 * (key0 + crow(r, hi)) + 31);
        const bool valid = dist >= 0;
        const float bb = bias_h[rel_bucket(dist < 0 ? 0 : dist)];
        s[r] = valid ? s[r] * SC2 + bb : NEGF;
        vm |= valid ? (1u << r) : 0u;
    }
    return vm;
}

constexpr int AW_IMP = 0, AW_OLDS = 4128, AW_SEL = 4128 + 8320, AW_NSEL = AW_SEL + 256, AW_BYTES = 12800;
constexpr int ATT_BIAS_OFF = 8 * AW_BYTES;
constexpr int LUTW_STRIDE = 612, LUTB_STRIDE = 228;
constexpr int ATT_LUTW_OFF = ATT_BIAS_OFF + 4096, ATT_LUTB_OFF = ATT_LUTW_OFF + 8 * LUTW_STRIDE * 4, ATT_LDS_END = ATT_LUTB_OFF + 8 * LUTB_STRIDE * 4;
static_assert(ATT_LDS_END <= LDS_BYTES, "attention LDS map");

template <int W>
DI void window_branch(const bf16_t* Kf  , const bf16_t* Vf  , int lane,
                      const bf16x8 (&qf)[4], const LAS float* lut_h  , int q0, int qpos, int c, int hi,
                      float& m, float& l, f32x16& o0, f32x16& o1) {
    const int kd = q0 & ~31;
    int kstart = q0 - (W - 1); kstart = kstart < 0 ? 0 : kstart; kstart &= ~31;
    bf16x8 kc[4];
    loadK32(Kf + (size_t)(kd >> 5) * 2048, lane, kc);
    const float sini = -m * (1.f / SC2);
    const bf16x8 ones8 = {0x3F80, 0x3F80, 0x3F80, 0x3F80, 0x3F80, 0x3F80, 0x3F80, 0x3F80};
    f32x16 lacc;
#pragma unroll
    for (int r = 0; r < 16; ++r) lacc[r] = 0.f;
#pragma unroll 1
    for (int key0 = kd; key0 >= kstart; key0 -= 32) {
        bf16x8 vf[2][2], kn[4];
        loadV32(Vf + (size_t)(key0 >> 5) * 2048, lane, vf);
        const int nk = key0 - 32 >= kstart ? key0 - 32 : key0;
        loadK32(Kf + (size_t)(nk >> 5) * 2048, lane, kn);
        f32x16 s;
#pragma unroll
        for (int r = 0; r < 16; ++r) s[r] = sini;
#pragma unroll
        for (int kk = 0; kk < 4; ++kk) s = MFMA32(kc[kk], qf[kk], s);
        const LAS float* pt = lut_h + (qpos - key0 - 4 * hi - 27);
#pragma unroll
        for (int r = 0; r < 16; ++r) s[r] = ex2(s[r] * SC2 + pt[27 - ((r & 3) + 8 * (r >> 2))]);
#pragma unroll
        for (int j = 0; j < 2; ++j) {
            const bf16x8 pb = pack8(s[8 * j], s[8 * j + 1], s[8 * j + 2], s[8 * j + 3], s[8 * j + 4], s[8 * j + 5], s[8 * j + 6], s[8 * j + 7]);
            o0 = MFMA32(vf[j][0], pb, o0);
            o1 = MFMA32(vf[j][1], pb, o1);
            lacc = MFMA32(ones8, pb, lacc);
        }
#pragma unroll
        for (int kk = 0; kk < 4; ++kk) kc[kk] = kn[kk];
    }
    l += 0.5f * lacc[0];
}

DI void phase_attn(const Args& a, int layer, LAS unsigned char* lds) {
    const int tid = opaque_tid(), lane = tid & 63, wave = tid >> 6;
    unsigned char* ws = a.ws;
    const bf16_t* P = (const bf16_t*)(ws + WS_P);
    bf16_t* O = (bf16_t*)(ws + WS_O);
    const int bg = blockIdx.x & 3, b = bg >> 1, g = bg & 1, wq = blockIdx.x >> 2, nwq = gridDim.x >> 2;
    LAS float* bias = (LAS float*)(lds + ATT_BIAS_OFF);
    LAS float* lutW = (LAS float*)(lds + ATT_LUTW_OFF);
    LAS float* lutB = (LAS float*)(lds + ATT_LUTB_OFF);
    for (int i = tid; i < 1024; i += NTHREADS) bias[i] = a.rel_bias[(i & 31) * 32 + (i >> 5)] * LOG2E;
    for (int i = tid; i < 8 * LUTW_STRIDE; i += NTHREADS) { const int hh = i / LUTW_STRIDE, dist = i % LUTW_STRIDE - 32;
        lutW[i] = (dist >= 0 && dist < 512) ? a.rel_bias[rel_bucket(dist) * 32 + g * 8 + hh] * LOG2E : NEGF; }
    for (int i = tid; i < 8 * LUTB_STRIDE; i += NTHREADS) { const int hh = i / LUTB_STRIDE, dist = i % LUTB_STRIDE - 32;
        lutB[i] = (dist >= 0 && dist < 128) ? a.rel_bias[rel_bucket(dist) * 32 + 16 + g * 8 + hh] * LOG2E : NEGF; }
    __syncthreads();
    LAS unsigned char* wl = lds + wave * AW_BYTES;
    LAS float* imp = (LAS float*)(wl + AW_IMP);
    LAS float* olds = (LAS float*)(wl + AW_OLDS);
    LAS int* sel = (LAS int*)(wl + AW_SEL);
    LAS int* nsel = (LAS int*)(wl + AW_NSEL);
    const int c = lane & 31, hi = lane >> 5, ql = c >> 3, h = c & 7;
    const bf16_t* Pb = P + (size_t)b * S * NP;
    const bf16_t* kcb = (const bf16_t*)(ws + WS_KC) + (size_t)bg * NCP * 64;
    const bf16_t* vct = (const bf16_t*)(ws + WS_VCT) + (size_t)bg * 64 * NCP;
    const bf16_t* vst = (const bf16_t*)(ws + WS_VST) + (size_t)bg * 64 * S;
    const bf16_t* vwt = (const bf16_t*)(ws + WS_VWT) + (size_t)bg * 64 * S;
    const bf16_t* kwf = (const bf16_t*)(ws + WS_KWF) + (size_t)bg * 64 * S;
    const bf16_t* kbf = (const bf16_t*)(ws + WS_KBF) + (size_t)bg * 64 * S;
    const bf16_t* ksf = (const bf16_t*)(ws + WS_KSF) + (size_t)bg * 64 * S;
    const bf16_t* vbt = (const bf16_t*)(ws + WS_VBT) + (size_t)bg * 64 * S;
    const float sinkv = a.sinks[layer * 16 + g * 8 + h] * LOG2E;
    const LAS float* bias_a = bias + (g * 8 + h) * 32;
    const float b31 = bias_a[31];
    const unsigned* kmx = (const unsigned*)(ws + WS_KMAX) + layer * 16 + bg;
    const float knS = sqrtf(__builtin_bit_cast(float, kmx[0])) * SC2, knW = sqrtf(__builtin_bit_cast(float, kmx[4])) * SC2;
    const float knB = sqrtf(__builtin_bit_cast(float, kmx[8])) * SC2, knC = sqrtf(__builtin_bit_cast(float, kmx[12])) * SC2;
    float bmaxA = bias_a[0], bmaxB = bias[(16 + g * 8 + h) * 32];
    for (int k = 1; k < 32; ++k) { bmaxA = fmaxf(bmaxA, bias_a[k]); bmaxB = fmaxf(bmaxB, bias[(16 + g * 8 + h) * 32 + k]); }
    bmaxA += 0.01f; bmaxB += 0.01f;

#pragma unroll 1
    for (int qt0 = wq; qt0 < S / 32 && wq < nwq; qt0 += nwq) {
        const int rnd = qt0 / nwq, qt32 = ((rnd & 1) && (rnd + 1) * nwq <= S / 32) ? rnd * nwq + (nwq - 1 - wq) : qt0;
        const int q0 = qt32 * 32 + wave * 4;
        const int qpos = q0 + ql;
        const size_t mrow = (size_t)(b * S + qpos);
        const bf16_t* prow = P + mrow * NP;
        {
            bf16x8 qf[4];
#pragma unroll
            for (int kk = 0; kk < 4; ++kk) qf[kk] = *(const bf16x8*)(prow + C_QB + (g * 8 + h) * 64 + kk * 16 + hi * 8);
            float qn2 = sumsq8(qf[0]) + sumsq8(qf[1]) + sumsq8(qf[2]) + sumsq8(qf[3]); qn2 += __shfl_xor(qn2, 32);
            float m = sqrtf(qn2) * knB + bmaxB, l = hi == 0 ? ex2(sinkv - m) : 0.f;
            f32x16 o0, o1;
#pragma unroll
            for (int r = 0; r < 16; ++r) { o0[r] = 0.f; o1[r] = 0.f; }
            window_branch<128>(kbf, vbt, lane, qf, lutB + h * LUTB_STRIDE + 32, q0, qpos, c, hi, m, l, o0, o1);
            const float lt = l + __shfl_xor(l, 32), inv = 1.f / lt;
            bf16_t* orow = O + mrow * D + 1024 + (g * 8 + h) * 64;
#pragma unroll
            for (int dt = 0; dt < 2; ++dt)
#pragma unroll
                for (int q4 = 0; q4 < 4; ++q4) {
                    const f32x16& oo = dt ? o1 : o0;
                    u32x2 w; w.x = pk2(oo[4 * q4] * inv, oo[4 * q4 + 1] * inv); w.y = pk2(oo[4 * q4 + 2] * inv, oo[4 * q4 + 3] * inv);
                    *(u32x2*)(orow + dt * 32 + 8 * q4 + 4 * hi) = w;
                }
        }
        const float gt0 = sigmoidf_(bf2f(prow[C_GATE + (g * 8 + h) * 3 + 0]));
        const float gt2 = sigmoidf_(bf2f(prow[C_GATE + (g * 8 + h) * 3 + 2]));
        bf16x8 qfa[4];
#pragma unroll
        for (int kk = 0; kk < 4; ++kk) qfa[kk] = *(const bf16x8*)(prow + C_QA + (g * 8 + h) * 64 + kk * 16 + hi * 8);
        float qnA; { float qn2 = sumsq8(qfa[0]) + sumsq8(qfa[1]) + sumsq8(qfa[2]) + sumsq8(qfa[3]); qn2 += __shfl_xor(qn2, 32); qnA = sqrtf(qn2); }
        for (int i = lane; i < 4 * 257; i += 64) imp[i] = 0.f;
        const int ntile = (q0 + 3) / 512 + 1;
        const int nfast = q0 >= 2040 ? (q0 - 2040) / 512 + 1 : 0;
        {
            float m = qnA * knC + bmaxA, l = 0.f;
            {
                bf16x8 kc[4];
                loadK32(kcb, lane, kc);
#pragma unroll 1
                for (int t = 0; t < ntile; ++t) {
                    bf16x8 kn[4];
                    const int tn = t + 1 < ntile ? t + 1 : t;
                    loadK32(kcb + (size_t)tn * 2048, lane, kn);
                    f32x16 s = qk32r(kc, qfa);
                    float alpha;
                    if (t < nfast) {
#pragma unroll
                        for (int r = 0; r < 16; ++r) s[r] = s[r] * SC2 + b31;
                        (void)softmax32<false>(s, 0u, m, l, alpha);
                    } else {
                        const unsigned vm = logits_cmp(s, t * 32, qpos, hi, bias_a);
                        (void)softmax32<true>(s, vm, m, l, alpha);
                    }
#pragma unroll
                    for (int kk = 0; kk < 4; ++kk) kc[kk] = kn[kk];
                }
            }
            const float lt = l + __shfl_xor(l, 32), inv = lt > 0.f ? 1.f / lt : 0.f;
            f32x16 o0, o1;
#pragma unroll
            for (int r = 0; r < 16; ++r) { o0[r] = 0.f; o1[r] = 0.f; }
            LDS_WAIT();
            bf16x8 kc[4];
            loadK32(kcb, lane, kc);
#pragma unroll 1
            for (int t = 0; t < ntile; ++t) {
                bf16x8 vf[2][2], kn[4];
                loadV32(vct + (size_t)t * 2048, lane, vf);
                const int tn = t + 1 < ntile ? t + 1 : t;
                loadK32(kcb + (size_t)tn * 2048, lane, kn);
                f32x16 s = qk32r(kc, qfa);
                if (t < nfast) {
#pragma unroll
                    for (int r = 0; r < 16; ++r) s[r] = ex2(s[r] * SC2 + (b31 - m)) * inv;
                } else {
                    const unsigned vm = logits_cmp(s, t * 32, qpos, hi, bias_a);
#pragma unroll
                    for (int r = 0; r < 16; ++r) s[r] = ((vm >> r) & 1u) ? ex2(s[r] - m) * inv : 0.f;
                }
#pragma unroll
                for (int grp = 0; grp < 4; ++grp) {
                    float wa = 2.f * (s[4 * grp] + s[4 * grp + 1] + s[4 * grp + 2]) + s[4 * grp + 3], wb = s[4 * grp + 3];
                    wa += __shfl_xor(wa, 1); wb += __shfl_xor(wb, 1);
                    wa += __shfl_xor(wa, 2); wb += __shfl_xor(wb, 2);
                    wa += __shfl_xor(wa, 4); wb += __shfl_xor(wb, 4);
                    const int j = t * 8 + 2 * grp + hi;
                    if (h == 0) {
                        (void)__hip_atomic_fetch_add(imp + ql * 257 + j, wa, __ATOMIC_RELAXED, __HIP_MEMORY_SCOPE_WORKGROUP);
                        (void)__hip_atomic_fetch_add(imp + ql * 257 + j + 1, wb, __ATOMIC_RELAXED, __HIP_MEMORY_SCOPE_WORKGROUP);
                    }
                }
                pv32r(s, vf, o0, o1);
#pragma unroll
                for (int kk = 0; kk < 4; ++kk) kc[kk] = kn[kk];
            }
#pragma unroll
            for (int r = 0; r < 16; ++r) { olds[c * 65 + crow(r, hi)] = gt0 * o0[r]; olds[c * 65 + 32 + crow(r, hi)] = gt0 * o1[r]; }
        }
        LDS_WAIT();
        {
            const int tq = lane >> 4, sub = lane & 15;
            const int qp = q0 + tq, cb = qp >> 6;
            float v[16];
#pragma unroll
            for (int i = 0; i < 16; ++i) { const int j = sub + 16 * i; v[i] = (j >= 1 && j <= cb - 2) ? imp[tq * 257 + j] : -1.f; }
            int n = (cb < 2 ? cb : 2) + 1;
            if (sub == 0) {
                sel[tq * 16 + 0] = 0;
                if (cb >= 1) sel[tq * 16 + n - 1] = cb;
                if (cb >= 2) sel[tq * 16 + 1] = cb - 1;
            }
#pragma unroll 1
            for (int k = 0; k < 13; ++k) {
                float bv = v[0]; int bj = sub;
#pragma unroll
                for (int i = 1; i < 16; ++i) { if (v[i] > bv) { bv = v[i]; bj = sub + 16 * i; } }
#pragma unroll
                for (int off = 1; off < 16; off <<= 1) {
                    const float ov = __shfl_xor(bv, off); const int oj = __shfl_xor(bj, off);
                    if (ov > bv || (ov == bv && oj < bj)) { bv = ov; bj = oj; }
                }
                if (bv >= 0.f) {
                    if (sub == 0) sel[tq * 16 + n] = bj;
                    n += 1;
#pragma unroll
                    for (int i = 0; i < 16; ++i) { if (bj == sub + 16 * i) v[i] = -1.f; }
                }
            }
            if (sub == 0) nsel[tq] = n;
        }
        LDS_WAIT();
        {
            const int hh = lane & 15, qd = lane >> 4, hd = hh & 7;
            const LAS float* bias_s = bias + (g * 8 + hd) * 32;
            const float b31s = bias_s[31];

#pragma unroll 1
            for (int qi = 0; qi < 4; ++qi) {
                const int qp = q0 + qi;
                const bf16_t* pr = Pb + (size_t)qp * NP;
                bf16x8 qf[2];
#pragma unroll
                for (int kk = 0; kk < 2; ++kk) qf[kk] = *(const bf16x8*)(pr + C_QA + (g * 8 + hd) * 64 + kk * 32 + qd * 8);
                const float gt1 = sigmoidf_(bf2f(pr[C_GATE + (g * 8 + hd) * 3 + 1]));
                float qs2 = sumsq8(qf[0]) + sumsq8(qf[1]); qs2 += __shfl_xor(qs2, 16); qs2 += __shfl_xor(qs2, 32);
                const float m = sqrtf(qs2) * knS + bmaxA; const float l = 0.f;
                const bf16x8 ones8s = {0x3F80, 0x3F80, 0x3F80, 0x3F80, 0x3F80, 0x3F80, 0x3F80, 0x3F80};
                f32x4 lacc = (f32x4){0.f, 0.f, 0.f, 0.f};
                f32x4 o[4];
#pragma unroll
                for (int dt = 0; dt < 4; ++dt) o[dt] = (f32x4){0.f, 0.f, 0.f, 0.f};
                const int ns = __builtin_amdgcn_readfirstlane(nsel[qi]);
                int jb = __builtin_amdgcn_readfirstlane(sel[qi * 16]);
                bf16x8 ka[4][2];
#pragma unroll
                for (int t = 0; t < 4; ++t)
#pragma unroll
                    for (int kk = 0; kk < 2; ++kk) ka[t][kk] = *(const bf16x8*)(ksf + (size_t)jb * 4096 + ((t * 2 + kk) * 64 + lane) * 8);
#pragma unroll 1
                for (int k = 0; k < ns; ++k) {
                    bf16x8 va[2][4], kn[4][2];
#pragma unroll
                    for (int j = 0; j < 2; ++j)
#pragma unroll
                        for (int dt = 0; dt < 4; ++dt) va[j][dt] = *(const bf16x8*)(vst + (size_t)jb * 4096 + ((j * 4 + dt) * 64 + lane) * 8);
                    const int jn = __builtin_amdgcn_readfirstlane(sel[qi * 16 + (k + 1 < ns ? k + 1 : k)]);
#pragma unroll
                    for (int t = 0; t < 4; ++t)
#pragma unroll
                        for (int kk = 0; kk < 2; ++kk) kn[t][kk] = *(const bf16x8*)(ksf + (size_t)jn * 4096 + ((t * 2 + kk) * 64 + lane) * 8);
                    f32x4 s[4];
#pragma unroll
                    for (int t = 0; t < 4; ++t) {
                        s[t] = (f32x4){0.f, 0.f, 0.f, 0.f};
#pragma unroll
                        for (int kk = 0; kk < 2; ++kk) s[t] = MFMA16(ka[t][kk], qf[kk], s[t]);
                    }
                    if (qp - (jb * 64 + 63) >= 1513) {
                        const float cst = b31s - m;
#pragma unroll
                        for (int t = 0; t < 4; ++t)
#pragma unroll
                            for (int r = 0; r < 4; ++r) s[t][r] = s[t][r] * SC2 + cst;
                    } else {
#pragma unroll
                        for (int t = 0; t < 4; ++t)
#pragma unroll
                            for (int r = 0; r < 4; ++r) {
                                const int dist = qp - (jb * 64 + 16 * t + 4 * qd + r);
                                const float bb = bias_s[rel_bucket(dist < 0 ? 0 : dist)];
                                s[t][r] = dist >= 0 ? s[t][r] * SC2 + (bb - m) : NEGF;
                            }
                    }
#pragma unroll
                    for (int t = 0; t < 4; ++t)
#pragma unroll
                        for (int r = 0; r < 4; ++r) s[t][r] = ex2(s[t][r]);
#pragma unroll
                    for (int j = 0; j < 2; ++j) {
                        const bf16x8 pb = pack8(s[2 * j][0], s[2 * j][1], s[2 * j][2], s[2 * j][3], s[2 * j + 1][0], s[2 * j + 1][1], s[2 * j + 1][2], s[2 * j + 1][3]);
#pragma unroll
                        for (int dt = 0; dt < 4; ++dt) o[dt] = MFMA16(va[j][dt], pb, o[dt]);
                        lacc = MFMA16(ones8s, pb, lacc);
                    }
                    jb = jn;
#pragma unroll
                    for (int t = 0; t < 4; ++t)
#pragma unroll
                        for (int kk = 0; kk < 2; ++kk) ka[t][kk] = kn[t][kk];
                }
                const float lt = l + lacc[0];
                const float inv = lt > 0.f ? gt1 / lt : 0.f;
                if (hh < 8) {
#pragma unroll
                    for (int dt = 0; dt < 4; ++dt)
#pragma unroll
                        for (int r = 0; r < 4; ++r) olds[(qi * 8 + hh) * 65 + 16 * dt + 4 * qd + r] += o[dt][r] * inv;
                }
            }
        }
        LDS_WAIT();
        {
            float m = qnA * knW + bmaxA, l = 0.f;
            f32x16 o0, o1;
#pragma unroll
            for (int r = 0; r < 16; ++r) { o0[r] = 0.f; o1[r] = 0.f; }
            window_branch<512>(kwf, vwt, lane, qfa, lutW + h * LUTW_STRIDE + 32, q0, qpos, c, hi, m, l, o0, o1);
            const float lt = l + __shfl_xor(l, 32), inv = lt > 0.f ? gt2 / lt : 0.f;
            bf16_t* orow = O + mrow * D + (g * 8 + h) * 64;
#pragma unroll
            for (int dt = 0; dt < 2; ++dt)
#pragma unroll
                for (int q4 = 0; q4 < 4; ++q4) {
                    const f32x16& oo = dt ? o1 : o0;
                    const int d0 = dt * 32 + 8 * q4 + 4 * hi;
                    const float e0 = oo[4 * q4] * inv + olds[c * 65 + d0], e1 = oo[4 * q4 + 1] * inv + olds[c * 65 + d0 + 1];
                    const float e2 = oo[4 * q4 + 2] * inv + olds[c * 65 + d0 + 2], e3 = oo[4 * q4 + 3] * inv + olds[c * 65 + d0 + 3];
                    u32x2 w; w.x = pk2(e0, e1); w.y = pk2(e2, e3);
                    *(u32x2*)(orow + d0) = w;
                }
        }
        LDS_WAIT();
    }
}

DI unsigned ordf(float f) { const unsigned u = __builtin_bit_cast(unsigned, f); return (u & 0x80000000u) ? ~u : (u | 0x80000000u); }
DI float unordf(unsigned k) { const unsigned u = (k & 0x80000000u) ? (k & 0x7fffffffu) : ~k; return __builtin_bit_cast(float, u); }

DI void peer_half_topk(const bf16_t* qrow  , const bf16_t* subk  , int hi, int lane, LAS unsigned* ltop) {
    unsigned keys[64];
    asm volatile("" : "+v"(subk));
#pragma unroll
    for (int rt = 0; rt < 4; ++rt) {
        f32x16 acc;
#pragma unroll
        for (int r = 0; r < 16; ++r) acc[r] = 0.f;
#pragma unroll
        for (int kk = 0; kk < 8; ++kk) {
            const bf16x8 af = *(const bf16x8*)(subk + (size_t)(rt * 32) * 128 + kk * 16);
            const bf16x8 bf = *(const bf16x8*)(qrow + kk * 16);
            acc = MFMA32(af, bf, acc);
        }
#pragma unroll
        for (int r = 0; r < 16; ++r) { const int n = rt * 32 + crow(r, hi); keys[rt * 16 + r] = (ordf(acc[r]) & ~0x7Fu) | (unsigned)(127 - n); }
    }
#pragma unroll 1
    for (int k = 0; k < 16; ++k) {
        unsigned mx = keys[0];
#pragma unroll
        for (int i = 1; i < 64; ++i) mx = mx > keys[i] ? mx : keys[i];
        const unsigned om = (unsigned)__shfl_xor((int)mx, 32);
        mx = mx > om ? mx : om;
        ltop[k * 64 + lane] = mx;
#pragma unroll
        for (int i = 0; i < 64; ++i) keys[i] = keys[i] == mx ? 0u : keys[i];
    }
}

DI void phase_peer_select(const Args& a, int layer, LAS unsigned char* lds) {
    const int tid = opaque_tid(), lane = tid & 63, wave = tid >> 6;
    const int gw = blockIdx.x * 8 + wave, NGW = gridDim.x * 8;
    unsigned char* ws = a.ws;
    const bf16_t* Q2 = (const bf16_t*)(ws + WS_Q2);
    const bf16_t* subk = (const bf16_t*)(ws + WS_SUBK) + (size_t)layer * 2 * 128 * 128;
    int* IDX = (int*)(ws + WS_IDX);
    float* GATE = (float*)(ws + WS_GATE);
    LAS unsigned* lt1 = (LAS unsigned*)(lds + wave * 8192);
    LAS unsigned* lt2 = lt1 + 1024;
    const int c = lane & 31, hi = lane >> 5, tl = c >> 3, h = c & 7;
#pragma unroll 1
    for (int unit = gw; unit < M / 4; unit += NGW) {
        const size_t m = (size_t)unit * 4 + tl;
        const bf16_t* qrow = Q2 + m * D + h * 256 + hi * 8;
        peer_half_topk(qrow, subk + (size_t)c * 128 + hi * 8, hi, lane, lt1);
        peer_half_topk(qrow + 128, subk + 128 * 128 + (size_t)c * 128 + hi * 8, hi, lane, lt2);
        LDS_WAIT();
        unsigned t1[16], t2[16];
#pragma unroll
        for (int i = 0; i < 16; ++i) { t1[i] = lt1[i * 64 + lane]; t2[i] = lt2[i * 64 + lane]; }
        unsigned ck[16][16];
#pragma unroll
        for (int x = 0; x < 16; ++x)
#pragma unroll
            for (int y = 0; y < 16; ++y)
                if ((x + 1) * (y + 1) <= 16) ck[x][y] = (ordf(unordf(t1[x] & ~0x7Fu) + unordf(t2[y] & ~0x7Fu)) & ~0xFFu) | (unsigned)(255 - (x * 16 + y));
        const float scmax = unordf(ck[0][0] & ~0xFFu);
        int* ip = IDX + m * 128 + h * 16; float* gp = GATE + m * 128 + h * 16;
        float sum = 0.f;
#pragma unroll 1
        for (int k = 0; k < 16; ++k) {
            unsigned mx = 0u;
#pragma unroll
            for (int x = 0; x < 16; ++x)
#pragma unroll
                for (int y = 0; y < 16; ++y)
                    if ((x + 1) * (y + 1) <= 16) mx = mx > ck[x][y] ? mx : ck[x][y];
#pragma unroll
            for (int x = 0; x < 16; ++x)
#pragma unroll
                for (int y = 0; y < 16; ++y)
                    if ((x + 1) * (y + 1) <= 16) ck[x][y] = ck[x][y] == mx ? 0u : ck[x][y];
            const int ci = 255 - (int)(mx & 0xFFu);
            const int e = (int)(127u - (lt1[(ci >> 4) * 64 + lane] & 0x7Fu)) * 128 + (int)(127u - (lt2[(ci & 15) * 64 + lane] & 0x7Fu));
            const float ek = __expf(unordf(mx & ~0xFFu) - scmax);
            sum += ek;
            if (hi == 0) { ip[k] = e; gp[k] = ek; }
        }
        if (hi == 0) ((float*)(ws + WS_GSUM))[m * 8 + h] = 1.f / sum;
        LDS_WAIT();
    }
}

#define FP8_LO(w) __builtin_amdgcn_cvt_pk_f32_fp8((int)(w), false)
#define FP8_HI(w) __builtin_amdgcn_cvt_pk_f32_fp8((int)(w), true)
DI float dot16(const float (&x)[32], int o, const u32x4 w) {
    const f32x2 a0 = FP8_LO(w.x), a1 = FP8_HI(w.x), a2 = FP8_LO(w.y), a3 = FP8_HI(w.y), a4 = FP8_LO(w.z), a5 = FP8_HI(w.z), a6 = FP8_LO(w.w), a7 = FP8_HI(w.w);
    return (x[o + 0] * a0.x + x[o + 1] * a0.y + x[o + 2] * a1.x + x[o + 3] * a1.y) + (x[o + 4] * a2.x + x[o + 5] * a2.y + x[o + 6] * a3.x + x[o + 7] * a3.y)
         + (x[o + 8] * a4.x + x[o + 9] * a4.y + x[o + 10] * a5.x + x[o + 11] * a5.y) + (x[o + 12] * a6.x + x[o + 13] * a6.y + x[o + 14] * a7.x + x[o + 15] * a7.y);
}
DI float dot16p(const u32x4 xa, const u32x4 xb, const u32x4 w) {
    const f32x2 a0 = FP8_LO(w.x), a1 = FP8_HI(w.x), a2 = FP8_LO(w.y), a3 = FP8_HI(w.y), a4 = FP8_LO(w.z), a5 = FP8_HI(w.z), a6 = FP8_LO(w.w), a7 = FP8_HI(w.w);
    return (bflo(xa.x) * a0.x + bfhi(xa.x) * a0.y + bflo(xa.y) * a1.x + bfhi(xa.y) * a1.y) + (bflo(xa.z) * a2.x + bfhi(xa.z) * a2.y + bflo(xa.w) * a3.x + bfhi(xa.w) * a3.y)
         + (bflo(xb.x) * a4.x + bfhi(xb.x) * a4.y + bflo(xb.y) * a5.x + bfhi(xb.y) * a5.y) + (bflo(xb.z) * a6.x + bfhi(xb.z) * a6.y + bflo(xb.w) * a7.x + bfhi(xb.w) * a7.y);
}
DI void axpy16(float (&acc)[32], int o, float g, const u32x4 w) {
    const f32x2 a0 = FP8_LO(w.x), a1 = FP8_HI(w.x), a2 = FP8_LO(w.y), a3 = FP8_HI(w.y), a4 = FP8_LO(w.z), a5 = FP8_HI(w.z), a6 = FP8_LO(w.w), a7 = FP8_HI(w.w);
    acc[o + 0] += g * a0.x; acc[o + 1] += g * a0.y; acc[o + 2] += g * a1.x; acc[o + 3] += g * a1.y; acc[o + 4] += g * a2.x; acc[o + 5] += g * a2.y; acc[o + 6] += g * a3.x; acc[o + 7] += g * a3.y;
    acc[o + 8] += g * a4.x; acc[o + 9] += g * a4.y; acc[o + 10] += g * a5.x; acc[o + 11] += g * a5.y; acc[o + 12] += g * a6.x; acc[o + 13] += g * a6.y; acc[o + 14] += g * a7.x; acc[o + 15] += g * a7.y;
}
DI void phase_peer_gather(const Args& a, int layer) {
    const int tid = opaque_tid(), lane = tid & 63, wave = tid >> 6;
    const int gw = blockIdx.x * 8 + wave, NGW = gridDim.x * 8;
    unsigned char* ws = a.ws;
    const bf16_t* XN = (const bf16_t*)(ws + WS_XN);
    const unsigned char* U = ws + WS_U + (size_t)layer * NEXP * D;
    const unsigned char* V = ws + WS_V + (size_t)layer * NEXP * D;
    const unsigned lo16 = (unsigned)lane * 16u;
    const int* IDX = (const int*)(ws + WS_IDX);
    const float* GATE = (const float*)(ws + WS_GATE);
    const float* GSUM = (const float*)(ws + WS_GSUM);
#pragma unroll 1
    for (int m = gw; m < M; m += NGW) {
        u32x4 xp[4];
#pragma unroll
        for (int q = 0; q < 4; ++q) xp[q] = *(const u32x4*)(XN + (size_t)m * D + (q >> 1) * 1024 + lane * 16 + (q & 1) * 8);
        float acc[32];
#pragma unroll
        for (int i = 0; i < 32; ++i) acc[i] = 0.f;
        const int idA = IDX[(size_t)m * 128 + lane], idB = IDX[(size_t)m * 128 + 64 + lane];
        const float glA = GATE[(size_t)m * 128 + lane] * GSUM[(size_t)m * 8 + (lane >> 4)] * (1.f / V_SCALE);
        const float glB = GATE[(size_t)m * 128 + 64 + lane] * GSUM[(size_t)m * 8 + 4 + (lane >> 4)] * (1.f / V_SCALE);
        u32x4 cur[8];
#pragma unroll
        for (int j = 0; j < 4; ++j) { const unsigned of = (unsigned)__shfl(idA, j) * (unsigned)D + lo16; cur[2 * j] = *(const u32x4*)(U + of); cur[2 * j + 1] = *(const u32x4*)(U + of + 1024u); }
#pragma unroll 1
        for (int half = 0; half < 2; ++half) {
            const int idl = half ? idB : idA;
            const float gl = half ? glB : glA;
            float ghl = 0.f;
#pragma unroll 1
            for (int g4 = 0; g4 < 16; ++g4) {
                u32x4 nxt[8];
                { const unsigned char* base = g4 < 15 ? U : V; const int e0n = g4 < 15 ? (g4 + 1) * 4 : 0;
#pragma unroll
                  for (int j = 0; j < 4; ++j) { const unsigned of = (unsigned)__shfl(idl, e0n + j) * (unsigned)D + lo16; nxt[2 * j] = *(const u32x4*)(base + of); nxt[2 * j + 1] = *(const u32x4*)(base + of + 1024u); } }
                const float d0 = dot16p(xp[0], xp[1], cur[0]) + dot16p(xp[2], xp[3], cur[1]); __builtin_amdgcn_sched_barrier(0);
                const float d1 = dot16p(xp[0], xp[1], cur[2]) + dot16p(xp[2], xp[3], cur[3]); __builtin_amdgcn_sched_barrier(0);
                const float d2 = dot16p(xp[0], xp[1], cur[4]) + dot16p(xp[2], xp[3], cur[5]); __builtin_amdgcn_sched_barrier(0);
                const float d3 = dot16p(xp[0], xp[1], cur[6]) + dot16p(xp[2], xp[3], cur[7]); __builtin_amdgcn_sched_barrier(0);
                const bool p1 = lane & 1, p2 = lane & 2;
                const float b0 = (p1 ? d1 : d0) + __shfl_xor(p1 ? d0 : d1, 1);
                const float b1 = (p1 ? d3 : d2) + __shfl_xor(p1 ? d2 : d3, 1);
                float cs = (p2 ? b1 : b0) + __shfl_xor(p2 ? b0 : b1, 2);
                cs += __shfl_xor(cs, 4); cs += __shfl_xor(cs, 8); cs += __shfl_xor(cs, 16); cs += __shfl_xor(cs, 32);
                const float hv = gelu_tanh(cs * (1.f / U_SCALE));
                ghl = ((lane >> 2) == g4) ? hv * gl : ghl;
#pragma unroll
                for (int j = 0; j < 8; ++j) cur[j] = nxt[j];
            }
#pragma unroll 1
            for (int g4 = 0; g4 < 16; ++g4) {
                u32x4 nxt[8];
                { const unsigned char* base = g4 < 15 ? V : U; const int e0n = g4 < 15 ? (g4 + 1) * 4 : 0; const int ids = g4 < 15 ? idl : idB;
#pragma unroll
                  for (int j = 0; j < 4; ++j) { const unsigned of = (unsigned)__shfl(ids, e0n + j) * (unsigned)D + lo16; nxt[2 * j] = *(const u32x4*)(base + of); nxt[2 * j + 1] = *(const u32x4*)(base + of + 1024u); } }
#pragma unroll
                for (int j = 0; j < 4; ++j) { const float gv = __shfl(ghl, g4 * 4 + j); axpy16(acc, 0, gv, cur[2 * j]); axpy16(acc, 16, gv, cur[2 * j + 1]); __builtin_amdgcn_sched_barrier(0); }
#pragma unroll
                for (int j = 0; j < 8; ++j) cur[j] = nxt[j];
            }
        }
        float ss = 0.f;
#pragma unroll
        for (int q = 0; q < 4; ++q) {
            const f32x4* hp = (const f32x4*)(a.out + (size_t)m * D + (q >> 1) * 1024 + lane * 16 + (q & 1) * 8);
            const f32x4 h0 = hp[0], h1 = hp[1];
            acc[q * 8 + 0] += h0.x; acc[q * 8 + 1] += h0.y; acc[q * 8 + 2] += h0.z; acc[q * 8 + 3] += h0.w;
            acc[q * 8 + 4] += h1.x; acc[q * 8 + 5] += h1.y; acc[q * 8 + 6] += h1.z; acc[q * 8 + 7] += h1.w;
#pragma unroll
            for (int e = 0; e < 8; ++e) ss += acc[q * 8 + e] * acc[q * 8 + e];
            __builtin_amdgcn_sched_barrier(0);
        }
        const float rstd = rsqrtf(wave_sum(ss) * (1.f / D) + 1e-6f);
        const float* gn = layer + 1 < NLAYER ? a.attn_norm + (size_t)(layer + 1) * D : a.final_norm;
        asm volatile("" : "+s"(gn));
#pragma unroll
        for (int q = 0; q < 4; ++q) {
            const int col = (q >> 1) * 1024 + lane * 16 + (q & 1) * 8;
            const f32x4 g0 = *(const f32x4*)(gn + col), g1 = *(const f32x4*)(gn + col + 4);
            f32x4 h0, h1;
            h0.x = acc[q * 8 + 0]; h0.y = acc[q * 8 + 1]; h0.z = acc[q * 8 + 2]; h0.w = acc[q * 8 + 3];
            h1.x = acc[q * 8 + 4]; h1.y = acc[q * 8 + 5]; h1.z = acc[q * 8 + 6]; h1.w = acc[q * 8 + 7];
            const f32x4 y0 = h0 * rstd * g0, y1 = h1 * rstd * g1;
            f32x4* hp = (f32x4*)(a.out + (size_t)m * D + col);
            if (layer + 1 < NLAYER) {
                hp[0] = h0; hp[1] = h1;
                u32x4 w; w.x = pk2(y0.x, y0.y); w.y = pk2(y0.z, y0.w); w.z = pk2(y1.x, y1.y); w.w = pk2(y1.z, y1.w);
                *(u32x4*)((bf16_t*)(ws + WS_XN) + (size_t)m * D + col) = w;
            } else { hp[0] = y0; hp[1] = y1; }
            __builtin_amdgcn_sched_barrier(0);
        }
    }
}

constexpr size_t WS_BAR = 95 * MiB;
#define XB_TMO      128
#define XB_XCNT(j)  (256  + 64 * (j))
#define XB_XSUB(j)  (1280 + 64 * (j))
#define XB_XGEN(j)  (2304 + 64 * (j))
#define XB_TOP      3328
#define XB_TOPGEN   3392
#define XCD_BAR_WORDS 3456
#define XB_SPIN_CAP (1u << 18)

__device__ __forceinline__ unsigned xb_ld(unsigned* p)              { return __hip_atomic_load(p, __ATOMIC_RELAXED, __HIP_MEMORY_SCOPE_AGENT); }
__device__ __forceinline__ unsigned xb_add(unsigned* p, unsigned v) { return __hip_atomic_fetch_add(p, v, __ATOMIC_RELAXED, __HIP_MEMORY_SCOPE_AGENT); }
__device__ __forceinline__ unsigned xb_xcc_id() { return (unsigned)__builtin_amdgcn_s_getreg((3 << 11) | 20) & 0xFu; }
#define XB_SPIN(cond, bar) do { unsigned _sp = 0; while (cond) { __builtin_amdgcn_s_sleep(1); \
    if ((++_sp & 255u) == 0u) { if (xb_ld(&(bar)[XB_TMO])) break; if (_sp > XB_SPIN_CAP) { atomicAdd(&(bar)[XB_TMO], 1u); break; } } } } while (0)

struct XcdBarrier {
    unsigned* bar; unsigned x;
    volatile LAS unsigned* st;
};

__device__ __forceinline__ XcdBarrier xcd_barrier_post(unsigned* bar, volatile LAS unsigned* st) {
    XcdBarrier b; b.bar = bar; b.x = xb_xcc_id(); b.st = st;
    if (threadIdx.x == 0) (void)xb_add(&bar[XB_XCNT(b.x)], 1u);
    return b;
}
__device__ __forceinline__ void xcd_barrier_complete(unsigned* bar, unsigned x, unsigned& nloc, unsigned& nx) {
    const unsigned G = gridDim.x * gridDim.y * gridDim.z;
    unsigned sum, cnt, mine, sp = 0u;
    for (;;) {
        sum = 0u; cnt = 0u; mine = 0u;
#pragma unroll
        for (unsigned j = 0; j < 16; ++j) { const unsigned c = xb_ld(&bar[XB_XCNT(j)]); sum += c; cnt += (c > 0u) ? 1u : 0u; mine = (j == x) ? c : mine; }
        if (sum == G) break;
        __builtin_amdgcn_s_sleep(1);
        if ((++sp & 255u) == 0u) { if (xb_ld(&bar[XB_TMO])) break; if (sp > XB_SPIN_CAP) { atomicAdd(&bar[XB_TMO], 1u); break; } }
    }
    nloc = mine > 0u ? mine : 1u; nx = cnt > 0u ? cnt : 1u;
}

__device__ __forceinline__ void xcd_barrier(const XcdBarrier& b) {
    asm volatile("s_waitcnt vmcnt(0)" ::: "memory");
    __syncthreads();
    if (threadIdx.x == 0) {
        unsigned* bar = b.bar;
        __builtin_amdgcn_s_waitcnt(0);
        unsigned nloc = b.st[0], nx = b.st[1];
        if (nloc == 0u) { xcd_barrier_complete(bar, b.x, nloc, nx); b.st[0] = nloc; b.st[1] = nx; }
        const unsigned old = xb_add(&bar[XB_XSUB(b.x)], 1u);
        const unsigned gen = old / nloc;
        if (old + 1u == (gen + 1u) * nloc) {
            __builtin_amdgcn_fence(__ATOMIC_RELEASE, "agent");
            asm volatile("s_waitcnt vmcnt(0)" ::: "memory");
            const unsigned og = xb_add(&bar[XB_TOP], 1u);
            const unsigned tg = og / nx;
            if (og + 1u == (tg + 1u) * nx) xb_add(&bar[XB_TOPGEN], 1u);
            else XB_SPIN(xb_ld(&bar[XB_TOPGEN]) == tg, bar);
            __builtin_amdgcn_fence(__ATOMIC_ACQUIRE, "agent");
            xb_add(&bar[XB_XGEN(b.x)], 1u);
            asm volatile("s_waitcnt vmcnt(0)" ::: "memory");
        } else {
            XB_SPIN(xb_ld(&bar[XB_XGEN(b.x)]) == gen, bar);
            __builtin_amdgcn_fence(__ATOMIC_ACQUIRE, "agent");
            asm volatile("s_waitcnt vmcnt(0)" ::: "memory");
        }
    }
    __syncthreads();
}

constexpr int NPHASE = 20;
template <int KIND>
DI void run_phase(const Args& a, int layer, LAS unsigned char* lds) {
    unsigned char* ws = a.ws;
    if constexpr (KIND == 0) { phase_prologue(a, lds); phase_rms_bf16(a.x, a.attn_norm, (bf16_t*)(ws + WS_XN)); }
    if constexpr (KIND == 1) phase_rms_bf16(layer == 0 ? a.x : a.out, a.attn_norm + (size_t)layer * D, (bf16_t*)(ws + WS_XN));
    if constexpr (KIND == 2 || KIND == 7) {
        const bool inproj = KIND == 2;
        const int N = inproj ? C_GATE : D, ldw = inproj ? NP : D;
        pg8::Gemm g{(const bf16_t*)(ws + WS_XN), (const bf16_t*)(ws + (inproj ? WS_WIN : WS_WQ)) + (size_t)layer * ldw * D, M, N, D};
        pg8::StaticOrder So; So.init(M, N, (int)gridDim.x, (int)blockIdx.x);
        pg8::EpiBf16<0> E{(bf16_t*)(ws + (inproj ? WS_P : WS_Q2)), ldw, nullptr, 0, 0, 1.f};
        pg8::gemm_phase<pg8::EpiBf16<0>, pg8::StaticOrder, true, true>(lds, g, So, E);
    }
    if constexpr (KIND == 3) phase_prep(a, layer, lds);
    if constexpr (KIND == 4) phase_attn(a, layer, lds);
    if constexpr (KIND == 5) {
        pg8::Gemm g{(const bf16_t*)(ws + WS_O), (const bf16_t*)(ws + WS_WOUT) + (size_t)layer * D * D, M, D, D};
        pg8::StaticOrder So; So.init(M, D, (int)gridDim.x, (int)blockIdx.x);
        EpiResid E{layer == 0 ? a.x : a.out, a.out, D};
        pg8::gemm_phase<EpiResid, pg8::StaticOrder, true, true>(lds, g, So, E);
    }
    if constexpr (KIND == 6) phase_rms_bf16(a.out, a.ffn_norm + (size_t)layer * D, (bf16_t*)(ws + WS_XN));
    if constexpr (KIND == 8) phase_peer_select(a, layer, lds);
    if constexpr (KIND == 9) phase_peer_gather(a, layer);
    if constexpr (KIND == 10) phase_rms_final(a.out, a.final_norm);
}

#ifndef MK_PER_PHASE
#define MK_PER_PHASE 0
#endif

#if MK_PER_PHASE
template <int KIND>
__global__ void __launch_bounds__(NTHREADS, 2) k_phase(Args a, int layer) {
    extern __shared__ __attribute__((aligned(16))) unsigned char lds_raw[];
    run_phase<KIND>(a, layer, (LAS unsigned char*)lds_raw);
}
template <int KIND> static void launch_phase(const Args& a, int layer, int grid, hipStream_t stream) {
    static bool attr = false;
    if (!attr) { (void)hipFuncSetAttribute((const void*)k_phase<KIND>, hipFuncAttributeMaxDynamicSharedMemorySize, LDS_BYTES); attr = true; }
    hipLaunchKernelGGL(k_phase<KIND>, dim3(grid), dim3(NTHREADS), LDS_BYTES, stream, a, layer);
}
#else
__global__ void __launch_bounds__(NTHREADS, 2) hybrid_fwd(Args a) {
    extern __shared__ __attribute__((aligned(16))) unsigned char lds_raw[];
    LAS unsigned char* lds = (LAS unsigned char*)lds_raw;
    volatile LAS unsigned* bst = (volatile LAS unsigned*)(lds + LDS_BYTES - 16);
    if (threadIdx.x < 4) bst[threadIdx.x] = 0u;
    __syncthreads();
    const XcdBarrier xbar = xcd_barrier_post((unsigned*)(a.ws + WS_BAR), bst);
    bool first_seam = true;
#pragma unroll 1
    for (int ph = a.ph_lo; ph < a.ph_hi; ++ph) {
        if (ph == NPHASE - 1 || ph == 10 || ph == 1) continue;
        if (ph == 0) run_phase<0>(a, 0, lds);
        else if (ph == NPHASE - 1) run_phase<10>(a, 0, lds);
        else {
            const int layer = (ph - 1) / 9, k = (ph - 1) % 9;
            if (k == 0) run_phase<1>(a, layer, lds);
            else if (k == 1) run_phase<2>(a, layer, lds);
            else if (k == 2) run_phase<3>(a, layer, lds);
            else if (k == 3) run_phase<4>(a, layer, lds);
            else if (k == 4) run_phase<5>(a, layer, lds);
            else if (k == 5) run_phase<6>(a, layer, lds);
            else if (k == 6) run_phase<7>(a, layer, lds);
            else if (k == 7) run_phase<8>(a, layer, lds);
            else run_phase<9>(a, layer, lds);
        }
        if (ph + 1 < a.ph_hi) { if (first_seam) { cg::this_grid().sync(); first_seam = false; } else xcd_barrier(xbar); }
    }
}
#endif

extern "C" void kernel_launch(void* const* d_in, const int* in_sizes, int n_in, void* d_out, int out_size, void* d_ws, size_t ws_size, hipStream_t stream) {
    static int grid = 0;
    if (grid == 0) {
        if (n_in != 18 || out_size != M * D || ws_size < WS_END) { fprintf(stderr, "kernel_launch: unexpected shapes (n_in %d, out %d, ws %zu)\n", n_in, out_size, ws_size); grid = -1; return; }
        int dev = 0, cus = 0;
        if (hipGetDevice(&dev) != hipSuccess || hipDeviceGetAttribute(&cus, hipDeviceAttributeMultiprocessorCount, dev) != hipSuccess) { grid = -1; return; }
#if !MK_PER_PHASE
        if (hipFuncSetAttribute((const void*)hybrid_fwd, hipFuncAttributeMaxDynamicSharedMemorySize, LDS_BYTES) != hipSuccess) { fprintf(stderr, "kernel_launch: hipFuncSetAttribute failed\n"); grid = -1; return; }
        int per_cu = 0;
        if (hipOccupancyMaxActiveBlocksPerMultiprocessor(&per_cu, (const void*)hybrid_fwd, NTHREADS, LDS_BYTES) != hipSuccess || per_cu < 1) fprintf(stderr, "kernel_launch: occupancy query says %d\n", per_cu);
        (void)hipGetLastError();
#endif
        grid = cus;
    }
    if (grid < 0) return;
    Args a{};
    a.x = (const float*)d_in[0]; a.attn_norm = (const float*)d_in[1]; a.w_in = (const float*)d_in[2]; a.cmp_pos_k = (const float*)d_in[3];
    a.cmp_w1_k = (const float*)d_in[4]; a.cmp_w2_k = (const float*)d_in[5]; a.cmp_pos_v = (const float*)d_in[6]; a.cmp_w1_v = (const float*)d_in[7];
    a.cmp_w2_v = (const float*)d_in[8]; a.sinks = (const float*)d_in[9]; a.w_out = (const float*)d_in[10]; a.ffn_norm = (const float*)d_in[11];
    a.peer_wq = (const float*)d_in[12]; a.peer_subkeys = (const float*)d_in[13]; a.peer_u = (const float*)d_in[14]; a.peer_v = (const float*)d_in[15];
    a.rel_bias = (const float*)d_in[16]; a.final_norm = (const float*)d_in[17];
    a.out = (float*)d_out; a.ws = (unsigned char*)d_ws;
    a.ph_lo = 0; a.ph_hi = NPHASE;
#if MK_PER_PHASE
    launch_phase<0>(a, 0, grid, stream);
    for (int l = 0; l < NLAYER; ++l) {
        launch_phase<2>(a, l, grid, stream); launch_phase<3>(a, l, grid, stream);
        launch_phase<4>(a, l, grid, stream); launch_phase<5>(a, l, grid, stream); launch_phase<6>(a, l, grid, stream);
        launch_phase<7>(a, l, grid, stream); launch_phase<8>(a, l, grid, stream); launch_phase<9>(a, l, grid, stream);
    }
#else
    (void)hipMemsetAsync((unsigned char*)d_ws + WS_BAR, 0, 16384, stream);
    void* args[] = {&a};
    const hipError_t e = hipLaunchCooperativeKernel((const void*)hybrid_fwd, dim3(grid), dim3(NTHREADS), args, LDS_BYTES, stream);
    if (e != hipSuccess) fprintf(stderr, "kernel_launch: cooperative launch failed: %s (grid %d)\n", hipGetErrorString(e), grid);
#endif
}
```

```cpp
#include <hip/hip_runtime.h>
#include <cstdio>
#include <cstdint>
__device__ __forceinline__ int opaque_tid() { int t = threadIdx.x; asm volatile("" : "+v"(t)); return t; }
namespace pg8 {
#define PG8_LAS __attribute__((address_space(3)))
typedef unsigned short bf16_t;
typedef short bf16x8 __attribute__((ext_vector_type(8)));
typedef float f32x4 __attribute__((ext_vector_type(4)));
typedef unsigned u32x4 __attribute__((ext_vector_type(4)));
constexpr int BM = 256, BK = 64, HALF = 128, HTB = HALF * BK * 2  , STAGE_BYTES = 8 * HTB, NXCD = 8, WGM = 8;

__host__ __device__ __forceinline__ int lds_byte(int r, int c) { const int st = (r >> 4) * 2 + (c >> 5), rr = r & 15, cc = c & 31, ob = rr * 64 + cc * 2; return st * 1024 + (ob ^ (((ob >> 9) & 1) << 5)); }
__host__ __device__ __forceinline__ void stage_rc(int b, int& R, int& C) { const int st = b / 1024, sb = b % 1024, swz = sb ^ (((sb >> 9) & 1) << 5); R = (st >> 1) * 16 + swz / 64; C = (st & 1) * 32 + (swz % 64) / 2; }
__host__ __device__ __forceinline__ int perm32(int rho) { const int n = rho >> 4, i = rho & 15; return 8 * (i >> 2) + 4 * n + (i & 3); }

struct Unit { int pm, pn; };
struct Gemm { const bf16_t* A; const bf16_t* Bt; int M, N, K; };

struct StaticOrder {
    int nM, nN, nwg, G, c;
    __host__ __device__ void init(int M, int N, int G_, int c_) { nM = M / BM; nN = N / BM; nwg = nM * nN; G = G_; c = c_; }
    __host__ __device__ bool next(int i, Unit& u) const {
        const long L = (long)i * G + c; if (L >= nwg) return false;
        int wgid = (int)L; { const int q = nwg / NXCD, r = nwg % NXCD, xcd = wgid % NXCD, off = wgid / NXCD; wgid = (xcd < r ? xcd * (q + 1) : r * (q + 1) + (xcd - r) * q) + off; }
        const int nig = WGM * nN, gid = wgid / nig, fm = gid * WGM, gsz = (nM - fm) < WGM ? (nM - fm) : WGM;
        u.pm = fm + ((wgid % nig) % gsz); u.pn = (wgid % nig) / gsz; return true;
    }
    __device__ __forceinline__ void a_ready(const Unit&) const {}
    __device__ __forceinline__ void done(const Unit&) const {}
};

__device__ __forceinline__ unsigned cvt_pk_bf16(float lo, float hi) { unsigned r; asm volatile("v_cvt_pk_bf16_f32 %0, %1, %2" : "=v"(r) : "v"(lo), "v"(hi)); return r; }
typedef float f32x2 __attribute__((ext_vector_type(2)));
__device__ __forceinline__ f32x2 gelu_pk(f32x2 v) {
    const f32x2 av = __builtin_elementwise_abs(v), d = av * 0.2316418882f + 1.0f;
    f32x2 t; t.x = __builtin_amdgcn_rcpf(d.x); t.y = __builtin_amdgcn_rcpf(d.y);
    f32x2 q = t * 0.5307027145f + (-0.7265760135f); q = q * t + 0.7107068705f; q = q * t + (-0.142248368f); q = q * t + 0.127414796f; q = q * t;
    const f32x2 s = (v * v) * (-0.72134752044f);
    f32x2 e; e.x = __builtin_amdgcn_exp2f(s.x); e.y = __builtin_amdgcn_exp2f(s.y);
    const f32x2 m = v * (q * e), r = v - m;
    f32x2 o; o.x = v.x < 0.f ? m.x : r.x; o.y = v.y < 0.f ? m.y : r.y; return o;
}

template <int ACT  > struct EpiBf16 {
    static constexpr bool PERM = true, AFTER_DRAIN = false; static_assert(ACT == 0 || ACT == 1, "EpiBf16: ACT is 0 (none) or 1 (gelu_pk)");
    bf16_t* O; int ldc; const float* bias; int split_cols; size_t split_stride; float scale0;
    __device__ __forceinline__ void operator()(const f32x4 (&acc)[2][2][4][2], const Unit& u, int wr, int wc, int fr, int fq) const {
        const int row0 = u.pm * BM + wr * 64 + fr; int colt = u.pn * BM; bf16_t* base = O;
        float sc = 1.f; if (split_cols) { const int t = colt / split_cols; base += (size_t)t * split_stride; colt -= t * split_cols; if (t == 0) sc = scale0; }
        const int col0 = colt + wc * 32 + 8 * fq, bcol0 = u.pn * BM + wc * 32 + 8 * fq;
        f32x4 bv[2][2];
#pragma unroll
        for (int bj = 0; bj < 2; ++bj)
#pragma unroll
            for (int n = 0; n < 2; ++n) bv[bj][n] = bias ? *(const f32x4*)(bias + bcol0 + bj * HALF + 4 * n) : (f32x4){0.f, 0.f, 0.f, 0.f};
#pragma unroll
        for (int ai = 0; ai < 2; ++ai)
#pragma unroll
            for (int m = 0; m < 4; ++m) { bf16_t* rowp = base + (size_t)(row0 + ai * HALF + m * 16) * ldc + col0;
#pragma unroll
                for (int bj = 0; bj < 2; ++bj) { f32x4 v0 = acc[ai][bj][m][0] + bv[bj][0], v1 = acc[ai][bj][m][1] + bv[bj][1];
                    if (ACT == 1) { f32x2 a = gelu_pk((f32x2){v0[0], v0[1]}), b = gelu_pk((f32x2){v0[2], v0[3]}), c = gelu_pk((f32x2){v1[0], v1[1]}), d = gelu_pk((f32x2){v1[2], v1[3]});
                        v0 = (f32x4){a.x, a.y, b.x, b.y}; v1 = (f32x4){c.x, c.y, d.x, d.y}; }
                    v0 = v0 * sc; v1 = v1 * sc; u32x4 w; w.x = cvt_pk_bf16(v0[0], v0[1]); w.y = cvt_pk_bf16(v0[2], v0[3]); w.z = cvt_pk_bf16(v1[0], v1[1]); w.w = cvt_pk_bf16(v1[2], v1[3]);
                    *(u32x4*)(rowp + bj * HALF) = w; } }
    }
};
template <class Epi, class Sched, bool ALIGN_EPI = false, bool SP2 = false>
__device__ __forceinline__ void gemm_phase(PG8_LAS unsigned char* lds, const Gemm g, const Sched& S, const Epi& E) {
    const int tid = opaque_tid(), wid = __builtin_amdgcn_readfirstlane(tid >> 6), lane = tid & 63, wr = wid >> 2, wc = wid & 3, fr = lane & 15, fq = lane >> 4;
    const int K = g.K, nt = K / BK;
    unsigned voffA[2], voffB[2];
#pragma unroll
    for (int i = 0; i < 2; ++i) { int R, C; stage_rc(tid * 16 + i * 8192, R, C); const int Rb = Epi::PERM ? ((R & ~31) + perm32(R & 31)) : R;
        voffA[i] = (unsigned)(R * K + C) * 2u; voffB[i] = (unsigned)(Rb * K + C) * 2u; }
    const size_t kstep = (size_t)(BK * 2);
    const size_t hstep = (size_t)HALF * K * 2;
    const size_t tstep = 2 * hstep;
    const unsigned ldsw = (unsigned)wid * 1024u;
    const int aoff = lds_byte(wr * 64 + fr, fq * 8), boff = lds_byte(wc * 32 + fr, fq * 8);
#define PG8_SA(b, h) (((b) * 2 + (h)) * HTB)
#define PG8_SB(b, h) ((4 + (b) * 2 + (h)) * HTB)
#define PG8_STAGE(bufoff, gbase, voff) do { _Pragma("unroll") for (int _i = 0; _i < 2; ++_i) \
        __builtin_amdgcn_global_load_lds((const unsigned*)((const char*)(gbase) + (voff)[_i]), (PG8_LAS unsigned*)(lds + (bufoff) + ldsw + _i * 8192), 16, 0, 0); } while (0)
#define PG8_LDA(dst, b, h) do { _Pragma("unroll") for (int m = 0; m < 4; ++m) _Pragma("unroll") for (int k = 0; k < 2; ++k) dst[m][k] = *(const PG8_LAS bf16x8*)(lds + PG8_SA(b, h) + aoff + m * 2048 + k * 1024); } while (0)
#define PG8_LDB(dst, b, h) do { _Pragma("unroll") for (int n = 0; n < 2; ++n) _Pragma("unroll") for (int k = 0; k < 2; ++k) dst[n][k] = *(const PG8_LAS bf16x8*)(lds + PG8_SB(b, h) + boff + n * 2048 + k * 1024); } while (0)
#define PG8_MMA(ai, bj, At, Bt) do { __builtin_amdgcn_s_setprio(1); _Pragma("unroll") for (int m = 0; m < 4; ++m) _Pragma("unroll") for (int n = 0; n < 2; ++n) _Pragma("unroll") for (int k = 0; k < 2; ++k) \
        acc[ai][bj][m][n] = __builtin_amdgcn_mfma_f32_16x16x32_bf16(Bt[n][k], At[m][k], acc[ai][bj][m][n], 0, 0, 0); __builtin_amdgcn_s_setprio(0); } while (0)
#define PG8_WAIT_V(n) asm volatile("s_waitcnt vmcnt(" #n ")" ::: "memory")
#define PG8_WAIT_L(n) asm volatile("s_waitcnt lgkmcnt(" #n ")" ::: "memory")
#define PG8_BAR __builtin_amdgcn_s_barrier()
#define PG8_SCHED __builtin_amdgcn_sched_barrier(0)
    Unit cur, nxt; int ui = 0;
    if (!S.next(0, cur)) return;
    f32x4 acc[2][2][4][2];
#pragma unroll
    for (int a = 0; a < 2; ++a)
#pragma unroll
        for (int b = 0; b < 2; ++b)
#pragma unroll
            for (int m = 0; m < 4; ++m)
#pragma unroll
                for (int n = 0; n < 2; ++n) acc[a][b][m][n] = (f32x4){0.f, 0.f, 0.f, 0.f};
    bf16x8 At[4][2], B0[2][2], B1[2][2];
    const char* cA = (const char*)g.A + (size_t)cur.pm * tstep; const char* cB = (const char*)g.Bt + (size_t)cur.pn * tstep;
    S.a_ready(cur);
    if constexpr (SP2) {
        PG8_STAGE(PG8_SB(0, 0), cB, voffB); PG8_STAGE(PG8_SB(0, 1), cB + hstep, voffB); PG8_STAGE(PG8_SA(0, 0), cA, voffA); PG8_STAGE(PG8_SA(0, 1), cA + hstep, voffA);
        if (wr == 1) PG8_BAR;
        PG8_WAIT_V(2); PG8_BAR;
        PG8_STAGE(PG8_SB(1, 0), cB + kstep, voffB); PG8_STAGE(PG8_SA(1, 0), cA + kstep, voffA); PG8_STAGE(PG8_SB(1, 1), cB + hstep + kstep, voffB);
        PG8_WAIT_V(6); PG8_BAR;
    } else {
        PG8_STAGE(PG8_SB(0, 0), cB, voffB); PG8_STAGE(PG8_SA(0, 0), cA, voffA); PG8_STAGE(PG8_SB(0, 1), cB + hstep, voffB); PG8_STAGE(PG8_SA(0, 1), cA + hstep, voffA);
        if (wr == 1) PG8_BAR;
        PG8_WAIT_V(4); PG8_BAR;
        PG8_STAGE(PG8_SB(1, 0), cB + kstep, voffB); PG8_STAGE(PG8_SA(1, 0), cA + kstep, voffA); PG8_STAGE(PG8_SB(1, 1), cB + hstep + kstep, voffB);
        PG8_WAIT_V(6); PG8_BAR;
    }
    for (;;) {
        const bool has_next = S.next(ui + 1, nxt);
        const char* nA = has_next ? (const char*)g.A + (size_t)nxt.pm * tstep : cA; const char* nB = has_next ? (const char*)g.Bt + (size_t)nxt.pn * tstep : cB;
        for (int t = 0; t < nt; t += 2) {
            const bool last = (t == nt - 2);
            const char* a1 = cA + (size_t)(t + 1) * kstep;
            const char* a2 = last ? nA : cA + (size_t)(t + 2) * kstep; const char* b2 = last ? nB : cB + (size_t)(t + 2) * kstep;
            const char* a3 = a2 + kstep; const char* b3 = b2 + kstep;
            if (last && has_next) S.a_ready(nxt);
            if constexpr (SP2) {
            PG8_LDB(B0, 0, 0); PG8_LDB(B1, 0, 1); PG8_SCHED; PG8_LDA(At, 0, 0); PG8_STAGE(PG8_SA(1, 1), a1 + hstep, voffA);
            PG8_WAIT_V(8); PG8_WAIT_L(0); PG8_BAR; PG8_MMA(0, 0, At, B0); PG8_MMA(0, 1, At, B1); PG8_BAR; PG8_SCHED;
            PG8_LDA(At, 0, 1); PG8_STAGE(PG8_SB(0, 0), b2, voffB); PG8_STAGE(PG8_SB(0, 1), b2 + hstep, voffB); PG8_STAGE(PG8_SA(0, 0), a2, voffA);
            PG8_WAIT_V(8); PG8_WAIT_L(0); PG8_BAR; PG8_MMA(1, 0, At, B0); PG8_MMA(1, 1, At, B1); PG8_BAR; PG8_SCHED;
            PG8_LDB(B0, 1, 0); PG8_LDB(B1, 1, 1); PG8_SCHED; PG8_LDA(At, 1, 0); PG8_STAGE(PG8_SA(0, 1), a2 + hstep, voffA);
            PG8_WAIT_V(8); PG8_WAIT_L(0); PG8_BAR; PG8_MMA(0, 0, At, B0); PG8_MMA(0, 1, At, B1); PG8_BAR; PG8_SCHED;
            PG8_LDA(At, 1, 1); PG8_STAGE(PG8_SB(1, 0), b3, voffB); PG8_STAGE(PG8_SB(1, 1), b3 + hstep, voffB); PG8_STAGE(PG8_SA(1, 0), a3, voffA);
            PG8_WAIT_V(8); PG8_WAIT_L(0); PG8_BAR; PG8_MMA(1, 0, At, B0); PG8_MMA(1, 1, At, B1); PG8_BAR; PG8_SCHED;
            } else {
            PG8_LDB(B0, 0, 0); PG8_SCHED; PG8_LDA(At, 0, 0); PG8_STAGE(PG8_SA(1, 1), a1 + hstep, voffA);
            PG8_WAIT_L(8); PG8_BAR; PG8_WAIT_L(0); PG8_MMA(0, 0, At, B0); PG8_BAR; PG8_SCHED;
            PG8_LDB(B1, 0, 1); PG8_STAGE(PG8_SB(0, 0), b2, voffB);
            PG8_BAR; PG8_WAIT_L(0); PG8_MMA(0, 1, At, B1); PG8_BAR;
            PG8_LDA(At, 0, 1); PG8_STAGE(PG8_SA(0, 0), a2, voffA);
            PG8_BAR; PG8_WAIT_L(0); PG8_MMA(1, 0, At, B0); PG8_BAR; PG8_SCHED;
            PG8_STAGE(PG8_SB(0, 1), b2 + hstep, voffB);
            PG8_WAIT_V(6); PG8_BAR; PG8_MMA(1, 1, At, B1); PG8_BAR;
            PG8_LDB(B0, 1, 0); PG8_SCHED; PG8_LDA(At, 1, 0); PG8_STAGE(PG8_SA(0, 1), a2 + hstep, voffA);
            PG8_WAIT_L(8); PG8_BAR; PG8_WAIT_L(0); PG8_MMA(0, 0, At, B0); PG8_BAR; PG8_SCHED;
            PG8_LDB(B1, 1, 1); PG8_STAGE(PG8_SB(1, 0), b3, voffB);
            PG8_BAR; PG8_WAIT_L(0); PG8_MMA(0, 1, At, B1); PG8_BAR;
            PG8_LDA(At, 1, 1); PG8_STAGE(PG8_SA(1, 0), a3, voffA);
            PG8_BAR; PG8_WAIT_L(0); PG8_MMA(1, 0, At, B0); PG8_BAR; PG8_SCHED;
            PG8_STAGE(PG8_SB(1, 1), b3 + hstep, voffB);
            PG8_WAIT_V(6); PG8_BAR; PG8_MMA(1, 1, At, B1); PG8_BAR;
            }
        }
        if constexpr (ALIGN_EPI) { if (wr == 0) PG8_BAR; }
        if constexpr (!Epi::AFTER_DRAIN) { E(acc, cur, wr, wc, fr, fq); S.done(cur); }
        if (!has_next) break;
#pragma unroll
        for (int a = 0; a < 2; ++a)
#pragma unroll
            for (int b = 0; b < 2; ++b)
#pragma unroll
                for (int m = 0; m < 4; ++m)
#pragma unroll
                    for (int n = 0; n < 2; ++n) acc[a][b][m][n] = (f32x4){0.f, 0.f, 0.f, 0.f};
        cur = nxt; cA = nA; cB = nB; ++ui;
        if constexpr (ALIGN_EPI) { if (wr == 1) PG8_BAR; }
    }
    PG8_WAIT_V(0);
    if constexpr (!ALIGN_EPI) { if (wr == 0) PG8_BAR; }
    PG8_BAR;
    if constexpr (Epi::AFTER_DRAIN) { E.fused(acc, cur, wr, wc, fr, fq, lds, wid, lane); S.done(cur); }
#undef PG8_SA
#undef PG8_SB
#undef PG8_STAGE
#undef PG8_LDA
#undef PG8_LDB
#undef PG8_MMA
#undef PG8_WAIT_V
#undef PG8_WAIT_L
#undef PG8_BAR
#undef PG8_SCHED
}
}

#include <hip/hip_cooperative_groups.h>
namespace cg = cooperative_groups;

#define DI __device__ __forceinline__
#define LAS __attribute__((address_space(3)))
typedef unsigned short bf16_t;
typedef short bf16x8 __attribute__((ext_vector_type(8)));
typedef float f32x4 __attribute__((ext_vector_type(4)));
typedef float f32x2 __attribute__((ext_vector_type(2)));
typedef float f32x16 __attribute__((ext_vector_type(16)));
typedef unsigned u32x4 __attribute__((ext_vector_type(4)));
typedef unsigned u32x2 __attribute__((ext_vector_type(2)));
typedef __bf16 bf16v2 __attribute__((ext_vector_type(2)));

#define MFMA32(a, b, c) __builtin_amdgcn_mfma_f32_32x32x16_bf16((a), (b), (c), 0, 0, 0)
#define MFMA16(a, b, c) __builtin_amdgcn_mfma_f32_16x16x32_bf16((a), (b), (c), 0, 0, 0)
#define LDS_WAIT() asm volatile("s_waitcnt lgkmcnt(0)" ::: "memory")

constexpr int NB = 2, S = 16384, D = 2048, M = NB * S, NLAYER = 2;
constexpr int NPROJ = 3120, NP = 3328;
constexpr int C_QA = 0, C_QB = 1024, C_KC = 2048, C_VC = 2176, C_KS = 2304, C_VS = 2432, C_KW = 2560, C_VW = 2688, C_KB = 2816, C_VB = 2944, C_GATE = 3072;
constexpr int NCP = 1024;
constexpr int NEXP = 16384;
constexpr float NEGF = -1e30f;

constexpr size_t MiB = 1u << 20;
constexpr size_t WS_WIN = 0;
constexpr size_t WS_WOUT = 28 * MiB;
constexpr size_t WS_WQ = 46 * MiB;
constexpr size_t WS_CW1 = 64 * MiB;
constexpr size_t WS_SUBK = 67 * MiB;
constexpr size_t WS_KC = 68 * MiB;
constexpr size_t WS_VCT = 69 * MiB;
constexpr size_t WS_VST = 70 * MiB;
constexpr size_t WS_VWT = 78 * MiB;
constexpr size_t WS_VBT = 86 * MiB;
constexpr size_t WS_IDX = 96 * MiB;
constexpr size_t WS_GATE = 112 * MiB;
constexpr size_t WS_GSUM = 94 * MiB;
constexpr size_t WS_U = 128 * MiB;
constexpr size_t WS_V = 256 * MiB;
constexpr size_t WS_KSF = 192 * MiB, WS_KWF = 200 * MiB, WS_KBF = 208 * MiB;
constexpr size_t WS_KMAX = 95 * MiB + 65536;
constexpr size_t WS_XN = 384 * MiB;
constexpr size_t WS_O = 512 * MiB;
constexpr size_t WS_Q2 = 640 * MiB;
constexpr size_t WS_P = 768 * MiB;
constexpr size_t WS_END = 1000 * MiB;

constexpr int LDS_BYTES = 139264;
constexpr int NTHREADS = 512;

struct Args {
    const float* x; const float* attn_norm; const float* w_in; const float* cmp_pos_k; const float* cmp_w1_k; const float* cmp_w2_k;
    const float* cmp_pos_v; const float* cmp_w1_v; const float* cmp_w2_v; const float* sinks; const float* w_out; const float* ffn_norm;
    const float* peer_wq; const float* peer_subkeys; const float* peer_u; const float* peer_v; const float* rel_bias; const float* final_norm;
    float* out; unsigned char* ws; int ph_lo, ph_hi;
};

DI unsigned f2bf(float f) { unsigned u = __builtin_bit_cast(unsigned, f); return (u + 0x7fffu + ((u >> 16) & 1u)) >> 16; }
DI unsigned pk2(float lo, float hi) { const f32x2 v = {lo, hi}; return __builtin_bit_cast(unsigned, __builtin_convertvector(v, bf16v2)); }
DI float bflo(unsigned w) { return __builtin_bit_cast(float, w << 16); }
DI float bfhi(unsigned w) { return __builtin_bit_cast(float, w & 0xffff0000u); }
DI float bf2f(bf16_t v) { return __builtin_bit_cast(float, (unsigned)v << 16); }
DI float wave_sum(float v) {
#pragma unroll
    for (int o = 1; o < 64; o <<= 1) v += __shfl_xor(v, o);
    return v;
}
DI float gelu_tanh(float x) {
    const float y = 0.7978845608028654f * (x + 0.044715f * x * x * x);
    const float t = __expf(2.f * y);
    const float th = 1.f - 2.f / (t + 1.f);
    return 0.5f * x * (1.f + th);
}
DI float sigmoidf_(float x) { return 1.f / (1.f + __expf(-x)); }
DI int crow(int r, int hi) { return (r & 3) + 8 * (r >> 2) + 4 * hi; }
DI int rel_bucket(int d) {
    const float lf = __log2f((float)(d < 1 ? 1 : d));
    int b = 16 + (int)((lf - 4.0f) * (16.0f / 7.0f));
    b = b > 31 ? 31 : b;
    return d < 16 ? d : b;
}
DI bf16x8 pack8(float a0, float a1, float a2, float a3, float a4, float a5, float a6, float a7) {
    u32x4 p; p.x = pk2(a0, a1); p.y = pk2(a2, a3); p.z = pk2(a4, a5); p.w = pk2(a6, a7);
    return __builtin_bit_cast(bf16x8, p);
}

DI int win_srccol(int n) {
    if (n < 1024) return n;
    if (n < 2048) return 1840 + (n - 1024);
    if (n < 2816) return 1024 + (n - 2048);
    if (n < 3072) return 2864 + (n - 2816);
    if (n < 3120) return 1792 + (n - 3072);
    return -1;
}
template <bool WIN>
DI void transpose_item(const float* W, int K, int Nsrc, bf16_t* WT, int k0, int n0, LAS float* scr, int lane) {
    const int nd = n0 + (lane & 31);
    const int ns = WIN ? win_srccol(nd) : nd;
#pragma unroll 8
    for (int i = 0; i < 32; ++i) { const int kk = 2 * i + (lane >> 5); scr[kk * 33 + (lane & 31)] = ns >= 0 ? W[(size_t)(k0 + kk) * Nsrc + ns] : 0.f; }
    LDS_WAIT();
    const int c = lane & 7;
#pragma unroll
    for (int j = 0; j < 4; ++j) { const int n = (lane >> 3) + 8 * j; const LAS float* s = scr + (8 * c) * 33 + n;
        u32x4 o; o.x = pk2(s[0 * 33], s[1 * 33]); o.y = pk2(s[2 * 33], s[3 * 33]); o.z = pk2(s[4 * 33], s[5 * 33]); o.w = pk2(s[6 * 33], s[7 * 33]);
        *(u32x4*)(WT + (size_t)(n0 + n) * K + k0 + 8 * c) = o; }
    LDS_WAIT();
}
template <bool WIN>
DI void transpose_matrix(const float* W, int K, int Nsrc, int Ndst, bf16_t* WT, LAS float* scr, int lane, int gw, int NGW) {
    const int nblk = Ndst / 32, nitems = (K / 64) * nblk;
    for (int it = gw; it < nitems; it += NGW) transpose_item<WIN>(W, K, Nsrc, WT, 64 * (it / nblk), 32 * (it % nblk), scr, lane);
}
DI void convert_rows(const float* src, bf16_t* dst, size_t n8, size_t gt, size_t ngt) {
    for (size_t i = gt; i < n8; i += ngt) {
        const f32x4 a = ((const f32x4*)src)[2 * i], b = ((const f32x4*)src)[2 * i + 1];
        u32x4 o; o.x = pk2(a.x, a.y); o.y = pk2(a.z, a.w); o.z = pk2(b.x, b.y); o.w = pk2(b.z, b.w);
        ((u32x4*)dst)[i] = o;
    }
}
constexpr float U_SCALE = 512.f, V_SCALE = 64.f;
DI void convert_rows_fp8(const float* src, unsigned char* dst, size_t n16, float scale, size_t gt, size_t ngt) {
    for (size_t i = gt; i < n16; i += ngt) {
        const f32x4 a = ((const f32x4*)src)[4 * i] * scale, b = ((const f32x4*)src)[4 * i + 1] * scale, c = ((const f32x4*)src)[4 * i + 2] * scale, d = ((const f32x4*)src)[4 * i + 3] * scale;
        u32x4 o;
        o.x = (unsigned)__builtin_amdgcn_cvt_pk_fp8_f32(a.z, a.w, __builtin_amdgcn_cvt_pk_fp8_f32(a.x, a.y, 0, false), true);
        o.y = (unsigned)__builtin_amdgcn_cvt_pk_fp8_f32(b.z, b.w, __builtin_amdgcn_cvt_pk_fp8_f32(b.x, b.y, 0, false), true);
        o.z = (unsigned)__builtin_amdgcn_cvt_pk_fp8_f32(c.z, c.w, __builtin_amdgcn_cvt_pk_fp8_f32(c.x, c.y, 0, false), true);
        o.w = (unsigned)__builtin_amdgcn_cvt_pk_fp8_f32(d.z, d.w, __builtin_amdgcn_cvt_pk_fp8_f32(d.x, d.y, 0, false), true);
        ((u32x4*)dst)[i] = o;
    }
}
DI void phase_prologue(const Args& a, LAS unsigned char* lds) {
    const int tid = opaque_tid(), lane = tid & 63, wave = tid >> 6;
    if (blockIdx.x == 0 && tid < 32) ((unsigned*)(a.ws + WS_KMAX))[tid] = 0u;
    const int gw = blockIdx.x * 8 + wave, NGW = gridDim.x * 8;
    LAS float* scr = (LAS float*)(lds + wave * 8448);
    unsigned char* ws = a.ws;
    for (int l = 0; l < NLAYER; ++l) {
        transpose_matrix<true>(a.w_in + (size_t)l * D * NPROJ, D, NPROJ, NP, (bf16_t*)(ws + WS_WIN) + (size_t)l * NP * D, scr, lane, gw, NGW);
        transpose_matrix<false>(a.w_out + (size_t)l * D * D, D, D, D, (bf16_t*)(ws + WS_WOUT) + (size_t)l * D * D, scr, lane, gw, NGW);
        transpose_matrix<false>(a.peer_wq + (size_t)l * D * D, D, D, D, (bf16_t*)(ws + WS_WQ) + (size_t)l * D * D, scr, lane, gw, NGW);
        transpose_matrix<false>(a.cmp_w1_k + (size_t)l * 2048 * 128, 2048, 128, 128, (bf16_t*)(ws + WS_CW1) + (size_t)(l * 2 + 0) * 128 * 2048, scr, lane, gw, NGW);
        transpose_matrix<false>(a.cmp_w1_v + (size_t)l * 2048 * 128, 2048, 128, 128, (bf16_t*)(ws + WS_CW1) + (size_t)(l * 2 + 1) * 128 * 2048, scr, lane, gw, NGW);
    }
    const size_t gt = (size_t)blockIdx.x * NTHREADS + tid, ngt = (size_t)gridDim.x * NTHREADS;
    convert_rows_fp8(a.peer_u, ws + WS_U, (size_t)NLAYER * NEXP * D / 16, U_SCALE, gt, ngt);
    convert_rows_fp8(a.peer_v, ws + WS_V, (size_t)NLAYER * NEXP * D / 16, V_SCALE, gt, ngt);
    convert_rows(a.peer_subkeys, (bf16_t*)(ws + WS_SUBK), (size_t)NLAYER * 2 * 128 * 128 / 8, gt, ngt);
}

DI void phase_rms_bf16(const float* X, const float* g, bf16_t* XN) {
    const int tid = opaque_tid(), lane = tid & 63, wave = tid >> 6;
    const int gw = blockIdx.x * 8 + wave, NGW = gridDim.x * 8;
    f32x4 gv[8];
#pragma unroll
    for (int j = 0; j < 8; ++j) gv[j] = ((const f32x4*)g)[lane + 64 * j];
    for (int m = gw; m < M; m += NGW) {
        const f32x4* xr = (const f32x4*)(X + (size_t)m * D);
        f32x4 v[8]; float s = 0.f;
#pragma unroll
        for (int j = 0; j < 8; ++j) { v[j] = xr[lane + 64 * j]; s += (v[j].x * v[j].x + v[j].y * v[j].y) + (v[j].z * v[j].z + v[j].w * v[j].w); }
        const float rstd = rsqrtf(wave_sum(s) * (1.f / D) + 1e-6f);
        u32x2* o8 = (u32x2*)(XN + (size_t)m * D);
#pragma unroll
        for (int j = 0; j < 8; ++j) { const f32x4 y = v[j] * rstd * gv[j]; u32x2 w; w.x = pk2(y.x, y.y); w.y = pk2(y.z, y.w); o8[lane + 64 * j] = w; }
    }
}
DI void phase_rms_final(float* X, const float* g) {
    const int tid = opaque_tid(), lane = tid & 63, wave = tid >> 6;
    const int gw = blockIdx.x * 8 + wave, NGW = gridDim.x * 8;
    f32x4 gv[8];
#pragma unroll
    for (int j = 0; j < 8; ++j) gv[j] = ((const f32x4*)g)[lane + 64 * j];
    for (int m = gw; m < M; m += NGW) {
        f32x4* xr = (f32x4*)(X + (size_t)m * D);
        f32x4 v[8]; float s = 0.f;
#pragma unroll
        for (int j = 0; j < 8; ++j) { v[j] = xr[lane + 64 * j]; s += (v[j].x * v[j].x + v[j].y * v[j].y) + (v[j].z * v[j].z + v[j].w * v[j].w); }
        const float rstd = rsqrtf(wave_sum(s) * (1.f / D) + 1e-6f);
#pragma unroll
        for (int j = 0; j < 8; ++j) xr[lane + 64 * j] = v[j] * rstd * gv[j];
    }
}

struct EpiResid {
    static constexpr bool PERM = false, AFTER_DRAIN = false;
    const float* base; float* out; int ldc;
    DI void operator()(const pg8::f32x4 (&acc)[2][2][4][2], const pg8::Unit& u, int wr, int wc, int fr, int fq) const {
        const int col0 = u.pn * pg8::BM + wc * 32 + 4 * fq;
#pragma unroll
        for (int ai = 0; ai < 2; ++ai)
#pragma unroll
            for (int m = 0; m < 4; ++m) {
                const size_t off = (size_t)(u.pm * pg8::BM + ai * pg8::HALF + wr * 64 + m * 16 + fr) * ldc + col0;
#pragma unroll
                for (int bj = 0; bj < 2; ++bj)
#pragma unroll
                    for (int n = 0; n < 2; ++n) { const size_t o = off + bj * pg8::HALF + n * 16; const pg8::f32x4 bs = *(const pg8::f32x4*)(base + o); *(pg8::f32x4*)(out + o) = bs + acc[ai][bj][m][n]; }
                asm volatile("" ::: "memory");
            }
    }
};

DI void phase_prep(const Args& a, int layer, LAS unsigned char* lds) {
    const int tid = opaque_tid(), lane = tid & 63, wave = tid >> 6;
    const int gw = blockIdx.x * 8 + wave, NGW = gridDim.x * 8;
    unsigned char* ws = a.ws;
    const bf16_t* P = (const bf16_t*)(ws + WS_P);
    {
        LAS bf16_t* scr = (LAS bf16_t*)(lds + wave * 9216);
        for (int it = gw; it < 6 * 4 * 256; it += NGW) {
            const int which = it / 1024, bg = (it / 256) & 3, st = it & 255, b = bg >> 1, g = bg & 1;
            if (which >= 3) {
                const int srccol = (which == 3 ? C_KS : which == 4 ? C_KW : C_KB) + g * 64;
                bf16_t* dst = (bf16_t*)(ws + (which == 3 ? WS_KSF : which == 4 ? WS_KWF : WS_KBF)) + (size_t)bg * 64 * S + (size_t)st * 4096;
                float rmax = 0.f;
#pragma unroll
                for (int i = 0; i < 8; ++i) { const int tok = i * 8 + (lane >> 3), q = lane & 7;
                    const u32x4 v = *(const u32x4*)(P + (size_t)(b * S + st * 64 + tok) * NP + srccol + q * 8);
                    const int pos = which == 3 ? (((tok >> 4) * 2 + (q >> 2)) * 64 + (q & 3) * 16 + (tok & 15))
                                               : ((tok >> 5) * 256 + (q >> 1) * 64 + (q & 1) * 32 + (tok & 31));
                    *(u32x4*)(dst + pos * 8) = v;
                    float ss = bflo(v.x) * bflo(v.x) + bfhi(v.x) * bfhi(v.x) + bflo(v.y) * bflo(v.y) + bfhi(v.y) * bfhi(v.y)
                             + bflo(v.z) * bflo(v.z) + bfhi(v.z) * bfhi(v.z) + bflo(v.w) * bflo(v.w) + bfhi(v.w) * bfhi(v.w);
                    ss += __shfl_xor(ss, 1); ss += __shfl_xor(ss, 2); ss += __shfl_xor(ss, 4);
                    rmax = fmaxf(rmax, ss); }
                rmax = fmaxf(rmax, __shfl_xor(rmax, 8)); rmax = fmaxf(rmax, __shfl_xor(rmax, 16)); rmax = fmaxf(rmax, __shfl_xor(rmax, 32));
                if (lane == 0) atomicMax((unsigned*)(ws + WS_KMAX) + (layer * 4 + (which - 3)) * 4 + bg, __builtin_bit_cast(unsigned, rmax));
                continue;
            }
            const int srccol = (which == 0 ? C_VS : which == 1 ? C_VW : C_VB) + g * 64;
            bf16_t* dst = (bf16_t*)(ws + (which == 0 ? WS_VST : which == 1 ? WS_VWT : WS_VBT)) + (size_t)bg * 64 * S + (size_t)st * 4096;
#pragma unroll
            for (int i = 0; i < 8; ++i) { const int tok = i * 8 + (lane >> 3), ch = lane & 7;
                const u32x4 v = *(const u32x4*)(P + (size_t)(b * S + st * 64 + tok) * NP + srccol + ch * 8);
                *(LAS u32x4*)(scr + tok * 72 + ch * 8) = v; }
            LDS_WAIT();
#pragma unroll
            for (int f = 0; f < 8; ++f) {
                int d, kb0, kstep;
                if (which == 0) { const int j = f >> 2, dt = f & 3, hh = lane & 15, qd = lane >> 4; d = 16 * dt + hh; kb0 = 16 * j + 4 * qd; kstep = 32; }
                else { const int tl = f >> 2, j = (f >> 1) & 1, dt = f & 1, c = lane & 31, hi = lane >> 5; d = dt * 32 + c; kb0 = tl * 32 + 16 * j + 4 * hi; kstep = 8; }
                unsigned e[8];
#pragma unroll
                for (int i = 0; i < 8; ++i) e[i] = scr[(kb0 + (i & 3) + kstep * (i >> 2)) * 72 + d];
                u32x4 o; o.x = e[0] | (e[1] << 16); o.y = e[2] | (e[3] << 16); o.z = e[4] | (e[5] << 16); o.w = e[6] | (e[7] << 16);
                *(u32x4*)(dst + (f * 64 + lane) * 8) = o;
            }
            LDS_WAIT();
        }
    }
    {
        const bf16_t* XN = (const bf16_t*)(ws + WS_XN);
        const bf16_t* wg = (const bf16_t*)(ws + WS_WIN) + (size_t)layer * NP * D + (size_t)C_GATE * D;
        bf16_t* Pw = (bf16_t*)(ws + WS_P);
        const int c = lane & 31, hi = lane >> 5;
        for (int it = NGW - 1 - gw; it < M / 32; it += NGW) {
            const bf16_t* ar = XN + (size_t)(it * 32 + c) * D + hi * 8;
            const bf16_t* b0 = wg + (size_t)c * D + hi * 8, *b1 = wg + (size_t)(32 + c) * D + hi * 8;
            f32x16 a0, a1;
#pragma unroll
            for (int r = 0; r < 16; ++r) { a0[r] = 0.f; a1[r] = 0.f; }
#pragma unroll 8
            for (int kk = 0; kk < 128; ++kk) {
                const bf16x8 af = *(const bf16x8*)(ar + kk * 16);
                a0 = MFMA32(af, *(const bf16x8*)(b0 + kk * 16), a0);
                a1 = MFMA32(af, *(const bf16x8*)(b1 + kk * 16), a1);
            }
#pragma unroll
            for (int r = 0; r < 16; ++r) {
                bf16_t* pr = Pw + (size_t)(it * 32 + crow(r, hi)) * NP + C_GATE;
                pr[c] = (bf16_t)f2bf(a0[r]);
                if (c < 16) pr[32 + c] = (bf16_t)f2bf(a1[r]);
            }
        }
    }
    __syncthreads();
    {
        LAS float* H = (LAS float*)lds;
        const int c = lane & 31, hi = lane >> 5, rg = wave >> 2, nt = wave & 3;
        for (int it = blockIdx.x; it < 128; it += gridDim.x) {
            const int kv = it >> 6, bg = (it >> 4) & 3, rt = it & 15, b = bg >> 1, g = bg & 1;
            const float* pos = (kv ? a.cmp_pos_v : a.cmp_pos_k) + (size_t)layer * 32 * 64;
            const bf16_t* w1t = (const bf16_t*)(ws + WS_CW1) + (size_t)(layer * 2 + kv) * 128 * 2048;
            const float* w2 = (kv ? a.cmp_w2_v : a.cmp_w2_k) + (size_t)layer * 128 * 64;
            int irow = rt * 64 + rg * 32 + c; irow = irow > 1022 ? 1022 : irow;
            const bf16_t* src = P + (size_t)(b * S + 16 * irow) * NP + (kv ? C_VC : C_KC) + g * 64;
            const bf16_t* bsrc = w1t + (size_t)(nt * 32 + c) * 2048 + hi * 8;
            f32x16 acc;
#pragma unroll
            for (int r = 0; r < 16; ++r) acc[r] = 0.f;
#pragma unroll 4
            for (int kk = 0; kk < 128; ++kk) {
                const int tok = kk >> 2, d = (kk & 3) * 16 + hi * 8;
                const u32x4 sv = *(const u32x4*)(src + (size_t)tok * NP + d);
                const f32x4 p0 = *(const f32x4*)(pos + tok * 64 + d), p1 = *(const f32x4*)(pos + tok * 64 + d + 4);
                const bf16x8 af = pack8(bflo(sv.x) + p0.x, bfhi(sv.x) + p0.y, bflo(sv.y) + p0.z, bfhi(sv.y) + p0.w,
                                        bflo(sv.z) + p1.x, bfhi(sv.z) + p1.y, bflo(sv.w) + p1.z, bfhi(sv.w) + p1.w);
                const bf16x8 bf = *(const bf16x8*)(bsrc + kk * 16);
                acc = MFMA32(af, bf, acc);
            }
#pragma unroll
            for (int r = 0; r < 16; ++r) H[(rg * 32 + crow(r, hi)) * 129 + nt * 32 + c] = gelu_tanh(acc[r]);
            __syncthreads();
            {
                const int i = tid >> 3, dc = (tid & 7) * 8;
                float o[8];
#pragma unroll
                for (int e = 0; e < 8; ++e) o[e] = 0.f;
                for (int n = 0; n < 128; ++n) {
                    const float hv = H[i * 129 + n];
                    const f32x4 wa = *(const f32x4*)(w2 + n * 64 + dc), wb = *(const f32x4*)(w2 + n * 64 + dc + 4);
                    o[0] += hv * wa.x; o[1] += hv * wa.y; o[2] += hv * wa.z; o[3] += hv * wa.w;
                    o[4] += hv * wb.x; o[5] += hv * wb.y; o[6] += hv * wb.z; o[7] += hv * wb.w;
                }
                const int ig = rt * 64 + i;
                if (ig > 1022) {
#pragma unroll
                    for (int e = 0; e < 8; ++e) o[e] = 0.f;
                }
                if (kv == 0) {
                    u32x4 w; w.x = pk2(o[0], o[1]); w.y = pk2(o[2], o[3]); w.z = pk2(o[4], o[5]); w.w = pk2(o[6], o[7]);
                    float ss = bflo(w.x) * bflo(w.x) + bfhi(w.x) * bfhi(w.x) + bflo(w.y) * bflo(w.y) + bfhi(w.y) * bfhi(w.y)
                             + bflo(w.z) * bflo(w.z) + bfhi(w.z) * bfhi(w.z) + bflo(w.w) * bflo(w.w) + bfhi(w.w) * bfhi(w.w);
                    ss += __shfl_xor(ss, 1); ss += __shfl_xor(ss, 2); ss += __shfl_xor(ss, 4);
                    ss = fmaxf(ss, __shfl_xor(ss, 8)); ss = fmaxf(ss, __shfl_xor(ss, 16)); ss = fmaxf(ss, __shfl_xor(ss, 32));
                    if (lane == 0) atomicMax((unsigned*)(ws + WS_KMAX) + (layer * 4 + 3) * 4 + bg, __builtin_bit_cast(unsigned, ss));
                    const int q = dc >> 3;
                    *(u32x4*)((bf16_t*)(ws + WS_KC) + (size_t)bg * NCP * 64 + (size_t)(ig >> 5) * 2048 + ((q >> 1) * 64 + (q & 1) * 32 + (ig & 31)) * 8) = w;
                } else {
                    const int kk5 = ig & 31, jj = kk5 >> 4, rem = kk5 & 15, hh1 = (rem >> 2) & 1, ii = (rem >> 3) * 4 + (rem & 3);
                    bf16_t* vt = (bf16_t*)(ws + WS_VCT) + (size_t)bg * 64 * NCP + (size_t)(ig >> 5) * 2048 + ii;
#pragma unroll
                    for (int e = 0; e < 8; ++e) { const int dd = dc + e; vt[((jj * 2 + (dd >> 5)) * 64 + hh1 * 32 + (dd & 31)) * 8] = (bf16_t)f2bf(o[e]); }
                }
            }
            __syncthreads();
        }
    }
}

constexpr float LOG2E = 1.4426950408889634f, SC2 = 0.125f * 1.4426950408889634f;
DI float ex2(float x) { return __builtin_amdgcn_exp2f(x); }
DI void loadK32(const bf16_t* kt, int lane, bf16x8 (&k)[4]) {
#pragma unroll
    for (int kk = 0; kk < 4; ++kk) k[kk] = *(const bf16x8*)(kt + (kk * 64 + lane) * 8);
}
DI f32x16 qk32r(const bf16x8 (&k)[4], const bf16x8 (&q)[4]) {
    f32x16 s;
#pragma unroll
    for (int r = 0; r < 16; ++r) s[r] = 0.f;
#pragma unroll
    for (int kk = 0; kk < 4; ++kk) s = MFMA32(k[kk], q[kk], s);
    return s;
}
DI void loadV32(const bf16_t* vt, int lane, bf16x8 (&v)[2][2]) {
#pragma unroll
    for (int j = 0; j < 2; ++j)
#pragma unroll
        for (int dt = 0; dt < 2; ++dt) v[j][dt] = *(const bf16x8*)(vt + ((j * 2 + dt) * 64 + lane) * 8);
}
DI void pv32r(const f32x16& p, const bf16x8 (&v)[2][2], f32x16& o0, f32x16& o1) {
#pragma unroll
    for (int j = 0; j < 2; ++j) {
        const bf16x8 pb = pack8(p[8 * j], p[8 * j + 1], p[8 * j + 2], p[8 * j + 3], p[8 * j + 4], p[8 * j + 5], p[8 * j + 6], p[8 * j + 7]);
        o0 = MFMA32(v[j][0], pb, o0);
        o1 = MFMA32(v[j][1], pb, o1);
    }
}
template <bool MASKED>
DI bool softmax32(f32x16& s, unsigned vm, float& m, float& l, float& alpha) {
    float sum = 0.f;
#pragma unroll
    for (int r = 0; r < 16; ++r) { float p = ex2(s[r] - m); if (MASKED) p = ((vm >> r) & 1u) ? p : 0.f; s[r] = p; sum += p; }
    l += sum; alpha = 1.f;
    return false;
}
DI float sumsq8(const bf16x8 v) { const u32x4 w = __builtin_bit_cast(u32x4, v);
    return bflo(w.x) * bflo(w.x) + bfhi(w.x) * bfhi(w.x) + bflo(w.y) * bflo(w.y) + bfhi(w.y) * bfhi(w.y) + bflo(w.z) * bflo(w.z) + bfhi(w.z) * bfhi(w.z) + bflo(w.w) * bflo(w.w) + bfhi(w.w) * bfhi(w.w); }
DI unsigned logits_cmp(f32x16& s, int key0, int qpos, int hi, const LAS float* bias_h) {
    unsigned vm = 0u;
#pragma unroll
    for (int r = 0; r < 16; ++r) {
        const int dist = qpos - (16 * (key0 + crow(r, hi)) + 31);
        const bool valid = dist >= 0;
        const float bb = bias_h[rel_bucket(dist < 0 ? 0 : dist)];
        s[r] = valid ? s[r] * SC2 + bb : NEGF;
        vm |= valid ? (1u << r) : 0u;
    }
    return vm;
}

constexpr int AW_IMP = 0, AW_OLDS = 4128, AW_SEL = 4128 + 8320, AW_NSEL = AW_SEL + 256, AW_BYTES = 12800;
constexpr int ATT_BIAS_OFF = 8 * AW_BYTES;
constexpr int LUTW_STRIDE = 612, LUTB_STRIDE = 228;
constexpr int ATT_LUTW_OFF = ATT_BIAS_OFF + 4096, ATT_LUTB_OFF = ATT_LUTW_OFF + 8 * LUTW_STRIDE * 4, ATT_LDS_END = ATT_LUTB_OFF + 8 * LUTB_STRIDE * 4;
static_assert(ATT_LDS_END <= LDS_BYTES, "attention LDS map");

template <int W>
DI void window_branch(const bf16_t* Kf  , const bf16_t* Vf  , int lane,
                      const bf16x8 (&qf)[4], const LAS float* lut_h  , int q0, int qpos, int c, int hi,
                      float& m, float& l, f32x16& o0, f32x16& o1) {
    const int kd = q0 & ~31;
    int kstart = q0 - (W - 1); kstart = kstart < 0 ? 0 : kstart; kstart &= ~31;
    bf16x8 kc[4];
    loadK32(Kf + (size_t)(kd >> 5) * 2048, lane, kc);
    const float sini = -m * (1.f / SC2);
#pragma unroll 1
    for (int key0 = kd; key0 >= kstart; key0 -= 32) {
        bf16x8 vf[2][2], kn[4];
        loadV32(Vf + (size_t)(key0 >> 5) * 2048, lane, vf);
        const int nk = key0 - 32 >= kstart ? key0 - 32 : key0;
        loadK32(Kf + (size_t)(nk >> 5) * 2048, lane, kn);
        f32x16 s;
#pragma unroll
        for (int r = 0; r < 16; ++r) s[r] = sini;
#pragma unroll
        for (int kk = 0; kk < 4; ++kk) s = MFMA32(kc[kk], qf[kk], s);
        const LAS float* pt = lut_h + (qpos - key0 - 4 * hi - 27);
        float sum = 0.f;
#pragma unroll
        for (int r = 0; r < 16; ++r) { const float p = ex2(s[r] * SC2 + pt[27 - ((r & 3) + 8 * (r >> 2))]); s[r] = p; sum += p; }
        l += sum;
        pv32r(s, vf, o0, o1);
#pragma unroll
        for (int kk = 0; kk < 4; ++kk) kc[kk] = kn[kk];
    }
}

DI void phase_attn(const Args& a, int layer, LAS unsigned char* lds) {
    const int tid = opaque_tid(), lane = tid & 63, wave = tid >> 6;
    unsigned char* ws = a.ws;
    const bf16_t* P = (const bf16_t*)(ws + WS_P);
    bf16_t* O = (bf16_t*)(ws + WS_O);
    const int bg = blockIdx.x & 3, b = bg >> 1, g = bg & 1, wq = blockIdx.x >> 2, nwq = gridDim.x >> 2;
    LAS float* bias = (LAS float*)(lds + ATT_BIAS_OFF);
    LAS float* lutW = (LAS float*)(lds + ATT_LUTW_OFF);
    LAS float* lutB = (LAS float*)(lds + ATT_LUTB_OFF);
    for (int i = tid; i < 1024; i += NTHREADS) bias[i] = a.rel_bias[(i & 31) * 32 + (i >> 5)] * LOG2E;
    for (int i = tid; i < 8 * LUTW_STRIDE; i += NTHREADS) { const int hh = i / LUTW_STRIDE, dist = i % LUTW_STRIDE - 32;
        lutW[i] = (dist >= 0 && dist < 512) ? a.rel_bias[rel_bucket(dist) * 32 + g * 8 + hh] * LOG2E : NEGF; }
    for (int i = tid; i < 8 * LUTB_STRIDE; i += NTHREADS) { const int hh = i / LUTB_STRIDE, dist = i % LUTB_STRIDE - 32;
        lutB[i] = (dist >= 0 && dist < 128) ? a.rel_bias[rel_bucket(dist) * 32 + 16 + g * 8 + hh] * LOG2E : NEGF; }
    __syncthreads();
    LAS unsigned char* wl = lds + wave * AW_BYTES;
    LAS float* imp = (LAS float*)(wl + AW_IMP);
    LAS float* olds = (LAS float*)(wl + AW_OLDS);
    LAS int* sel = (LAS int*)(wl + AW_SEL);
    LAS int* nsel = (LAS int*)(wl + AW_NSEL);
    const int c = lane & 31, hi = lane >> 5, ql = c >> 3, h = c & 7;
    const bf16_t* Pb = P + (size_t)b * S * NP;
    const bf16_t* kcb = (const bf16_t*)(ws + WS_KC) + (size_t)bg * NCP * 64;
    const bf16_t* vct = (const bf16_t*)(ws + WS_VCT) + (size_t)bg * 64 * NCP;
    const bf16_t* vst = (const bf16_t*)(ws + WS_VST) + (size_t)bg * 64 * S;
    const bf16_t* vwt = (const bf16_t*)(ws + WS_VWT) + (size_t)bg * 64 * S;
    const bf16_t* kwf = (const bf16_t*)(ws + WS_KWF) + (size_t)bg * 64 * S;
    const bf16_t* kbf = (const bf16_t*)(ws + WS_KBF) + (size_t)bg * 64 * S;
    const bf16_t* ksf = (const bf16_t*)(ws + WS_KSF) + (size_t)bg * 64 * S;
    const bf16_t* vbt = (const bf16_t*)(ws + WS_VBT) + (size_t)bg * 64 * S;
    const float sinkv = a.sinks[layer * 16 + g * 8 + h] * LOG2E;
    const LAS float* bias_a = bias + (g * 8 + h) * 32;
    const float b31 = bias_a[31];
    const unsigned* kmx = (const unsigned*)(ws + WS_KMAX) + layer * 16 + bg;
    const float knS = sqrtf(__builtin_bit_cast(float, kmx[0])) * SC2, knW = sqrtf(__builtin_bit_cast(float, kmx[4])) * SC2;
    const float knB = sqrtf(__builtin_bit_cast(float, kmx[8])) * SC2, knC = sqrtf(__builtin_bit_cast(float, kmx[12])) * SC2;
    float bmaxA = bias_a[0], bmaxB = bias[(16 + g * 8 + h) * 32];
    for (int k = 1; k < 32; ++k) { bmaxA = fmaxf(bmaxA, bias_a[k]); bmaxB = fmaxf(bmaxB, bias[(16 + g * 8 + h) * 32 + k]); }
    bmaxA += 0.01f; bmaxB += 0.01f;

#pragma unroll 1
    for (int qt0 = wq; qt0 < S / 32 && wq < nwq; qt0 += nwq) {
        const int rnd = qt0 / nwq, qt32 = ((rnd & 1) && (rnd + 1) * nwq <= S / 32) ? rnd * nwq + (nwq - 1 - wq) : qt0;
        const int q0 = qt32 * 32 + wave * 4;
        const int qpos = q0 + ql;
        const size_t mrow = (size_t)(b * S + qpos);
        const bf16_t* prow = P + mrow * NP;
        {
            bf16x8 qf[4];
#pragma unroll
            for (int kk = 0; kk < 4; ++kk) qf[kk] = *(const bf16x8*)(prow + C_QB + (g * 8 + h) * 64 + kk * 16 + hi * 8);
            float qn2 = sumsq8(qf[0]) + sumsq8(qf[1]) + sumsq8(qf[2]) + sumsq8(qf[3]); qn2 += __shfl_xor(qn2, 32);
            float m = sqrtf(qn2) * knB + bmaxB, l = hi == 0 ? ex2(sinkv - m) : 0.f;
            f32x16 o0, o1;
#pragma unroll
            for (int r = 0; r < 16; ++r) { o0[r] = 0.f; o1[r] = 0.f; }
            window_branch<128>(kbf, vbt, lane, qf, lutB + h * LUTB_STRIDE + 32, q0, qpos, c, hi, m, l, o0, o1);
            const float lt = l + __shfl_xor(l, 32), inv = 1.f / lt;
            bf16_t* orow = O + mrow * D + 1024 + (g * 8 + h) * 64;
#pragma unroll
            for (int dt = 0; dt < 2; ++dt)
#pragma unroll
                for (int q4 = 0; q4 < 4; ++q4) {
                    const f32x16& oo = dt ? o1 : o0;
                    u32x2 w; w.x = pk2(oo[4 * q4] * inv, oo[4 * q4 + 1] * inv); w.y = pk2(oo[4 * q4 + 2] * inv, oo[4 * q4 + 3] * inv);
                    *(u32x2*)(orow + dt * 32 + 8 * q4 + 4 * hi) = w;
                }
        }
        const float gt0 = sigmoidf_(bf2f(prow[C_GATE + (g * 8 + h) * 3 + 0]));
        bf16x8 qfa[4];
#pragma unroll
        for (int kk = 0; kk < 4; ++kk) qfa[kk] = *(const bf16x8*)(prow + C_QA + (g * 8 + h) * 64 + kk * 16 + hi * 8);
        float qnA; { float qn2 = sumsq8(qfa[0]) + sumsq8(qfa[1]) + sumsq8(qfa[2]) + sumsq8(qfa[3]); qn2 += __shfl_xor(qn2, 32); qnA = sqrtf(qn2); }
        for (int i = lane; i < 4 * 257; i += 64) imp[i] = 0.f;
        const int ntile = (q0 + 3) / 512 + 1;
        const int nfast = q0 >= 2040 ? (q0 - 2040) / 512 + 1 : 0;
        {
            float m = qnA * knC + bmaxA, l = 0.f;
            {
                bf16x8 kc[4];
                loadK32(kcb, lane, kc);
#pragma unroll 1
                for (int t = 0; t < ntile; ++t) {
                    bf16x8 kn[4];
                    const int tn = t + 1 < ntile ? t + 1 : t;
                    loadK32(kcb + (size_t)tn * 2048, lane, kn);
                    f32x16 s = qk32r(kc, qfa);
                    float alpha;
                    if (t < nfast) {
#pragma unroll
                        for (int r = 0; r < 16; ++r) s[r] = s[r] * SC2 + b31;
                        (void)softmax32<false>(s, 0u, m, l, alpha);
                    } else {
                        const unsigned vm = logits_cmp(s, t * 32, qpos, hi, bias_a);
                        (void)softmax32<true>(s, vm, m, l, alpha);
                    }
#pragma unroll
                    for (int kk = 0; kk < 4; ++kk) kc[kk] = kn[kk];
                }
            }
            const float lt = l + __shfl_xor(l, 32), inv = lt > 0.f ? 1.f / lt : 0.f;
            f32x16 o0, o1;
#pragma unroll
            for (int r = 0; r < 16; ++r) { o0[r] = 0.f; o1[r] = 0.f; }
            LDS_WAIT();
            bf16x8 kc[4];
            loadK32(kcb, lane, kc);
#pragma unroll 1
            for (int t = 0; t < ntile; ++t) {
                bf16x8 vf[2][2], kn[4];
                loadV32(vct + (size_t)t * 2048, lane, vf);
                const int tn = t + 1 < ntile ? t + 1 : t;
                loadK32(kcb + (size_t)tn * 2048, lane, kn);
                f32x16 s = qk32r(kc, qfa);
                if (t < nfast) {
#pragma unroll
                    for (int r = 0; r < 16; ++r) s[r] = ex2(s[r] * SC2 + (b31 - m)) * inv;
                } else {
                    const unsigned vm = logits_cmp(s, t * 32, qpos, hi, bias_a);
#pragma unroll
                    for (int r = 0; r < 16; ++r) s[r] = ((vm >> r) & 1u) ? ex2(s[r] - m) * inv : 0.f;
                }
#pragma unroll
                for (int grp = 0; grp < 4; ++grp) {
                    float wa = 2.f * (s[4 * grp] + s[4 * grp + 1] + s[4 * grp + 2]) + s[4 * grp + 3], wb = s[4 * grp + 3];
                    wa += __shfl_xor(wa, 1); wb += __shfl_xor(wb, 1);
                    wa += __shfl_xor(wa, 2); wb += __shfl_xor(wb, 2);
                    wa += __shfl_xor(wa, 4); wb += __shfl_xor(wb, 4);
                    const int j = t * 8 + 2 * grp + hi;
                    if (h == 0) {
                        (void)__hip_atomic_fetch_add(imp + ql * 257 + j, wa, __ATOMIC_RELAXED, __HIP_MEMORY_SCOPE_WORKGROUP);
                        (void)__hip_atomic_fetch_add(imp + ql * 257 + j + 1, wb, __ATOMIC_RELAXED, __HIP_MEMORY_SCOPE_WORKGROUP);
                    }
                }
                pv32r(s, vf, o0, o1);
#pragma unroll
                for (int kk = 0; kk < 4; ++kk) kc[kk] = kn[kk];
            }
#pragma unroll
            for (int r = 0; r < 16; ++r) { olds[c * 65 + crow(r, hi)] = gt0 * o0[r]; olds[c * 65 + 32 + crow(r, hi)] = gt0 * o1[r]; }
        }
        LDS_WAIT();
        {
            const int tq = lane >> 4, sub = lane & 15;
            const int qp = q0 + tq, cb = qp >> 6;
            float v[16];
#pragma unroll
            for (int i = 0; i < 16; ++i) { const int j = sub + 16 * i; v[i] = (j >= 1 && j <= cb - 2) ? imp[tq * 257 + j] : -1.f; }
            int n = (cb < 2 ? cb : 2) + 1;
            if (sub == 0) {
                sel[tq * 16 + 0] = 0;
                if (cb >= 1) sel[tq * 16 + n - 1] = cb;
                if (cb >= 2) sel[tq * 16 + 1] = cb - 1;
            }
#pragma unroll 1
            for (int k = 0; k < 13; ++k) {
                float bv = v[0]; int bj = sub;
#pragma unroll
                for (int i = 1; i < 16; ++i) { if (v[i] > bv) { bv = v[i]; bj = sub + 16 * i; } }
#pragma unroll
                for (int off = 1; off < 16; off <<= 1) {
                    const float ov = __shfl_xor(bv, off); const int oj = __shfl_xor(bj, off);
                    if (ov > bv || (ov == bv && oj < bj)) { bv = ov; bj = oj; }
                }
                if (bv >= 0.f) {
                    if (sub == 0) sel[tq * 16 + n] = bj;
                    n += 1;
#pragma unroll
                    for (int i = 0; i < 16; ++i) { if (bj == sub + 16 * i) v[i] = -1.f; }
                }
            }
            if (sub == 0) nsel[tq] = n;
        }
        LDS_WAIT();
        {
            const int hh = lane & 15, qd = lane >> 4, hd = hh & 7;
            const LAS float* bias_s = bias + (g * 8 + hd) * 32;
            const float b31s = bias_s[31];

#pragma unroll 1
            for (int qi = 0; qi < 4; ++qi) {
                const int qp = q0 + qi;
                const bf16_t* pr = Pb + (size_t)qp * NP;
                bf16x8 qf[2];
#pragma unroll
                for (int kk = 0; kk < 2; ++kk) qf[kk] = *(const bf16x8*)(pr + C_QA + (g * 8 + hd) * 64 + kk * 32 + qd * 8);
                float qs2 = sumsq8(qf[0]) + sumsq8(qf[1]); qs2 += __shfl_xor(qs2, 16); qs2 += __shfl_xor(qs2, 32);
                const float m = sqrtf(qs2) * knS + bmaxA; float l = 0.f;
                const bool lowc = hh < 8;
                const bf16x8 zero8 = {0, 0, 0, 0, 0, 0, 0, 0};
                bf16x8 qlo[2], qhi[2];
#pragma unroll
                for (int kk = 0; kk < 2; ++kk) { qlo[kk] = lowc ? qf[kk] : zero8; qhi[kk] = lowc ? zero8 : qf[kk]; }
                const int hs = hh >> 3;
                f32x4 o[4];
#pragma unroll
                for (int dt = 0; dt < 4; ++dt) o[dt] = (f32x4){0.f, 0.f, 0.f, 0.f};
                const int ns = __builtin_amdgcn_readfirstlane(nsel[qi]);
                int jb = __builtin_amdgcn_readfirstlane(sel[qi * 16]);
                bf16x8 ka[4][2];
#pragma unroll
                for (int t = 0; t < 4; ++t)
#pragma unroll
                    for (int kk = 0; kk < 2; ++kk) ka[t][kk] = *(const bf16x8*)(ksf + (size_t)jb * 4096 + ((t * 2 + kk) * 64 + lane) * 8);
#pragma unroll 1
                for (int k = 0; k < ns; ++k) {
                    bf16x8 va[2][4], kn[4][2];
#pragma unroll
                    for (int j = 0; j < 2; ++j)
#pragma unroll
                        for (int dt = 0; dt < 4; ++dt) va[j][dt] = *(const bf16x8*)(vst + (size_t)jb * 4096 + ((j * 4 + dt) * 64 + lane) * 8);
                    const int jn = __builtin_amdgcn_readfirstlane(sel[qi * 16 + (k + 1 < ns ? k + 1 : k)]);
#pragma unroll
                    for (int t = 0; t < 4; ++t)
#pragma unroll
                        for (int kk = 0; kk < 2; ++kk) kn[t][kk] = *(const bf16x8*)(ksf + (size_t)jn * 4096 + ((t * 2 + kk) * 64 + lane) * 8);
                    f32x4 s[2];
#pragma unroll
                    for (int u = 0; u < 2; ++u) {
                        s[u] = (f32x4){0.f, 0.f, 0.f, 0.f};
#pragma unroll
                        for (int kk = 0; kk < 2; ++kk) { s[u] = MFMA16(ka[2 * u][kk], qlo[kk], s[u]); s[u] = MFMA16(ka[2 * u + 1][kk], qhi[kk], s[u]); }
                    }
                    if (qp - (jb * 64 + 63) >= 1513) {
                        const float cst = b31s - m;
#pragma unroll
                        for (int u = 0; u < 2; ++u)
#pragma unroll
                            for (int r = 0; r < 4; ++r) s[u][r] = s[u][r] * SC2 + cst;
                    } else {
#pragma unroll
                        for (int u = 0; u < 2; ++u)
#pragma unroll
                            for (int r = 0; r < 4; ++r) {
                                const int dist = qp - (jb * 64 + 16 * (2 * u + hs) + 4 * qd + r);
                                const float bb = bias_s[rel_bucket(dist < 0 ? 0 : dist)];
                                s[u][r] = dist >= 0 ? s[u][r] * SC2 + (bb - m) : NEGF;
                            }
                    }
                    float sum = 0.f;
#pragma unroll
                    for (int u = 0; u < 2; ++u)
#pragma unroll
                        for (int r = 0; r < 4; ++r) { const float p = ex2(s[u][r]); s[u][r] = p; sum += p; }
                    l += sum;
                    {
                        const bf16x8 p8 = pack8(s[0][0], s[0][1], s[0][2], s[0][3], s[1][0], s[1][1], s[1][2], s[1][3]);
                        const bf16x8 plo = lowc ? p8 : zero8, phi = lowc ? zero8 : p8;
#pragma unroll
                        for (int dt = 0; dt < 4; ++dt) { o[dt] = MFMA16(va[0][dt], plo, o[dt]); o[dt] = MFMA16(va[1][dt], phi, o[dt]); }
                    }
                    jb = jn;
#pragma unroll
                    for (int t = 0; t < 4; ++t)
#pragma unroll
                        for (int kk = 0; kk < 2; ++kk) ka[t][kk] = kn[t][kk];
                }
                float lt = l + __shfl_xor(l, 16); lt += __shfl_xor(lt, 32); lt += __shfl_xor(lt, 8);
#pragma unroll
                for (int dt = 0; dt < 4; ++dt)
#pragma unroll
                    for (int r = 0; r < 4; ++r) o[dt][r] += __shfl_xor(o[dt][r], 8);
                const float gt1 = sigmoidf_(bf2f(Pb[(size_t)qp * NP + C_GATE + (g * 8 + hd) * 3 + 1]));
                const float inv = lt > 0.f ? gt1 / lt : 0.f;
                if (hh < 8) {
#pragma unroll
                    for (int dt = 0; dt < 4; ++dt)
#pragma unroll
                        for (int r = 0; r < 4; ++r) olds[(qi * 8 + hh) * 65 + 16 * dt + 4 * qd + r] += o[dt][r] * inv;
                }
            }
        }
        LDS_WAIT();
        {
            int lw = lane; asm volatile("" : "+v"(lw));
            const int c = lw & 31, hi = lw >> 5, h = c & 7, qpos = q0 + (c >> 3);
            const size_t mrow = (size_t)(b * S + qpos);
            const bf16_t* prow = P + mrow * NP;
            const float gt2 = sigmoidf_(bf2f(prow[C_GATE + (g * 8 + h) * 3 + 2]));
            bf16x8 qfw[4];
#pragma unroll
            for (int kk = 0; kk < 4; ++kk) qfw[kk] = *(const bf16x8*)(prow + C_QA + (g * 8 + h) * 64 + kk * 16 + hi * 8);
            float qnW; { float qn2 = sumsq8(qfw[0]) + sumsq8(qfw[1]) + sumsq8(qfw[2]) + sumsq8(qfw[3]); qn2 += __shfl_xor(qn2, 32); qnW = sqrtf(qn2); }
            float m = qnW * knW + bmaxA, l = 0.f;
            f32x16 o0, o1;
#pragma unroll
            for (int r = 0; r < 16; ++r) { o0[r] = 0.f; o1[r] = 0.f; }
            window_branch<512>(kwf, vwt, lw, qfw, lutW + h * LUTW_STRIDE + 32, q0, qpos, c, hi, m, l, o0, o1);
            const float lt = l + __shfl_xor(l, 32), inv = lt > 0.f ? gt2 / lt : 0.f;
            bf16_t* orow = O + mrow * D + (g * 8 + h) * 64;
#pragma unroll
            for (int dt = 0; dt < 2; ++dt)
#pragma unroll
                for (int q4 = 0; q4 < 4; ++q4) {
                    const f32x16& oo = dt ? o1 : o0;
                    const int d0 = dt * 32 + 8 * q4 + 4 * hi;
                    const float e0 = oo[4 * q4] * inv + olds[c * 65 + d0], e1 = oo[4 * q4 + 1] * inv + olds[c * 65 + d0 + 1];
                    const float e2 = oo[4 * q4 + 2] * inv + olds[c * 65 + d0 + 2], e3 = oo[4 * q4 + 3] * inv + olds[c * 65 + d0 + 3];
                    u32x2 w; w.x = pk2(e0, e1); w.y = pk2(e2, e3);
                    *(u32x2*)(orow + d0) = w;
                }
        }
        LDS_WAIT();
    }
}

DI unsigned ordf(float f) { const unsigned u = __builtin_bit_cast(unsigned, f); return (u & 0x80000000u) ? ~u : (u | 0x80000000u); }
DI float unordf(unsigned k) { const unsigned u = (k & 0x80000000u) ? (k & 0x7fffffffu) : ~k; return __builtin_bit_cast(float, u); }

DI void peer_half_topk(const bf16_t* qrow  , const bf16_t* subk  , int hi, int lane, LAS unsigned* ltop) {
    unsigned keys[64];
    asm volatile("" : "+v"(subk));
#pragma unroll
    for (int rt = 0; rt < 4; ++rt) {
        f32x16 acc;
#pragma unroll
        for (int r = 0; r < 16; ++r) acc[r] = 0.f;
#pragma unroll
        for (int kk = 0; kk < 8; ++kk) {
            const bf16x8 af = *(const bf16x8*)(subk + (size_t)(rt * 32) * 128 + kk * 16);
            const bf16x8 bf = *(const bf16x8*)(qrow + kk * 16);
            acc = MFMA32(af, bf, acc);
        }
#pragma unroll
        for (int r = 0; r < 16; ++r) { const int n = rt * 32 + crow(r, hi); keys[rt * 16 + r] = (ordf(acc[r]) & ~0x7Fu) | (unsigned)(127 - n); }
    }
#pragma unroll 1
    for (int k = 0; k < 16; ++k) {
        unsigned mx = keys[0];
#pragma unroll
        for (int i = 1; i < 64; ++i) mx = mx > keys[i] ? mx : keys[i];
        const unsigned om = (unsigned)__shfl_xor((int)mx, 32);
        mx = mx > om ? mx : om;
        ltop[k * 64 + lane] = mx;
#pragma unroll
        for (int i = 0; i < 64; ++i) keys[i] = keys[i] == mx ? 0u : keys[i];
    }
}

DI void phase_peer_select(const Args& a, int layer, LAS unsigned char* lds) {
    const int tid = opaque_tid(), lane = tid & 63, wave = tid >> 6;
    const int gw = blockIdx.x * 8 + wave, NGW = gridDim.x * 8;
    unsigned char* ws = a.ws;
    const bf16_t* Q2 = (const bf16_t*)(ws + WS_Q2);
    const bf16_t* subk = (const bf16_t*)(ws + WS_SUBK) + (size_t)layer * 2 * 128 * 128;
    int* IDX = (int*)(ws + WS_IDX);
    float* GATE = (float*)(ws + WS_GATE);
    LAS unsigned* lt1 = (LAS unsigned*)(lds + wave * 8192);
    LAS unsigned* lt2 = lt1 + 1024;
    const int c = lane & 31, hi = lane >> 5, tl = c >> 3, h = c & 7;
#pragma unroll 1
    for (int unit = gw; unit < M / 4; unit += NGW) {
        const size_t m = (size_t)unit * 4 + tl;
        const bf16_t* qrow = Q2 + m * D + h * 256 + hi * 8;
        peer_half_topk(qrow, subk + (size_t)c * 128 + hi * 8, hi, lane, lt1);
        peer_half_topk(qrow + 128, subk + 128 * 128 + (size_t)c * 128 + hi * 8, hi, lane, lt2);
        LDS_WAIT();
        unsigned t1[16], t2[16];
#pragma unroll
        for (int i = 0; i < 16; ++i) { t1[i] = lt1[i * 64 + lane]; t2[i] = lt2[i * 64 + lane]; }
        unsigned ck[16][16];
#pragma unroll
        for (int x = 0; x < 16; ++x)
#pragma unroll
            for (int y = 0; y < 16; ++y)
                if ((x + 1) * (y + 1) <= 16) ck[x][y] = (ordf(unordf(t1[x] & ~0x7Fu) + unordf(t2[y] & ~0x7Fu)) & ~0xFFu) | (unsigned)(255 - (x * 16 + y));
        const float scmax = unordf(ck[0][0] & ~0xFFu);
        int* ip = IDX + m * 128 + h * 16; float* gp = GATE + m * 128 + h * 16;
        float sum = 0.f;
#pragma unroll 1
        for (int k = 0; k < 16; ++k) {
            unsigned mx = 0u;
#pragma unroll
            for (int x = 0; x < 16; ++x)
#pragma unroll
                for (int y = 0; y < 16; ++y)
                    if ((x + 1) * (y + 1) <= 16) mx = mx > ck[x][y] ? mx : ck[x][y];
#pragma unroll
            for (int x = 0; x < 16; ++x)
#pragma unroll
                for (int y = 0; y < 16; ++y)
                    if ((x + 1) * (y + 1) <= 16) ck[x][y] = ck[x][y] == mx ? 0u : ck[x][y];
            const int ci = 255 - (int)(mx & 0xFFu);
            const int e = (int)(127u - (lt1[(ci >> 4) * 64 + lane] & 0x7Fu)) * 128 + (int)(127u - (lt2[(ci & 15) * 64 + lane] & 0x7Fu));
            const float ek = __expf(unordf(mx & ~0xFFu) - scmax);
            sum += ek;
            if (hi == 0) { ip[k] = e; gp[k] = ek; }
        }
        if (hi == 0) ((float*)(ws + WS_GSUM))[m * 8 + h] = 1.f / sum;
        LDS_WAIT();
    }
}

#define FP8_LO(w) __builtin_amdgcn_cvt_pk_f32_fp8((int)(w), false)
#define FP8_HI(w) __builtin_amdgcn_cvt_pk_f32_fp8((int)(w), true)
DI float dot16(const float (&x)[32], int o, const u32x4 w) {
    const f32x2 a0 = FP8_LO(w.x), a1 = FP8_HI(w.x), a2 = FP8_LO(w.y), a3 = FP8_HI(w.y), a4 = FP8_LO(w.z), a5 = FP8_HI(w.z), a6 = FP8_LO(w.w), a7 = FP8_HI(w.w);
    return (x[o + 0] * a0.x + x[o + 1] * a0.y + x[o + 2] * a1.x + x[o + 3] * a1.y) + (x[o + 4] * a2.x + x[o + 5] * a2.y + x[o + 6] * a3.x + x[o + 7] * a3.y)
         + (x[o + 8] * a4.x + x[o + 9] * a4.y + x[o + 10] * a5.x + x[o + 11] * a5.y) + (x[o + 12] * a6.x + x[o + 13] * a6.y + x[o + 14] * a7.x + x[o + 15] * a7.y);
}
DI float dot16p(const u32x4 xa, const u32x4 xb, const u32x4 w) {
    const f32x2 a0 = FP8_LO(w.x), a1 = FP8_HI(w.x), a2 = FP8_LO(w.y), a3 = FP8_HI(w.y), a4 = FP8_LO(w.z), a5 = FP8_HI(w.z), a6 = FP8_LO(w.w), a7 = FP8_HI(w.w);
    return (bflo(xa.x) * a0.x + bfhi(xa.x) * a0.y + bflo(xa.y) * a1.x + bfhi(xa.y) * a1.y) + (bflo(xa.z) * a2.x + bfhi(xa.z) * a2.y + bflo(xa.w) * a3.x + bfhi(xa.w) * a3.y)
         + (bflo(xb.x) * a4.x + bfhi(xb.x) * a4.y + bflo(xb.y) * a5.x + bfhi(xb.y) * a5.y) + (bflo(xb.z) * a6.x + bfhi(xb.z) * a6.y + bflo(xb.w) * a7.x + bfhi(xb.w) * a7.y);
}
DI void axpy16(float (&acc)[32], int o, float g, const u32x4 w) {
    const f32x2 a0 = FP8_LO(w.x), a1 = FP8_HI(w.x), a2 = FP8_LO(w.y), a3 = FP8_HI(w.y), a4 = FP8_LO(w.z), a5 = FP8_HI(w.z), a6 = FP8_LO(w.w), a7 = FP8_HI(w.w);
    acc[o + 0] += g * a0.x; acc[o + 1] += g * a0.y; acc[o + 2] += g * a1.x; acc[o + 3] += g * a1.y; acc[o + 4] += g * a2.x; acc[o + 5] += g * a2.y; acc[o + 6] += g * a3.x; acc[o + 7] += g * a3.y;
    acc[o + 8] += g * a4.x; acc[o + 9] += g * a4.y; acc[o + 10] += g * a5.x; acc[o + 11] += g * a5.y; acc[o + 12] += g * a6.x; acc[o + 13] += g * a6.y; acc[o + 14] += g * a7.x; acc[o + 15] += g * a7.y;
}
DI void phase_peer_gather(const Args& a, int layer) {
    const int tid = opaque_tid(), lane = tid & 63, wave = tid >> 6;
    const int gw = blockIdx.x * 8 + wave, NGW = gridDim.x * 8;
    unsigned char* ws = a.ws;
    const bf16_t* XN = (const bf16_t*)(ws + WS_XN);
    const unsigned char* U = ws + WS_U + (size_t)layer * NEXP * D;
    const unsigned char* V = ws + WS_V + (size_t)layer * NEXP * D;
    const unsigned lo16 = (unsigned)lane * 16u;
    const int* IDX = (const int*)(ws + WS_IDX);
    const float* GATE = (const float*)(ws + WS_GATE);
    const float* GSUM = (const float*)(ws + WS_GSUM);
#pragma unroll 1
    for (int m = gw; m < M; m += NGW) {
        u32x4 xp[4];
#pragma unroll
        for (int q = 0; q < 4; ++q) xp[q] = *(const u32x4*)(XN + (size_t)m * D + (q >> 1) * 1024 + lane * 16 + (q & 1) * 8);
        float acc[32];
#pragma unroll
        for (int i = 0; i < 32; ++i) acc[i] = 0.f;
        const int idA = IDX[(size_t)m * 128 + lane], idB = IDX[(size_t)m * 128 + 64 + lane];
        const float glA = GATE[(size_t)m * 128 + lane] * GSUM[(size_t)m * 8 + (lane >> 4)] * (1.f / V_SCALE);
        const float glB = GATE[(size_t)m * 128 + 64 + lane] * GSUM[(size_t)m * 8 + 4 + (lane >> 4)] * (1.f / V_SCALE);
        u32x4 cur[8];
#pragma unroll
        for (int j = 0; j < 4; ++j) { const unsigned of = (unsigned)__shfl(idA, j) * (unsigned)D + lo16; cur[2 * j] = *(const u32x4*)(U + of); cur[2 * j + 1] = *(const u32x4*)(U + of + 1024u); }
#pragma unroll 1
        for (int half = 0; half < 2; ++half) {
            const int idl = half ? idB : idA;
            const float gl = half ? glB : glA;
            float ghl = 0.f;
#pragma unroll 1
            for (int g4 = 0; g4 < 16; ++g4) {
                u32x4 nxt[8];
                { const unsigned char* base = g4 < 15 ? U : V; const int e0n = g4 < 15 ? (g4 + 1) * 4 : 0;
#pragma unroll
                  for (int j = 0; j < 4; ++j) { const unsigned of = (unsigned)__shfl(idl, e0n + j) * (unsigned)D + lo16; nxt[2 * j] = *(const u32x4*)(base + of); nxt[2 * j + 1] = *(const u32x4*)(base + of + 1024u); } }
                const float d0 = dot16p(xp[0], xp[1], cur[0]) + dot16p(xp[2], xp[3], cur[1]); __builtin_amdgcn_sched_barrier(0);
                const float d1 = dot16p(xp[0], xp[1], cur[2]) + dot16p(xp[2], xp[3], cur[3]); __builtin_amdgcn_sched_barrier(0);
                const float d2 = dot16p(xp[0], xp[1], cur[4]) + dot16p(xp[2], xp[3], cur[5]); __builtin_amdgcn_sched_barrier(0);
                const float d3 = dot16p(xp[0], xp[1], cur[6]) + dot16p(xp[2], xp[3], cur[7]); __builtin_amdgcn_sched_barrier(0);
                const bool p1 = lane & 1, p2 = lane & 2;
                const float b0 = (p1 ? d1 : d0) + __shfl_xor(p1 ? d0 : d1, 1);
                const float b1 = (p1 ? d3 : d2) + __shfl_xor(p1 ? d2 : d3, 1);
                float cs = (p2 ? b1 : b0) + __shfl_xor(p2 ? b0 : b1, 2);
                cs += __shfl_xor(cs, 4); cs += __shfl_xor(cs, 8); cs += __shfl_xor(cs, 16); cs += __shfl_xor(cs, 32);
                const float hv = gelu_tanh(cs * (1.f / U_SCALE));
                ghl = ((lane >> 2) == g4) ? hv * gl : ghl;
#pragma unroll
                for (int j = 0; j < 8; ++j) cur[j] = nxt[j];
            }
#pragma unroll 1
            for (int g4 = 0; g4 < 16; ++g4) {
                u32x4 nxt[8];
                { const unsigned char* base = g4 < 15 ? V : U; const int e0n = g4 < 15 ? (g4 + 1) * 4 : 0; const int ids = g4 < 15 ? idl : idB;
#pragma unroll
                  for (int j = 0; j < 4; ++j) { const unsigned of = (unsigned)__shfl(ids, e0n + j) * (unsigned)D + lo16; nxt[2 * j] = *(const u32x4*)(base + of); nxt[2 * j + 1] = *(const u32x4*)(base + of + 1024u); } }
#pragma unroll
                for (int j = 0; j < 4; ++j) { const float gv = __shfl(ghl, g4 * 4 + j); axpy16(acc, 0, gv, cur[2 * j]); axpy16(acc, 16, gv, cur[2 * j + 1]); __builtin_amdgcn_sched_barrier(0); }
#pragma unroll
                for (int j = 0; j < 8; ++j) cur[j] = nxt[j];
            }
        }
        float ss = 0.f;
#pragma unroll
        for (int q = 0; q < 4; ++q) {
            const f32x4* hp = (const f32x4*)(a.out + (size_t)m * D + (q >> 1) * 1024 + lane * 16 + (q & 1) * 8);
            const f32x4 h0 = hp[0], h1 = hp[1];
            acc[q * 8 + 0] += h0.x; acc[q * 8 + 1] += h0.y; acc[q * 8 + 2] += h0.z; acc[q * 8 + 3] += h0.w;
            acc[q * 8 + 4] += h1.x; acc[q * 8 + 5] += h1.y; acc[q * 8 + 6] += h1.z; acc[q * 8 + 7] += h1.w;
#pragma unroll
            for (int e = 0; e < 8; ++e) ss += acc[q * 8 + e] * acc[q * 8 + e];
            __builtin_amdgcn_sched_barrier(0);
        }
        const float rstd = rsqrtf(wave_sum(ss) * (1.f / D) + 1e-6f);
        const float* gn = layer + 1 < NLAYER ? a.attn_norm + (size_t)(layer + 1) * D : a.final_norm;
        asm volatile("" : "+s"(gn));
#pragma unroll
        for (int q = 0; q < 4; ++q) {
            const int col = (q >> 1) * 1024 + lane * 16 + (q & 1) * 8;
            const f32x4 g0 = *(const f32x4*)(gn + col), g1 = *(const f32x4*)(gn + col + 4);
            f32x4 h0, h1;
            h0.x = acc[q * 8 + 0]; h0.y = acc[q * 8 + 1]; h0.z = acc[q * 8 + 2]; h0.w = acc[q * 8 + 3];
            h1.x = acc[q * 8 + 4]; h1.y = acc[q * 8 + 5]; h1.z = acc[q * 8 + 6]; h1.w = acc[q * 8 + 7];
            const f32x4 y0 = h0 * rstd * g0, y1 = h1 * rstd * g1;
            f32x4* hp = (f32x4*)(a.out + (size_t)m * D + col);
            if (layer + 1 < NLAYER) {
                hp[0] = h0; hp[1] = h1;
                u32x4 w; w.x = pk2(y0.x, y0.y); w.y = pk2(y0.z, y0.w); w.z = pk2(y1.x, y1.y); w.w = pk2(y1.z, y1.w);
                *(u32x4*)((bf16_t*)(ws + WS_XN) + (size_t)m * D + col) = w;
            } else { hp[0] = y0; hp[1] = y1; }
            __builtin_amdgcn_sched_barrier(0);
        }
    }
}

constexpr size_t WS_BAR = 95 * MiB;
#define XB_TMO      128
#define XB_XCNT(j)  (256  + 64 * (j))
#define XB_XSUB(j)  (1280 + 64 * (j))
#define XB_XGEN(j)  (2304 + 64 * (j))
#define XB_TOP      3328
#define XB_TOPGEN   3392
#define XCD_BAR_WORDS 3456
#define XB_SPIN_CAP (1u << 18)

__device__ __forceinline__ unsigned xb_ld(unsigned* p)              { return __hip_atomic_load(p, __ATOMIC_RELAXED, __HIP_MEMORY_SCOPE_AGENT); }
__device__ __forceinline__ unsigned xb_add(unsigned* p, unsigned v) { return __hip_atomic_fetch_add(p, v, __ATOMIC_RELAXED, __HIP_MEMORY_SCOPE_AGENT); }
__device__ __forceinline__ unsigned xb_xcc_id() { return (unsigned)__builtin_amdgcn_s_getreg((3 << 11) | 20) & 0xFu; }
#define XB_SPIN(cond, bar) do { unsigned _sp = 0; while (cond) { __builtin_amdgcn_s_sleep(1); \
    if ((++_sp & 255u) == 0u) { if (xb_ld(&(bar)[XB_TMO])) break; if (_sp > XB_SPIN_CAP) { atomicAdd(&(bar)[XB_TMO], 1u); break; } } } } while (0)

struct XcdBarrier {
    unsigned* bar; unsigned x;
    volatile LAS unsigned* st;
};

__device__ __forceinline__ XcdBarrier xcd_barrier_post(unsigned* bar, volatile LAS unsigned* st) {
    XcdBarrier b; b.bar = bar; b.x = xb_xcc_id(); b.st = st;
    if (threadIdx.x == 0) (void)xb_add(&bar[XB_XCNT(b.x)], 1u);
    return b;
}
__device__ __forceinline__ void xcd_barrier_complete(unsigned* bar, unsigned x, unsigned& nloc, unsigned& nx) {
    const unsigned G = gridDim.x * gridDim.y * gridDim.z;
    unsigned sum, cnt, mine, sp = 0u;
    for (;;) {
        sum = 0u; cnt = 0u; mine = 0u;
#pragma unroll
        for (unsigned j = 0; j < 16; ++j) { const unsigned c = xb_ld(&bar[XB_XCNT(j)]); sum += c; cnt += (c > 0u) ? 1u : 0u; mine = (j == x) ? c : mine; }
        if (sum == G) break;
        __builtin_amdgcn_s_sleep(1);
        if ((++sp & 255u) == 0u) { if (xb_ld(&bar[XB_TMO])) break; if (sp > XB_SPIN_CAP) { atomicAdd(&bar[XB_TMO], 1u); break; } }
    }
    nloc = mine > 0u ? mine : 1u; nx = cnt > 0u ? cnt : 1u;
}

__device__ __forceinline__ void xcd_barrier(const XcdBarrier& b) {
    asm volatile("s_waitcnt vmcnt(0)" ::: "memory");
    __syncthreads();
    if (threadIdx.x == 0) {
        unsigned* bar = b.bar;
        __builtin_amdgcn_s_waitcnt(0);
        unsigned nloc = b.st[0], nx = b.st[1];
        if (nloc == 0u) { xcd_barrier_complete(bar, b.x, nloc, nx); b.st[0] = nloc; b.st[1] = nx; }
        const unsigned old = xb_add(&bar[XB_XSUB(b.x)], 1u);
        const unsigned gen = old / nloc;
        if (old + 1u == (gen + 1u) * nloc) {
            __builtin_amdgcn_fence(__ATOMIC_RELEASE, "agent");
            asm volatile("s_waitcnt vmcnt(0)" ::: "memory");
            const unsigned og = xb_add(&bar[XB_TOP], 1u);
            const unsigned tg = og / nx;
            if (og + 1u == (tg + 1u) * nx) xb_add(&bar[XB_TOPGEN], 1u);
            else XB_SPIN(xb_ld(&bar[XB_TOPGEN]) == tg, bar);
            __builtin_amdgcn_fence(__ATOMIC_ACQUIRE, "agent");
            xb_add(&bar[XB_XGEN(b.x)], 1u);
            asm volatile("s_waitcnt vmcnt(0)" ::: "memory");
        } else {
            XB_SPIN(xb_ld(&bar[XB_XGEN(b.x)]) == gen, bar);
            __builtin_amdgcn_fence(__ATOMIC_ACQUIRE, "agent");
            asm volatile("s_waitcnt vmcnt(0)" ::: "memory");
        }
    }
    __syncthreads();
}

constexpr int NPHASE = 20;
template <int KIND>
DI void run_phase(const Args& a, int layer, LAS unsigned char* lds) {
    unsigned char* ws = a.ws;
    if constexpr (KIND == 0) { phase_prologue(a, lds); phase_rms_bf16(a.x, a.attn_norm, (bf16_t*)(ws + WS_XN)); }
    if constexpr (KIND == 1) phase_rms_bf16(layer == 0 ? a.x : a.out, a.attn_norm + (size_t)layer * D, (bf16_t*)(ws + WS_XN));
    if constexpr (KIND == 2 || KIND == 7) {
        const bool inproj = KIND == 2;
        const int N = inproj ? C_GATE : D, ldw = inproj ? NP : D;
        pg8::Gemm g{(const bf16_t*)(ws + WS_XN), (const bf16_t*)(ws + (inproj ? WS_WIN : WS_WQ)) + (size_t)layer * ldw * D, M, N, D};
        pg8::StaticOrder So; So.init(M, N, (int)gridDim.x, (int)blockIdx.x);
        pg8::EpiBf16<0> E{(bf16_t*)(ws + (inproj ? WS_P : WS_Q2)), ldw, nullptr, 0, 0, 1.f};
        pg8::gemm_phase<pg8::EpiBf16<0>, pg8::StaticOrder, true, true>(lds, g, So, E);
    }
    if constexpr (KIND == 3) phase_prep(a, layer, lds);
    if constexpr (KIND == 4) phase_attn(a, layer, lds);
    if constexpr (KIND == 5) {
        pg8::Gemm g{(const bf16_t*)(ws + WS_O), (const bf16_t*)(ws + WS_WOUT) + (size_t)layer * D * D, M, D, D};
        pg8::StaticOrder So; So.init(M, D, (int)gridDim.x, (int)blockIdx.x);
        EpiResid E{layer == 0 ? a.x : a.out, a.out, D};
        pg8::gemm_phase<EpiResid, pg8::StaticOrder, true, true>(lds, g, So, E);
    }
    if constexpr (KIND == 6) phase_rms_bf16(a.out, a.ffn_norm + (size_t)layer * D, (bf16_t*)(ws + WS_XN));
    if constexpr (KIND == 8) phase_peer_select(a, layer, lds);
    if constexpr (KIND == 9) phase_peer_gather(a, layer);
    if constexpr (KIND == 10) phase_rms_final(a.out, a.final_norm);
}

#ifndef MK_PER_PHASE
#define MK_PER_PHASE 0
#endif

#if MK_PER_PHASE
template <int KIND>
__global__ void __launch_bounds__(NTHREADS, 2) k_phase(Args a, int layer) {
    extern __shared__ __attribute__((aligned(16))) unsigned char lds_raw[];
    run_phase<KIND>(a, layer, (LAS unsigned char*)lds_raw);
}
template <int KIND> static void launch_phase(const Args& a, int layer, int grid, hipStream_t stream) {
    static bool attr = false;
    if (!attr) { (void)hipFuncSetAttribute((const void*)k_phase<KIND>, hipFuncAttributeMaxDynamicSharedMemorySize, LDS_BYTES); attr = true; }
    hipLaunchKernelGGL(k_phase<KIND>, dim3(grid), dim3(NTHREADS), LDS_BYTES, stream, a, layer);
}
#else
__global__ void __launch_bounds__(NTHREADS, 2) hybrid_fwd(Args a) {
    extern __shared__ __attribute__((aligned(16))) unsigned char lds_raw[];
    LAS unsigned char* lds = (LAS unsigned char*)lds_raw;
    volatile LAS unsigned* bst = (volatile LAS unsigned*)(lds + LDS_BYTES - 16);
    if (threadIdx.x < 4) bst[threadIdx.x] = 0u;
    __syncthreads();
    const XcdBarrier xbar = xcd_barrier_post((unsigned*)(a.ws + WS_BAR), bst);
    bool first_seam = true;
#pragma unroll 1
    for (int ph = a.ph_lo; ph < a.ph_hi; ++ph) {
        if (ph == NPHASE - 1 || ph == 10 || ph == 1) continue;
        if (ph == 0) run_phase<0>(a, 0, lds);
        else if (ph == NPHASE - 1) run_phase<10>(a, 0, lds);
        else {
            const int layer = (ph - 1) / 9, k = (ph - 1) % 9;
            if (k == 0) run_phase<1>(a, layer, lds);
            else if (k == 1) run_phase<2>(a, layer, lds);
            else if (k == 2) run_phase<3>(a, layer, lds);
            else if (k == 3) run_phase<4>(a, layer, lds);
            else if (k == 4) run_phase<5>(a, layer, lds);
            else if (k == 5) run_phase<6>(a, layer, lds);
            else if (k == 6) run_phase<7>(a, layer, lds);
            else if (k == 7) run_phase<8>(a, layer, lds);
            else run_phase<9>(a, layer, lds);
        }
        if (ph + 1 < a.ph_hi) { if (first_seam) { cg::this_grid().sync(); first_seam = false; } else xcd_barrier(xbar); }
    }
}
#endif

extern "C" void kernel_launch(void* const* d_in, const int* in_sizes, int n_in, void* d_out, int out_size, void* d_ws, size_t ws_size, hipStream_t stream) {
    static int grid = 0;
    if (grid == 0) {
        if (n_in != 18 || out_size != M * D || ws_size < WS_END) { fprintf(stderr, "kernel_launch: unexpected shapes (n_in %d, out %d, ws %zu)\n", n_in, out_size, ws_size); grid = -1; return; }
        int dev = 0, cus = 0;
        if (hipGetDevice(&dev) != hipSuccess || hipDeviceGetAttribute(&cus, hipDeviceAttributeMultiprocessorCount, dev) != hipSuccess) { grid = -1; return; }
#if !MK_PER_PHASE
        if (hipFuncSetAttribute((const void*)hybrid_fwd, hipFuncAttributeMaxDynamicSharedMemorySize, LDS_BYTES) != hipSuccess) { fprintf(stderr, "kernel_launch: hipFuncSetAttribute failed\n"); grid = -1; return; }
        int per_cu = 0;
        if (hipOccupancyMaxActiveBlocksPerMultiprocessor(&per_cu, (const void*)hybrid_fwd, NTHREADS, LDS_BYTES) != hipSuccess || per_cu < 1) fprintf(stderr, "kernel_launch: occupancy query says %d\n", per_cu);
        (void)hipGetLastError();
#endif
        grid = cus;
    }
    if (grid < 0) return;
    Args a{};
    a.x = (const float*)d_in[0]; a.attn_norm = (const float*)d_in[1]; a.w_in = (const float*)d_in[2]; a.cmp_pos_k = (const float*)d_in[3];
    a.cmp_w1_k = (const float*)d_in[4]; a.cmp_w2_k = (const float*)d_in[5]; a.cmp_pos_v = (const float*)d_in[6]; a.cmp_w1_v = (const float*)d_in[7];
    a.cmp_w2_v = (const float*)d_in[8]; a.sinks = (const float*)d_in[9]; a.w_out = (const float*)d_in[10]; a.ffn_norm = (const float*)d_in[11];
    a.peer_wq = (const float*)d_in[12]; a.peer_subkeys = (const float*)d_in[13]; a.peer_u = (const float*)d_in[14]; a.peer_v = (const float*)d_in[15];
    a.rel_bias = (const float*)d_in[16]; a.final_norm = (const float*)d_in[17];
    a.out = (float*)d_out; a.ws = (unsigned char*)d_ws;
    a.ph_lo = 0; a.ph_hi = NPHASE;
#if MK_PER_PHASE
    launch_phase<0>(a, 0, grid, stream);
    for (int l = 0; l < NLAYER; ++l) {
        launch_phase<2>(a, l, grid, stream); launch_phase<3>(a, l, grid, stream);
        launch_phase<4>(a, l, grid, stream); launch_phase<5>(a, l, grid, stream); launch_phase<6>(a, l, grid, stream);
        launch_phase<7>(a, l, grid, stream); launch_phase<8>(a, l, grid, stream); launch_phase<9>(a, l, grid, stream);
    }
#else
    (void)hipMemsetAsync((unsigned char*)d_ws + WS_BAR, 0, 16384, stream);
    void* args[] = {&a};
    const hipError_t e = hipLaunchCooperativeKernel((const void*)hybrid_fwd, dim3(grid), dim3(NTHREADS), args, LDS_BYTES, stream);
    if (e != hipSuccess) fprintf(stderr, "kernel_launch: cooperative launch failed: %s (grid %d)\n", hipGetErrorString(e), grid);
#endif
}
```

```cpp
#include <hip/hip_runtime.h>
#include <cstdio>
#include <cstdint>
__device__ __forceinline__ int opaque_tid() { int t = threadIdx.x; asm volatile("" : "+v"(t)); return t; }
namespace pg8 {
#define PG8_LAS __attribute__((address_space(3)))
typedef unsigned short bf16_t;
typedef short bf16x8 __attribute__((ext_vector_type(8)));
typedef float f32x4 __attribute__((ext_vector_type(4)));
typedef unsigned u32x4 __attribute__((ext_vector_type(4)));
constexpr int BM = 256, BK = 64, HALF = 128, HTB = HALF * BK * 2  , STAGE_BYTES = 8 * HTB, NXCD = 8, WGM = 8;

__host__ __device__ __forceinline__ int lds_byte(int r, int c) { const int st = (r >> 4) * 2 + (c >> 5), rr = r & 15, cc = c & 31, ob = rr * 64 + cc * 2; return st * 1024 + (ob ^ (((ob >> 9) & 1) << 5)); }
__host__ __device__ __forceinline__ void stage_rc(int b, int& R, int& C) { const int st = b / 1024, sb = b % 1024, swz = sb ^ (((sb >> 9) & 1) << 5); R = (st >> 1) * 16 + swz / 64; C = (st & 1) * 32 + (swz % 64) / 2; }
__host__ __device__ __forceinline__ int perm32(int rho) { const int n = rho >> 4, i = rho & 15; return 8 * (i >> 2) + 4 * n + (i & 3); }

struct Unit { int pm, pn; };
struct Gemm { const bf16_t* A; const bf16_t* Bt; int M, N, K; };

struct StaticOrder {
    int nM, nN, nwg, G, c;
    __host__ __device__ void init(int M, int N, int G_, int c_) { nM = M / BM; nN = N / BM; nwg = nM * nN; G = G_; c = c_; }
    __host__ __device__ bool next(int i, Unit& u) const {
        const long L = (long)i * G + c; if (L >= nwg) return false;
        int wgid = (int)L; { const int q = nwg / NXCD, r = nwg % NXCD, xcd = wgid % NXCD, off = wgid / NXCD; wgid = (xcd < r ? xcd * (q + 1) : r * (q + 1) + (xcd - r) * q) + off; }
        const int nig = WGM * nN, gid = wgid / nig, fm = gid * WGM, gsz = (nM - fm) < WGM ? (nM - fm) : WGM;
        u.pm = fm + ((wgid % nig) % gsz); u.pn = (wgid % nig) / gsz; return true;
    }
    __device__ __forceinline__ void a_ready(const Unit&) const {}
    __device__ __forceinline__ void done(const Unit&) const {}
};

__device__ __forceinline__ unsigned cvt_pk_bf16(float lo, float hi) { unsigned r; asm volatile("v_cvt_pk_bf16_f32 %0, %1, %2" : "=v"(r) : "v"(lo), "v"(hi)); return r; }
typedef float f32x2 __attribute__((ext_vector_type(2)));
__device__ __forceinline__ f32x2 gelu_pk(f32x2 v) {
    const f32x2 av = __builtin_elementwise_abs(v), d = av * 0.2316418882f + 1.0f;
    f32x2 t; t.x = __builtin_amdgcn_rcpf(d.x); t.y = __builtin_amdgcn_rcpf(d.y);
    f32x2 q = t * 0.5307027145f + (-0.7265760135f); q = q * t + 0.7107068705f; q = q * t + (-0.142248368f); q = q * t + 0.127414796f; q = q * t;
    const f32x2 s = (v * v) * (-0.72134752044f);
    f32x2 e; e.x = __builtin_amdgcn_exp2f(s.x); e.y = __builtin_amdgcn_exp2f(s.y);
    const f32x2 m = v * (q * e), r = v - m;
    f32x2 o; o.x = v.x < 0.f ? m.x : r.x; o.y = v.y < 0.f ? m.y : r.y; return o;
}

template <int ACT  > struct EpiBf16 {
    static constexpr bool PERM = true, AFTER_DRAIN = false; static_assert(ACT == 0 || ACT == 1, "EpiBf16: ACT is 0 (none) or 1 (gelu_pk)");
    bf16_t* O; int ldc; const float* bias; int split_cols; size_t split_stride; float scale0;
    __device__ __forceinline__ void operator()(const f32x4 (&acc)[2][2][4][2], const Unit& u, int wr, int wc, int fr, int fq) const {
        const int row0 = u.pm * BM + wr * 64 + fr; int colt = u.pn * BM; bf16_t* base = O;
        float sc = 1.f; if (split_cols) { const int t = colt / split_cols; base += (size_t)t * split_stride; colt -= t * split_cols; if (t == 0) sc = scale0; }
        const int col0 = colt + wc * 32 + 8 * fq, bcol0 = u.pn * BM + wc * 32 + 8 * fq;
        f32x4 bv[2][2];
#pragma unroll
        for (int bj = 0; bj < 2; ++bj)
#pragma unroll
            for (int n = 0; n < 2; ++n) bv[bj][n] = bias ? *(const f32x4*)(bias + bcol0 + bj * HALF + 4 * n) : (f32x4){0.f, 0.f, 0.f, 0.f};
#pragma unroll
        for (int ai = 0; ai < 2; ++ai)
#pragma unroll
            for (int m = 0; m < 4; ++m) { bf16_t* rowp = base + (size_t)(row0 + ai * HALF + m * 16) * ldc + col0;
#pragma unroll
                for (int bj = 0; bj < 2; ++bj) { f32x4 v0 = acc[ai][bj][m][0] + bv[bj][0], v1 = acc[ai][bj][m][1] + bv[bj][1];
                    if (ACT == 1) { f32x2 a = gelu_pk((f32x2){v0[0], v0[1]}), b = gelu_pk((f32x2){v0[2], v0[3]}), c = gelu_pk((f32x2){v1[0], v1[1]}), d = gelu_pk((f32x2){v1[2], v1[3]});
                        v0 = (f32x4){a.x, a.y, b.x, b.y}; v1 = (f32x4){c.x, c.y, d.x, d.y}; }
                    v0 = v0 * sc; v1 = v1 * sc; u32x4 w; w.x = cvt_pk_bf16(v0[0], v0[1]); w.y = cvt_pk_bf16(v0[2], v0[3]); w.z = cvt_pk_bf16(v1[0], v1[1]); w.w = cvt_pk_bf16(v1[2], v1[3]);
                    *(u32x4*)(rowp + bj * HALF) = w; } }
    }
};
template <class Epi, class Sched, bool ALIGN_EPI = false, bool SP2 = false>
__device__ __forceinline__ void gemm_phase(PG8_LAS unsigned char* lds, const Gemm g, const Sched& S, const Epi& E) {
    const int tid = opaque_tid(), wid = __builtin_amdgcn_readfirstlane(tid >> 6), lane = tid & 63, wr = wid >> 2, wc = wid & 3, fr = lane & 15, fq = lane >> 4;
    const int K = g.K, nt = K / BK;
    unsigned voffA[2], voffB[2];
#pragma unroll
    for (int i = 0; i < 2; ++i) { int R, C; stage_rc(tid * 16 + i * 8192, R, C); const int Rb = Epi::PERM ? ((R & ~31) + perm32(R & 31)) : R;
        voffA[i] = (unsigned)(R * K + C) * 2u; voffB[i] = (unsigned)(Rb * K + C) * 2u; }
    const size_t kstep = (size_t)(BK * 2);
    const size_t hstep = (size_t)HALF * K * 2;
    const size_t tstep = 2 * hstep;
    const unsigned ldsw = (unsigned)wid * 1024u;
    const int aoff = lds_byte(wr * 64 + fr, fq * 8), boff = lds_byte(wc * 32 + fr, fq * 8);
#define PG8_SA(b, h) (((b) * 2 + (h)) * HTB)
#define PG8_SB(b, h) ((4 + (b) * 2 + (h)) * HTB)
#define PG8_STAGE(bufoff, gbase, voff) do { _Pragma("unroll") for (int _i = 0; _i < 2; ++_i) \
        __builtin_amdgcn_global_load_lds((const unsigned*)((const char*)(gbase) + (voff)[_i]), (PG8_LAS unsigned*)(lds + (bufoff) + ldsw + _i * 8192), 16, 0, 0); } while (0)
#define PG8_LDA(dst, b, h) do { _Pragma("unroll") for (int m = 0; m < 4; ++m) _Pragma("unroll") for (int k = 0; k < 2; ++k) dst[m][k] = *(const PG8_LAS bf16x8*)(lds + PG8_SA(b, h) + aoff + m * 2048 + k * 1024); } while (0)
#define PG8_LDB(dst, b, h) do { _Pragma("unroll") for (int n = 0; n < 2; ++n) _Pragma("unroll") for (int k = 0; k < 2; ++k) dst[n][k] = *(const PG8_LAS bf16x8*)(lds + PG8_SB(b, h) + boff + n * 2048 + k * 1024); } while (0)
#define PG8_MMA(ai, bj, At, Bt) do { __builtin_amdgcn_s_setprio(1); _Pragma("unroll") for (int m = 0; m < 4; ++m) _Pragma("unroll") for (int n = 0; n < 2; ++n) _Pragma("unroll") for (int k = 0; k < 2; ++k) \
        acc[ai][bj][m][n] = __builtin_amdgcn_mfma_f32_16x16x32_bf16(Bt[n][k], At[m][k], acc[ai][bj][m][n], 0, 0, 0); __builtin_amdgcn_s_setprio(0); } while (0)
#define PG8_WAIT_V(n) asm volatile("s_waitcnt vmcnt(" #n ")" ::: "memory")
#define PG8_WAIT_L(n) asm volatile("s_waitcnt lgkmcnt(" #n ")" ::: "memory")
#define PG8_BAR __builtin_amdgcn_s_barrier()
#define PG8_SCHED __builtin_amdgcn_sched_barrier(0)
    Unit cur, nxt; int ui = 0;
    if (!S.next(0, cur)) return;
    f32x4 acc[2][2][4][2];
#pragma unroll
    for (int a = 0; a < 2; ++a)
#pragma unroll
        for (int b = 0; b < 2; ++b)
#pragma unroll
            for (int m = 0; m < 4; ++m)
#pragma unroll
                for (int n = 0; n < 2; ++n) acc[a][b][m][n] = (f32x4){0.f, 0.f, 0.f, 0.f};
    bf16x8 At[4][2], B0[2][2], B1[2][2];
    const char* cA = (const char*)g.A + (size_t)cur.pm * tstep; const char* cB = (const char*)g.Bt + (size_t)cur.pn * tstep;
    S.a_ready(cur);
    if constexpr (SP2) {
        PG8_STAGE(PG8_SB(0, 0), cB, voffB); PG8_STAGE(PG8_SB(0, 1), cB + hstep, voffB); PG8_STAGE(PG8_SA(0, 0), cA, voffA); PG8_STAGE(PG8_SA(0, 1), cA + hstep, voffA);
        if (wr == 1) PG8_BAR;
        PG8_WAIT_V(2); PG8_BAR;
        PG8_STAGE(PG8_SB(1, 0), cB + kstep, voffB); PG8_STAGE(PG8_SA(1, 0), cA + kstep, voffA); PG8_STAGE(PG8_SB(1, 1), cB + hstep + kstep, voffB);
        PG8_WAIT_V(6); PG8_BAR;
    } else {
        PG8_STAGE(PG8_SB(0, 0), cB, voffB); PG8_STAGE(PG8_SA(0, 0), cA, voffA); PG8_STAGE(PG8_SB(0, 1), cB + hstep, voffB); PG8_STAGE(PG8_SA(0, 1), cA + hstep, voffA);
        if (wr == 1) PG8_BAR;
        PG8_WAIT_V(4); PG8_BAR;
        PG8_STAGE(PG8_SB(1, 0), cB + kstep, voffB); PG8_STAGE(PG8_SA(1, 0), cA + kstep, voffA); PG8_STAGE(PG8_SB(1, 1), cB + hstep + kstep, voffB);
        PG8_WAIT_V(6); PG8_BAR;
    }
    for (;;) {
        const bool has_next = S.next(ui + 1, nxt);
        const char* nA = has_next ? (const char*)g.A + (size_t)nxt.pm * tstep : cA; const char* nB = has_next ? (const char*)g.Bt + (size_t)nxt.pn * tstep : cB;
        for (int t = 0; t < nt; t += 2) {
            const bool last = (t == nt - 2);
            const char* a1 = cA + (size_t)(t + 1) * kstep;
            const char* a2 = last ? nA : cA + (size_t)(t + 2) * kstep; const char* b2 = last ? nB : cB + (size_t)(t + 2) * kstep;
            const char* a3 = a2 + kstep; const char* b3 = b2 + kstep;
            if (last && has_next) S.a_ready(nxt);
            if constexpr (SP2) {
            PG8_LDB(B0, 0, 0); PG8_LDB(B1, 0, 1); PG8_SCHED; PG8_LDA(At, 0, 0); PG8_STAGE(PG8_SA(1, 1), a1 + hstep, voffA);
            PG8_WAIT_V(8); PG8_WAIT_L(0); PG8_BAR; PG8_MMA(0, 0, At, B0); PG8_MMA(0, 1, At, B1); PG8_BAR; PG8_SCHED;
            PG8_LDA(At, 0, 1); PG8_STAGE(PG8_SB(0, 0), b2, voffB); PG8_STAGE(PG8_SB(0, 1), b2 + hstep, voffB); PG8_STAGE(PG8_SA(0, 0), a2, voffA);
            PG8_WAIT_V(8); PG8_WAIT_L(0); PG8_BAR; PG8_MMA(1, 0, At, B0); PG8_MMA(1, 1, At, B1); PG8_BAR; PG8_SCHED;
            PG8_LDB(B0, 1, 0); PG8_LDB(B1, 1, 1); PG8_SCHED; PG8_LDA(At, 1, 0); PG8_STAGE(PG8_SA(0, 1), a2 + hstep, voffA);
            PG8_WAIT_V(8); PG8_WAIT_L(0); PG8_BAR; PG8_MMA(0, 0, At, B0); PG8_MMA(0, 1, At, B1); PG8_BAR; PG8_SCHED;
            PG8_LDA(At, 1, 1); PG8_STAGE(PG8_SB(1, 0), b3, voffB); PG8_STAGE(PG8_SB(1, 1), b3 + hstep, voffB); PG8_STAGE(PG8_SA(1, 0), a3, voffA);
            PG8_WAIT_V(8); PG8_WAIT_L(0); PG8_BAR; PG8_MMA(1, 0, At, B0); PG8_MMA(1, 1, At, B1); PG8_BAR; PG8_SCHED;
            } else {
            PG8_LDB(B0, 0, 0); PG8_SCHED; PG8_LDA(At, 0, 0); PG8_STAGE(PG8_SA(1, 1), a1 + hstep, voffA);
            PG8_WAIT_L(8); PG8_BAR; PG8_WAIT_L(0); PG8_MMA(0, 0, At, B0); PG8_BAR; PG8_SCHED;
            PG8_LDB(B1, 0, 1); PG8_STAGE(PG8_SB(0, 0), b2, voffB);
            PG8_BAR; PG8_WAIT_L(0); PG8_MMA(0, 1, At, B1); PG8_BAR;
            PG8_LDA(At, 0, 1); PG8_STAGE(PG8_SA(0, 0), a2, voffA);
            PG8_BAR; PG8_WAIT_L(0); PG8_MMA(1, 0, At, B0); PG8_BAR; PG8_SCHED;
            PG8_STAGE(PG8_SB(0, 1), b2 + hstep, voffB);
            PG8_WAIT_V(6); PG8_BAR; PG8_MMA(1, 1, At, B1); PG8_BAR;
            PG8_LDB(B0, 1, 0); PG8_SCHED; PG8_LDA(At, 1, 0); PG8_STAGE(PG8_SA(0, 1), a2 + hstep, voffA);
            PG8_WAIT_L(8); PG8_BAR; PG8_WAIT_L(0); PG8_MMA(0, 0, At, B0); PG8_BAR; PG8_SCHED;
            PG8_LDB(B1, 1, 1); PG8_STAGE(PG8_SB(1, 0), b3, voffB);
            PG8_BAR; PG8_WAIT_L(0); PG8_MMA(0, 1, At, B1); PG8_BAR;
            PG8_LDA(At, 1, 1); PG8_STAGE(PG8_SA(1, 0), a3, voffA);
            PG8_BAR; PG8_WAIT_L(0); PG8_MMA(1, 0, At, B0); PG8_BAR; PG8_SCHED;
            PG8_STAGE(PG8_SB(1, 1), b3 + hstep, voffB);
            PG8_WAIT_V(6); PG8_BAR; PG8_MMA(1, 1, At, B1); PG8_BAR;
            }
        }
        if constexpr (ALIGN_EPI) { if (wr == 0) PG8_BAR; }
        if constexpr (!Epi::AFTER_DRAIN) { E(acc, cur, wr, wc, fr, fq); S.done(cur); }
        if (!has_next) break;
#pragma unroll
        for (int a = 0; a < 2; ++a)
#pragma unroll
            for (int b = 0; b < 2; ++b)
#pragma unroll
                for (int m = 0; m < 4; ++m)
#pragma unroll
                    for (int n = 0; n < 2; ++n) acc[a][b][m][n] = (f32x4){0.f, 0.f, 0.f, 0.f};
        cur = nxt; cA = nA; cB = nB; ++ui;
        if constexpr (ALIGN_EPI) { if (wr == 1) PG8_BAR; }
    }
    PG8_WAIT_V(0);
    if constexpr (!ALIGN_EPI) { if (wr == 0) PG8_BAR; }
    PG8_BAR;
    if constexpr (Epi::AFTER_DRAIN) { E.fused(acc, cur, wr, wc, fr, fq, lds, wid, lane); S.done(cur); }
#undef PG8_SA
#undef PG8_SB
#undef PG8_STAGE
#undef PG8_LDA
#undef PG8_LDB
#undef PG8_MMA
#undef PG8_WAIT_V
#undef PG8_WAIT_L
#undef PG8_BAR
#undef PG8_SCHED
}
}

#include <hip/hip_cooperative_groups.h>
namespace cg = cooperative_groups;

#define DI __device__ __forceinline__
#define LAS __attribute__((address_space(3)))
typedef unsigned short bf16_t;
typedef short bf16x8 __attribute__((ext_vector_type(8)));
typedef float f32x4 __attribute__((ext_vector_type(4)));
typedef float f32x2 __attribute__((ext_vector_type(2)));
typedef float f32x16 __attribute__((ext_vector_type(16)));
typedef unsigned u32x4 __attribute__((ext_vector_type(4)));
typedef unsigned u32x2 __attribute__((ext_vector_type(2)));
typedef __bf16 bf16v2 __attribute__((ext_vector_type(2)));

#define MFMA32(a, b, c) __builtin_amdgcn_mfma_f32_32x32x16_bf16((a), (b), (c), 0, 0, 0)
#define MFMA16(a, b, c) __builtin_amdgcn_mfma_f32_16x16x32_bf16((a), (b), (c), 0, 0, 0)
#define LDS_WAIT() asm volatile("s_waitcnt lgkmcnt(0)" ::: "memory")

constexpr int NB = 2, S = 16384, D = 2048, M = NB * S, NLAYER = 2;
constexpr int NPROJ = 3120, NP = 3328;
constexpr int C_QA = 0, C_QB = 1024, C_KC = 2048, C_VC = 2176, C_KS = 2304, C_VS = 2432, C_KW = 2560, C_VW = 2688, C_KB = 2816, C_VB = 2944, C_GATE = 3072;
constexpr int NCP = 1024;
constexpr int NEXP = 16384;
constexpr float NEGF = -1e30f;

constexpr size_t MiB = 1u << 20;
constexpr size_t WS_WIN = 0;
constexpr size_t WS_WOUT = 28 * MiB;
constexpr size_t WS_WQ = 46 * MiB;
constexpr size_t WS_CW1 = 64 * MiB;
constexpr size_t WS_SUBK = 67 * MiB;
constexpr size_t WS_KC = 68 * MiB;
constexpr size_t WS_VCT = 69 * MiB;
constexpr size_t WS_VST = 70 * MiB;
constexpr size_t WS_VWT = 78 * MiB;
constexpr size_t WS_VBT = 86 * MiB;
constexpr size_t WS_IDX = 96 * MiB;
constexpr size_t WS_GATE = 112 * MiB;
constexpr size_t WS_GSUM = 94 * MiB;
constexpr size_t WS_U = 128 * MiB;
constexpr size_t WS_V = 256 * MiB;
constexpr size_t WS_KSF = 192 * MiB, WS_KWF = 200 * MiB, WS_KBF = 208 * MiB;
constexpr size_t WS_KMAX = 95 * MiB + 65536;
constexpr size_t WS_XN = 384 * MiB;
constexpr size_t WS_O = 512 * MiB;
constexpr size_t WS_Q2 = 640 * MiB;
constexpr size_t WS_P = 768 * MiB;
constexpr size_t WS_END = 1000 * MiB;

constexpr int LDS_BYTES = 139264;
constexpr int NTHREADS = 512;

struct Args {
    const float* x; const float* attn_norm; const float* w_in; const float* cmp_pos_k; const float* cmp_w1_k; const float* cmp_w2_k;
    const float* cmp_pos_v; const float* cmp_w1_v; const float* cmp_w2_v; const float* sinks; const float* w_out; const float* ffn_norm;
    const float* peer_wq; const float* peer_subkeys; const float* peer_u; const float* peer_v; const float* rel_bias; const float* final_norm;
    float* out; unsigned char* ws; int ph_lo, ph_hi;
};

DI unsigned f2bf(float f) { unsigned u = __builtin_bit_cast(unsigned, f); return (u + 0x7fffu + ((u >> 16) & 1u)) >> 16; }
DI unsigned pk2(float lo, float hi) { const f32x2 v = {lo, hi}; return __builtin_bit_cast(unsigned, __builtin_convertvector(v, bf16v2)); }
DI float bflo(unsigned w) { return __builtin_bit_cast(float, w << 16); }
DI float bfhi(unsigned w) { return __builtin_bit_cast(float, w & 0xffff0000u); }
DI float bf2f(bf16_t v) { return __builtin_bit_cast(float, (unsigned)v << 16); }
DI float wave_sum(float v) {
#pragma unroll
    for (int o = 1; o < 64; o <<= 1) v += __shfl_xor(v, o);
    return v;
}
DI float gelu_tanh(float x) {
    const float y = 0.7978845608028654f * (x + 0.044715f * x * x * x);
    const float t = __expf(2.f * y);
    const float th = 1.f - 2.f / (t + 1.f);
    return 0.5f * x * (1.f + th);
}
DI float sigmoidf_(float x) { return 1.f / (1.f + __expf(-x)); }
DI int crow(int r, int hi) { return (r & 3) + 8 * (r >> 2) + 4 * hi; }
DI int rel_bucket(int d) {
    const float lf = __log2f((float)(d < 1 ? 1 : d));
    int b = 16 + (int)((lf - 4.0f) * (16.0f / 7.0f));
    b = b > 31 ? 31 : b;
    return d < 16 ? d : b;
}
DI bf16x8 pack8(float a0, float a1, float a2, float a3, float a4, float a5, float a6, float a7) {
    u32x4 p; p.x = pk2(a0, a1); p.y = pk2(a2, a3); p.z = pk2(a4, a5); p.w = pk2(a6, a7);
    return __builtin_bit_cast(bf16x8, p);
}

DI int win_srccol(int n) {
    if (n < 1024) return n;
    if (n < 2048) return 1840 + (n - 1024);
    if (n < 2816) return 1024 + (n - 2048);
    if (n < 3072) return 2864 + (n - 2816);
    if (n < 3120) return 1792 + (n - 3072);
    return -1;
}
template <bool WIN>
DI void transpose_item(const float* W, int K, int Nsrc, bf16_t* WT, int k0, int n0, LAS float* scr, int lane) {
    const int nd = n0 + (lane & 31);
    const int ns = WIN ? win_srccol(nd) : nd;
#pragma unroll 8
    for (int i = 0; i < 32; ++i) { const int kk = 2 * i + (lane >> 5); scr[kk * 33 + (lane & 31)] = ns >= 0 ? W[(size_t)(k0 + kk) * Nsrc + ns] : 0.f; }
    LDS_WAIT();
    const int c = lane & 7;
#pragma unroll
    for (int j = 0; j < 4; ++j) { const int n = (lane >> 3) + 8 * j; const LAS float* s = scr + (8 * c) * 33 + n;
        u32x4 o; o.x = pk2(s[0 * 33], s[1 * 33]); o.y = pk2(s[2 * 33], s[3 * 33]); o.z = pk2(s[4 * 33], s[5 * 33]); o.w = pk2(s[6 * 33], s[7 * 33]);
        *(u32x4*)(WT + (size_t)(n0 + n) * K + k0 + 8 * c) = o; }
    LDS_WAIT();
}
template <bool WIN>
DI void transpose_matrix(const float* W, int K, int Nsrc, int Ndst, bf16_t* WT, LAS float* scr, int lane, int gw, int NGW) {
    const int nblk = Ndst / 32, nitems = (K / 64) * nblk;
    for (int it = gw; it < nitems; it += NGW) transpose_item<WIN>(W, K, Nsrc, WT, 64 * (it / nblk), 32 * (it % nblk), scr, lane);
}
DI void convert_rows(const float* src, bf16_t* dst, size_t n8, size_t gt, size_t ngt) {
    for (size_t i = gt; i < n8; i += ngt) {
        const f32x4 a = ((const f32x4*)src)[2 * i], b = ((const f32x4*)src)[2 * i + 1];
        u32x4 o; o.x = pk2(a.x, a.y); o.y = pk2(a.z, a.w); o.z = pk2(b.x, b.y); o.w = pk2(b.z, b.w);
        ((u32x4*)dst)[i] = o;
    }
}
constexpr float U_SCALE = 512.f, V_SCALE = 64.f;
DI void convert_rows_fp8(const float* src, unsigned char* dst, size_t n16, float scale, size_t gt, size_t ngt) {
    for (size_t i = gt; i < n16; i += ngt) {
        const f32x4 a = ((const f32x4*)src)[4 * i] * scale, b = ((const f32x4*)src)[4 * i + 1] * scale, c = ((const f32x4*)src)[4 * i + 2] * scale, d = ((const f32x4*)src)[4 * i + 3] * scale;
        u32x4 o;
        o.x = (unsigned)__builtin_amdgcn_cvt_pk_fp8_f32(a.z, a.w, __builtin_amdgcn_cvt_pk_fp8_f32(a.x, a.y, 0, false), true);
        o.y = (unsigned)__builtin_amdgcn_cvt_pk_fp8_f32(b.z, b.w, __builtin_amdgcn_cvt_pk_fp8_f32(b.x, b.y, 0, false), true);
        o.z = (unsigned)__builtin_amdgcn_cvt_pk_fp8_f32(c.z, c.w, __builtin_amdgcn_cvt_pk_fp8_f32(c.x, c.y, 0, false), true);
        o.w = (unsigned)__builtin_amdgcn_cvt_pk_fp8_f32(d.z, d.w, __builtin_amdgcn_cvt_pk_fp8_f32(d.x, d.y, 0, false), true);
        ((u32x4*)dst)[i] = o;
    }
}
DI void phase_prologue(const Args& a, LAS unsigned char* lds) {
    const int tid = opaque_tid(), lane = tid & 63, wave = tid >> 6;
    if (blockIdx.x == 0 && tid < 32) ((unsigned*)(a.ws + WS_KMAX))[tid] = 0u;
    const int gw = blockIdx.x * 8 + wave, NGW = gridDim.x * 8;
    LAS float* scr = (LAS float*)(lds + wave * 8448);
    unsigned char* ws = a.ws;
    for (int l = 0; l < NLAYER; ++l) {
        transpose_matrix<true>(a.w_in + (size_t)l * D * NPROJ, D, NPROJ, NP, (bf16_t*)(ws + WS_WIN) + (size_t)l * NP * D, scr, lane, gw, NGW);
        transpose_matrix<false>(a.w_out + (size_t)l * D * D, D, D, D, (bf16_t*)(ws + WS_WOUT) + (size_t)l * D * D, scr, lane, gw, NGW);
        transpose_matrix<false>(a.peer_wq + (size_t)l * D * D, D, D, D, (bf16_t*)(ws + WS_WQ) + (size_t)l * D * D, scr, lane, gw, NGW);
        transpose_matrix<false>(a.cmp_w1_k + (size_t)l * 2048 * 128, 2048, 128, 128, (bf16_t*)(ws + WS_CW1) + (size_t)(l * 2 + 0) * 128 * 2048, scr, lane, gw, NGW);
        transpose_matrix<false>(a.cmp_w1_v + (size_t)l * 2048 * 128, 2048, 128, 128, (bf16_t*)(ws + WS_CW1) + (size_t)(l * 2 + 1) * 128 * 2048, scr, lane, gw, NGW);
    }
    const size_t gt = (size_t)blockIdx.x * NTHREADS + tid, ngt = (size_t)gridDim.x * NTHREADS;
    convert_rows_fp8(a.peer_u, ws + WS_U, (size_t)NLAYER * NEXP * D / 16, U_SCALE, gt, ngt);
    convert_rows_fp8(a.peer_v, ws + WS_V, (size_t)NLAYER * NEXP * D / 16, V_SCALE, gt, ngt);
    convert_rows(a.peer_subkeys, (bf16_t*)(ws + WS_SUBK), (size_t)NLAYER * 2 * 128 * 128 / 8, gt, ngt);
}

DI void phase_rms_bf16(const float* X, const float* g, bf16_t* XN) {
    const int tid = opaque_tid(), lane = tid & 63, wave = tid >> 6;
    const int gw = blockIdx.x * 8 + wave, NGW = gridDim.x * 8;
    f32x4 gv[8];
#pragma unroll
    for (int j = 0; j < 8; ++j) gv[j] = ((const f32x4*)g)[lane + 64 * j];
    for (int m = gw; m < M; m += NGW) {
        const f32x4* xr = (const f32x4*)(X + (size_t)m * D);
        f32x4 v[8]; float s = 0.f;
#pragma unroll
        for (int j = 0; j < 8; ++j) { v[j] = xr[lane + 64 * j]; s += (v[j].x * v[j].x + v[j].y * v[j].y) + (v[j].z * v[j].z + v[j].w * v[j].w); }
        const float rstd = rsqrtf(wave_sum(s) * (1.f / D) + 1e-6f);
        u32x2* o8 = (u32x2*)(XN + (size_t)m * D);
#pragma unroll
        for (int j = 0; j < 8; ++j) { const f32x4 y = v[j] * rstd * gv[j]; u32x2 w; w.x = pk2(y.x, y.y); w.y = pk2(y.z, y.w); o8[lane + 64 * j] = w; }
    }
}
DI void phase_rms_final(float* X, const float* g) {
    const int tid = opaque_tid(), lane = tid & 63, wave = tid >> 6;
    const int gw = blockIdx.x * 8 + wave, NGW = gridDim.x * 8;
    f32x4 gv[8];
#pragma unroll
    for (int j = 0; j < 8; ++j) gv[j] = ((const f32x4*)g)[lane + 64 * j];
    for (int m = gw; m < M; m += NGW) {
        f32x4* xr = (f32x4*)(X + (size_t)m * D);
        f32x4 v[8]; float s = 0.f;
#pragma unroll
        for (int j = 0; j < 8; ++j) { v[j] = xr[lane + 64 * j]; s += (v[j].x * v[j].x + v[j].y * v[j].y) + (v[j].z * v[j].z + v[j].w * v[j].w); }
        const float rstd = rsqrtf(wave_sum(s) * (1.f / D) + 1e-6f);
#pragma unroll
        for (int j = 0; j < 8; ++j) xr[lane + 64 * j] = v[j] * rstd * gv[j];
    }
}

struct EpiResid {
    static constexpr bool PERM = false, AFTER_DRAIN = false;
    const float* base; float* out; int ldc;
    DI void operator()(const pg8::f32x4 (&acc)[2][2][4][2], const pg8::Unit& u, int wr, int wc, int fr, int fq) const {
        const int col0 = u.pn * pg8::BM + wc * 32 + 4 * fq;
#pragma unroll
        for (int ai = 0; ai < 2; ++ai)
#pragma unroll
            for (int m = 0; m < 4; ++m) {
                const size_t off = (size_t)(u.pm * pg8::BM + ai * pg8::HALF + wr * 64 + m * 16 + fr) * ldc + col0;
#pragma unroll
                for (int bj = 0; bj < 2; ++bj)
#pragma unroll
                    for (int n = 0; n < 2; ++n) { const size_t o = off + bj * pg8::HALF + n * 16; const pg8::f32x4 bs = *(const pg8::f32x4*)(base + o); *(pg8::f32x4*)(out + o) = bs + acc[ai][bj][m][n]; }
                asm volatile("" ::: "memory");
            }
    }
};

DI void phase_prep(const Args& a, int layer, LAS unsigned char* lds) {
    const int tid = opaque_tid(), lane = tid & 63, wave = tid >> 6;
    const int gw = blockIdx.x * 8 + wave, NGW = gridDim.x * 8;
    unsigned char* ws = a.ws;
    const bf16_t* P = (const bf16_t*)(ws + WS_P);
    {
        LAS bf16_t* scr = (LAS bf16_t*)(lds + wave * 9216);
        for (int it = gw; it < 6 * 4 * 256; it += NGW) {
            const int which = it / 1024, bg = (it / 256) & 3, st = it & 255, b = bg >> 1, g = bg & 1;
            if (which >= 3) {
                const int srccol = (which == 3 ? C_KS : which == 4 ? C_KW : C_KB) + g * 64;
                bf16_t* dst = (bf16_t*)(ws + (which == 3 ? WS_KSF : which == 4 ? WS_KWF : WS_KBF)) + (size_t)bg * 64 * S + (size_t)st * 4096;
                float rmax = 0.f;
#pragma unroll
                for (int i = 0; i < 8; ++i) { const int tok = i * 8 + (lane >> 3), q = lane & 7;
                    const u32x4 v = *(const u32x4*)(P + (size_t)(b * S + st * 64 + tok) * NP + srccol + q * 8);
                    const int pos = which == 3 ? (((tok >> 4) * 2 + (q >> 2)) * 64 + (q & 3) * 16 + (tok & 15))
                                               : ((tok >> 5) * 256 + (q >> 1) * 64 + (q & 1) * 32 + (tok & 31));
                    *(u32x4*)(dst + pos * 8) = v;
                    float ss = bflo(v.x) * bflo(v.x) + bfhi(v.x) * bfhi(v.x) + bflo(v.y) * bflo(v.y) + bfhi(v.y) * bfhi(v.y)
                             + bflo(v.z) * bflo(v.z) + bfhi(v.z) * bfhi(v.z) + bflo(v.w) * bflo(v.w) + bfhi(v.w) * bfhi(v.w);
                    ss += __shfl_xor(ss, 1); ss += __shfl_xor(ss, 2); ss += __shfl_xor(ss, 4);
                    rmax = fmaxf(rmax, ss); }
                rmax = fmaxf(rmax, __shfl_xor(rmax, 8)); rmax = fmaxf(rmax, __shfl_xor(rmax, 16)); rmax = fmaxf(rmax, __shfl_xor(rmax, 32));
                if (lane == 0) atomicMax((unsigned*)(ws + WS_KMAX) + (layer * 4 + (which - 3)) * 4 + bg, __builtin_bit_cast(unsigned, rmax));
                continue;
            }
            const int srccol = (which == 0 ? C_VS : which == 1 ? C_VW : C_VB) + g * 64;
            bf16_t* dst = (bf16_t*)(ws + (which == 0 ? WS_VST : which == 1 ? WS_VWT : WS_VBT)) + (size_t)bg * 64 * S + (size_t)st * 4096;
#pragma unroll
            for (int i = 0; i < 8; ++i) { const int tok = i * 8 + (lane >> 3), ch = lane & 7;
                const u32x4 v = *(const u32x4*)(P + (size_t)(b * S + st * 64 + tok) * NP + srccol + ch * 8);
                *(LAS u32x4*)(scr + tok * 72 + ch * 8) = v; }
            LDS_WAIT();
#pragma unroll
            for (int f = 0; f < 8; ++f) {
                int d, kb0, kstep;
                if (which == 0) { const int j = f >> 2, dt = f & 3, hh = lane & 15, qd = lane >> 4; d = 16 * dt + hh; kb0 = 16 * j + 4 * qd; kstep = 32; }
                else { const int tl = f >> 2, j = (f >> 1) & 1, dt = f & 1, c = lane & 31, hi = lane >> 5; d = dt * 32 + c; kb0 = tl * 32 + 16 * j + 4 * hi; kstep = 8; }
                unsigned e[8];
#pragma unroll
                for (int i = 0; i < 8; ++i) e[i] = scr[(kb0 + (i & 3) + kstep * (i >> 2)) * 72 + d];
                u32x4 o; o.x = e[0] | (e[1] << 16); o.y = e[2] | (e[3] << 16); o.z = e[4] | (e[5] << 16); o.w = e[6] | (e[7] << 16);
                *(u32x4*)(dst + (f * 64 + lane) * 8) = o;
            }
            LDS_WAIT();
        }
    }
    {
        const bf16_t* XN = (const bf16_t*)(ws + WS_XN);
        const bf16_t* wg = (const bf16_t*)(ws + WS_WIN) + (size_t)layer * NP * D + (size_t)C_GATE * D;
        bf16_t* Pw = (bf16_t*)(ws + WS_P);
        const int c = lane & 31, hi = lane >> 5;
        for (int it = NGW - 1 - gw; it < M / 32; it += NGW) {
            const bf16_t* ar = XN + (size_t)(it * 32 + c) * D + hi * 8;
            const bf16_t* b0 = wg + (size_t)c * D + hi * 8, *b1 = wg + (size_t)(32 + c) * D + hi * 8;
            f32x16 a0, a1;
#pragma unroll
            for (int r = 0; r < 16; ++r) { a0[r] = 0.f; a1[r] = 0.f; }
#pragma unroll 8
            for (int kk = 0; kk < 128; ++kk) {
                const bf16x8 af = *(const bf16x8*)(ar + kk * 16);
                a0 = MFMA32(af, *(const bf16x8*)(b0 + kk * 16), a0);
                a1 = MFMA32(af, *(const bf16x8*)(b1 + kk * 16), a1);
            }
#pragma unroll
            for (int r = 0; r < 16; ++r) {
                bf16_t* pr = Pw + (size_t)(it * 32 + crow(r, hi)) * NP + C_GATE;
                pr[c] = (bf16_t)f2bf(a0[r]);
                if (c < 16) pr[32 + c] = (bf16_t)f2bf(a1[r]);
            }
        }
    }
    __syncthreads();
    {
        LAS float* H = (LAS float*)lds;
        const int c = lane & 31, hi = lane >> 5, rg = wave >> 2, nt = wave & 3;
        for (int it = blockIdx.x; it < 128; it += gridDim.x) {
            const int kv = it >> 6, bg = (it >> 4) & 3, rt = it & 15, b = bg >> 1, g = bg & 1;
            const float* pos = (kv ? a.cmp_pos_v : a.cmp_pos_k) + (size_t)layer * 32 * 64;
            const bf16_t* w1t = (const bf16_t*)(ws + WS_CW1) + (size_t)(layer * 2 + kv) * 128 * 2048;
            const float* w2 = (kv ? a.cmp_w2_v : a.cmp_w2_k) + (size_t)layer * 128 * 64;
            int irow = rt * 64 + rg * 32 + c; irow = irow > 1022 ? 1022 : irow;
            const bf16_t* src = P + (size_t)(b * S + 16 * irow) * NP + (kv ? C_VC : C_KC) + g * 64;
            const bf16_t* bsrc = w1t + (size_t)(nt * 32 + c) * 2048 + hi * 8;
            f32x16 acc;
#pragma unroll
            for (int r = 0; r < 16; ++r) acc[r] = 0.f;
#pragma unroll 4
            for (int kk = 0; kk < 128; ++kk) {
                const int tok = kk >> 2, d = (kk & 3) * 16 + hi * 8;
                const u32x4 sv = *(const u32x4*)(src + (size_t)tok * NP + d);
                const f32x4 p0 = *(const f32x4*)(pos + tok * 64 + d), p1 = *(const f32x4*)(pos + tok * 64 + d + 4);
                const bf16x8 af = pack8(bflo(sv.x) + p0.x, bfhi(sv.x) + p0.y, bflo(sv.y) + p0.z, bfhi(sv.y) + p0.w,
                                        bflo(sv.z) + p1.x, bfhi(sv.z) + p1.y, bflo(sv.w) + p1.z, bfhi(sv.w) + p1.w);
                const bf16x8 bf = *(const bf16x8*)(bsrc + kk * 16);
                acc = MFMA32(af, bf, acc);
            }
#pragma unroll
            for (int r = 0; r < 16; ++r) H[(rg * 32 + crow(r, hi)) * 129 + nt * 32 + c] = gelu_tanh(acc[r]);
            __syncthreads();
            {
                const int i = tid >> 3, dc = (tid & 7) * 8;
                float o[8];
#pragma unroll
                for (int e = 0; e < 8; ++e) o[e] = 0.f;
                for (int n = 0; n < 128; ++n) {
                    const float hv = H[i * 129 + n];
                    const f32x4 wa = *(const f32x4*)(w2 + n * 64 + dc), wb = *(const f32x4*)(w2 + n * 64 + dc + 4);
                    o[0] += hv * wa.x; o[1] += hv * wa.y; o[2] += hv * wa.z; o[3] += hv * wa.w;
                    o[4] += hv * wb.x; o[5] += hv * wb.y; o[6] += hv * wb.z; o[7] += hv * wb.w;
                }
                const int ig = rt * 64 + i;
                if (ig > 1022) {
#pragma unroll
                    for (int e = 0; e < 8; ++e) o[e] = 0.f;
                }
                if (kv == 0) {
                    u32x4 w; w.x = pk2(o[0], o[1]); w.y = pk2(o[2], o[3]); w.z = pk2(o[4], o[5]); w.w = pk2(o[6], o[7]);
                    float ss = bflo(w.x) * bflo(w.x) + bfhi(w.x) * bfhi(w.x) + bflo(w.y) * bflo(w.y) + bfhi(w.y) * bfhi(w.y)
                             + bflo(w.z) * bflo(w.z) + bfhi(w.z) * bfhi(w.z) + bflo(w.w) * bflo(w.w) + bfhi(w.w) * bfhi(w.w);
                    ss += __shfl_xor(ss, 1); ss += __shfl_xor(ss, 2); ss += __shfl_xor(ss, 4);
                    ss = fmaxf(ss, __shfl_xor(ss, 8)); ss = fmaxf(ss, __shfl_xor(ss, 16)); ss = fmaxf(ss, __shfl_xor(ss, 32));
                    if (lane == 0) atomicMax((unsigned*)(ws + WS_KMAX) + (layer * 4 + 3) * 4 + bg, __builtin_bit_cast(unsigned, ss));
                    const int q = dc >> 3;
                    *(u32x4*)((bf16_t*)(ws + WS_KC) + (size_t)bg * NCP * 64 + (size_t)(ig >> 5) * 2048 + ((q >> 1) * 64 + (q & 1) * 32 + (ig & 31)) * 8) = w;
                } else {
                    const int kk5 = ig & 31, jj = kk5 >> 4, rem = kk5 & 15, hh1 = (rem >> 2) & 1, ii = (rem >> 3) * 4 + (rem & 3);
                    bf16_t* vt = (bf16_t*)(ws + WS_VCT) + (size_t)bg * 64 * NCP + (size_t)(ig >> 5) * 2048 + ii;
#pragma unroll
                    for (int e = 0; e < 8; ++e) { const int dd = dc + e; vt[((jj * 2 + (dd >> 5)) * 64 + hh1 * 32 + (dd & 31)) * 8] = (bf16_t)f2bf(o[e]); }
                }
            }
            __syncthreads();
        }
    }
}

constexpr float LOG2E = 1.4426950408889634f, SC2 = 0.125f * 1.4426950408889634f;
DI float ex2(float x) { return __builtin_amdgcn_exp2f(x); }
DI void loadK32(const bf16_t* kt, int lane, bf16x8 (&k)[4]) {
#pragma unroll
    for (int kk = 0; kk < 4; ++kk) k[kk] = *(const bf16x8*)(kt + (kk * 64 + lane) * 8);
}
DI f32x16 qk32r(const bf16x8 (&k)[4], const bf16x8 (&q)[4]) {
    f32x16 s;
#pragma unroll
    for (int r = 0; r < 16; ++r) s[r] = 0.f;
#pragma unroll
    for (int kk = 0; kk < 4; ++kk) s = MFMA32(k[kk], q[kk], s);
    return s;
}
DI void loadV32(const bf16_t* vt, int lane, bf16x8 (&v)[2][2]) {
#pragma unroll
    for (int j = 0; j < 2; ++j)
#pragma unroll
        for (int dt = 0; dt < 2; ++dt) v[j][dt] = *(const bf16x8*)(vt + ((j * 2 + dt) * 64 + lane) * 8);
}
DI void pv32r(const f32x16& p, const bf16x8 (&v)[2][2], f32x16& o0, f32x16& o1) {
#pragma unroll
    for (int j = 0; j < 2; ++j) {
        const bf16x8 pb = pack8(p[8 * j], p[8 * j + 1], p[8 * j + 2], p[8 * j + 3], p[8 * j + 4], p[8 * j + 5], p[8 * j + 6], p[8 * j + 7]);
        o0 = MFMA32(v[j][0], pb, o0);
        o1 = MFMA32(v[j][1], pb, o1);
    }
}
template <bool MASKED>
DI bool softmax32(f32x16& s, unsigned vm, float& m, float& l, float& alpha) {
    float sum = 0.f;
#pragma unroll
    for (int r = 0; r < 16; ++r) { float p = ex2(s[r] - m); if (MASKED) p = ((vm >> r) & 1u) ? p : 0.f; s[r] = p; sum += p; }
    l += sum; alpha = 1.f;
    return false;
}
DI float sumsq8(const bf16x8 v) { const u32x4 w = __builtin_bit_cast(u32x4, v);
    return bflo(w.x) * bflo(w.x) + bfhi(w.x) * bfhi(w.x) + bflo(w.y) * bflo(w.y) + bfhi(w.y) * bfhi(w.y) + bflo(w.z) * bflo(w.z) + bfhi(w.z) * bfhi(w.z) + bflo(w.w) * bflo(w.w) + bfhi(w.w) * bfhi(w.w); }
DI unsigned logits_cmp(f32x16& s, int key0, int qpos, int hi, const LAS float* bias_h) {
    unsigned vm = 0u;
#pragma unroll
    for (int r = 0; r < 16; ++r) {
        const int dist = qpos - (16 * (key0 + crow(r, hi)) + 31);
        const bool valid = dist >= 0;
        const float bb = bias_h[rel_bucket(dist < 0 ? 0 : dist)];
        s[r] = valid ? s[r] * SC2 + bb : NEGF;
        vm |= valid ? (1u << r) : 0u;
    }
    return vm;
}

constexpr int AW_IMP = 0, AW_OLDS = 4128, AW_SEL = 4128 + 8320, AW_NSEL = AW_SEL + 256, AW_BYTES = 12800;
constexpr int ATT_BIAS_OFF = 8 * AW_BYTES;
constexpr int LUTW_STRIDE = 612, LUTB_STRIDE = 228;
constexpr int ATT_LUTW_OFF = ATT_BIAS_OFF + 4096, ATT_LUTB_OFF = ATT_LUTW_OFF + 8 * LUTW_STRIDE * 4, ATT_LDS_END = ATT_LUTB_OFF + 8 * LUTB_STRIDE * 4;
static_assert(ATT_LDS_END <= LDS_BYTES, "attention LDS map");

template <int W>
DI void window_branch(const bf16_t* Kf  , const bf16_t* Vf  , int lane,
                      const bf16x8 (&qf)[4], const LAS float* lut_h  , int q0, int qpos, int c, int hi,
                      float& m, float& l, f32x16& o0, f32x16& o1) {
    const int kd = q0 & ~31;
    int kstart = q0 - (W - 1); kstart = kstart < 0 ? 0 : kstart; kstart &= ~31;
    bf16x8 kc[4];
    loadK32(Kf + (size_t)(kd >> 5) * 2048, lane, kc);
    const float sini = -m * (1.f / SC2);
#pragma unroll 1
    for (int key0 = kd; key0 >= kstart; key0 -= 32) {
        bf16x8 vf[2][2], kn[4];
        loadV32(Vf + (size_t)(key0 >> 5) * 2048, lane, vf);
        const int nk = key0 - 32 >= kstart ? key0 - 32 : key0;
        loadK32(Kf + (size_t)(nk >> 5) * 2048, lane, kn);
        f32x16 s;
#pragma unroll
        for (int r = 0; r < 16; ++r) s[r] = sini;
#pragma unroll
        for (int kk = 0; kk < 4; ++kk) s = MFMA32(kc[kk], qf[kk], s);
        const LAS float* pt = lut_h + (qpos - key0 - 4 * hi - 27);
        float sum = 0.f;
#pragma unroll
        for (int r = 0; r < 16; ++r) { const float p = ex2(s[r] * SC2 + pt[27 - ((r & 3) + 8 * (r >> 2))]); s[r] = p; sum += p; }
        l += sum;
        pv32r(s, vf, o0, o1);
#pragma unroll
        for (int kk = 0; kk < 4; ++kk) kc[kk] = kn[kk];
    }
}

DI void phase_attn(const Args& a, int layer, LAS unsigned char* lds) {
    const int tid = opaque_tid(), lane = tid & 63, wave = tid >> 6;
    unsigned char* ws = a.ws;
    const bf16_t* P = (const bf16_t*)(ws + WS_P);
    bf16_t* O = (bf16_t*)(ws + WS_O);
    const int bg = blockIdx.x & 3, b = bg >> 1, g = bg & 1, wq = blockIdx.x >> 2, nwq = gridDim.x >> 2;
    LAS float* bias = (LAS float*)(lds + ATT_BIAS_OFF);
    LAS float* lutW = (LAS float*)(lds + ATT_LUTW_OFF);
    LAS float* lutB = (LAS float*)(lds + ATT_LUTB_OFF);
    for (int i = tid; i < 1024; i += NTHREADS) bias[i] = a.rel_bias[(i & 31) * 32 + (i >> 5)] * LOG2E;
    for (int i = tid; i < 8 * LUTW_STRIDE; i += NTHREADS) { const int hh = i / LUTW_STRIDE, dist = i % LUTW_STRIDE - 32;
        lutW[i] = (dist >= 0 && dist < 512) ? a.rel_bias[rel_bucket(dist) * 32 + g * 8 + hh] * LOG2E : NEGF; }
    for (int i = tid; i < 8 * LUTB_STRIDE; i += NTHREADS) { const int hh = i / LUTB_STRIDE, dist = i % LUTB_STRIDE - 32;
        lutB[i] = (dist >= 0 && dist < 128) ? a.rel_bias[rel_bucket(dist) * 32 + 16 + g * 8 + hh] * LOG2E : NEGF; }
    __syncthreads();
    LAS unsigned char* wl = lds + wave * AW_BYTES;
    LAS float* imp = (LAS float*)(wl + AW_IMP);
    LAS float* olds = (LAS float*)(wl + AW_OLDS);
    LAS int* sel = (LAS int*)(wl + AW_SEL);
    LAS int* nsel = (LAS int*)(wl + AW_NSEL);
    const int c = lane & 31, hi = lane >> 5, ql = c >> 3, h = c & 7;
    const bf16_t* Pb = P + (size_t)b * S * NP;
    const bf16_t* kcb = (const bf16_t*)(ws + WS_KC) + (size_t)bg * NCP * 64;
    const bf16_t* vct = (const bf16_t*)(ws + WS_VCT) + (size_t)bg * 64 * NCP;
    const bf16_t* vst = (const bf16_t*)(ws + WS_VST) + (size_t)bg * 64 * S;
    const bf16_t* vwt = (const bf16_t*)(ws + WS_VWT) + (size_t)bg * 64 * S;
    const bf16_t* kwf = (const bf16_t*)(ws + WS_KWF) + (size_t)bg * 64 * S;
    const bf16_t* kbf = (const bf16_t*)(ws + WS_KBF) + (size_t)bg * 64 * S;
    const bf16_t* ksf = (const bf16_t*)(ws + WS_KSF) + (size_t)bg * 64 * S;
    const bf16_t* vbt = (const bf16_t*)(ws + WS_VBT) + (size_t)bg * 64 * S;
    const float sinkv = a.sinks[layer * 16 + g * 8 + h] * LOG2E;
    const LAS float* bias_a = bias + (g * 8 + h) * 32;
    const float b31 = bias_a[31];
    const unsigned* kmx = (const unsigned*)(ws + WS_KMAX) + layer * 16 + bg;
    const float knS = sqrtf(__builtin_bit_cast(float, kmx[0])) * SC2, knW = sqrtf(__builtin_bit_cast(float, kmx[4])) * SC2;
    const float knB = sqrtf(__builtin_bit_cast(float, kmx[8])) * SC2, knC = sqrtf(__builtin_bit_cast(float, kmx[12])) * SC2;
    float bmaxA = bias_a[0], bmaxB = bias[(16 + g * 8 + h) * 32];
    for (int k = 1; k < 32; ++k) { bmaxA = fmaxf(bmaxA, bias_a[k]); bmaxB = fmaxf(bmaxB, bias[(16 + g * 8 + h) * 32 + k]); }
    bmaxA += 0.01f; bmaxB += 0.01f;

#pragma unroll 1
    for (int qt0 = wq; qt0 < S / 32 && wq < nwq; qt0 += nwq) {
        const int rnd = qt0 / nwq, qt32 = ((rnd & 1) && (rnd + 1) * nwq <= S / 32) ? rnd * nwq + (nwq - 1 - wq) : qt0;
        const int q0 = qt32 * 32 + wave * 4;
        const int qpos = q0 + ql;
        const size_t mrow = (size_t)(b * S + qpos);
        const bf16_t* prow = P + mrow * NP;
        {
            bf16x8 qf[4];
#pragma unroll
            for (int kk = 0; kk < 4; ++kk) qf[kk] = *(const bf16x8*)(prow + C_QB + (g * 8 + h) * 64 + kk * 16 + hi * 8);
            float qn2 = sumsq8(qf[0]) + sumsq8(qf[1]) + sumsq8(qf[2]) + sumsq8(qf[3]); qn2 += __shfl_xor(qn2, 32);
            float m = sqrtf(qn2) * knB + bmaxB, l = hi == 0 ? ex2(sinkv - m) : 0.f;
            f32x16 o0, o1;
#pragma unroll
            for (int r = 0; r < 16; ++r) { o0[r] = 0.f; o1[r] = 0.f; }
            window_branch<128>(kbf, vbt, lane, qf, lutB + h * LUTB_STRIDE + 32, q0, qpos, c, hi, m, l, o0, o1);
            const float lt = l + __shfl_xor(l, 32), inv = 1.f / lt;
            bf16_t* orow = O + mrow * D + 1024 + (g * 8 + h) * 64;
#pragma unroll
            for (int dt = 0; dt < 2; ++dt)
#pragma unroll
                for (int q4 = 0; q4 < 4; ++q4) {
                    const f32x16& oo = dt ? o1 : o0;
                    u32x2 w; w.x = pk2(oo[4 * q4] * inv, oo[4 * q4 + 1] * inv); w.y = pk2(oo[4 * q4 + 2] * inv, oo[4 * q4 + 3] * inv);
                    *(u32x2*)(orow + dt * 32 + 8 * q4 + 4 * hi) = w;
                }
        }
        const float gt0 = sigmoidf_(bf2f(prow[C_GATE + (g * 8 + h) * 3 + 0]));
        bf16x8 qfa[4];
#pragma unroll
        for (int kk = 0; kk < 4; ++kk) qfa[kk] = *(const bf16x8*)(prow + C_QA + (g * 8 + h) * 64 + kk * 16 + hi * 8);
        float qnA; { float qn2 = sumsq8(qfa[0]) + sumsq8(qfa[1]) + sumsq8(qfa[2]) + sumsq8(qfa[3]); qn2 += __shfl_xor(qn2, 32); qnA = sqrtf(qn2); }
        for (int i = lane; i < 4 * 257; i += 64) imp[i] = 0.f;
        const int ntile = (q0 + 3) / 512 + 1;
        const int nfast = q0 >= 2040 ? (q0 - 2040) / 512 + 1 : 0;
        {
            float m = qnA * knC + bmaxA, l = 0.f;
            {
                bf16x8 kc[4];
                loadK32(kcb, lane, kc);
#pragma unroll 1
                for (int t = 0; t < ntile; ++t) {
                    bf16x8 kn[4];
                    const int tn = t + 1 < ntile ? t + 1 : t;
                    loadK32(kcb + (size_t)tn * 2048, lane, kn);
                    f32x16 s = qk32r(kc, qfa);
                    float alpha;
                    if (t < nfast) {
#pragma unroll
                        for (int r = 0; r < 16; ++r) s[r] = s[r] * SC2 + b31;
                        (void)softmax32<false>(s, 0u, m, l, alpha);
                    } else {
                        const unsigned vm = logits_cmp(s, t * 32, qpos, hi, bias_a);
                        (void)softmax32<true>(s, vm, m, l, alpha);
                    }
#pragma unroll
                    for (int kk = 0; kk < 4; ++kk) kc[kk] = kn[kk];
                }
            }
            const float lt = l + __shfl_xor(l, 32), inv = lt > 0.f ? 1.f / lt : 0.f;
            f32x16 o0, o1;
#pragma unroll
            for (int r = 0; r < 16; ++r) { o0[r] = 0.f; o1[r] = 0.f; }
            LDS_WAIT();
            bf16x8 kc[4];
            loadK32(kcb, lane, kc);
#pragma unroll 1
            for (int t = 0; t < ntile; ++t) {
                bf16x8 vf[2][2], kn[4];
                loadV32(vct + (size_t)t * 2048, lane, vf);
                const int tn = t + 1 < ntile ? t + 1 : t;
                loadK32(kcb + (size_t)tn * 2048, lane, kn);
                f32x16 s = qk32r(kc, qfa);
                if (t < nfast) {
#pragma unroll
                    for (int r = 0; r < 16; ++r) s[r] = ex2(s[r] * SC2 + (b31 - m)) * inv;
                } else {
                    const unsigned vm = logits_cmp(s, t * 32, qpos, hi, bias_a);
#pragma unroll
                    for (int r = 0; r < 16; ++r) s[r] = ((vm >> r) & 1u) ? ex2(s[r] - m) * inv : 0.f;
                }
#pragma unroll
                for (int grp = 0; grp < 4; ++grp) {
                    float wa = 2.f * (s[4 * grp] + s[4 * grp + 1] + s[4 * grp + 2]) + s[4 * grp + 3], wb = s[4 * grp + 3];
                    wa += __shfl_xor(wa, 1); wb += __shfl_xor(wb, 1);
                    wa += __shfl_xor(wa, 2); wb += __shfl_xor(wb, 2);
                    wa += __shfl_xor(wa, 4); wb += __shfl_xor(wb, 4);
                    const int j = t * 8 + 2 * grp + hi;
                    if (h == 0) {
                        (void)__hip_atomic_fetch_add(imp + ql * 257 + j, wa, __ATOMIC_RELAXED, __HIP_MEMORY_SCOPE_WORKGROUP);
                        (void)__hip_atomic_fetch_add(imp + ql * 257 + j + 1, wb, __ATOMIC_RELAXED, __HIP_MEMORY_SCOPE_WORKGROUP);
                    }
                }
                pv32r(s, vf, o0, o1);
#pragma unroll
                for (int kk = 0; kk < 4; ++kk) kc[kk] = kn[kk];
            }
#pragma unroll
            for (int r = 0; r < 16; ++r) { olds[c * 65 + crow(r, hi)] = gt0 * o0[r]; olds[c * 65 + 32 + crow(r, hi)] = gt0 * o1[r]; }
        }
        LDS_WAIT();
        {
            const int tq = lane >> 4, sub = lane & 15;
            const int qp = q0 + tq, cb = qp >> 6;
            float v[16];
#pragma unroll
            for (int i = 0; i < 16; ++i) { const int j = sub + 16 * i; v[i] = (j >= 1 && j <= cb - 2) ? imp[tq * 257 + j] : -1.f; }
            int n = (cb < 2 ? cb : 2) + 1;
            if (sub == 0) {
                sel[tq * 16 + 0] = 0;
                if (cb >= 1) sel[tq * 16 + n - 1] = cb;
                if (cb >= 2) sel[tq * 16 + 1] = cb - 1;
            }
#pragma unroll 1
            for (int k = 0; k < 13; ++k) {
                float bv = v[0]; int bj = sub;
#pragma unroll
                for (int i = 1; i < 16; ++i) { if (v[i] > bv) { bv = v[i]; bj = sub + 16 * i; } }
#pragma unroll
                for (int off = 1; off < 16; off <<= 1) {
                    const float ov = __shfl_xor(bv, off); const int oj = __shfl_xor(bj, off);
                    if (ov > bv || (ov == bv && oj < bj)) { bv = ov; bj = oj; }
                }
                if (bv >= 0.f) {
                    if (sub == 0) sel[tq * 16 + n] = bj;
                    n += 1;
#pragma unroll
                    for (int i = 0; i < 16; ++i) { if (bj == sub + 16 * i) v[i] = -1.f; }
                }
            }
            if (sub == 0) nsel[tq] = n;
        }
        LDS_WAIT();
        {
            const int hh = lane & 15, qd = lane >> 4, hd = hh & 7;
            const LAS float* bias_s = bias + (g * 8 + hd) * 32;
            const float b31s = bias_s[31];

#pragma unroll 1
            for (int qi = 0; qi < 4; ++qi) {
                const int qp = q0 + qi;
                const bf16_t* pr = Pb + (size_t)qp * NP;
                bf16x8 qf[2];
#pragma unroll
                for (int kk = 0; kk < 2; ++kk) qf[kk] = *(const bf16x8*)(pr + C_QA + (g * 8 + hd) * 64 + kk * 32 + qd * 8);
                float qs2 = sumsq8(qf[0]) + sumsq8(qf[1]); qs2 += __shfl_xor(qs2, 16); qs2 += __shfl_xor(qs2, 32);
                const float m = sqrtf(qs2) * knS + bmaxA; float l = 0.f;
                const bool lowc = hh < 8;
                const bf16x8 zero8 = {0, 0, 0, 0, 0, 0, 0, 0};
                bf16x8 qlo[2], qhi[2];
#pragma unroll
                for (int kk = 0; kk < 2; ++kk) { qlo[kk] = lowc ? qf[kk] : zero8; qhi[kk] = lowc ? zero8 : qf[kk]; }
                const int hs = hh >> 3;
                f32x4 o[4];
#pragma unroll
                for (int dt = 0; dt < 4; ++dt) o[dt] = (f32x4){0.f, 0.f, 0.f, 0.f};
                const int ns = __builtin_amdgcn_readfirstlane(nsel[qi]);
                int jb = __builtin_amdgcn_readfirstlane(sel[qi * 16]);
                bf16x8 ka[4][2];
#pragma unroll
                for (int t = 0; t < 4; ++t)
#pragma unroll
                    for (int kk = 0; kk < 2; ++kk) ka[t][kk] = *(const bf16x8*)(ksf + (size_t)jb * 4096 + ((t * 2 + kk) * 64 + lane) * 8);
#pragma unroll 1
                for (int k = 0; k < ns; ++k) {
                    bf16x8 va[2][4], kn[4][2];
#pragma unroll
                    for (int j = 0; j < 2; ++j)
#pragma unroll
                        for (int dt = 0; dt < 4; ++dt) va[j][dt] = *(const bf16x8*)(vst + (size_t)jb * 4096 + ((j * 4 + dt) * 64 + lane) * 8);
                    const int jn = __builtin_amdgcn_readfirstlane(sel[qi * 16 + (k + 1 < ns ? k + 1 : k)]);
#pragma unroll
                    for (int t = 0; t < 4; ++t)
#pragma unroll
                        for (int kk = 0; kk < 2; ++kk) kn[t][kk] = *(const bf16x8*)(ksf + (size_t)jn * 4096 + ((t * 2 + kk) * 64 + lane) * 8);
                    f32x4 s[2];
#pragma unroll
                    for (int u = 0; u < 2; ++u) {
                        s[u] = (f32x4){0.f, 0.f, 0.f, 0.f};
#pragma unroll
                        for (int kk = 0; kk < 2; ++kk) { s[u] = MFMA16(ka[2 * u][kk], qlo[kk], s[u]); s[u] = MFMA16(ka[2 * u + 1][kk], qhi[kk], s[u]); }
                    }
                    if (qp - (jb * 64 + 63) >= 1513) {
                        const float cst = b31s - m;
#pragma unroll
                        for (int u = 0; u < 2; ++u)
#pragma unroll
                            for (int r = 0; r < 4; ++r) s[u][r] = s[u][r] * SC2 + cst;
                    } else {
#pragma unroll
                        for (int u = 0; u < 2; ++u)
#pragma unroll
                            for (int r = 0; r < 4; ++r) {
                                const int dist = qp - (jb * 64 + 16 * (2 * u + hs) + 4 * qd + r);
                                const float bb = bias_s[rel_bucket(dist < 0 ? 0 : dist)];
                                s[u][r] = dist >= 0 ? s[u][r] * SC2 + (bb - m) : NEGF;
                            }
                    }
                    float sum = 0.f;
#pragma unroll
                    for (int u = 0; u < 2; ++u)
#pragma unroll
                        for (int r = 0; r < 4; ++r) { const float p = ex2(s[u][r]); s[u][r] = p; sum += p; }
                    l += sum;
                    {
                        const bf16x8 p8 = pack8(s[0][0], s[0][1], s[0][2], s[0][3], s[1][0], s[1][1], s[1][2], s[1][3]);
                        const bf16x8 plo = lowc ? p8 : zero8, phi = lowc ? zero8 : p8;
#pragma unroll
                        for (int dt = 0; dt < 4; ++dt) { o[dt] = MFMA16(va[0][dt], plo, o[dt]); o[dt] = MFMA16(va[1][dt], phi, o[dt]); }
                    }
                    jb = jn;
#pragma unroll
                    for (int t = 0; t < 4; ++t)
#pragma unroll
                        for (int kk = 0; kk < 2; ++kk) ka[t][kk] = kn[t][kk];
                }
                float lt = l + __shfl_xor(l, 16); lt += __shfl_xor(lt, 32); lt += __shfl_xor(lt, 8);
#pragma unroll
                for (int dt = 0; dt < 4; ++dt)
#pragma unroll
                    for (int r = 0; r < 4; ++r) o[dt][r] += __shfl_xor(o[dt][r], 8);
                const float gt1 = sigmoidf_(bf2f(Pb[(size_t)qp * NP + C_GATE + (g * 8 + hd) * 3 + 1]));
                const float inv = lt > 0.f ? gt1 / lt : 0.f;
                if (hh < 8) {
#pragma unroll
                    for (int dt = 0; dt < 4; ++dt)
#pragma unroll
                        for (int r = 0; r < 4; ++r) olds[(qi * 8 + hh) * 65 + 16 * dt + 4 * qd + r] += o[dt][r] * inv;
                }
            }
        }
        LDS_WAIT();
        {
            int lw = lane; asm volatile("" : "+v"(lw));
            const int c = lw & 31, hi = lw >> 5, h = c & 7, qpos = q0 + (c >> 3);
            const size_t mrow = (size_t)(b * S + qpos);
            const bf16_t* prow = P + mrow * NP;
            const float gt2 = sigmoidf_(bf2f(prow[C_GATE + (g * 8 + h) * 3 + 2]));
            bf16x8 qfw[4];
#pragma unroll
            for (int kk = 0; kk < 4; ++kk) qfw[kk] = *(const bf16x8*)(prow + C_QA + (g * 8 + h) * 64 + kk * 16 + hi * 8);
            float qnW; { float qn2 = sumsq8(qfw[0]) + sumsq8(qfw[1]) + sumsq8(qfw[2]) + sumsq8(qfw[3]); qn2 += __shfl_xor(qn2, 32); qnW = sqrtf(qn2); }
            float m = qnW * knW + bmaxA, l = 0.f;
            f32x16 o0, o1;
#pragma unroll
            for (int r = 0; r < 16; ++r) { o0[r] = 0.f; o1[r] = 0.f; }
            window_branch<512>(kwf, vwt, lw, qfw, lutW + h * LUTW_STRIDE + 32, q0, qpos, c, hi, m, l, o0, o1);
            const float lt = l + __shfl_xor(l, 32), inv = lt > 0.f ? gt2 / lt : 0.f;
            bf16_t* orow = O + mrow * D + (g * 8 + h) * 64;
#pragma unroll
            for (int dt = 0; dt < 2; ++dt)
#pragma unroll
                for (int q4 = 0; q4 < 4; ++q4) {
                    const f32x16& oo = dt ? o1 : o0;
                    const int d0 = dt * 32 + 8 * q4 + 4 * hi;
                    const float e0 = oo[4 * q4] * inv + olds[c * 65 + d0], e1 = oo[4 * q4 + 1] * inv + olds[c * 65 + d0 + 1];
                    const float e2 = oo[4 * q4 + 2] * inv + olds[c * 65 + d0 + 2], e3 = oo[4 * q4 + 3] * inv + olds[c * 65 + d0 + 3];
                    u32x2 w; w.x = pk2(e0, e1); w.y = pk2(e2, e3);
                    *(u32x2*)(orow + d0) = w;
                }
        }
        LDS_WAIT();
    }
}

DI unsigned ordf(float f) { const unsigned u = __builtin_bit_cast(unsigned, f); return (u & 0x80000000u) ? ~u : (u | 0x80000000u); }
DI float unordf(unsigned k) { const unsigned u = (k & 0x80000000u) ? (k & 0x7fffffffu) : ~k; return __builtin_bit_cast(float, u); }

DI void peer_half_topk(const bf16_t* qrow  , const bf16_t* subk  , int hi, int lane, LAS unsigned* ltop) {
    unsigned keys[64];
    asm volatile("" : "+v"(subk));
#pragma unroll
    for (int rt = 0; rt < 4; ++rt) {
        f32x16 acc;
#pragma unroll
        for (int r = 0; r < 16; ++r) acc[r] = 0.f;
#pragma unroll
        for (int kk = 0; kk < 8; ++kk) {
            const bf16x8 af = *(const bf16x8*)(subk + (size_t)(rt * 32) * 128 + kk * 16);
            const bf16x8 bf = *(const bf16x8*)(qrow + kk * 16);
            acc = MFMA32(af, bf, acc);
        }
#pragma unroll
        for (int r = 0; r < 16; ++r) { const int n = rt * 32 + crow(r, hi); keys[rt * 16 + r] = (ordf(acc[r]) & ~0x7Fu) | (unsigned)(127 - n); }
    }
#pragma unroll 1
    for (int k = 0; k < 16; ++k) {
        unsigned mx = keys[0];
#pragma unroll
        for (int i = 1; i < 64; ++i) mx = mx > keys[i] ? mx : keys[i];
        const unsigned om = (unsigned)__shfl_xor((int)mx, 32);
        mx = mx > om ? mx : om;
        ltop[k * 64 + lane] = mx;
#pragma unroll
        for (int i = 0; i < 64; ++i) keys[i] = keys[i] == mx ? 0u : keys[i];
    }
}

DI void phase_peer_select(const Args& a, int layer, LAS unsigned char* lds) {
    const int tid = opaque_tid(), lane = tid & 63, wave = tid >> 6;
    const int gw = blockIdx.x * 8 + wave, NGW = gridDim.x * 8;
    unsigned char* ws = a.ws;
    const bf16_t* Q2 = (const bf16_t*)(ws + WS_Q2);
    const bf16_t* subk = (const bf16_t*)(ws + WS_SUBK) + (size_t)layer * 2 * 128 * 128;
    int* IDX = (int*)(ws + WS_IDX);
    float* GATE = (float*)(ws + WS_GATE);
    LAS unsigned* lt1 = (LAS unsigned*)(lds + wave * 8192);
    LAS unsigned* lt2 = lt1 + 1024;
    const int c = lane & 31, hi = lane >> 5, tl = c >> 3, h = c & 7;
#pragma unroll 1
    for (int unit = gw; unit < M / 4; unit += NGW) {
        const size_t m = (size_t)unit * 4 + tl;
        const bf16_t* qrow = Q2 + m * D + h * 256 + hi * 8;
        peer_half_topk(qrow, subk + (size_t)c * 128 + hi * 8, hi, lane, lt1);
        peer_half_topk(qrow + 128, subk + 128 * 128 + (size_t)c * 128 + hi * 8, hi, lane, lt2);
        LDS_WAIT();
        unsigned t1[16], t2[16];
#pragma unroll
        for (int i = 0; i < 16; ++i) { t1[i] = lt1[i * 64 + lane]; t2[i] = lt2[i * 64 + lane]; }
        unsigned ck[16][16];
#pragma unroll
        for (int x = 0; x < 16; ++x)
#pragma unroll
            for (int y = 0; y < 16; ++y)
                if ((x + 1) * (y + 1) <= 16) ck[x][y] = (ordf(unordf(t1[x] & ~0x7Fu) + unordf(t2[y] & ~0x7Fu)) & ~0xFFu) | (unsigned)(255 - (x * 16 + y));
        const float scmax = unordf(ck[0][0] & ~0xFFu);
        int* ip = IDX + m * 128 + h * 16; float* gp = GATE + m * 128 + h * 16;
        float sum = 0.f;
#pragma unroll 1
        for (int k = 0; k < 16; ++k) {
            unsigned mx = 0u;
#pragma unroll
            for (int x = 0; x < 16; ++x)
#pragma unroll
                for (int y = 0; y < 16; ++y)
                    if ((x + 1) * (y + 1) <= 16) mx = mx > ck[x][y] ? mx : ck[x][y];
#pragma unroll
            for (int x = 0; x < 16; ++x)
#pragma unroll
                for (int y = 0; y < 16; ++y)
                    if ((x + 1) * (y + 1) <= 16) ck[x][y] = ck[x][y] == mx ? 0u : ck[x][y];
            const int ci = 255 - (int)(mx & 0xFFu);
            const int e = (int)(127u - (lt1[(ci >> 4) * 64 + lane] & 0x7Fu)) * 128 + (int)(127u - (lt2[(ci & 15) * 64 + lane] & 0x7Fu));
            const float ek = __expf(unordf(mx & ~0xFFu) - scmax);
            sum += ek;
            if (hi == 0) { ip[k] = e; gp[k] = ek; }
        }
        if (hi == 0) ((float*)(ws + WS_GSUM))[m * 8 + h] = 1.f / sum;
        LDS_WAIT();
    }
}

#define FP8_LO(w) __builtin_amdgcn_cvt_pk_f32_fp8((int)(w), false)
#define FP8_HI(w) __builtin_amdgcn_cvt_pk_f32_fp8((int)(w), true)
DI float dot16(const float (&x)[32], int o, const u32x4 w) {
    const f32x2 a0 = FP8_LO(w.x), a1 = FP8_HI(w.x), a2 = FP8_LO(w.y), a3 = FP8_HI(w.y), a4 = FP8_LO(w.z), a5 = FP8_HI(w.z), a6 = FP8_LO(w.w), a7 = FP8_HI(w.w);
    return (x[o + 0] * a0.x + x[o + 1] * a0.y + x[o + 2] * a1.x + x[o + 3] * a1.y) + (x[o + 4] * a2.x + x[o + 5] * a2.y + x[o + 6] * a3.x + x[o + 7] * a3.y)
         + (x[o + 8] * a4.x + x[o + 9] * a4.y + x[o + 10] * a5.x + x[o + 11] * a5.y) + (x[o + 12] * a6.x + x[o + 13] * a6.y + x[o + 14] * a7.x + x[o + 15] * a7.y);
}
DI float dot16p(const u32x4 xa, const u32x4 xb, const u32x4 w) {
    const f32x2 a0 = FP8_LO(w.x), a1 = FP8_HI(w.x), a2 = FP8_LO(w.y), a3 = FP8_HI(w.y), a4 = FP8_LO(w.z), a5 = FP8_HI(w.z), a6 = FP8_LO(w.w), a7 = FP8_HI(w.w);
    return (bflo(xa.x) * a0.x + bfhi(xa.x) * a0.y + bflo(xa.y) * a1.x + bfhi(xa.y) * a1.y) + (bflo(xa.z) * a2.x + bfhi(xa.z) * a2.y + bflo(xa.w) * a3.x + bfhi(xa.w) * a3.y)
         + (bflo(xb.x) * a4.x + bfhi(xb.x) * a4.y + bflo(xb.y) * a5.x + bfhi(xb.y) * a5.y) + (bflo(xb.z) * a6.x + bfhi(xb.z) * a6.y + bflo(xb.w) * a7.x + bfhi(xb.w) * a7.y);
}
DI void axpy16(float (&acc)[32], int o, float g, const u32x4 w) {
    const f32x2 a0 = FP8_LO(w.x), a1 = FP8_HI(w.x), a2 = FP8_LO(w.y), a3 = FP8_HI(w.y), a4 = FP8_LO(w.z), a5 = FP8_HI(w.z), a6 = FP8_LO(w.w), a7 = FP8_HI(w.w);
    acc[o + 0] += g * a0.x; acc[o + 1] += g * a0.y; acc[o + 2] += g * a1.x; acc[o + 3] += g * a1.y; acc[o + 4] += g * a2.x; acc[o + 5] += g * a2.y; acc[o + 6] += g * a3.x; acc[o + 7] += g * a3.y;
    acc[o + 8] += g * a4.x; acc[o + 9] += g * a4.y; acc[o + 10] += g * a5.x; acc[o + 11] += g * a5.y; acc[o + 12] += g * a6.x; acc[o + 13] += g * a6.y; acc[o + 14] += g * a7.x; acc[o + 15] += g * a7.y;
}
DI void gat_load8(const unsigned char* base, int idlo, int idhi, int g4, unsigned lo16, u32x4 (&buf)[8]) {
    const int ids = g4 < 16 ? idlo : idhi, e0 = (g4 & 15) * 4;
#pragma unroll
    for (int j = 0; j < 4; ++j) { const unsigned of = (unsigned)__shfl(ids, e0 + j) * (unsigned)D + lo16; buf[2 * j] = *(const u32x4*)(base + of); buf[2 * j + 1] = *(const u32x4*)(base + of + 1024u); }
}
DI float dots4(const u32x4 (&xp)[4], const u32x4 b0, const u32x4 b1, const u32x4 b2, const u32x4 b3, const u32x4 b4, const u32x4 b5, const u32x4 b6, const u32x4 b7, int lane) {
    const float d0 = dot16p(xp[0], xp[1], b0) + dot16p(xp[2], xp[3], b1); __builtin_amdgcn_sched_barrier(0);
    const float d1 = dot16p(xp[0], xp[1], b2) + dot16p(xp[2], xp[3], b3); __builtin_amdgcn_sched_barrier(0);
    const float d2 = dot16p(xp[0], xp[1], b4) + dot16p(xp[2], xp[3], b5); __builtin_amdgcn_sched_barrier(0);
    const float d3 = dot16p(xp[0], xp[1], b6) + dot16p(xp[2], xp[3], b7); __builtin_amdgcn_sched_barrier(0);
    const bool p1 = lane & 1, p2 = lane & 2;
    const float b0s = (p1 ? d1 : d0) + __shfl_xor(p1 ? d0 : d1, 1);
    const float b1s = (p1 ? d3 : d2) + __shfl_xor(p1 ? d2 : d3, 1);
    float cs = (p2 ? b1s : b0s) + __shfl_xor(p2 ? b0s : b1s, 2);
    cs += __shfl_xor(cs, 4); cs += __shfl_xor(cs, 8); cs += __shfl_xor(cs, 16); cs += __shfl_xor(cs, 32);
    return cs;
}
DI void phase_peer_u(const Args& a, int layer) {
    const int tid = opaque_tid(), lane = tid & 63, wave = tid >> 6;
    const int gw = blockIdx.x * 8 + wave, NGW = gridDim.x * 8;
    unsigned char* ws = a.ws;
    const bf16_t* XN = (const bf16_t*)(ws + WS_XN);
    const unsigned char* U = ws + WS_U + (size_t)layer * NEXP * D;
    const unsigned lo16 = (unsigned)lane * 16u;
    const int* IDX = (const int*)(ws + WS_IDX);
    float* GATE = (float*)(ws + WS_GATE);
    const float* GSUM = (const float*)(ws + WS_GSUM);
    int m = gw;
    if (m < M) {
        int idA = IDX[(size_t)m * 128 + lane], idB = IDX[(size_t)m * 128 + 64 + lane];
        u32x4 xp[4];
#pragma unroll
        for (int q = 0; q < 4; ++q) xp[q] = *(const u32x4*)(XN + (size_t)m * D + (q >> 1) * 1024 + lane * 16 + (q & 1) * 8);
        u32x4 cur[8];
        gat_load8(U, idA, idB, 0, lo16, cur);
#pragma unroll 1
        for (; m < M; m += NGW) {
            const int mn = m + NGW < M ? m + NGW : m;
            const int idAn = IDX[(size_t)mn * 128 + lane], idBn = IDX[(size_t)mn * 128 + 64 + lane];
            u32x4 xpn[4];
#pragma unroll
            for (int q = 0; q < 4; ++q) xpn[q] = *(const u32x4*)(XN + (size_t)mn * D + (q >> 1) * 1024 + lane * 16 + (q & 1) * 8);
            const float glA = GATE[(size_t)m * 128 + lane] * GSUM[(size_t)m * 8 + (lane >> 4)] * (1.f / V_SCALE);
            const float glB = GATE[(size_t)m * 128 + 64 + lane] * GSUM[(size_t)m * 8 + 4 + (lane >> 4)] * (1.f / V_SCALE);
            float ghA = 0.f, ghB = 0.f;
#pragma unroll 1
            for (int g4 = 0; g4 < 32; ++g4) {
                u32x4 nxt[8];
                if (g4 < 31) gat_load8(U, idA, idB, g4 + 1, lo16, nxt); else gat_load8(U, idAn, idBn, 0, lo16, nxt);
                const float c0 = dots4(xp, cur[0], cur[1], cur[2], cur[3], cur[4], cur[5], cur[6], cur[7], lane);
                const float hv = gelu_tanh(c0 * (1.f / U_SCALE));
                const bool mine = (lane >> 2) == (g4 & 15);
                if (g4 < 16) ghA = mine ? hv * glA : ghA; else ghB = mine ? hv * glB : ghB;
#pragma unroll
                for (int j = 0; j < 8; ++j) cur[j] = nxt[j];
            }
            GATE[(size_t)m * 128 + lane] = ghA; GATE[(size_t)m * 128 + 64 + lane] = ghB;
            idA = idAn; idB = idBn;
#pragma unroll
            for (int q = 0; q < 4; ++q) xp[q] = xpn[q];
        }
    }
}
DI void phase_peer_v(const Args& a, int layer) {
    const int tid = opaque_tid(), lane = tid & 63, wave = tid >> 6;
    const int gw = blockIdx.x * 8 + wave, NGW = gridDim.x * 8;
    unsigned char* ws = a.ws;
    const unsigned char* V = ws + WS_V + (size_t)layer * NEXP * D;
    const unsigned lo16 = (unsigned)lane * 16u;
    const int* IDX = (const int*)(ws + WS_IDX);
    const float* GH = (const float*)(ws + WS_GATE);
    int m = gw;
    if (m < M) {
        int idA = IDX[(size_t)m * 128 + lane], idB = IDX[(size_t)m * 128 + 64 + lane];
        u32x4 cur[8];
        gat_load8(V, idA, idB, 0, lo16, cur);
#pragma unroll 1
        for (; m < M; m += NGW) {
            const int mn = m + NGW < M ? m + NGW : m;
            const int idAn = IDX[(size_t)mn * 128 + lane], idBn = IDX[(size_t)mn * 128 + 64 + lane];
            const float ghA = GH[(size_t)m * 128 + lane], ghB = GH[(size_t)m * 128 + 64 + lane];
            float acc[32];
#pragma unroll
            for (int i = 0; i < 32; ++i) acc[i] = 0.f;
#pragma unroll 1
            for (int g4 = 0; g4 < 32; ++g4) {
                u32x4 nxt[8];
                if (g4 < 31) gat_load8(V, idA, idB, g4 + 1, lo16, nxt); else gat_load8(V, idAn, idBn, 0, lo16, nxt);
                const float ghs = g4 < 16 ? ghA : ghB;
#pragma unroll
                for (int j = 0; j < 4; ++j) { const float gv = __shfl(ghs, (g4 & 15) * 4 + j); axpy16(acc, 0, gv, cur[2 * j]); axpy16(acc, 16, gv, cur[2 * j + 1]); __builtin_amdgcn_sched_barrier(0); }
#pragma unroll
                for (int j = 0; j < 8; ++j) cur[j] = nxt[j];
            }
            idA = idAn; idB = idBn;
            float ss = 0.f;
#pragma unroll
            for (int q = 0; q < 4; ++q) {
                const f32x4* hp = (const f32x4*)(a.out + (size_t)m * D + (q >> 1) * 1024 + lane * 16 + (q & 1) * 8);
                const f32x4 h0 = hp[0], h1 = hp[1];
                acc[q * 8 + 0] += h0.x; acc[q * 8 + 1] += h0.y; acc[q * 8 + 2] += h0.z; acc[q * 8 + 3] += h0.w;
                acc[q * 8 + 4] += h1.x; acc[q * 8 + 5] += h1.y; acc[q * 8 + 6] += h1.z; acc[q * 8 + 7] += h1.w;
#pragma unroll
                for (int e = 0; e < 8; ++e) ss += acc[q * 8 + e] * acc[q * 8 + e];
                __builtin_amdgcn_sched_barrier(0);
            }
            const float rstd = rsqrtf(wave_sum(ss) * (1.f / D) + 1e-6f);
            const float* gn = layer + 1 < NLAYER ? a.attn_norm + (size_t)(layer + 1) * D : a.final_norm;
            asm volatile("" : "+s"(gn));
#pragma unroll
            for (int q = 0; q < 4; ++q) {
                const int col = (q >> 1) * 1024 + lane * 16 + (q & 1) * 8;
                const f32x4 g0 = *(const f32x4*)(gn + col), g1 = *(const f32x4*)(gn + col + 4);
                f32x4 h0, h1;
                h0.x = acc[q * 8 + 0]; h0.y = acc[q * 8 + 1]; h0.z = acc[q * 8 + 2]; h0.w = acc[q * 8 + 3];
                h1.x = acc[q * 8 + 4]; h1.y = acc[q * 8 + 5]; h1.z = acc[q * 8 + 6]; h1.w = acc[q * 8 + 7];
                const f32x4 y0 = h0 * rstd * g0, y1 = h1 * rstd * g1;
                f32x4* hp = (f32x4*)(a.out + (size_t)m * D + col);
                if (layer + 1 < NLAYER) {
                    hp[0] = h0; hp[1] = h1;
                    u32x4 w; w.x = pk2(y0.x, y0.y); w.y = pk2(y0.z, y0.w); w.z = pk2(y1.x, y1.y); w.w = pk2(y1.z, y1.w);
                    *(u32x4*)((bf16_t*)(ws + WS_XN) + (size_t)m * D + col) = w;
                } else { hp[0] = y0; hp[1] = y1; }
                __builtin_amdgcn_sched_barrier(0);
            }
        }
    }
}

constexpr size_t WS_BAR = 95 * MiB;
#define XB_TMO      128
#define XB_XCNT(j)  (256  + 64 * (j))
#define XB_XSUB(j)  (1280 + 64 * (j))
#define XB_XGEN(j)  (2304 + 64 * (j))
#define XB_TOP      3328
#define XB_TOPGEN   3392
#define XCD_BAR_WORDS 3456
#define XB_SPIN_CAP (1u << 18)

__device__ __forceinline__ unsigned xb_ld(unsigned* p)              { return __hip_atomic_load(p, __ATOMIC_RELAXED, __HIP_MEMORY_SCOPE_AGENT); }
__device__ __forceinline__ unsigned xb_add(unsigned* p, unsigned v) { return __hip_atomic_fetch_add(p, v, __ATOMIC_RELAXED, __HIP_MEMORY_SCOPE_AGENT); }
__device__ __forceinline__ unsigned xb_xcc_id() { return (unsigned)__builtin_amdgcn_s_getreg((3 << 11) | 20) & 0xFu; }
#define XB_SPIN(cond, bar) do { unsigned _sp = 0; while (cond) { __builtin_amdgcn_s_sleep(1); \
    if ((++_sp & 255u) == 0u) { if (xb_ld(&(bar)[XB_TMO])) break; if (_sp > XB_SPIN_CAP) { atomicAdd(&(bar)[XB_TMO], 1u); break; } } } } while (0)

struct XcdBarrier {
    unsigned* bar; unsigned x;
    volatile LAS unsigned* st;
};

__device__ __forceinline__ XcdBarrier xcd_barrier_post(unsigned* bar, volatile LAS unsigned* st) {
    XcdBarrier b; b.bar = bar; b.x = xb_xcc_id(); b.st = st;
    if (threadIdx.x == 0) (void)xb_add(&bar[XB_XCNT(b.x)], 1u);
    return b;
}
__device__ __forceinline__ void xcd_barrier_complete(unsigned* bar, unsigned x, unsigned& nloc, unsigned& nx) {
    const unsigned G = gridDim.x * gridDim.y * gridDim.z;
    unsigned sum, cnt, mine, sp = 0u;
    for (;;) {
        sum = 0u; cnt = 0u; mine = 0u;
#pragma unroll
        for (unsigned j = 0; j < 16; ++j) { const unsigned c = xb_ld(&bar[XB_XCNT(j)]); sum += c; cnt += (c > 0u) ? 1u : 0u; mine = (j == x) ? c : mine; }
        if (sum == G) break;
        __builtin_amdgcn_s_sleep(1);
        if ((++sp & 255u) == 0u) { if (xb_ld(&bar[XB_TMO])) break; if (sp > XB_SPIN_CAP) { atomicAdd(&bar[XB_TMO], 1u); break; } }
    }
    nloc = mine > 0u ? mine : 1u; nx = cnt > 0u ? cnt : 1u;
}

__device__ __forceinline__ void xcd_barrier(const XcdBarrier& b) {
    asm volatile("s_waitcnt vmcnt(0)" ::: "memory");
    __syncthreads();
    if (threadIdx.x == 0) {
        unsigned* bar = b.bar;
        __builtin_amdgcn_s_waitcnt(0);
        unsigned nloc = b.st[0], nx = b.st[1];
        if (nloc == 0u) { xcd_barrier_complete(bar, b.x, nloc, nx); b.st[0] = nloc; b.st[1] = nx; }
        const unsigned old = xb_add(&bar[XB_XSUB(b.x)], 1u);
        const unsigned gen = old / nloc;
        if (old + 1u == (gen + 1u) * nloc) {
            __builtin_amdgcn_fence(__ATOMIC_RELEASE, "agent");
            asm volatile("s_waitcnt vmcnt(0)" ::: "memory");
            const unsigned og = xb_add(&bar[XB_TOP], 1u);
            const unsigned tg = og / nx;
            if (og + 1u == (tg + 1u) * nx) xb_add(&bar[XB_TOPGEN], 1u);
            else XB_SPIN(xb_ld(&bar[XB_TOPGEN]) == tg, bar);
            __builtin_amdgcn_fence(__ATOMIC_ACQUIRE, "agent");
            xb_add(&bar[XB_XGEN(b.x)], 1u);
            asm volatile("s_waitcnt vmcnt(0)" ::: "memory");
        } else {
            XB_SPIN(xb_ld(&bar[XB_XGEN(b.x)]) == gen, bar);
            __builtin_amdgcn_fence(__ATOMIC_ACQUIRE, "agent");
            asm volatile("s_waitcnt vmcnt(0)" ::: "memory");
        }
    }
    __syncthreads();
}

constexpr int NPHASE = 22, PH_PER_LAYER = 10;
template <int KIND>
DI void run_phase(const Args& a, int layer, LAS unsigned char* lds) {
    unsigned char* ws = a.ws;
    if constexpr (KIND == 0) { phase_prologue(a, lds); phase_rms_bf16(a.x, a.attn_norm, (bf16_t*)(ws + WS_XN)); }
    if constexpr (KIND == 1) phase_rms_bf16(layer == 0 ? a.x : a.out, a.attn_norm + (size_t)layer * D, (bf16_t*)(ws + WS_XN));
    if constexpr (KIND == 2 || KIND == 7) {
        const bool inproj = KIND == 2;
        const int N = inproj ? C_GATE : D, ldw = inproj ? NP : D;
        pg8::Gemm g{(const bf16_t*)(ws + WS_XN), (const bf16_t*)(ws + (inproj ? WS_WIN : WS_WQ)) + (size_t)layer * ldw * D, M, N, D};
        pg8::StaticOrder So; So.init(M, N, (int)gridDim.x, (int)blockIdx.x);
        pg8::EpiBf16<0> E{(bf16_t*)(ws + (inproj ? WS_P : WS_Q2)), ldw, nullptr, 0, 0, 1.f};
        pg8::gemm_phase<pg8::EpiBf16<0>, pg8::StaticOrder, true, true>(lds, g, So, E);
    }
    if constexpr (KIND == 3) phase_prep(a, layer, lds);
    if constexpr (KIND == 4) phase_attn(a, layer, lds);
    if constexpr (KIND == 5) {
        pg8::Gemm g{(const bf16_t*)(ws + WS_O), (const bf16_t*)(ws + WS_WOUT) + (size_t)layer * D * D, M, D, D};
        pg8::StaticOrder So; So.init(M, D, (int)gridDim.x, (int)blockIdx.x);
        EpiResid E{layer == 0 ? a.x : a.out, a.out, D};
        pg8::gemm_phase<EpiResid, pg8::StaticOrder, true, true>(lds, g, So, E);
    }
    if constexpr (KIND == 6) phase_rms_bf16(a.out, a.ffn_norm + (size_t)layer * D, (bf16_t*)(ws + WS_XN));
    if constexpr (KIND == 8) phase_peer_select(a, layer, lds);
    if constexpr (KIND == 9) phase_peer_u(a, layer);
    if constexpr (KIND == 14) phase_peer_v(a, layer);
    if constexpr (KIND == 10) phase_rms_final(a.out, a.final_norm);
}

#ifndef MK_PER_PHASE
#define MK_PER_PHASE 0
#endif

#if MK_PER_PHASE
template <int KIND>
__global__ void __launch_bounds__(NTHREADS, 2) k_phase(Args a, int layer) {
    extern __shared__ __attribute__((aligned(16))) unsigned char lds_raw[];
    run_phase<KIND>(a, layer, (LAS unsigned char*)lds_raw);
}
template <int KIND> static void launch_phase(const Args& a, int layer, int grid, hipStream_t stream) {
    static bool attr = false;
    if (!attr) { (void)hipFuncSetAttribute((const void*)k_phase<KIND>, hipFuncAttributeMaxDynamicSharedMemorySize, LDS_BYTES); attr = true; }
    hipLaunchKernelGGL(k_phase<KIND>, dim3(grid), dim3(NTHREADS), LDS_BYTES, stream, a, layer);
}
#else
__global__ void __launch_bounds__(NTHREADS, 2) hybrid_fwd(Args a) {
    extern __shared__ __attribute__((aligned(16))) unsigned char lds_raw[];
    LAS unsigned char* lds = (LAS unsigned char*)lds_raw;
    volatile LAS unsigned* bst = (volatile LAS unsigned*)(lds + LDS_BYTES - 16);
    if (threadIdx.x < 4) bst[threadIdx.x] = 0u;
    __syncthreads();
    const XcdBarrier xbar = xcd_barrier_post((unsigned*)(a.ws + WS_BAR), bst);
    bool first_seam = true;
#pragma unroll 1
    for (int ph = a.ph_lo; ph < a.ph_hi; ++ph) {
        if (ph == NPHASE - 1 || ph == 1 + PH_PER_LAYER || ph == 1) continue;
        if (ph == 0) run_phase<0>(a, 0, lds);
        else if (ph == NPHASE - 1) run_phase<10>(a, 0, lds);
        else {
            const int layer = (ph - 1) / PH_PER_LAYER, k = (ph - 1) % PH_PER_LAYER;
            if (k == 0) run_phase<1>(a, layer, lds);
            else if (k == 1) run_phase<2>(a, layer, lds);
            else if (k == 2) run_phase<3>(a, layer, lds);
            else if (k == 3) run_phase<4>(a, layer, lds);
            else if (k == 4) run_phase<5>(a, layer, lds);
            else if (k == 5) run_phase<6>(a, layer, lds);
            else if (k == 6) run_phase<7>(a, layer, lds);
            else if (k == 7) run_phase<8>(a, layer, lds);
            else if (k == 8) run_phase<9>(a, layer, lds);
            else run_phase<14>(a, layer, lds);
        }
        if (ph + 1 < a.ph_hi) { if (first_seam) { cg::this_grid().sync(); first_seam = false; } else xcd_barrier(xbar); }
    }
}
#endif

extern "C" void kernel_launch(void* const* d_in, const int* in_sizes, int n_in, void* d_out, int out_size, void* d_ws, size_t ws_size, hipStream_t stream) {
    static int grid = 0;
    if (grid == 0) {
        if (n_in != 18 || out_size != M * D || ws_size < WS_END) { fprintf(stderr, "kernel_launch: unexpected shapes (n_in %d, out %d, ws %zu)\n", n_in, out_size, ws_size); grid = -1; return; }
        int dev = 0, cus = 0;
        if (hipGetDevice(&dev) != hipSuccess || hipDeviceGetAttribute(&cus, hipDeviceAttributeMultiprocessorCount, dev) != hipSuccess) { grid = -1; return; }
#if !MK_PER_PHASE
        if (hipFuncSetAttribute((const void*)hybrid_fwd, hipFuncAttributeMaxDynamicSharedMemorySize, LDS_BYTES) != hipSuccess) { fprintf(stderr, "kernel_launch: hipFuncSetAttribute failed\n"); grid = -1; return; }
        int per_cu = 0;
        if (hipOccupancyMaxActiveBlocksPerMultiprocessor(&per_cu, (const void*)hybrid_fwd, NTHREADS, LDS_BYTES) != hipSuccess || per_cu < 1) fprintf(stderr, "kernel_launch: occupancy query says %d\n", per_cu);
        (void)hipGetLastError();
#endif
        grid = cus;
    }
    if (grid < 0) return;
    Args a{};
    a.x = (const float*)d_in[0]; a.attn_norm = (const float*)d_in[1]; a.w_in = (const float*)d_in[2]; a.cmp_pos_k = (const float*)d_in[3];
    a.cmp_w1_k = (const float*)d_in[4]; a.cmp_w2_k = (const float*)d_in[5]; a.cmp_pos_v = (const float*)d_in[6]; a.cmp_w1_v = (const float*)d_in[7];
    a.cmp_w2_v = (const float*)d_in[8]; a.sinks = (const float*)d_in[9]; a.w_out = (const float*)d_in[10]; a.ffn_norm = (const float*)d_in[11];
    a.peer_wq = (const float*)d_in[12]; a.peer_subkeys = (const float*)d_in[13]; a.peer_u = (const float*)d_in[14]; a.peer_v = (const float*)d_in[15];
    a.rel_bias = (const float*)d_in[16]; a.final_norm = (const float*)d_in[17];
    a.out = (float*)d_out; a.ws = (unsigned char*)d_ws;
    a.ph_lo = 0; a.ph_hi = NPHASE;
#if MK_PER_PHASE
    launch_phase<0>(a, 0, grid, stream);
    for (int l = 0; l < NLAYER; ++l) {
        launch_phase<2>(a, l, grid, stream); launch_phase<3>(a, l, grid, stream);
        launch_phase<4>(a, l, grid, stream); launch_phase<5>(a, l, grid, stream); launch_phase<6>(a, l, grid, stream);
        launch_phase<7>(a, l, grid, stream); launch_phase<8>(a, l, grid, stream); launch_phase<9>(a, l, grid, stream); launch_phase<14>(a, l, grid, stream);
    }
#else
    (void)hipMemsetAsync((unsigned char*)d_ws + WS_BAR, 0, 16384, stream);
    void* args[] = {&a};
    const hipError_t e = hipLaunchCooperativeKernel((const void*)hybrid_fwd, dim3(grid), dim3(NTHREADS), args, LDS_BYTES, stream);
    if (e != hipSuccess) fprintf(stderr, "kernel_launch: cooperative launch failed: %s (grid %d)\n", hipGetErrorString(e), grid);
#endif
}
```

```cpp
#include <hip/hip_runtime.h>
#include <cstdio>
#include <cstdint>
__device__ __forceinline__ int opaque_tid() { int t = threadIdx.x; asm volatile("" : "+v"(t)); return t; }
namespace pg8 {
#define PG8_LAS __attribute__((address_space(3)))
typedef unsigned short bf16_t;
typedef short bf16x8 __attribute__((ext_vector_type(8)));
typedef float f32x4 __attribute__((ext_vector_type(4)));
typedef unsigned u32x4 __attribute__((ext_vector_type(4)));
constexpr int BM = 256, BK = 64, HALF = 128, HTB = HALF * BK * 2  , STAGE_BYTES = 8 * HTB, NXCD = 8, WGM = 8;

__host__ __device__ __forceinline__ int lds_byte(int r, int c) { const int st = (r >> 4) * 2 + (c >> 5), rr = r & 15, cc = c & 31, ob = rr * 64 + cc * 2; return st * 1024 + (ob ^ (((ob >> 9) & 1) << 5)); }
__host__ __device__ __forceinline__ void stage_rc(int b, int& R, int& C) { const int st = b / 1024, sb = b % 1024, swz = sb ^ (((sb >> 9) & 1) << 5); R = (st >> 1) * 16 + swz / 64; C = (st & 1) * 32 + (swz % 64) / 2; }
__host__ __device__ __forceinline__ int perm32(int rho) { const int n = rho >> 4, i = rho & 15; return 8 * (i >> 2) + 4 * n + (i & 3); }

struct Unit { int pm, pn; };
struct Gemm { const bf16_t* A; const bf16_t* Bt; int M, N, K; };

struct StaticOrder {
    int nM, nN, nwg, G, c;
    __host__ __device__ void init(int M, int N, int G_, int c_) { nM = M / BM; nN = N / BM; nwg = nM * nN; G = G_; c = c_; }
    __host__ __device__ bool next(int i, Unit& u) const {
        const long L = (long)i * G + c; if (L >= nwg) return false;
        int wgid = (int)L; { const int q = nwg / NXCD, r = nwg % NXCD, xcd = wgid % NXCD, off = wgid / NXCD; wgid = (xcd < r ? xcd * (q + 1) : r * (q + 1) + (xcd - r) * q) + off; }
        const int nig = WGM * nN, gid = wgid / nig, fm = gid * WGM, gsz = (nM - fm) < WGM ? (nM - fm) : WGM;
        u.pm = fm + ((wgid % nig) % gsz); u.pn = (wgid % nig) / gsz; return true;
    }
    __device__ __forceinline__ void a_ready(const Unit&) const {}
    __device__ __forceinline__ void done(const Unit&) const {}
};

__device__ __forceinline__ unsigned cvt_pk_bf16(float lo, float hi) { unsigned r; asm volatile("v_cvt_pk_bf16_f32 %0, %1, %2" : "=v"(r) : "v"(lo), "v"(hi)); return r; }
typedef float f32x2 __attribute__((ext_vector_type(2)));
__device__ __forceinline__ f32x2 gelu_pk(f32x2 v) {
    const f32x2 av = __builtin_elementwise_abs(v), d = av * 0.2316418882f + 1.0f;
    f32x2 t; t.x = __builtin_amdgcn_rcpf(d.x); t.y = __builtin_amdgcn_rcpf(d.y);
    f32x2 q = t * 0.5307027145f + (-0.7265760135f); q = q * t + 0.7107068705f; q = q * t + (-0.142248368f); q = q * t + 0.127414796f; q = q * t;
    const f32x2 s = (v * v) * (-0.72134752044f);
    f32x2 e; e.x = __builtin_amdgcn_exp2f(s.x); e.y = __builtin_amdgcn_exp2f(s.y);
    const f32x2 m = v * (q * e), r = v - m;
    f32x2 o; o.x = v.x < 0.f ? m.x : r.x; o.y = v.y < 0.f ? m.y : r.y; return o;
}

template <int ACT  > struct EpiBf16 {
    static constexpr bool PERM = true, AFTER_DRAIN = false; static_assert(ACT == 0 || ACT == 1, "EpiBf16: ACT is 0 (none) or 1 (gelu_pk)");
    bf16_t* O; int ldc; const float* bias; int split_cols; size_t split_stride; float scale0;
    __device__ __forceinline__ void operator()(const f32x4 (&acc)[2][2][4][2], const Unit& u, int wr, int wc, int fr, int fq) const {
        const int row0 = u.pm * BM + wr * 64 + fr; int colt = u.pn * BM; bf16_t* base = O;
        float sc = 1.f; if (split_cols) { const int t = colt / split_cols; base += (size_t)t * split_stride; colt -= t * split_cols; if (t == 0) sc = scale0; }
        const int col0 = colt + wc * 32 + 8 * fq, bcol0 = u.pn * BM + wc * 32 + 8 * fq;
        f32x4 bv[2][2];
#pragma unroll
        for (int bj = 0; bj < 2; ++bj)
#pragma unroll
            for (int n = 0; n < 2; ++n) bv[bj][n] = bias ? *(const f32x4*)(bias + bcol0 + bj * HALF + 4 * n) : (f32x4){0.f, 0.f, 0.f, 0.f};
#pragma unroll
        for (int ai = 0; ai < 2; ++ai)
#pragma unroll
            for (int m = 0; m < 4; ++m) { bf16_t* rowp = base + (size_t)(row0 + ai * HALF + m * 16) * ldc + col0;
#pragma unroll
                for (int bj = 0; bj < 2; ++bj) { f32x4 v0 = acc[ai][bj][m][0] + bv[bj][0], v1 = acc[ai][bj][m][1] + bv[bj][1];
                    if (ACT == 1) { f32x2 a = gelu_pk((f32x2){v0[0], v0[1]}), b = gelu_pk((f32x2){v0[2], v0[3]}), c = gelu_pk((f32x2){v1[0], v1[1]}), d = gelu_pk((f32x2){v1[2], v1[3]});
                        v0 = (f32x4){a.x, a.y, b.x, b.y}; v1 = (f32x4){c.x, c.y, d.x, d.y}; }
                    v0 = v0 * sc; v1 = v1 * sc; u32x4 w; w.x = cvt_pk_bf16(v0[0], v0[1]); w.y = cvt_pk_bf16(v0[2], v0[3]); w.z = cvt_pk_bf16(v1[0], v1[1]); w.w = cvt_pk_bf16(v1[2], v1[3]);
                    *(u32x4*)(rowp + bj * HALF) = w; } }
    }
};
template <class Epi, class Sched, bool ALIGN_EPI = false, bool SP2 = false>
__device__ __forceinline__ void gemm_phase(PG8_LAS unsigned char* lds, const Gemm g, const Sched& S, const Epi& E) {
    const int tid = opaque_tid(), wid = __builtin_amdgcn_readfirstlane(tid >> 6), lane = tid & 63, wr = wid >> 2, wc = wid & 3, fr = lane & 15, fq = lane >> 4;
    const int K = g.K, nt = K / BK;
    unsigned voffA[2], voffB[2];
#pragma unroll
    for (int i = 0; i < 2; ++i) { int R, C; stage_rc(tid * 16 + i * 8192, R, C); const int Rb = Epi::PERM ? ((R & ~31) + perm32(R & 31)) : R;
        voffA[i] = (unsigned)(R * K + C) * 2u; voffB[i] = (unsigned)(Rb * K + C) * 2u; }
    const size_t kstep = (size_t)(BK * 2);
    const size_t hstep = (size_t)HALF * K * 2;
    const size_t tstep = 2 * hstep;
    const unsigned ldsw = (unsigned)wid * 1024u;
    const int aoff = lds_byte(wr * 64 + fr, fq * 8), boff = lds_byte(wc * 32 + fr, fq * 8);
#define PG8_SA(b, h) (((b) * 2 + (h)) * HTB)
#define PG8_SB(b, h) ((4 + (b) * 2 + (h)) * HTB)
#define PG8_STAGE(bufoff, gbase, voff) do { _Pragma("unroll") for (int _i = 0; _i < 2; ++_i) \
        __builtin_amdgcn_global_load_lds((const unsigned*)((const char*)(gbase) + (voff)[_i]), (PG8_LAS unsigned*)(lds + (bufoff) + ldsw + _i * 8192), 16, 0, 0); } while (0)
#define PG8_LDA(dst, b, h) do { _Pragma("unroll") for (int m = 0; m < 4; ++m) _Pragma("unroll") for (int k = 0; k < 2; ++k) dst[m][k] = *(const PG8_LAS bf16x8*)(lds + PG8_SA(b, h) + aoff + m * 2048 + k * 1024); } while (0)
#define PG8_LDB(dst, b, h) do { _Pragma("unroll") for (int n = 0; n < 2; ++n) _Pragma("unroll") for (int k = 0; k < 2; ++k) dst[n][k] = *(const PG8_LAS bf16x8*)(lds + PG8_SB(b, h) + boff + n * 2048 + k * 1024); } while (0)
#define PG8_MMA(ai, bj, At, Bt) do { __builtin_amdgcn_s_setprio(1); _Pragma("unroll") for (int m = 0; m < 4; ++m) _Pragma("unroll") for (int n = 0; n < 2; ++n) _Pragma("unroll") for (int k = 0; k < 2; ++k) \
        acc[ai][bj][m][n] = __builtin_amdgcn_mfma_f32_16x16x32_bf16(Bt[n][k], At[m][k], acc[ai][bj][m][n], 0, 0, 0); __builtin_amdgcn_s_setprio(0); } while (0)
#define PG8_WAIT_V(n) asm volatile("s_waitcnt vmcnt(" #n ")" ::: "memory")
#define PG8_WAIT_L(n) asm volatile("s_waitcnt lgkmcnt(" #n ")" ::: "memory")
#define PG8_BAR __builtin_amdgcn_s_barrier()
#define PG8_SCHED __builtin_amdgcn_sched_barrier(0)
    Unit cur, nxt; int ui = 0;
    if (!S.next(0, cur)) return;
    f32x4 acc[2][2][4][2];
#pragma unroll
    for (int a = 0; a < 2; ++a)
#pragma unroll
        for (int b = 0; b < 2; ++b)
#pragma unroll
            for (int m = 0; m < 4; ++m)
#pragma unroll
                for (int n = 0; n < 2; ++n) acc[a][b][m][n] = (f32x4){0.f, 0.f, 0.f, 0.f};
    bf16x8 At[4][2], B0[2][2], B1[2][2];
    const char* cA = (const char*)g.A + (size_t)cur.pm * tstep; const char* cB = (const char*)g.Bt + (size_t)cur.pn * tstep;
    S.a_ready(cur);
    if constexpr (SP2) {
        PG8_STAGE(PG8_SB(0, 0), cB, voffB); PG8_STAGE(PG8_SB(0, 1), cB + hstep, voffB); PG8_STAGE(PG8_SA(0, 0), cA, voffA); PG8_STAGE(PG8_SA(0, 1), cA + hstep, voffA);
        if (wr == 1) PG8_BAR;
        PG8_WAIT_V(2); PG8_BAR;
        PG8_STAGE(PG8_SB(1, 0), cB + kstep, voffB); PG8_STAGE(PG8_SA(1, 0), cA + kstep, voffA); PG8_STAGE(PG8_SB(1, 1), cB + hstep + kstep, voffB);
        PG8_WAIT_V(6); PG8_BAR;
    } else {
        PG8_STAGE(PG8_SB(0, 0), cB, voffB); PG8_STAGE(PG8_SA(0, 0), cA, voffA); PG8_STAGE(PG8_SB(0, 1), cB + hstep, voffB); PG8_STAGE(PG8_SA(0, 1), cA + hstep, voffA);
        if (wr == 1) PG8_BAR;
        PG8_WAIT_V(4); PG8_BAR;
        PG8_STAGE(PG8_SB(1, 0), cB + kstep, voffB); PG8_STAGE(PG8_SA(1, 0), cA + kstep, voffA); PG8_STAGE(PG8_SB(1, 1), cB + hstep + kstep, voffB);
        PG8_WAIT_V(6); PG8_BAR;
    }
    for (;;) {
        const bool has_next = S.next(ui + 1, nxt);
        const char* nA = has_next ? (const char*)g.A + (size_t)nxt.pm * tstep : cA; const char* nB = has_next ? (const char*)g.Bt + (size_t)nxt.pn * tstep : cB;
        for (int t = 0; t < nt; t += 2) {
            const bool last = (t == nt - 2);
            const char* a1 = cA + (size_t)(t + 1) * kstep;
            const char* a2 = last ? nA : cA + (size_t)(t + 2) * kstep; const char* b2 = last ? nB : cB + (size_t)(t + 2) * kstep;
            const char* a3 = a2 + kstep; const char* b3 = b2 + kstep;
            if (last && has_next) S.a_ready(nxt);
            if constexpr (SP2) {
            PG8_LDB(B0, 0, 0); PG8_LDB(B1, 0, 1); PG8_SCHED; PG8_LDA(At, 0, 0); PG8_STAGE(PG8_SA(1, 1), a1 + hstep, voffA);
            PG8_WAIT_V(8); PG8_WAIT_L(0); PG8_BAR; PG8_MMA(0, 0, At, B0); PG8_MMA(0, 1, At, B1); PG8_BAR; PG8_SCHED;
            PG8_LDA(At, 0, 1); PG8_STAGE(PG8_SB(0, 0), b2, voffB); PG8_STAGE(PG8_SB(0, 1), b2 + hstep, voffB); PG8_STAGE(PG8_SA(0, 0), a2, voffA);
            PG8_WAIT_V(8); PG8_WAIT_L(0); PG8_BAR; PG8_MMA(1, 0, At, B0); PG8_MMA(1, 1, At, B1); PG8_BAR; PG8_SCHED;
            PG8_LDB(B0, 1, 0); PG8_LDB(B1, 1, 1); PG8_SCHED; PG8_LDA(At, 1, 0); PG8_STAGE(PG8_SA(0, 1), a2 + hstep, voffA);
            PG8_WAIT_V(8); PG8_WAIT_L(0); PG8_BAR; PG8_MMA(0, 0, At, B0); PG8_MMA(0, 1, At, B1); PG8_BAR; PG8_SCHED;
            PG8_LDA(At, 1, 1); PG8_STAGE(PG8_SB(1, 0), b3, voffB); PG8_STAGE(PG8_SB(1, 1), b3 + hstep, voffB); PG8_STAGE(PG8_SA(1, 0), a3, voffA);
            PG8_WAIT_V(8); PG8_WAIT_L(0); PG8_BAR; PG8_MMA(1, 0, At, B0); PG8_MMA(1, 1, At, B1); PG8_BAR; PG8_SCHED;
            } else {
            PG8_LDB(B0, 0, 0); PG8_SCHED; PG8_LDA(At, 0, 0); PG8_STAGE(PG8_SA(1, 1), a1 + hstep, voffA);
            PG8_WAIT_L(8); PG8_BAR; PG8_WAIT_L(0); PG8_MMA(0, 0, At, B0); PG8_BAR; PG8_SCHED;
            PG8_LDB(B1, 0, 1); PG8_STAGE(PG8_SB(0, 0), b2, voffB);
            PG8_BAR; PG8_WAIT_L(0); PG8_MMA(0, 1, At, B1); PG8_BAR;
            PG8_LDA(At, 0, 1); PG8_STAGE(PG8_SA(0, 0), a2, voffA);
            PG8_BAR; PG8_WAIT_L(0); PG8_MMA(1, 0, At, B0); PG8_BAR; PG8_SCHED;
            PG8_STAGE(PG8_SB(0, 1), b2 + hstep, voffB);
            PG8_WAIT_V(6); PG8_BAR; PG8_MMA(1, 1, At, B1); PG8_BAR;
            PG8_LDB(B0, 1, 0); PG8_SCHED; PG8_LDA(At, 1, 0); PG8_STAGE(PG8_SA(0, 1), a2 + hstep, voffA);
            PG8_WAIT_L(8); PG8_BAR; PG8_WAIT_L(0); PG8_MMA(0, 0, At, B0); PG8_BAR; PG8_SCHED;
            PG8_LDB(B1, 1, 1); PG8_STAGE(PG8_SB(1, 0), b3, voffB);
            PG8_BAR; PG8_WAIT_L(0); PG8_MMA(0, 1, At, B1); PG8_BAR;
            PG8_LDA(At, 1, 1); PG8_STAGE(PG8_SA(1, 0), a3, voffA);
            PG8_BAR; PG8_WAIT_L(0); PG8_MMA(1, 0, At, B0); PG8_BAR; PG8_SCHED;
            PG8_STAGE(PG8_SB(1, 1), b3 + hstep, voffB);
            PG8_WAIT_V(6); PG8_BAR; PG8_MMA(1, 1, At, B1); PG8_BAR;
            }
        }
        if constexpr (ALIGN_EPI) { if (wr == 0) PG8_BAR; }
        if constexpr (!Epi::AFTER_DRAIN) { E(acc, cur, wr, wc, fr, fq); S.done(cur); }
        if (!has_next) break;
#pragma unroll
        for (int a = 0; a < 2; ++a)
#pragma unroll
            for (int b = 0; b < 2; ++b)
#pragma unroll
                for (int m = 0; m < 4; ++m)
#pragma unroll
                    for (int n = 0; n < 2; ++n) acc[a][b][m][n] = (f32x4){0.f, 0.f, 0.f, 0.f};
        cur = nxt; cA = nA; cB = nB; ++ui;
        if constexpr (ALIGN_EPI) { if (wr == 1) PG8_BAR; }
    }
    PG8_WAIT_V(0);
    if constexpr (!ALIGN_EPI) { if (wr == 0) PG8_BAR; }
    PG8_BAR;
    if constexpr (Epi::AFTER_DRAIN) { E.fused(acc, cur, wr, wc, fr, fq, lds, wid, lane); S.done(cur); }
#undef PG8_SA
#undef PG8_SB
#undef PG8_STAGE
#undef PG8_LDA
#undef PG8_LDB
#undef PG8_MMA
#undef PG8_WAIT_V
#undef PG8_WAIT_L
#undef PG8_BAR
#undef PG8_SCHED
}
}

#include <hip/hip_cooperative_groups.h>
namespace cg = cooperative_groups;

#define DI __device__ __forceinline__
#define LAS __attribute__((address_space(3)))
typedef unsigned short bf16_t;
typedef short bf16x8 __attribute__((ext_vector_type(8)));
typedef float f32x4 __attribute__((ext_vector_type(4)));
typedef float f32x2 __attribute__((ext_vector_type(2)));
typedef float f32x16 __attribute__((ext_vector_type(16)));
typedef unsigned u32x4 __attribute__((ext_vector_type(4)));
typedef unsigned u32x2 __attribute__((ext_vector_type(2)));
typedef __bf16 bf16v2 __attribute__((ext_vector_type(2)));

#define MFMA32(a, b, c) __builtin_amdgcn_mfma_f32_32x32x16_bf16((a), (b), (c), 0, 0, 0)
#define MFMA16(a, b, c) __builtin_amdgcn_mfma_f32_16x16x32_bf16((a), (b), (c), 0, 0, 0)
#define LDS_WAIT() asm volatile("s_waitcnt lgkmcnt(0)" ::: "memory")

constexpr int NB = 2, S = 16384, D = 2048, M = NB * S, NLAYER = 2;
constexpr int NPROJ = 3120, NP = 3328;
constexpr int C_QA = 0, C_QB = 1024, C_KC = 2048, C_VC = 2176, C_KS = 2304, C_VS = 2432, C_KW = 2560, C_VW = 2688, C_KB = 2816, C_VB = 2944, C_GATE = 3072;
constexpr int NCP = 1024;
constexpr int NEXP = 16384;
constexpr float NEGF = -1e30f;

constexpr size_t MiB = 1u << 20;
constexpr size_t WS_WIN = 0;
constexpr size_t WS_WOUT = 28 * MiB;
constexpr size_t WS_WQ = 46 * MiB;
constexpr size_t WS_CW1 = 64 * MiB;
constexpr size_t WS_SUBK = 67 * MiB;
constexpr size_t WS_KC = 68 * MiB;
constexpr size_t WS_VCT = 69 * MiB;
constexpr size_t WS_VST = 70 * MiB;
constexpr size_t WS_VWT = 78 * MiB;
constexpr size_t WS_VBT = 86 * MiB;
constexpr size_t WS_IDX = 96 * MiB;
constexpr size_t WS_GATE = 112 * MiB;
constexpr size_t WS_GSUM = 94 * MiB;
constexpr size_t WS_U = 128 * MiB;
constexpr size_t WS_V = 256 * MiB;
constexpr size_t WS_KSF = 192 * MiB, WS_KWF = 200 * MiB, WS_KBF = 208 * MiB;
constexpr size_t WS_KMAX = 95 * MiB + 65536;
constexpr size_t WS_RSS = 192 * MiB + 24 * MiB;
constexpr size_t WS_XN = 384 * MiB;
constexpr size_t WS_O = 512 * MiB;
constexpr size_t WS_Q2 = 640 * MiB;
constexpr size_t WS_P = 768 * MiB;
constexpr size_t WS_END = 1000 * MiB;

constexpr int LDS_BYTES = 139264;
constexpr int NTHREADS = 512;

struct Args {
    const float* x; const float* attn_norm; const float* w_in; const float* cmp_pos_k; const float* cmp_w1_k; const float* cmp_w2_k;
    const float* cmp_pos_v; const float* cmp_w1_v; const float* cmp_w2_v; const float* sinks; const float* w_out; const float* ffn_norm;
    const float* peer_wq; const float* peer_subkeys; const float* peer_u; const float* peer_v; const float* rel_bias; const float* final_norm;
    float* out; unsigned char* ws; int ph_lo, ph_hi;
};

DI unsigned f2bf(float f) { unsigned u = __builtin_bit_cast(unsigned, f); return (u + 0x7fffu + ((u >> 16) & 1u)) >> 16; }
DI unsigned pk2(float lo, float hi) { const f32x2 v = {lo, hi}; return __builtin_bit_cast(unsigned, __builtin_convertvector(v, bf16v2)); }
DI float bflo(unsigned w) { return __builtin_bit_cast(float, w << 16); }
DI float bfhi(unsigned w) { return __builtin_bit_cast(float, w & 0xffff0000u); }
DI float bf2f(bf16_t v) { return __builtin_bit_cast(float, (unsigned)v << 16); }
DI float wave_sum(float v) {
#pragma unroll
    for (int o = 1; o < 64; o <<= 1) v += __shfl_xor(v, o);
    return v;
}
DI float gelu_tanh(float x) {
    const float y = 0.7978845608028654f * (x + 0.044715f * x * x * x);
    const float t = __expf(2.f * y);
    const float th = 1.f - 2.f / (t + 1.f);
    return 0.5f * x * (1.f + th);
}
DI float sigmoidf_(float x) { return 1.f / (1.f + __expf(-x)); }
DI int crow(int r, int hi) { return (r & 3) + 8 * (r >> 2) + 4 * hi; }
DI int rel_bucket(int d) {
    const float lf = __log2f((float)(d < 1 ? 1 : d));
    int b = 16 + (int)((lf - 4.0f) * (16.0f / 7.0f));
    b = b > 31 ? 31 : b;
    return d < 16 ? d : b;
}
DI bf16x8 pack8(float a0, float a1, float a2, float a3, float a4, float a5, float a6, float a7) {
    u32x4 p; p.x = pk2(a0, a1); p.y = pk2(a2, a3); p.z = pk2(a4, a5); p.w = pk2(a6, a7);
    return __builtin_bit_cast(bf16x8, p);
}

DI int win_srccol(int n) {
    if (n < 1024) return n;
    if (n < 2048) return 1840 + (n - 1024);
    if (n < 2816) return 1024 + (n - 2048);
    if (n < 3072) return 2864 + (n - 2816);
    if (n < 3120) return 1792 + (n - 3072);
    return -1;
}
template <bool WIN>
DI void transpose_item(const float* W, int K, int Nsrc, bf16_t* WT, int k0, int n0, LAS float* scr, int lane, const float* gk = nullptr) {
    const int nd = n0 + (lane & 31);
    const int ns = WIN ? win_srccol(nd) : nd;
#pragma unroll 8
    for (int i = 0; i < 32; ++i) { const int kk = 2 * i + (lane >> 5); scr[kk * 33 + (lane & 31)] = (ns >= 0 ? W[(size_t)(k0 + kk) * Nsrc + ns] : 0.f) * (gk ? gk[k0 + kk] : 1.f); }
    LDS_WAIT();
    const int c = lane & 7;
#pragma unroll
    for (int j = 0; j < 4; ++j) { const int n = (lane >> 3) + 8 * j; const LAS float* s = scr + (8 * c) * 33 + n;
        u32x4 o; o.x = pk2(s[0 * 33], s[1 * 33]); o.y = pk2(s[2 * 33], s[3 * 33]); o.z = pk2(s[4 * 33], s[5 * 33]); o.w = pk2(s[6 * 33], s[7 * 33]);
        *(u32x4*)(WT + (size_t)(n0 + n) * K + k0 + 8 * c) = o; }
    LDS_WAIT();
}
template <bool WIN>
DI void transpose_matrix(const float* W, int K, int Nsrc, int Ndst, bf16_t* WT, LAS float* scr, int lane, int gw, int NGW, const float* gk = nullptr) {
    const int nblk = Ndst / 32, nitems = (K / 64) * nblk;
    for (int it = gw; it < nitems; it += NGW) transpose_item<WIN>(W, K, Nsrc, WT, 64 * (it / nblk), 32 * (it % nblk), scr, lane, gk);
}
DI void convert_rows(const float* src, bf16_t* dst, size_t n8, size_t gt, size_t ngt) {
    for (size_t i = gt; i < n8; i += ngt) {
        const f32x4 a = ((const f32x4*)src)[2 * i], b = ((const f32x4*)src)[2 * i + 1];
        u32x4 o; o.x = pk2(a.x, a.y); o.y = pk2(a.z, a.w); o.z = pk2(b.x, b.y); o.w = pk2(b.z, b.w);
        ((u32x4*)dst)[i] = o;
    }
}
constexpr float U_SCALE = 512.f, V_SCALE = 64.f;
DI void convert_rows_fp8(const float* src, unsigned char* dst, size_t n16, float scale, size_t gt, size_t ngt, const float* gnorm = nullptr) {
    for (size_t i = gt; i < n16; i += ngt) {
        f32x4 a = ((const f32x4*)src)[4 * i] * scale, b = ((const f32x4*)src)[4 * i + 1] * scale, c = ((const f32x4*)src)[4 * i + 2] * scale, d = ((const f32x4*)src)[4 * i + 3] * scale;
        if (gnorm) { const f32x4* gp = (const f32x4*)(gnorm + ((16 * i) / ((size_t)NEXP * D)) * D + (16 * i) % D); a = a * gp[0]; b = b * gp[1]; c = c * gp[2]; d = d * gp[3]; }
        u32x4 o;
        o.x = (unsigned)__builtin_amdgcn_cvt_pk_fp8_f32(a.z, a.w, __builtin_amdgcn_cvt_pk_fp8_f32(a.x, a.y, 0, false), true);
        o.y = (unsigned)__builtin_amdgcn_cvt_pk_fp8_f32(b.z, b.w, __builtin_amdgcn_cvt_pk_fp8_f32(b.x, b.y, 0, false), true);
        o.z = (unsigned)__builtin_amdgcn_cvt_pk_fp8_f32(c.z, c.w, __builtin_amdgcn_cvt_pk_fp8_f32(c.x, c.y, 0, false), true);
        o.w = (unsigned)__builtin_amdgcn_cvt_pk_fp8_f32(d.z, d.w, __builtin_amdgcn_cvt_pk_fp8_f32(d.x, d.y, 0, false), true);
        ((u32x4*)dst)[i] = o;
    }
}
DI void phase_prologue(const Args& a, LAS unsigned char* lds) {
    const int tid = opaque_tid(), lane = tid & 63, wave = tid >> 6;
    if (blockIdx.x == 0 && tid < 32) ((unsigned*)(a.ws + WS_KMAX))[tid] = 0u;
    const int gw = blockIdx.x * 8 + wave, NGW = gridDim.x * 8;
    LAS float* scr = (LAS float*)(lds + wave * 8448);
    unsigned char* ws = a.ws;
    for (int l = 0; l < NLAYER; ++l) {
        transpose_matrix<true>(a.w_in + (size_t)l * D * NPROJ, D, NPROJ, NP, (bf16_t*)(ws + WS_WIN) + (size_t)l * NP * D, scr, lane, gw, NGW);
        transpose_matrix<false>(a.w_out + (size_t)l * D * D, D, D, D, (bf16_t*)(ws + WS_WOUT) + (size_t)l * D * D, scr, lane, gw, NGW);
        transpose_matrix<false>(a.peer_wq + (size_t)l * D * D, D, D, D, (bf16_t*)(ws + WS_WQ) + (size_t)l * D * D, scr, lane, gw, NGW, a.ffn_norm + (size_t)l * D);
        transpose_matrix<false>(a.cmp_w1_k + (size_t)l * 2048 * 128, 2048, 128, 128, (bf16_t*)(ws + WS_CW1) + (size_t)(l * 2 + 0) * 128 * 2048, scr, lane, gw, NGW);
        transpose_matrix<false>(a.cmp_w1_v + (size_t)l * 2048 * 128, 2048, 128, 128, (bf16_t*)(ws + WS_CW1) + (size_t)(l * 2 + 1) * 128 * 2048, scr, lane, gw, NGW);
    }
    const size_t gt = (size_t)blockIdx.x * NTHREADS + tid, ngt = (size_t)gridDim.x * NTHREADS;
    convert_rows_fp8(a.peer_u, ws + WS_U, (size_t)NLAYER * NEXP * D / 16, U_SCALE, gt, ngt, a.ffn_norm);
    convert_rows_fp8(a.peer_v, ws + WS_V, (size_t)NLAYER * NEXP * D / 16, V_SCALE, gt, ngt);
    convert_rows(a.peer_subkeys, (bf16_t*)(ws + WS_SUBK), (size_t)NLAYER * 2 * 128 * 128 / 8, gt, ngt);
}

DI void phase_rms_bf16(const float* X, const float* g, bf16_t* XN) {
    const int tid = opaque_tid(), lane = tid & 63, wave = tid >> 6;
    const int gw = blockIdx.x * 8 + wave, NGW = gridDim.x * 8;
    f32x4 gv[8];
#pragma unroll
    for (int j = 0; j < 8; ++j) gv[j] = ((const f32x4*)g)[lane + 64 * j];
    for (int m = gw; m < M; m += NGW) {
        const f32x4* xr = (const f32x4*)(X + (size_t)m * D);
        f32x4 v[8]; float s = 0.f;
#pragma unroll
        for (int j = 0; j < 8; ++j) { v[j] = xr[lane + 64 * j]; s += (v[j].x * v[j].x + v[j].y * v[j].y) + (v[j].z * v[j].z + v[j].w * v[j].w); }
        const float rstd = rsqrtf(wave_sum(s) * (1.f / D) + 1e-6f);
        u32x2* o8 = (u32x2*)(XN + (size_t)m * D);
#pragma unroll
        for (int j = 0; j < 8; ++j) { const f32x4 y = v[j] * rstd * gv[j]; u32x2 w; w.x = pk2(y.x, y.y); w.y = pk2(y.z, y.w); o8[lane + 64 * j] = w; }
    }
}
DI void phase_rms_final(float* X, const float* g) {
    const int tid = opaque_tid(), lane = tid & 63, wave = tid >> 6;
    const int gw = blockIdx.x * 8 + wave, NGW = gridDim.x * 8;
    f32x4 gv[8];
#pragma unroll
    for (int j = 0; j < 8; ++j) gv[j] = ((const f32x4*)g)[lane + 64 * j];
    for (int m = gw; m < M; m += NGW) {
        f32x4* xr = (f32x4*)(X + (size_t)m * D);
        f32x4 v[8]; float s = 0.f;
#pragma unroll
        for (int j = 0; j < 8; ++j) { v[j] = xr[lane + 64 * j]; s += (v[j].x * v[j].x + v[j].y * v[j].y) + (v[j].z * v[j].z + v[j].w * v[j].w); }
        const float rstd = rsqrtf(wave_sum(s) * (1.f / D) + 1e-6f);
#pragma unroll
        for (int j = 0; j < 8; ++j) xr[lane + 64 * j] = v[j] * rstd * gv[j];
    }
}

struct EpiResid {
    static constexpr bool PERM = false, AFTER_DRAIN = false;
    const float* base; float* out; int ldc; bf16_t* hb; float* rss;
    DI void operator()(const pg8::f32x4 (&acc)[2][2][4][2], const pg8::Unit& u, int wr, int wc, int fr, int fq) const {
        const int col0 = u.pn * pg8::BM + wc * 32 + 4 * fq;
#pragma unroll
        for (int ai = 0; ai < 2; ++ai)
#pragma unroll
            for (int m = 0; m < 4; ++m) {
                const int row = u.pm * pg8::BM + ai * pg8::HALF + wr * 64 + m * 16 + fr;
                const size_t off = (size_t)row * ldc + col0;
                float ssq = 0.f;
#pragma unroll
                for (int bj = 0; bj < 2; ++bj)
#pragma unroll
                    for (int n = 0; n < 2; ++n) { const size_t o = off + bj * pg8::HALF + n * 16; const pg8::f32x4 bs = *(const pg8::f32x4*)(base + o); const pg8::f32x4 v = bs + acc[ai][bj][m][n];
                        *(pg8::f32x4*)(out + o) = v; ssq += (v[0] * v[0] + v[1] * v[1]) + (v[2] * v[2] + v[3] * v[3]);
                        u32x2 w; w.x = pk2(v[0], v[1]); w.y = pk2(v[2], v[3]); *(u32x2*)(hb + o) = w; }
                ssq += __shfl_xor(ssq, 16); ssq += __shfl_xor(ssq, 32);
                if (fq == 0) rss[(size_t)row * 32 + u.pn * 4 + wc] = ssq;
                asm volatile("" ::: "memory");
            }
    }
};
struct EpiBf16RS {
    static constexpr bool PERM = true, AFTER_DRAIN = false;
    bf16_t* O; int ldc; const float* rss;
    DI void operator()(const pg8::f32x4 (&acc)[2][2][4][2], const pg8::Unit& u, int wr, int wc, int fr, int fq) const {
        const int row0 = u.pm * pg8::BM + wr * 64 + fr, col0 = u.pn * pg8::BM + wc * 32 + 8 * fq;
#pragma unroll
        for (int ai = 0; ai < 2; ++ai)
#pragma unroll
            for (int m = 0; m < 4; ++m) {
                const int row = row0 + ai * pg8::HALF + m * 16;
                float sc = 1.f;
                if (rss) { const pg8::f32x4* rp = (const pg8::f32x4*)(rss + (size_t)row * 32); pg8::f32x4 t = rp[0];
#pragma unroll
                    for (int j = 1; j < 8; ++j) t += rp[j];
                    sc = rsqrtf(((t[0] + t[1]) + (t[2] + t[3])) * (1.f / D) + 1e-6f); }
                bf16_t* rowp = O + (size_t)row * ldc + col0;
#pragma unroll
                for (int bj = 0; bj < 2; ++bj) { const pg8::f32x4 v0 = acc[ai][bj][m][0] * sc, v1 = acc[ai][bj][m][1] * sc;
                    u32x4 w; w.x = pk2(v0[0], v0[1]); w.y = pk2(v0[2], v0[3]); w.z = pk2(v1[0], v1[1]); w.w = pk2(v1[2], v1[3]);
                    *(u32x4*)(rowp + bj * pg8::HALF) = w; }
            }
    }
};

DI void phase_prep(const Args& a, int layer, LAS unsigned char* lds) {
    const int tid = opaque_tid(), lane = tid & 63, wave = tid >> 6;
    const int gw = blockIdx.x * 8 + wave, NGW = gridDim.x * 8;
    unsigned char* ws = a.ws;
    const bf16_t* P = (const bf16_t*)(ws + WS_P);
    {
        LAS bf16_t* scr = (LAS bf16_t*)(lds + wave * 9216);
        for (int it = gw; it < 6 * 4 * 256; it += NGW) {
            const int which = it / 1024, bg = (it / 256) & 3, st = it & 255, b = bg >> 1, g = bg & 1;
            if (which >= 3) {
                const int srccol = (which == 3 ? C_KS : which == 4 ? C_KW : C_KB) + g * 64;
                bf16_t* dst = (bf16_t*)(ws + (which == 3 ? WS_KSF : which == 4 ? WS_KWF : WS_KBF)) + (size_t)bg * 64 * S + (size_t)st * 4096;
                float rmax = 0.f;
#pragma unroll
                for (int i = 0; i < 8; ++i) { const int tok = i * 8 + (lane >> 3), q = lane & 7;
                    const u32x4 v = *(const u32x4*)(P + (size_t)(b * S + st * 64 + tok) * NP + srccol + q * 8);
                    const int pos = which == 3 ? (((tok >> 4) * 2 + (q >> 2)) * 64 + (q & 3) * 16 + (tok & 15))
                                               : ((tok >> 5) * 256 + (q >> 1) * 64 + (q & 1) * 32 + (tok & 31));
                    *(u32x4*)(dst + pos * 8) = v;
                    float ss = bflo(v.x) * bflo(v.x) + bfhi(v.x) * bfhi(v.x) + bflo(v.y) * bflo(v.y) + bfhi(v.y) * bfhi(v.y)
                             + bflo(v.z) * bflo(v.z) + bfhi(v.z) * bfhi(v.z) + bflo(v.w) * bflo(v.w) + bfhi(v.w) * bfhi(v.w);
                    ss += __shfl_xor(ss, 1); ss += __shfl_xor(ss, 2); ss += __shfl_xor(ss, 4);
                    rmax = fmaxf(rmax, ss); }
                rmax = fmaxf(rmax, __shfl_xor(rmax, 8)); rmax = fmaxf(rmax, __shfl_xor(rmax, 16)); rmax = fmaxf(rmax, __shfl_xor(rmax, 32));
                if (lane == 0) atomicMax((unsigned*)(ws + WS_KMAX) + (layer * 4 + (which - 3)) * 4 + bg, __builtin_bit_cast(unsigned, rmax));
                continue;
            }
            const int srccol = (which == 0 ? C_VS : which == 1 ? C_VW : C_VB) + g * 64;
            bf16_t* dst = (bf16_t*)(ws + (which == 0 ? WS_VST : which == 1 ? WS_VWT : WS_VBT)) + (size_t)bg * 64 * S + (size_t)st * 4096;
#pragma unroll
            for (int i = 0; i < 8; ++i) { const int tok = i * 8 + (lane >> 3), ch = lane & 7;
                const u32x4 v = *(const u32x4*)(P + (size_t)(b * S + st * 64 + tok) * NP + srccol + ch * 8);
                *(LAS u32x4*)(scr + tok * 72 + ch * 8) = v; }
            LDS_WAIT();
#pragma unroll
            for (int f = 0; f < 8; ++f) {
                int d, kb0, kstep;
                if (which == 0) { const int j = f >> 2, dt = f & 3, hh = lane & 15, qd = lane >> 4; d = 16 * dt + hh; kb0 = 16 * j + 4 * qd; kstep = 32; }
                else { const int tl = f >> 2, j = (f >> 1) & 1, dt = f & 1, c = lane & 31, hi = lane >> 5; d = dt * 32 + c; kb0 = tl * 32 + 16 * j + 4 * hi; kstep = 8; }
                unsigned e[8];
#pragma unroll
                for (int i = 0; i < 8; ++i) e[i] = scr[(kb0 + (i & 3) + kstep * (i >> 2)) * 72 + d];
                u32x4 o; o.x = e[0] | (e[1] << 16); o.y = e[2] | (e[3] << 16); o.z = e[4] | (e[5] << 16); o.w = e[6] | (e[7] << 16);
                *(u32x4*)(dst + (f * 64 + lane) * 8) = o;
            }
            LDS_WAIT();
        }
    }
    {
        const bf16_t* XN = (const bf16_t*)(ws + WS_XN);
        const bf16_t* wg = (const bf16_t*)(ws + WS_WIN) + (size_t)layer * NP * D + (size_t)C_GATE * D;
        bf16_t* Pw = (bf16_t*)(ws + WS_P);
        const int c = lane & 31, hi = lane >> 5;
        for (int it = NGW - 1 - gw; it < M / 32; it += NGW) {
            const bf16_t* ar = XN + (size_t)(it * 32 + c) * D + hi * 8;
            const bf16_t* b0 = wg + (size_t)c * D + hi * 8, *b1 = wg + (size_t)(32 + c) * D + hi * 8;
            f32x16 a0, a1;
#pragma unroll
            for (int r = 0; r < 16; ++r) { a0[r] = 0.f; a1[r] = 0.f; }
#pragma unroll 8
            for (int kk = 0; kk < 128; ++kk) {
                const bf16x8 af = *(const bf16x8*)(ar + kk * 16);
                a0 = MFMA32(af, *(const bf16x8*)(b0 + kk * 16), a0);
                a1 = MFMA32(af, *(const bf16x8*)(b1 + kk * 16), a1);
            }
#pragma unroll
            for (int r = 0; r < 16; ++r) {
                bf16_t* pr = Pw + (size_t)(it * 32 + crow(r, hi)) * NP + C_GATE;
                pr[c] = (bf16_t)f2bf(a0[r]);
                if (c < 16) pr[32 + c] = (bf16_t)f2bf(a1[r]);
            }
        }
    }
    __syncthreads();
    {
        LAS float* H = (LAS float*)lds;
        const int c = lane & 31, hi = lane >> 5, rg = wave >> 2, nt = wave & 3;
        for (int it = blockIdx.x; it < 128; it += gridDim.x) {
            const int kv = it >> 6, bg = (it >> 4) & 3, rt = it & 15, b = bg >> 1, g = bg & 1;
            const float* pos = (kv ? a.cmp_pos_v : a.cmp_pos_k) + (size_t)layer * 32 * 64;
            const bf16_t* w1t = (const bf16_t*)(ws + WS_CW1) + (size_t)(layer * 2 + kv) * 128 * 2048;
            const float* w2 = (kv ? a.cmp_w2_v : a.cmp_w2_k) + (size_t)layer * 128 * 64;
            int irow = rt * 64 + rg * 32 + c; irow = irow > 1022 ? 1022 : irow;
            const bf16_t* src = P + (size_t)(b * S + 16 * irow) * NP + (kv ? C_VC : C_KC) + g * 64;
            const bf16_t* bsrc = w1t + (size_t)(nt * 32 + c) * 2048 + hi * 8;
            f32x16 acc;
#pragma unroll
            for (int r = 0; r < 16; ++r) acc[r] = 0.f;
#pragma unroll 4
            for (int kk = 0; kk < 128; ++kk) {
                const int tok = kk >> 2, d = (kk & 3) * 16 + hi * 8;
                const u32x4 sv = *(const u32x4*)(src + (size_t)tok * NP + d);
                const f32x4 p0 = *(const f32x4*)(pos + tok * 64 + d), p1 = *(const f32x4*)(pos + tok * 64 + d + 4);
                const bf16x8 af = pack8(bflo(sv.x) + p0.x, bfhi(sv.x) + p0.y, bflo(sv.y) + p0.z, bfhi(sv.y) + p0.w,
                                        bflo(sv.z) + p1.x, bfhi(sv.z) + p1.y, bflo(sv.w) + p1.z, bfhi(sv.w) + p1.w);
                const bf16x8 bf = *(const bf16x8*)(bsrc + kk * 16);
                acc = MFMA32(af, bf, acc);
            }
#pragma unroll
            for (int r = 0; r < 16; ++r) H[(rg * 32 + crow(r, hi)) * 129 + nt * 32 + c] = gelu_tanh(acc[r]);
            __syncthreads();
            {
                const int i = tid >> 3, dc = (tid & 7) * 8;
                float o[8];
#pragma unroll
                for (int e = 0; e < 8; ++e) o[e] = 0.f;
                for (int n = 0; n < 128; ++n) {
                    const float hv = H[i * 129 + n];
                    const f32x4 wa = *(const f32x4*)(w2 + n * 64 + dc), wb = *(const f32x4*)(w2 + n * 64 + dc + 4);
                    o[0] += hv * wa.x; o[1] += hv * wa.y; o[2] += hv * wa.z; o[3] += hv * wa.w;
                    o[4] += hv * wb.x; o[5] += hv * wb.y; o[6] += hv * wb.z; o[7] += hv * wb.w;
                }
                const int ig = rt * 64 + i;
                if (ig > 1022) {
#pragma unroll
                    for (int e = 0; e < 8; ++e) o[e] = 0.f;
                }
                if (kv == 0) {
                    u32x4 w; w.x = pk2(o[0], o[1]); w.y = pk2(o[2], o[3]); w.z = pk2(o[4], o[5]); w.w = pk2(o[6], o[7]);
                    float ss = bflo(w.x) * bflo(w.x) + bfhi(w.x) * bfhi(w.x) + bflo(w.y) * bflo(w.y) + bfhi(w.y) * bfhi(w.y)
                             + bflo(w.z) * bflo(w.z) + bfhi(w.z) * bfhi(w.z) + bflo(w.w) * bflo(w.w) + bfhi(w.w) * bfhi(w.w);
                    ss += __shfl_xor(ss, 1); ss += __shfl_xor(ss, 2); ss += __shfl_xor(ss, 4);
                    ss = fmaxf(ss, __shfl_xor(ss, 8)); ss = fmaxf(ss, __shfl_xor(ss, 16)); ss = fmaxf(ss, __shfl_xor(ss, 32));
                    if (lane == 0) atomicMax((unsigned*)(ws + WS_KMAX) + (layer * 4 + 3) * 4 + bg, __builtin_bit_cast(unsigned, ss));
                    const int q = dc >> 3;
                    *(u32x4*)((bf16_t*)(ws + WS_KC) + (size_t)bg * NCP * 64 + (size_t)(ig >> 5) * 2048 + ((q >> 1) * 64 + (q & 1) * 32 + (ig & 31)) * 8) = w;
                } else {
                    const int kk5 = ig & 31, jj = kk5 >> 4, rem = kk5 & 15, hh1 = (rem >> 2) & 1, ii = (rem >> 3) * 4 + (rem & 3);
                    bf16_t* vt = (bf16_t*)(ws + WS_VCT) + (size_t)bg * 64 * NCP + (size_t)(ig >> 5) * 2048 + ii;
#pragma unroll
                    for (int e = 0; e < 8; ++e) { const int dd = dc + e; vt[((jj * 2 + (dd >> 5)) * 64 + hh1 * 32 + (dd & 31)) * 8] = (bf16_t)f2bf(o[e]); }
                }
            }
            __syncthreads();
        }
    }
}

constexpr float LOG2E = 1.4426950408889634f, SC2 = 0.125f * 1.4426950408889634f;
DI float ex2(float x) { return __builtin_amdgcn_exp2f(x); }
DI void loadK32(const bf16_t* kt, int lane, bf16x8 (&k)[4]) {
#pragma unroll
    for (int kk = 0; kk < 4; ++kk) k[kk] = *(const bf16x8*)(kt + (kk * 64 + lane) * 8);
}
DI f32x16 qk32r(const bf16x8 (&k)[4], const bf16x8 (&q)[4]) {
    f32x16 s;
#pragma unroll
    for (int r = 0; r < 16; ++r) s[r] = 0.f;
#pragma unroll
    for (int kk = 0; kk < 4; ++kk) s = MFMA32(k[kk], q[kk], s);
    return s;
}
DI void loadV32(const bf16_t* vt, int lane, bf16x8 (&v)[2][2]) {
#pragma unroll
    for (int j = 0; j < 2; ++j)
#pragma unroll
        for (int dt = 0; dt < 2; ++dt) v[j][dt] = *(const bf16x8*)(vt + ((j * 2 + dt) * 64 + lane) * 8);
}
DI void pv32r(const f32x16& p, const bf16x8 (&v)[2][2], f32x16& o0, f32x16& o1) {
#pragma unroll
    for (int j = 0; j < 2; ++j) {
        const bf16x8 pb = pack8(p[8 * j], p[8 * j + 1], p[8 * j + 2], p[8 * j + 3], p[8 * j + 4], p[8 * j + 5], p[8 * j + 6], p[8 * j + 7]);
        o0 = MFMA32(v[j][0], pb, o0);
        o1 = MFMA32(v[j][1], pb, o1);
    }
}
template <bool MASKED>
DI bool softmax32(f32x16& s, unsigned vm, float& m, float& l, float& alpha) {
    float sum = 0.f;
#pragma unroll
    for (int r = 0; r < 16; ++r) { float p = ex2(s[r] - m); if (MASKED) p = ((vm >> r) & 1u) ? p : 0.f; s[r] = p; sum += p; }
    l += sum; alpha = 1.f;
    return false;
}
DI float sumsq8(const bf16x8 v) { const u32x4 w = __builtin_bit_cast(u32x4, v);
    return bflo(w.x) * bflo(w.x) + bfhi(w.x) * bfhi(w.x) + bflo(w.y) * bflo(w.y) + bfhi(w.y) * bfhi(w.y) + bflo(w.z) * bflo(w.z) + bfhi(w.z) * bfhi(w.z) + bflo(w.w) * bflo(w.w) + bfhi(w.w) * bfhi(w.w); }
DI unsigned logits_cmp(f32x16& s, int key0, int qpos, int hi, const LAS float* bias_h) {
    unsigned vm = 0u;
#pragma unroll
    for (int r = 0; r < 16; ++r) {
        const int dist = qpos - (16 * (key0 + crow(r, hi)) + 31);
        const bool valid = dist >= 0;
        const float bb = bias_h[rel_bucket(dist < 0 ? 0 : dist)];
        s[r] = valid ? s[r] * SC2 + bb : NEGF;
        vm |= valid ? (1u << r) : 0u;
    }
    return vm;
}

constexpr int AW_IMP = 0, AW_OLDS = 4128, AW_SEL = 4128 + 8320, AW_NSEL = AW_SEL + 256, AW_BYTES = 12800;
constexpr int ATT_BIAS_OFF = 8 * AW_BYTES;
constexpr int LUTW_STRIDE = 612, LUTB_STRIDE = 228;
constexpr int ATT_LUTW_OFF = ATT_BIAS_OFF + 4096, ATT_LUTB_OFF = ATT_LUTW_OFF + 8 * LUTW_STRIDE * 4, ATT_LDS_END = ATT_LUTB_OFF + 8 * LUTB_STRIDE * 4;
static_assert(ATT_LDS_END <= LDS_BYTES, "attention LDS map");

template <int W>
DI void window_branch(const bf16_t* Kf  , const bf16_t* Vf  , int lane,
                      const bf16x8 (&qf)[4], const LAS float* lut_h  , int q0, int qpos, int c, int hi,
                      float& m, float& l, f32x16& o0, f32x16& o1) {
    const int kd = q0 & ~31;
    int kstart = q0 - (W - 1); kstart = kstart < 0 ? 0 : kstart; kstart &= ~31;
    bf16x8 kc[4];
    loadK32(Kf + (size_t)(kd >> 5) * 2048, lane, kc);
    const float sini = -m * (1.f / SC2);
#pragma unroll 1
    for (int key0 = kd; key0 >= kstart; key0 -= 32) {
        bf16x8 vf[2][2], kn[4];
        loadV32(Vf + (size_t)(key0 >> 5) * 2048, lane, vf);
        const int nk = key0 - 32 >= kstart ? key0 - 32 : key0;
        loadK32(Kf + (size_t)(nk >> 5) * 2048, lane, kn);
        f32x16 s;
#pragma unroll
        for (int r = 0; r < 16; ++r) s[r] = sini;
#pragma unroll
        for (int kk = 0; kk < 4; ++kk) s = MFMA32(kc[kk], qf[kk], s);
        const LAS float* pt = lut_h + (qpos - key0 - 4 * hi - 27);
        float sum = 0.f;
#pragma unroll
        for (int r = 0; r < 16; ++r) { const float p = ex2(s[r] * SC2 + pt[27 - ((r & 3) + 8 * (r >> 2))]); s[r] = p; sum += p; }
        l += sum;
        pv32r(s, vf, o0, o1);
#pragma unroll
        for (int kk = 0; kk < 4; ++kk) kc[kk] = kn[kk];
    }
}

DI void phase_attn(const Args& a, int layer, LAS unsigned char* lds) {
    const int tid = opaque_tid(), lane = tid & 63, wave = tid >> 6;
    unsigned char* ws = a.ws;
    const bf16_t* P = (const bf16_t*)(ws + WS_P);
    bf16_t* O = (bf16_t*)(ws + WS_O);
    const int bg = blockIdx.x & 3, b = bg >> 1, g = bg & 1, wq = blockIdx.x >> 2, nwq = gridDim.x >> 2;
    LAS float* bias = (LAS float*)(lds + ATT_BIAS_OFF);
    LAS float* lutW = (LAS float*)(lds + ATT_LUTW_OFF);
    LAS float* lutB = (LAS float*)(lds + ATT_LUTB_OFF);
    for (int i = tid; i < 1024; i += NTHREADS) bias[i] = a.rel_bias[(i & 31) * 32 + (i >> 5)] * LOG2E;
    for (int i = tid; i < 8 * LUTW_STRIDE; i += NTHREADS) { const int hh = i / LUTW_STRIDE, dist = i % LUTW_STRIDE - 32;
        lutW[i] = (dist >= 0 && dist < 512) ? a.rel_bias[rel_bucket(dist) * 32 + g * 8 + hh] * LOG2E : NEGF; }
    for (int i = tid; i < 8 * LUTB_STRIDE; i += NTHREADS) { const int hh = i / LUTB_STRIDE, dist = i % LUTB_STRIDE - 32;
        lutB[i] = (dist >= 0 && dist < 128) ? a.rel_bias[rel_bucket(dist) * 32 + 16 + g * 8 + hh] * LOG2E : NEGF; }
    __syncthreads();
    LAS unsigned char* wl = lds + wave * AW_BYTES;
    LAS float* imp = (LAS float*)(wl + AW_IMP);
    LAS float* olds = (LAS float*)(wl + AW_OLDS);
    LAS int* sel = (LAS int*)(wl + AW_SEL);
    LAS int* nsel = (LAS int*)(wl + AW_NSEL);
    const int c = lane & 31, hi = lane >> 5, ql = c >> 3, h = c & 7;
    const bf16_t* Pb = P + (size_t)b * S * NP;
    const bf16_t* kcb = (const bf16_t*)(ws + WS_KC) + (size_t)bg * NCP * 64;
    const bf16_t* vct = (const bf16_t*)(ws + WS_VCT) + (size_t)bg * 64 * NCP;
    const bf16_t* vst = (const bf16_t*)(ws + WS_VST) + (size_t)bg * 64 * S;
    const bf16_t* vwt = (const bf16_t*)(ws + WS_VWT) + (size_t)bg * 64 * S;
    const bf16_t* kwf = (const bf16_t*)(ws + WS_KWF) + (size_t)bg * 64 * S;
    const bf16_t* kbf = (const bf16_t*)(ws + WS_KBF) + (size_t)bg * 64 * S;
    const bf16_t* ksf = (const bf16_t*)(ws + WS_KSF) + (size_t)bg * 64 * S;
    const bf16_t* vbt = (const bf16_t*)(ws + WS_VBT) + (size_t)bg * 64 * S;
    const float sinkv = a.sinks[layer * 16 + g * 8 + h] * LOG2E;
    const LAS float* bias_a = bias + (g * 8 + h) * 32;
    const float b31 = bias_a[31];
    const unsigned* kmx = (const unsigned*)(ws + WS_KMAX) + layer * 16 + bg;
    const float knS = sqrtf(__builtin_bit_cast(float, kmx[0])) * SC2, knW = sqrtf(__builtin_bit_cast(float, kmx[4])) * SC2;
    const float knB = sqrtf(__builtin_bit_cast(float, kmx[8])) * SC2, knC = sqrtf(__builtin_bit_cast(float, kmx[12])) * SC2;
    float bmaxA = bias_a[0], bmaxB = bias[(16 + g * 8 + h) * 32];
    for (int k = 1; k < 32; ++k) { bmaxA = fmaxf(bmaxA, bias_a[k]); bmaxB = fmaxf(bmaxB, bias[(16 + g * 8 + h) * 32 + k]); }
    bmaxA += 0.01f; bmaxB += 0.01f;

#pragma unroll 1
    for (int qt0 = wq; qt0 < S / 32 && wq < nwq; qt0 += nwq) {
        const int rnd = qt0 / nwq, qt32 = ((rnd & 1) && (rnd + 1) * nwq <= S / 32) ? rnd * nwq + (nwq - 1 - wq) : qt0;
        const int q0 = qt32 * 32 + wave * 4;
        const int qpos = q0 + ql;
        const size_t mrow = (size_t)(b * S + qpos);
        const bf16_t* prow = P + mrow * NP;
        {
            bf16x8 qf[4];
#pragma unroll
            for (int kk = 0; kk < 4; ++kk) qf[kk] = *(const bf16x8*)(prow + C_QB + (g * 8 + h) * 64 + kk * 16 + hi * 8);
            float qn2 = sumsq8(qf[0]) + sumsq8(qf[1]) + sumsq8(qf[2]) + sumsq8(qf[3]); qn2 += __shfl_xor(qn2, 32);
            float m = sqrtf(qn2) * knB + bmaxB, l = hi == 0 ? ex2(sinkv - m) : 0.f;
            f32x16 o0, o1;
#pragma unroll
            for (int r = 0; r < 16; ++r) { o0[r] = 0.f; o1[r] = 0.f; }
            window_branch<128>(kbf, vbt, lane, qf, lutB + h * LUTB_STRIDE + 32, q0, qpos, c, hi, m, l, o0, o1);
            const float lt = l + __shfl_xor(l, 32), inv = 1.f / lt;
            bf16_t* orow = O + mrow * D + 1024 + (g * 8 + h) * 64;
#pragma unroll
            for (int dt = 0; dt < 2; ++dt)
#pragma unroll
                for (int q4 = 0; q4 < 4; ++q4) {
                    const f32x16& oo = dt ? o1 : o0;
                    u32x2 w; w.x = pk2(oo[4 * q4] * inv, oo[4 * q4 + 1] * inv); w.y = pk2(oo[4 * q4 + 2] * inv, oo[4 * q4 + 3] * inv);
                    *(u32x2*)(orow + dt * 32 + 8 * q4 + 4 * hi) = w;
                }
        }
        const float gt0 = sigmoidf_(bf2f(prow[C_GATE + (g * 8 + h) * 3 + 0]));
        bf16x8 qfa[4];
#pragma unroll
        for (int kk = 0; kk < 4; ++kk) qfa[kk] = *(const bf16x8*)(prow + C_QA + (g * 8 + h) * 64 + kk * 16 + hi * 8);
        float qnA; { float qn2 = sumsq8(qfa[0]) + sumsq8(qfa[1]) + sumsq8(qfa[2]) + sumsq8(qfa[3]); qn2 += __shfl_xor(qn2, 32); qnA = sqrtf(qn2); }
        for (int i = lane; i < 4 * 257; i += 64) imp[i] = 0.f;
        const int ntile = (q0 + 3) / 512 + 1;
        const int nfast = q0 >= 2040 ? (q0 - 2040) / 512 + 1 : 0;
        {
            float m = qnA * knC + bmaxA, l = 0.f;
            {
                bf16x8 kc[4];
                loadK32(kcb, lane, kc);
#pragma unroll 1
                for (int t = 0; t < ntile; ++t) {
                    bf16x8 kn[4];
                    const int tn = t + 1 < ntile ? t + 1 : t;
                    loadK32(kcb + (size_t)tn * 2048, lane, kn);
                    f32x16 s = qk32r(kc, qfa);
                    float alpha;
                    if (t < nfast) {
#pragma unroll
                        for (int r = 0; r < 16; ++r) s[r] = s[r] * SC2 + b31;
                        (void)softmax32<false>(s, 0u, m, l, alpha);
                    } else {
                        const unsigned vm = logits_cmp(s, t * 32, qpos, hi, bias_a);
                        (void)softmax32<true>(s, vm, m, l, alpha);
                    }
#pragma unroll
                    for (int kk = 0; kk < 4; ++kk) kc[kk] = kn[kk];
                }
            }
            const float lt = l + __shfl_xor(l, 32), inv = lt > 0.f ? 1.f / lt : 0.f;
            f32x16 o0, o1;
#pragma unroll
            for (int r = 0; r < 16; ++r) { o0[r] = 0.f; o1[r] = 0.f; }
            LDS_WAIT();
            bf16x8 kc[4];
            loadK32(kcb, lane, kc);
#pragma unroll 1
            for (int t = 0; t < ntile; ++t) {
                bf16x8 vf[2][2], kn[4];
                loadV32(vct + (size_t)t * 2048, lane, vf);
                const int tn = t + 1 < ntile ? t + 1 : t;
                loadK32(kcb + (size_t)tn * 2048, lane, kn);
                f32x16 s = qk32r(kc, qfa);
                if (t < nfast) {
#pragma unroll
                    for (int r = 0; r < 16; ++r) s[r] = ex2(s[r] * SC2 + (b31 - m)) * inv;
                } else {
                    const unsigned vm = logits_cmp(s, t * 32, qpos, hi, bias_a);
#pragma unroll
                    for (int r = 0; r < 16; ++r) s[r] = ((vm >> r) & 1u) ? ex2(s[r] - m) * inv : 0.f;
                }
#pragma unroll
                for (int grp = 0; grp < 4; ++grp) {
                    float wa = 2.f * (s[4 * grp] + s[4 * grp + 1] + s[4 * grp + 2]) + s[4 * grp + 3], wb = s[4 * grp + 3];
                    wa += __shfl_xor(wa, 1); wb += __shfl_xor(wb, 1);
                    wa += __shfl_xor(wa, 2); wb += __shfl_xor(wb, 2);
                    wa += __shfl_xor(wa, 4); wb += __shfl_xor(wb, 4);
                    const int j = t * 8 + 2 * grp + hi;
                    if (h == 0) {
                        (void)__hip_atomic_fetch_add(imp + ql * 257 + j, wa, __ATOMIC_RELAXED, __HIP_MEMORY_SCOPE_WORKGROUP);
                        (void)__hip_atomic_fetch_add(imp + ql * 257 + j + 1, wb, __ATOMIC_RELAXED, __HIP_MEMORY_SCOPE_WORKGROUP);
                    }
                }
                pv32r(s, vf, o0, o1);
#pragma unroll
                for (int kk = 0; kk < 4; ++kk) kc[kk] = kn[kk];
            }
#pragma unroll
            for (int r = 0; r < 16; ++r) { olds[c * 65 + crow(r, hi)] = gt0 * o0[r]; olds[c * 65 + 32 + crow(r, hi)] = gt0 * o1[r]; }
        }
        LDS_WAIT();
        {
            const int tq = lane >> 4, sub = lane & 15;
            const int qp = q0 + tq, cb = qp >> 6;
            float v[16];
#pragma unroll
            for (int i = 0; i < 16; ++i) { const int j = sub + 16 * i; v[i] = (j >= 1 && j <= cb - 2) ? imp[tq * 257 + j] : -1.f; }
            int n = (cb < 2 ? cb : 2) + 1;
            if (sub == 0) {
                sel[tq * 16 + 0] = 0;
                if (cb >= 1) sel[tq * 16 + n - 1] = cb;
                if (cb >= 2) sel[tq * 16 + 1] = cb - 1;
            }
#pragma unroll 1
            for (int k = 0; k < 13; ++k) {
                float bv = v[0]; int bj = sub;
#pragma unroll
                for (int i = 1; i < 16; ++i) { if (v[i] > bv) { bv = v[i]; bj = sub + 16 * i; } }
#pragma unroll
                for (int off = 1; off < 16; off <<= 1) {
                    const float ov = __shfl_xor(bv, off); const int oj = __shfl_xor(bj, off);
                    if (ov > bv || (ov == bv && oj < bj)) { bv = ov; bj = oj; }
                }
                if (bv >= 0.f) {
                    if (sub == 0) sel[tq * 16 + n] = bj;
                    n += 1;
#pragma unroll
                    for (int i = 0; i < 16; ++i) { if (bj == sub + 16 * i) v[i] = -1.f; }
                }
            }
            if (sub == 0) nsel[tq] = n;
        }
        LDS_WAIT();
        {
            const int hh = lane & 15, qd = lane >> 4, hd = hh & 7;
            const LAS float* bias_s = bias + (g * 8 + hd) * 32;
            const float b31s = bias_s[31];

#pragma unroll 1
            for (int qi = 0; qi < 4; ++qi) {
                const int qp = q0 + qi;
                const bf16_t* pr = Pb + (size_t)qp * NP;
                bf16x8 qf[2];
#pragma unroll
                for (int kk = 0; kk < 2; ++kk) qf[kk] = *(const bf16x8*)(pr + C_QA + (g * 8 + hd) * 64 + kk * 32 + qd * 8);
                float qs2 = sumsq8(qf[0]) + sumsq8(qf[1]); qs2 += __shfl_xor(qs2, 16); qs2 += __shfl_xor(qs2, 32);
                const float m = sqrtf(qs2) * knS + bmaxA; float l = 0.f;
                const bool lowc = hh < 8;
                const bf16x8 zero8 = {0, 0, 0, 0, 0, 0, 0, 0};
                bf16x8 qlo[2], qhi[2];
#pragma unroll
                for (int kk = 0; kk < 2; ++kk) { qlo[kk] = lowc ? qf[kk] : zero8; qhi[kk] = lowc ? zero8 : qf[kk]; }
                const int hs = hh >> 3;
                f32x4 o[4];
#pragma unroll
                for (int dt = 0; dt < 4; ++dt) o[dt] = (f32x4){0.f, 0.f, 0.f, 0.f};
                const int ns = __builtin_amdgcn_readfirstlane(nsel[qi]);
                int jb = __builtin_amdgcn_readfirstlane(sel[qi * 16]);
                bf16x8 ka[4][2];
#pragma unroll
                for (int t = 0; t < 4; ++t)
#pragma unroll
                    for (int kk = 0; kk < 2; ++kk) ka[t][kk] = *(const bf16x8*)(ksf + (size_t)jb * 4096 + ((t * 2 + kk) * 64 + lane) * 8);
#pragma unroll 1
                for (int k = 0; k < ns; ++k) {
                    bf16x8 va[2][4], kn[4][2];
#pragma unroll
                    for (int j = 0; j < 2; ++j)
#pragma unroll
                        for (int dt = 0; dt < 4; ++dt) va[j][dt] = *(const bf16x8*)(vst + (size_t)jb * 4096 + ((j * 4 + dt) * 64 + lane) * 8);
                    const int jn = __builtin_amdgcn_readfirstlane(sel[qi * 16 + (k + 1 < ns ? k + 1 : k)]);
#pragma unroll
                    for (int t = 0; t < 4; ++t)
#pragma unroll
                        for (int kk = 0; kk < 2; ++kk) kn[t][kk] = *(const bf16x8*)(ksf + (size_t)jn * 4096 + ((t * 2 + kk) * 64 + lane) * 8);
                    f32x4 s[2];
#pragma unroll
                    for (int u = 0; u < 2; ++u) {
                        s[u] = (f32x4){0.f, 0.f, 0.f, 0.f};
#pragma unroll
                        for (int kk = 0; kk < 2; ++kk) { s[u] = MFMA16(ka[2 * u][kk], qlo[kk], s[u]); s[u] = MFMA16(ka[2 * u + 1][kk], qhi[kk], s[u]); }
                    }
                    if (qp - (jb * 64 + 63) >= 1513) {
                        const float cst = b31s - m;
#pragma unroll
                        for (int u = 0; u < 2; ++u)
#pragma unroll
                            for (int r = 0; r < 4; ++r) s[u][r] = s[u][r] * SC2 + cst;
                    } else {
#pragma unroll
                        for (int u = 0; u < 2; ++u)
#pragma unroll
                            for (int r = 0; r < 4; ++r) {
                                const int dist = qp - (jb * 64 + 16 * (2 * u + hs) + 4 * qd + r);
                                const float bb = bias_s[rel_bucket(dist < 0 ? 0 : dist)];
                                s[u][r] = dist >= 0 ? s[u][r] * SC2 + (bb - m) : NEGF;
                            }
                    }
                    float sum = 0.f;
#pragma unroll
                    for (int u = 0; u < 2; ++u)
#pragma unroll
                        for (int r = 0; r < 4; ++r) { const float p = ex2(s[u][r]); s[u][r] = p; sum += p; }
                    l += sum;
                    {
                        const bf16x8 p8 = pack8(s[0][0], s[0][1], s[0][2], s[0][3], s[1][0], s[1][1], s[1][2], s[1][3]);
                        const bf16x8 plo = lowc ? p8 : zero8, phi = lowc ? zero8 : p8;
#pragma unroll
                        for (int dt = 0; dt < 4; ++dt) { o[dt] = MFMA16(va[0][dt], plo, o[dt]); o[dt] = MFMA16(va[1][dt], phi, o[dt]); }
                    }
                    jb = jn;
#pragma unroll
                    for (int t = 0; t < 4; ++t)
#pragma unroll
                        for (int kk = 0; kk < 2; ++kk) ka[t][kk] = kn[t][kk];
                }
                float lt = l + __shfl_xor(l, 16); lt += __shfl_xor(lt, 32); lt += __shfl_xor(lt, 8);
#pragma unroll
                for (int dt = 0; dt < 4; ++dt)
#pragma unroll
                    for (int r = 0; r < 4; ++r) o[dt][r] += __shfl_xor(o[dt][r], 8);
                const float gt1 = sigmoidf_(bf2f(Pb[(size_t)qp * NP + C_GATE + (g * 8 + hd) * 3 + 1]));
                const float inv = lt > 0.f ? gt1 / lt : 0.f;
                if (hh < 8) {
#pragma unroll
                    for (int dt = 0; dt < 4; ++dt)
#pragma unroll
                        for (int r = 0; r < 4; ++r) olds[(qi * 8 + hh) * 65 + 16 * dt + 4 * qd + r] += o[dt][r] * inv;
                }
            }
        }
        LDS_WAIT();
        {
            int lw = lane; asm volatile("" : "+v"(lw));
            const int c = lw & 31, hi = lw >> 5, h = c & 7, qpos = q0 + (c >> 3);
            const size_t mrow = (size_t)(b * S + qpos);
            const bf16_t* prow = P + mrow * NP;
            const float gt2 = sigmoidf_(bf2f(prow[C_GATE + (g * 8 + h) * 3 + 2]));
            bf16x8 qfw[4];
#pragma unroll
            for (int kk = 0; kk < 4; ++kk) qfw[kk] = *(const bf16x8*)(prow + C_QA + (g * 8 + h) * 64 + kk * 16 + hi * 8);
            float qnW; { float qn2 = sumsq8(qfw[0]) + sumsq8(qfw[1]) + sumsq8(qfw[2]) + sumsq8(qfw[3]); qn2 += __shfl_xor(qn2, 32); qnW = sqrtf(qn2); }
            float m = qnW * knW + bmaxA, l = 0.f;
            f32x16 o0, o1;
#pragma unroll
            for (int r = 0; r < 16; ++r) { o0[r] = 0.f; o1[r] = 0.f; }
            window_branch<512>(kwf, vwt, lw, qfw, lutW + h * LUTW_STRIDE + 32, q0, qpos, c, hi, m, l, o0, o1);
            const float lt = l + __shfl_xor(l, 32), inv = lt > 0.f ? gt2 / lt : 0.f;
            bf16_t* orow = O + mrow * D + (g * 8 + h) * 64;
#pragma unroll
            for (int dt = 0; dt < 2; ++dt)
#pragma unroll
                for (int q4 = 0; q4 < 4; ++q4) {
                    const f32x16& oo = dt ? o1 : o0;
                    const int d0 = dt * 32 + 8 * q4 + 4 * hi;
                    const float e0 = oo[4 * q4] * inv + olds[c * 65 + d0], e1 = oo[4 * q4 + 1] * inv + olds[c * 65 + d0 + 1];
                    const float e2 = oo[4 * q4 + 2] * inv + olds[c * 65 + d0 + 2], e3 = oo[4 * q4 + 3] * inv + olds[c * 65 + d0 + 3];
                    u32x2 w; w.x = pk2(e0, e1); w.y = pk2(e2, e3);
                    *(u32x2*)(orow + d0) = w;
                }
        }
        LDS_WAIT();
    }
}

DI unsigned ordf(float f) { const unsigned u = __builtin_bit_cast(unsigned, f); return (u & 0x80000000u) ? ~u : (u | 0x80000000u); }
DI float unordf(unsigned k) { const unsigned u = (k & 0x80000000u) ? (k & 0x7fffffffu) : ~k; return __builtin_bit_cast(float, u); }

DI void peer_half_topk(const bf16_t* qrow  , const bf16_t* subk  , int hi, int lane, LAS unsigned* ltop) {
    unsigned keys[64];
    asm volatile("" : "+v"(subk));
#pragma unroll
    for (int rt = 0; rt < 4; ++rt) {
        f32x16 acc;
#pragma unroll
        for (int r = 0; r < 16; ++r) acc[r] = 0.f;
#pragma unroll
        for (int kk = 0; kk < 8; ++kk) {
            const bf16x8 af = *(const bf16x8*)(subk + (size_t)(rt * 32) * 128 + kk * 16);
            const bf16x8 bf = *(const bf16x8*)(qrow + kk * 16);
            acc = MFMA32(af, bf, acc);
        }
#pragma unroll
        for (int r = 0; r < 16; ++r) { const int n = rt * 32 + crow(r, hi); keys[rt * 16 + r] = (ordf(acc[r]) & ~0x7Fu) | (unsigned)(127 - n); }
    }
#pragma unroll 1
    for (int k = 0; k < 16; ++k) {
        unsigned mx = keys[0];
#pragma unroll
        for (int i = 1; i < 64; ++i) mx = mx > keys[i] ? mx : keys[i];
        const unsigned om = (unsigned)__shfl_xor((int)mx, 32);
        mx = mx > om ? mx : om;
        ltop[k * 64 + lane] = mx;
#pragma unroll
        for (int i = 0; i < 64; ++i) keys[i] = keys[i] == mx ? 0u : keys[i];
    }
}

DI void phase_peer_select(const Args& a, int layer, LAS unsigned char* lds) {
    const int tid = opaque_tid(), lane = tid & 63, wave = tid >> 6;
    const int gw = blockIdx.x * 8 + wave, NGW = gridDim.x * 8;
    unsigned char* ws = a.ws;
    const bf16_t* Q2 = (const bf16_t*)(ws + WS_Q2);
    const bf16_t* subk = (const bf16_t*)(ws + WS_SUBK) + (size_t)layer * 2 * 128 * 128;
    int* IDX = (int*)(ws + WS_IDX);
    float* GATE = (float*)(ws + WS_GATE);
    LAS unsigned* lt1 = (LAS unsigned*)(lds + wave * 8192);
    LAS unsigned* lt2 = lt1 + 1024;
    const int c = lane & 31, hi = lane >> 5, tl = c >> 3, h = c & 7;
#pragma unroll 1
    for (int unit = gw; unit < M / 4; unit += NGW) {
        const size_t m = (size_t)unit * 4 + tl;
        const bf16_t* qrow = Q2 + m * D + h * 256 + hi * 8;
        peer_half_topk(qrow, subk + (size_t)c * 128 + hi * 8, hi, lane, lt1);
        peer_half_topk(qrow + 128, subk + 128 * 128 + (size_t)c * 128 + hi * 8, hi, lane, lt2);
        LDS_WAIT();
        unsigned t1[16], t2[16];
#pragma unroll
        for (int i = 0; i < 16; ++i) { t1[i] = lt1[i * 64 + lane]; t2[i] = lt2[i * 64 + lane]; }
        unsigned ck[16][16];
#pragma unroll
        for (int x = 0; x < 16; ++x)
#pragma unroll
            for (int y = 0; y < 16; ++y)
                if ((x + 1) * (y + 1) <= 16) ck[x][y] = (ordf(unordf(t1[x] & ~0x7Fu) + unordf(t2[y] & ~0x7Fu)) & ~0xFFu) | (unsigned)(255 - (x * 16 + y));
        const float scmax = unordf(ck[0][0] & ~0xFFu);
        int* ip = IDX + m * 128 + h * 16; float* gp = GATE + m * 128 + h * 16;
        float sum = 0.f;
#pragma unroll 1
        for (int k = 0; k < 16; ++k) {
            unsigned mx = 0u;
#pragma unroll
            for (int x = 0; x < 16; ++x)
#pragma unroll
                for (int y = 0; y < 16; ++y)
                    if ((x + 1) * (y + 1) <= 16) mx = mx > ck[x][y] ? mx : ck[x][y];
#pragma unroll
            for (int x = 0; x < 16; ++x)
#pragma unroll
                for (int y = 0; y < 16; ++y)
                    if ((x + 1) * (y + 1) <= 16) ck[x][y] = ck[x][y] == mx ? 0u : ck[x][y];
            const int ci = 255 - (int)(mx & 0xFFu);
            const int e = (int)(127u - (lt1[(ci >> 4) * 64 + lane] & 0x7Fu)) * 128 + (int)(127u - (lt2[(ci & 15) * 64 + lane] & 0x7Fu));
            const float ek = __expf(unordf(mx & ~0xFFu) - scmax);
            sum += ek;
            if (hi == 0) { ip[k] = e; gp[k] = ek; }
        }
        if (hi == 0) ((float*)(ws + WS_GSUM))[m * 8 + h] = 1.f / sum;
        LDS_WAIT();
    }
}

#define FP8_LO(w) __builtin_amdgcn_cvt_pk_f32_fp8((int)(w), false)
#define FP8_HI(w) __builtin_amdgcn_cvt_pk_f32_fp8((int)(w), true)
DI float dot16(const float (&x)[32], int o, const u32x4 w) {
    const f32x2 a0 = FP8_LO(w.x), a1 = FP8_HI(w.x), a2 = FP8_LO(w.y), a3 = FP8_HI(w.y), a4 = FP8_LO(w.z), a5 = FP8_HI(w.z), a6 = FP8_LO(w.w), a7 = FP8_HI(w.w);
    return (x[o + 0] * a0.x + x[o + 1] * a0.y + x[o + 2] * a1.x + x[o + 3] * a1.y) + (x[o + 4] * a2.x + x[o + 5] * a2.y + x[o + 6] * a3.x + x[o + 7] * a3.y)
         + (x[o + 8] * a4.x + x[o + 9] * a4.y + x[o + 10] * a5.x + x[o + 11] * a5.y) + (x[o + 12] * a6.x + x[o + 13] * a6.y + x[o + 14] * a7.x + x[o + 15] * a7.y);
}
DI float dot16p(const u32x4 xa, const u32x4 xb, const u32x4 w) {
    const f32x2 a0 = FP8_LO(w.x), a1 = FP8_HI(w.x), a2 = FP8_LO(w.y), a3 = FP8_HI(w.y), a4 = FP8_LO(w.z), a5 = FP8_HI(w.z), a6 = FP8_LO(w.w), a7 = FP8_HI(w.w);
    return (bflo(xa.x) * a0.x + bfhi(xa.x) * a0.y + bflo(xa.y) * a1.x + bfhi(xa.y) * a1.y) + (bflo(xa.z) * a2.x + bfhi(xa.z) * a2.y + bflo(xa.w) * a3.x + bfhi(xa.w) * a3.y)
         + (bflo(xb.x) * a4.x + bfhi(xb.x) * a4.y + bflo(xb.y) * a5.x + bfhi(xb.y) * a5.y) + (bflo(xb.z) * a6.x + bfhi(xb.z) * a6.y + bflo(xb.w) * a7.x + bfhi(xb.w) * a7.y);
}
DI void axpy16(float (&acc)[32], int o, float g, const u32x4 w) {
    const f32x2 a0 = FP8_LO(w.x), a1 = FP8_HI(w.x), a2 = FP8_LO(w.y), a3 = FP8_HI(w.y), a4 = FP8_LO(w.z), a5 = FP8_HI(w.z), a6 = FP8_LO(w.w), a7 = FP8_HI(w.w);
    acc[o + 0] += g * a0.x; acc[o + 1] += g * a0.y; acc[o + 2] += g * a1.x; acc[o + 3] += g * a1.y; acc[o + 4] += g * a2.x; acc[o + 5] += g * a2.y; acc[o + 6] += g * a3.x; acc[o + 7] += g * a3.y;
    acc[o + 8] += g * a4.x; acc[o + 9] += g * a4.y; acc[o + 10] += g * a5.x; acc[o + 11] += g * a5.y; acc[o + 12] += g * a6.x; acc[o + 13] += g * a6.y; acc[o + 14] += g * a7.x; acc[o + 15] += g * a7.y;
}
DI void gat_load8(const unsigned char* base, int idlo, int idhi, int g4, unsigned lo16, u32x4 (&buf)[8]) {
    const int ids = g4 < 16 ? idlo : idhi, e0 = (g4 & 15) * 4;
#pragma unroll
    for (int j = 0; j < 4; ++j) { const unsigned of = (unsigned)__shfl(ids, e0 + j) * (unsigned)D + lo16; buf[2 * j] = *(const u32x4*)(base + of); buf[2 * j + 1] = *(const u32x4*)(base + of + 1024u); }
}
DI float dots4(const u32x4 (&xp)[4], const u32x4 b0, const u32x4 b1, const u32x4 b2, const u32x4 b3, const u32x4 b4, const u32x4 b5, const u32x4 b6, const u32x4 b7, int lane) {
    const float d0 = dot16p(xp[0], xp[1], b0) + dot16p(xp[2], xp[3], b1); __builtin_amdgcn_sched_barrier(0);
    const float d1 = dot16p(xp[0], xp[1], b2) + dot16p(xp[2], xp[3], b3); __builtin_amdgcn_sched_barrier(0);
    const float d2 = dot16p(xp[0], xp[1], b4) + dot16p(xp[2], xp[3], b5); __builtin_amdgcn_sched_barrier(0);
    const float d3 = dot16p(xp[0], xp[1], b6) + dot16p(xp[2], xp[3], b7); __builtin_amdgcn_sched_barrier(0);
    const bool p1 = lane & 1, p2 = lane & 2;
    const float b0s = (p1 ? d1 : d0) + __shfl_xor(p1 ? d0 : d1, 1);
    const float b1s = (p1 ? d3 : d2) + __shfl_xor(p1 ? d2 : d3, 1);
    float cs = (p2 ? b1s : b0s) + __shfl_xor(p2 ? b0s : b1s, 2);
    cs += __shfl_xor(cs, 4); cs += __shfl_xor(cs, 8); cs += __shfl_xor(cs, 16); cs += __shfl_xor(cs, 32);
    return cs;
}
DI void phase_peer_u(const Args& a, int layer) {
    const int tid = opaque_tid(), lane = tid & 63, wave = tid >> 6;
    const int gw = blockIdx.x * 8 + wave, NGW = gridDim.x * 8;
    unsigned char* ws = a.ws;
    const bf16_t* XN = (const bf16_t*)(ws + WS_XN);
    const unsigned char* U = ws + WS_U + (size_t)layer * NEXP * D;
    const unsigned lo16 = (unsigned)lane * 16u;
    const int* IDX = (const int*)(ws + WS_IDX);
    float* GATE = (float*)(ws + WS_GATE);
    const float* GSUM = (const float*)(ws + WS_GSUM);
    int m = gw;
    if (m < M) {
        int idA = IDX[(size_t)m * 128 + lane], idB = IDX[(size_t)m * 128 + 64 + lane];
        u32x4 xp[4];
#pragma unroll
        for (int q = 0; q < 4; ++q) xp[q] = *(const u32x4*)(XN + (size_t)m * D + (q >> 1) * 1024 + lane * 16 + (q & 1) * 8);
        u32x4 cur[8];
        gat_load8(U, idA, idB, 0, lo16, cur);
#pragma unroll 1
        for (; m < M; m += NGW) {
            const int mn = m + NGW < M ? m + NGW : m;
            const int idAn = IDX[(size_t)mn * 128 + lane], idBn = IDX[(size_t)mn * 128 + 64 + lane];
            u32x4 xpn[4];
#pragma unroll
            for (int q = 0; q < 4; ++q) xpn[q] = *(const u32x4*)(XN + (size_t)mn * D + (q >> 1) * 1024 + lane * 16 + (q & 1) * 8);
            const float glA = GATE[(size_t)m * 128 + lane] * GSUM[(size_t)m * 8 + (lane >> 4)] * (1.f / V_SCALE);
            const float glB = GATE[(size_t)m * 128 + 64 + lane] * GSUM[(size_t)m * 8 + 4 + (lane >> 4)] * (1.f / V_SCALE);
            float ghA = 0.f, ghB = 0.f;
            const float rstdu = __builtin_bit_cast(float, __builtin_amdgcn_readfirstlane(__builtin_bit_cast(int, rsqrtf(wave_sum(lane < 32 ? ((const float*)(ws + WS_RSS))[((size_t)layer * M + m) * 32 + lane] : 0.f) * (1.f / D) + 1e-6f) * (1.f / U_SCALE))));
#pragma unroll 1
            for (int g4 = 0; g4 < 32; ++g4) {
                u32x4 nxt[8];
                if (g4 < 31) gat_load8(U, idA, idB, g4 + 1, lo16, nxt); else gat_load8(U, idAn, idBn, 0, lo16, nxt);
                const float c0 = dots4(xp, cur[0], cur[1], cur[2], cur[3], cur[4], cur[5], cur[6], cur[7], lane);
                const float hv = gelu_tanh(c0 * rstdu);
                const bool mine = (lane >> 2) == (g4 & 15);
                if (g4 < 16) ghA = mine ? hv * glA : ghA; else ghB = mine ? hv * glB : ghB;
#pragma unroll
                for (int j = 0; j < 8; ++j) cur[j] = nxt[j];
            }
            GATE[(size_t)m * 128 + lane] = ghA; GATE[(size_t)m * 128 + 64 + lane] = ghB;
            idA = idAn; idB = idBn;
#pragma unroll
            for (int q = 0; q < 4; ++q) xp[q] = xpn[q];
        }
    }
}
DI void phase_peer_v(const Args& a, int layer) {
    const int tid = opaque_tid(), lane = tid & 63, wave = tid >> 6;
    const int gw = blockIdx.x * 8 + wave, NGW = gridDim.x * 8;
    unsigned char* ws = a.ws;
    const unsigned char* V = ws + WS_V + (size_t)layer * NEXP * D;
    const unsigned lo16 = (unsigned)lane * 16u;
    const int* IDX = (const int*)(ws + WS_IDX);
    const float* GH = (const float*)(ws + WS_GATE);
    int m = gw;
    if (m < M) {
        int idA = IDX[(size_t)m * 128 + lane], idB = IDX[(size_t)m * 128 + 64 + lane];
        u32x4 cur[8];
        gat_load8(V, idA, idB, 0, lo16, cur);
#pragma unroll 1
        for (; m < M; m += NGW) {
            const int mn = m + NGW < M ? m + NGW : m;
            const int idAn = IDX[(size_t)mn * 128 + lane], idBn = IDX[(size_t)mn * 128 + 64 + lane];
            const float ghA = GH[(size_t)m * 128 + lane], ghB = GH[(size_t)m * 128 + 64 + lane];
            float acc[32];
#pragma unroll
            for (int i = 0; i < 32; ++i) acc[i] = 0.f;
#pragma unroll 1
            for (int g4 = 0; g4 < 32; ++g4) {
                u32x4 nxt[8];
                if (g4 < 31) gat_load8(V, idA, idB, g4 + 1, lo16, nxt); else gat_load8(V, idAn, idBn, 0, lo16, nxt);
                const float ghs = g4 < 16 ? ghA : ghB;
#pragma unroll
                for (int j = 0; j < 4; ++j) { const float gv = __shfl(ghs, (g4 & 15) * 4 + j); axpy16(acc, 0, gv, cur[2 * j]); axpy16(acc, 16, gv, cur[2 * j + 1]); __builtin_amdgcn_sched_barrier(0); }
#pragma unroll
                for (int j = 0; j < 8; ++j) cur[j] = nxt[j];
            }
            idA = idAn; idB = idBn;
            float ss = 0.f;
#pragma unroll
            for (int q = 0; q < 4; ++q) {
                const f32x4* hp = (const f32x4*)(a.out + (size_t)m * D + (q >> 1) * 1024 + lane * 16 + (q & 1) * 8);
                const f32x4 h0 = hp[0], h1 = hp[1];
                acc[q * 8 + 0] += h0.x; acc[q * 8 + 1] += h0.y; acc[q * 8 + 2] += h0.z; acc[q * 8 + 3] += h0.w;
                acc[q * 8 + 4] += h1.x; acc[q * 8 + 5] += h1.y; acc[q * 8 + 6] += h1.z; acc[q * 8 + 7] += h1.w;
#pragma unroll
                for (int e = 0; e < 8; ++e) ss += acc[q * 8 + e] * acc[q * 8 + e];
                __builtin_amdgcn_sched_barrier(0);
            }
            const float rstd = rsqrtf(wave_sum(ss) * (1.f / D) + 1e-6f);
            const float* gn = layer + 1 < NLAYER ? a.attn_norm + (size_t)(layer + 1) * D : a.final_norm;
            asm volatile("" : "+s"(gn));
#pragma unroll
            for (int q = 0; q < 4; ++q) {
                const int col = (q >> 1) * 1024 + lane * 16 + (q & 1) * 8;
                const f32x4 g0 = *(const f32x4*)(gn + col), g1 = *(const f32x4*)(gn + col + 4);
                f32x4 h0, h1;
                h0.x = acc[q * 8 + 0]; h0.y = acc[q * 8 + 1]; h0.z = acc[q * 8 + 2]; h0.w = acc[q * 8 + 3];
                h1.x = acc[q * 8 + 4]; h1.y = acc[q * 8 + 5]; h1.z = acc[q * 8 + 6]; h1.w = acc[q * 8 + 7];
                const f32x4 y0 = h0 * rstd * g0, y1 = h1 * rstd * g1;
                f32x4* hp = (f32x4*)(a.out + (size_t)m * D + col);
                if (layer + 1 < NLAYER) {
                    hp[0] = h0; hp[1] = h1;
                    u32x4 w; w.x = pk2(y0.x, y0.y); w.y = pk2(y0.z, y0.w); w.z = pk2(y1.x, y1.y); w.w = pk2(y1.z, y1.w);
                    *(u32x4*)((bf16_t*)(ws + WS_XN) + (size_t)m * D + col) = w;
                } else { hp[0] = y0; hp[1] = y1; }
                __builtin_amdgcn_sched_barrier(0);
            }
        }
    }
}

constexpr size_t WS_BAR = 95 * MiB;
#define XB_TMO      128
#define XB_XCNT(j)  (256  + 64 * (j))
#define XB_XSUB(j)  (1280 + 64 * (j))
#define XB_XGEN(j)  (2304 + 64 * (j))
#define XB_TOP      3328
#define XB_TOPGEN   3392
#define XCD_BAR_WORDS 3456
#define XB_SPIN_CAP (1u << 18)

__device__ __forceinline__ unsigned xb_ld(unsigned* p)              { return __hip_atomic_load(p, __ATOMIC_RELAXED, __HIP_MEMORY_SCOPE_AGENT); }
__device__ __forceinline__ unsigned xb_add(unsigned* p, unsigned v) { return __hip_atomic_fetch_add(p, v, __ATOMIC_RELAXED, __HIP_MEMORY_SCOPE_AGENT); }
__device__ __forceinline__ unsigned xb_xcc_id() { return (unsigned)__builtin_amdgcn_s_getreg((3 << 11) | 20) & 0xFu; }
#define XB_SPIN(cond, bar) do { unsigned _sp = 0; while (cond) { __builtin_amdgcn_s_sleep(1); \
    if ((++_sp & 255u) == 0u) { if (xb_ld(&(bar)[XB_TMO])) break; if (_sp > XB_SPIN_CAP) { atomicAdd(&(bar)[XB_TMO], 1u); break; } } } } while (0)

struct XcdBarrier {
    unsigned* bar; unsigned x;
    volatile LAS unsigned* st;
};

__device__ __forceinline__ XcdBarrier xcd_barrier_post(unsigned* bar, volatile LAS unsigned* st) {
    XcdBarrier b; b.bar = bar; b.x = xb_xcc_id(); b.st = st;
    if (threadIdx.x == 0) (void)xb_add(&bar[XB_XCNT(b.x)], 1u);
    return b;
}
__device__ __forceinline__ void xcd_barrier_complete(unsigned* bar, unsigned x, unsigned& nloc, unsigned& nx) {
    const unsigned G = gridDim.x * gridDim.y * gridDim.z;
    unsigned sum, cnt, mine, sp = 0u;
    for (;;) {
        sum = 0u; cnt = 0u; mine = 0u;
#pragma unroll
        for (unsigned j = 0; j < 16; ++j) { const unsigned c = xb_ld(&bar[XB_XCNT(j)]); sum += c; cnt += (c > 0u) ? 1u : 0u; mine = (j == x) ? c : mine; }
        if (sum == G) break;
        __builtin_amdgcn_s_sleep(1);
        if ((++sp & 255u) == 0u) { if (xb_ld(&bar[XB_TMO])) break; if (sp > XB_SPIN_CAP) { atomicAdd(&bar[XB_TMO], 1u); break; } }
    }
    nloc = mine > 0u ? mine : 1u; nx = cnt > 0u ? cnt : 1u;
}

__device__ __forceinline__ void xcd_barrier(const XcdBarrier& b) {
    asm volatile("s_waitcnt vmcnt(0)" ::: "memory");
    __syncthreads();
    if (threadIdx.x == 0) {
        unsigned* bar = b.bar;
        __builtin_amdgcn_s_waitcnt(0);
        unsigned nloc = b.st[0], nx = b.st[1];
        if (nloc == 0u) { xcd_barrier_complete(bar, b.x, nloc, nx); b.st[0] = nloc; b.st[1] = nx; }
        const unsigned old = xb_add(&bar[XB_XSUB(b.x)], 1u);
        const unsigned gen = old / nloc;
        if (old + 1u == (gen + 1u) * nloc) {
            __builtin_amdgcn_fence(__ATOMIC_RELEASE, "agent");
            asm volatile("s_waitcnt vmcnt(0)" ::: "memory");
            const unsigned og = xb_add(&bar[XB_TOP], 1u);
            const unsigned tg = og / nx;
            if (og + 1u == (tg + 1u) * nx) xb_add(&bar[XB_TOPGEN], 1u);
            else XB_SPIN(xb_ld(&bar[XB_TOPGEN]) == tg, bar);
            __builtin_amdgcn_fence(__ATOMIC_ACQUIRE, "agent");
            xb_add(&bar[XB_XGEN(b.x)], 1u);
            asm volatile("s_waitcnt vmcnt(0)" ::: "memory");
        } else {
            XB_SPIN(xb_ld(&bar[XB_XGEN(b.x)]) == gen, bar);
            __builtin_amdgcn_fence(__ATOMIC_ACQUIRE, "agent");
            asm volatile("s_waitcnt vmcnt(0)" ::: "memory");
        }
    }
    __syncthreads();
}

constexpr int NPHASE = 22, PH_PER_LAYER = 10;
template <int KIND>
DI void run_phase(const Args& a, int layer, LAS unsigned char* lds) {
    unsigned char* ws = a.ws;
    if constexpr (KIND == 0) { phase_prologue(a, lds); phase_rms_bf16(a.x, a.attn_norm, (bf16_t*)(ws + WS_XN)); }
    if constexpr (KIND == 1) phase_rms_bf16(layer == 0 ? a.x : a.out, a.attn_norm + (size_t)layer * D, (bf16_t*)(ws + WS_XN));
    if constexpr (KIND == 2 || KIND == 7) {
        const bool inproj = KIND == 2;
        const int N = inproj ? C_GATE : D, ldw = inproj ? NP : D;
        pg8::Gemm g{(const bf16_t*)(ws + WS_XN), (const bf16_t*)(ws + (inproj ? WS_WIN : WS_WQ)) + (size_t)layer * ldw * D, M, N, D};
        pg8::StaticOrder So; So.init(M, N, (int)gridDim.x, (int)blockIdx.x);
        EpiBf16RS E{(bf16_t*)(ws + (inproj ? WS_P : WS_Q2)), ldw, inproj ? nullptr : (const float*)(ws + WS_RSS) + (size_t)layer * M * 32};
        pg8::gemm_phase<EpiBf16RS, pg8::StaticOrder, true, true>(lds, g, So, E);
    }
    if constexpr (KIND == 3) phase_prep(a, layer, lds);
    if constexpr (KIND == 4) phase_attn(a, layer, lds);
    if constexpr (KIND == 5) {
        pg8::Gemm g{(const bf16_t*)(ws + WS_O), (const bf16_t*)(ws + WS_WOUT) + (size_t)layer * D * D, M, D, D};
        pg8::StaticOrder So; So.init(M, D, (int)gridDim.x, (int)blockIdx.x);
        EpiResid E{layer == 0 ? a.x : a.out, a.out, D, (bf16_t*)(ws + WS_XN), (float*)(ws + WS_RSS) + (size_t)layer * M * 32};
        pg8::gemm_phase<EpiResid, pg8::StaticOrder, true, true>(lds, g, So, E);
    }
    if constexpr (KIND == 6) phase_rms_bf16(a.out, a.ffn_norm + (size_t)layer * D, (bf16_t*)(ws + WS_XN));
    if constexpr (KIND == 8) phase_peer_select(a, layer, lds);
    if constexpr (KIND == 9) phase_peer_u(a, layer);
    if constexpr (KIND == 14) phase_peer_v(a, layer);
    if constexpr (KIND == 10) phase_rms_final(a.out, a.final_norm);
}

#ifndef MK_PER_PHASE
#define MK_PER_PHASE 0
#endif

#if MK_PER_PHASE
template <int KIND>
__global__ void __launch_bounds__(NTHREADS, 2) k_phase(Args a, int layer) {
    extern __shared__ __attribute__((aligned(16))) unsigned char lds_raw[];
    run_phase<KIND>(a, layer, (LAS unsigned char*)lds_raw);
}
template <int KIND> static void launch_phase(const Args& a, int layer, int grid, hipStream_t stream) {
    static bool attr = false;
    if (!attr) { (void)hipFuncSetAttribute((const void*)k_phase<KIND>, hipFuncAttributeMaxDynamicSharedMemorySize, LDS_BYTES); attr = true; }
    hipLaunchKernelGGL(k_phase<KIND>, dim3(grid), dim3(NTHREADS), LDS_BYTES, stream, a, layer);
}
#else
__global__ void __launch_bounds__(NTHREADS, 2) hybrid_fwd(Args a) {
    extern __shared__ __attribute__((aligned(16))) unsigned char lds_raw[];
    LAS unsigned char* lds = (LAS unsigned char*)lds_raw;
    volatile LAS unsigned* bst = (volatile LAS unsigned*)(lds + LDS_BYTES - 16);
    if (threadIdx.x < 4) bst[threadIdx.x] = 0u;
    __syncthreads();
    const XcdBarrier xbar = xcd_barrier_post((unsigned*)(a.ws + WS_BAR), bst);
    bool first_seam = true;
#pragma unroll 1
    for (int ph = a.ph_lo; ph < a.ph_hi; ++ph) {
        if (ph == NPHASE - 1 || ph == 1 + PH_PER_LAYER || ph == 1 || ph == 6 || ph == 6 + PH_PER_LAYER) continue;
        if (ph == 0) run_phase<0>(a, 0, lds);
        else if (ph == NPHASE - 1) run_phase<10>(a, 0, lds);
        else {
            const int layer = (ph - 1) / PH_PER_LAYER, k = (ph - 1) % PH_PER_LAYER;
            if (k == 0) run_phase<1>(a, layer, lds);
            else if (k == 1) run_phase<2>(a, layer, lds);
            else if (k == 2) run_phase<3>(a, layer, lds);
            else if (k == 3) run_phase<4>(a, layer, lds);
            else if (k == 4) run_phase<5>(a, layer, lds);
            else if (k == 5) run_phase<6>(a, layer, lds);
            else if (k == 6) run_phase<7>(a, layer, lds);
            else if (k == 7) run_phase<8>(a, layer, lds);
            else if (k == 8) run_phase<9>(a, layer, lds);
            else run_phase<14>(a, layer, lds);
        }
        if (ph + 1 < a.ph_hi) { if (first_seam) { cg::this_grid().sync(); first_seam = false; } else xcd_barrier(xbar); }
    }
}
#endif

extern "C" void kernel_launch(void* const* d_in, const int* in_sizes, int n_in, void* d_out, int out_size, void* d_ws, size_t ws_size, hipStream_t stream) {
    static int grid = 0;
    if (grid == 0) {
        if (n_in != 18 || out_size != M * D || ws_size < WS_END) { fprintf(stderr, "kernel_launch: unexpected shapes (n_in %d, out %d, ws %zu)\n", n_in, out_size, ws_size); grid = -1; return; }
        int dev = 0, cus = 0;
        if (hipGetDevice(&dev) != hipSuccess || hipDeviceGetAttribute(&cus, hipDeviceAttributeMultiprocessorCount, dev) != hipSuccess) { grid = -1; return; }
#if !MK_PER_PHASE
        if (hipFuncSetAttribute((const void*)hybrid_fwd, hipFuncAttributeMaxDynamicSharedMemorySize, LDS_BYTES) != hipSuccess) { fprintf(stderr, "kernel_launch: hipFuncSetAttribute failed\n"); grid = -1; return; }
        int per_cu = 0;
        if (hipOccupancyMaxActiveBlocksPerMultiprocessor(&per_cu, (const void*)hybrid_fwd, NTHREADS, LDS_BYTES) != hipSuccess || per_cu < 1) fprintf(stderr, "kernel_launch: occupancy query says %d\n", per_cu);
        (void)hipGetLastError();
#endif
        grid = cus;
    }
    if (grid < 0) return;
    Args a{};
    a.x = (const float*)d_in[0]; a.attn_norm = (const float*)d_in[1]; a.w_in = (const float*)d_in[2]; a.cmp_pos_k = (const float*)d_in[3];
    a.cmp_w1_k = (const float*)d_in[4]; a.cmp_w2_k = (const float*)d_in[5]; a.cmp_pos_v = (const float*)d_in[6]; a.cmp_w1_v = (const float*)d_in[7];
    a.cmp_w2_v = (const float*)d_in[8]; a.sinks = (const float*)d_in[9]; a.w_out = (const float*)d_in[10]; a.ffn_norm = (const float*)d_in[11];
    a.peer_wq = (const float*)d_in[12]; a.peer_subkeys = (const float*)d_in[13]; a.peer_u = (const float*)d_in[14]; a.peer_v = (const float*)d_in[15];
    a.rel_bias = (const float*)d_in[16]; a.final_norm = (const float*)d_in[17];
    a.out = (float*)d_out; a.ws = (unsigned char*)d_ws;
    a.ph_lo = 0; a.ph_hi = NPHASE;
#if MK_PER_PHASE
    launch_phase<0>(a, 0, grid, stream);
    for (int l = 0; l < NLAYER; ++l) {
        launch_phase<2>(a, l, grid, stream); launch_phase<3>(a, l, grid, stream);
        launch_phase<4>(a, l, grid, stream); launch_phase<5>(a, l, grid, stream);
        launch_phase<7>(a, l, grid, stream); launch_phase<8>(a, l, grid, stream); launch_phase<9>(a, l, grid, stream); launch_phase<14>(a, l, grid, stream);
    }
#else
    (void)hipMemsetAsync((unsigned char*)d_ws + WS_BAR, 0, 16384, stream);
    void* args[] = {&a};
    const hipError_t e = hipLaunchCooperativeKernel((const void*)hybrid_fwd, dim3(grid), dim3(NTHREADS), args, LDS_BYTES, stream);
    if (e != hipSuccess) fprintf(stderr, "kernel_launch: cooperative launch failed: %s (grid %d)\n", hipGetErrorString(e), grid);
#endif
}
```

```cpp
#include <hip/hip_runtime.h>
#include <cstdio>
#include <cstdint>
__device__ __forceinline__ int opaque_tid() { int t = threadIdx.x; asm volatile("" : "+v"(t)); return t; }
namespace pg8 {
#define PG8_LAS __attribute__((address_space(3)))
typedef unsigned short bf16_t;
typedef short bf16x8 __attribute__((ext_vector_type(8)));
typedef float f32x4 __attribute__((ext_vector_type(4)));
typedef unsigned u32x4 __attribute__((ext_vector_type(4)));
constexpr int BM = 256, BK = 64, HALF = 128, HTB = HALF * BK * 2  , STAGE_BYTES = 8 * HTB, NXCD = 8, WGM = 8;

__host__ __device__ __forceinline__ int lds_byte(int r, int c) { const int st = (r >> 4) * 2 + (c >> 5), rr = r & 15, cc = c & 31, ob = rr * 64 + cc * 2; return st * 1024 + (ob ^ (((ob >> 9) & 1) << 5)); }
__host__ __device__ __forceinline__ void stage_rc(int b, int& R, int& C) { const int st = b / 1024, sb = b % 1024, swz = sb ^ (((sb >> 9) & 1) << 5); R = (st >> 1) * 16 + swz / 64; C = (st & 1) * 32 + (swz % 64) / 2; }
__host__ __device__ __forceinline__ int perm32(int rho) { const int n = rho >> 4, i = rho & 15; return 8 * (i >> 2) + 4 * n + (i & 3); }

struct Unit { int pm, pn; };
struct Gemm { const bf16_t* A; const bf16_t* Bt; int M, N, K; };

struct StaticOrder {
    int nM, nN, nwg, G, c;
    __host__ __device__ void init(int M, int N, int G_, int c_) { nM = M / BM; nN = N / BM; nwg = nM * nN; G = G_; c = c_; }
    __host__ __device__ bool next(int i, Unit& u) const {
        const long L = (long)i * G + c; if (L >= nwg) return false;
        int wgid = (int)L; { const int q = nwg / NXCD, r = nwg % NXCD, xcd = wgid % NXCD, off = wgid / NXCD; wgid = (xcd < r ? xcd * (q + 1) : r * (q + 1) + (xcd - r) * q) + off; }
        const int nig = WGM * nN, gid = wgid / nig, fm = gid * WGM, gsz = (nM - fm) < WGM ? (nM - fm) : WGM;
        u.pm = fm + ((wgid % nig) % gsz); u.pn = (wgid % nig) / gsz; return true;
    }
    __device__ __forceinline__ void a_ready(const Unit&) const {}
    __device__ __forceinline__ void done(const Unit&) const {}
};

__device__ __forceinline__ unsigned cvt_pk_bf16(float lo, float hi) { unsigned r; asm volatile("v_cvt_pk_bf16_f32 %0, %1, %2" : "=v"(r) : "v"(lo), "v"(hi)); return r; }
typedef float f32x2 __attribute__((ext_vector_type(2)));
__device__ __forceinline__ f32x2 gelu_pk(f32x2 v) {
    const f32x2 av = __builtin_elementwise_abs(v), d = av * 0.2316418882f + 1.0f;
    f32x2 t; t.x = __builtin_amdgcn_rcpf(d.x); t.y = __builtin_amdgcn_rcpf(d.y);
    f32x2 q = t * 0.5307027145f + (-0.7265760135f); q = q * t + 0.7107068705f; q = q * t + (-0.142248368f); q = q * t + 0.127414796f; q = q * t;
    const f32x2 s = (v * v) * (-0.72134752044f);
    f32x2 e; e.x = __builtin_amdgcn_exp2f(s.x); e.y = __builtin_amdgcn_exp2f(s.y);
    const f32x2 m = v * (q * e), r = v - m;
    f32x2 o; o.x = v.x < 0.f ? m.x : r.x; o.y = v.y < 0.f ? m.y : r.y; return o;
}

template <int ACT  > struct EpiBf16 {
    static constexpr bool PERM = true, AFTER_DRAIN = false; static_assert(ACT == 0 || ACT == 1, "EpiBf16: ACT is 0 (none) or 1 (gelu_pk)");
    bf16_t* O; int ldc; const float* bias; int split_cols; size_t split_stride; float scale0;
    __device__ __forceinline__ void operator()(const f32x4 (&acc)[2][2][4][2], const Unit& u, int wr, int wc, int fr, int fq) const {
        const int row0 = u.pm * BM + wr * 64 + fr; int colt = u.pn * BM; bf16_t* base = O;
        float sc = 1.f; if (split_cols) { const int t = colt / split_cols; base += (size_t)t * split_stride; colt -= t * split_cols; if (t == 0) sc = scale0; }
        const int col0 = colt + wc * 32 + 8 * fq, bcol0 = u.pn * BM + wc * 32 + 8 * fq;
        f32x4 bv[2][2];
#pragma unroll
        for (int bj = 0; bj < 2; ++bj)
#pragma unroll
            for (int n = 0; n < 2; ++n) bv[bj][n] = bias ? *(const f32x4*)(bias + bcol0 + bj * HALF + 4 * n) : (f32x4){0.f, 0.f, 0.f, 0.f};
#pragma unroll
        for (int ai = 0; ai < 2; ++ai)
#pragma unroll
            for (int m = 0; m < 4; ++m) { bf16_t* rowp = base + (size_t)(row0 + ai * HALF + m * 16) * ldc + col0;
#pragma unroll
                for (int bj = 0; bj < 2; ++bj) { f32x4 v0 = acc[ai][bj][m][0] + bv[bj][0], v1 = acc[ai][bj][m][1] + bv[bj][1];
                    if (ACT == 1) { f32x2 a = gelu_pk((f32x2){v0[0], v0[1]}), b = gelu_pk((f32x2){v0[2], v0[3]}), c = gelu_pk((f32x2){v1[0], v1[1]}), d = gelu_pk((f32x2){v1[2], v1[3]});
                        v0 = (f32x4){a.x, a.y, b.x, b.y}; v1 = (f32x4){c.x, c.y, d.x, d.y}; }
                    v0 = v0 * sc; v1 = v1 * sc; u32x4 w; w.x = cvt_pk_bf16(v0[0], v0[1]); w.y = cvt_pk_bf16(v0[2], v0[3]); w.z = cvt_pk_bf16(v1[0], v1[1]); w.w = cvt_pk_bf16(v1[2], v1[3]);
                    *(u32x4*)(rowp + bj * HALF) = w; } }
    }
};
template <class Epi, class Sched, bool ALIGN_EPI = false, bool SP2 = false>
__device__ __forceinline__ void gemm_phase(PG8_LAS unsigned char* lds, const Gemm g, const Sched& S, const Epi& E) {
    const int tid = opaque_tid(), wid = __builtin_amdgcn_readfirstlane(tid >> 6), lane = tid & 63, wr = wid >> 2, wc = wid & 3, fr = lane & 15, fq = lane >> 4;
    const int K = g.K, nt = K / BK;
    unsigned voffA[2], voffB[2];
#pragma unroll
    for (int i = 0; i < 2; ++i) { int R, C; stage_rc(tid * 16 + i * 8192, R, C); const int Rb = Epi::PERM ? ((R & ~31) + perm32(R & 31)) : R;
        voffA[i] = (unsigned)(R * K + C) * 2u; voffB[i] = (unsigned)(Rb * K + C) * 2u; }
    const size_t kstep = (size_t)(BK * 2);
    const size_t hstep = (size_t)HALF * K * 2;
    const size_t tstep = 2 * hstep;
    const unsigned ldsw = (unsigned)wid * 1024u;
    const int aoff = lds_byte(wr * 64 + fr, fq * 8), boff = lds_byte(wc * 32 + fr, fq * 8);
#define PG8_SA(b, h) (((b) * 2 + (h)) * HTB)
#define PG8_SB(b, h) ((4 + (b) * 2 + (h)) * HTB)
#define PG8_STAGE(bufoff, gbase, voff) do { _Pragma("unroll") for (int _i = 0; _i < 2; ++_i) \
        __builtin_amdgcn_global_load_lds((const unsigned*)((const char*)(gbase) + (voff)[_i]), (PG8_LAS unsigned*)(lds + (bufoff) + ldsw + _i * 8192), 16, 0, 0); } while (0)
#define PG8_LDA(dst, b, h) do { _Pragma("unroll") for (int m = 0; m < 4; ++m) _Pragma("unroll") for (int k = 0; k < 2; ++k) dst[m][k] = *(const PG8_LAS bf16x8*)(lds + PG8_SA(b, h) + aoff + m * 2048 + k * 1024); } while (0)
#define PG8_LDB(dst, b, h) do { _Pragma("unroll") for (int n = 0; n < 2; ++n) _Pragma("unroll") for (int k = 0; k < 2; ++k) dst[n][k] = *(const PG8_LAS bf16x8*)(lds + PG8_SB(b, h) + boff + n * 2048 + k * 1024); } while (0)
#define PG8_MMA(ai, bj, At, Bt) do { __builtin_amdgcn_s_setprio(1); _Pragma("unroll") for (int m = 0; m < 4; ++m) _Pragma("unroll") for (int n = 0; n < 2; ++n) _Pragma("unroll") for (int k = 0; k < 2; ++k) \
        acc[ai][bj][m][n] = __builtin_amdgcn_mfma_f32_16x16x32_bf16(Bt[n][k], At[m][k], acc[ai][bj][m][n], 0, 0, 0); __builtin_amdgcn_s_setprio(0); } while (0)
#define PG8_WAIT_V(n) asm volatile("s_waitcnt vmcnt(" #n ")" ::: "memory")
#define PG8_WAIT_L(n) asm volatile("s_waitcnt lgkmcnt(" #n ")" ::: "memory")
#define PG8_BAR __builtin_amdgcn_s_barrier()
#define PG8_SCHED __builtin_amdgcn_sched_barrier(0)
    Unit cur, nxt; int ui = 0;
    if (!S.next(0, cur)) return;
    f32x4 acc[2][2][4][2];
#pragma unroll
    for (int a = 0; a < 2; ++a)
#pragma unroll
        for (int b = 0; b < 2; ++b)
#pragma unroll
            for (int m = 0; m < 4; ++m)
#pragma unroll
                for (int n = 0; n < 2; ++n) acc[a][b][m][n] = (f32x4){0.f, 0.f, 0.f, 0.f};
    bf16x8 At[4][2], B0[2][2], B1[2][2];
    const char* cA = (const char*)g.A + (size_t)cur.pm * tstep; const char* cB = (const char*)g.Bt + (size_t)cur.pn * tstep;
    S.a_ready(cur);
    if constexpr (SP2) {
        PG8_STAGE(PG8_SB(0, 0), cB, voffB); PG8_STAGE(PG8_SB(0, 1), cB + hstep, voffB); PG8_STAGE(PG8_SA(0, 0), cA, voffA); PG8_STAGE(PG8_SA(0, 1), cA + hstep, voffA);
        if (wr == 1) PG8_BAR;
        PG8_WAIT_V(2); PG8_BAR;
        PG8_STAGE(PG8_SB(1, 0), cB + kstep, voffB); PG8_STAGE(PG8_SA(1, 0), cA + kstep, voffA); PG8_STAGE(PG8_SB(1, 1), cB + hstep + kstep, voffB);
        PG8_WAIT_V(6); PG8_BAR;
    } else {
        PG8_STAGE(PG8_SB(0, 0), cB, voffB); PG8_STAGE(PG8_SA(0, 0), cA, voffA); PG8_STAGE(PG8_SB(0, 1), cB + hstep, voffB); PG8_STAGE(PG8_SA(0, 1), cA + hstep, voffA);
        if (wr == 1) PG8_BAR;
        PG8_WAIT_V(4); PG8_BAR;
        PG8_STAGE(PG8_SB(1, 0), cB + kstep, voffB); PG8_STAGE(PG8_SA(1, 0), cA + kstep, voffA); PG8_STAGE(PG8_SB(1, 1), cB + hstep + kstep, voffB);
        PG8_WAIT_V(6); PG8_BAR;
    }
    for (;;) {
        const bool has_next = S.next(ui + 1, nxt);
        const char* nA = has_next ? (const char*)g.A + (size_t)nxt.pm * tstep : cA; const char* nB = has_next ? (const char*)g.Bt + (size_t)nxt.pn * tstep : cB;
        for (int t = 0; t < nt; t += 2) {
            const bool last = (t == nt - 2);
            const char* a1 = cA + (size_t)(t + 1) * kstep;
            const char* a2 = last ? nA : cA + (size_t)(t + 2) * kstep; const char* b2 = last ? nB : cB + (size_t)(t + 2) * kstep;
            const char* a3 = a2 + kstep; const char* b3 = b2 + kstep;
            if (last && has_next) S.a_ready(nxt);
            if constexpr (SP2) {
            PG8_LDB(B0, 0, 0); PG8_LDB(B1, 0, 1); PG8_SCHED; PG8_LDA(At, 0, 0); PG8_STAGE(PG8_SA(1, 1), a1 + hstep, voffA);
            PG8_WAIT_V(8); PG8_WAIT_L(0); PG8_BAR; PG8_MMA(0, 0, At, B0); PG8_MMA(0, 1, At, B1); PG8_BAR; PG8_SCHED;
            PG8_LDA(At, 0, 1); PG8_STAGE(PG8_SB(0, 0), b2, voffB); PG8_STAGE(PG8_SB(0, 1), b2 + hstep, voffB); PG8_STAGE(PG8_SA(0, 0), a2, voffA);
            PG8_WAIT_V(8); PG8_WAIT_L(0); PG8_BAR; PG8_MMA(1, 0, At, B0); PG8_MMA(1, 1, At, B1); PG8_BAR; PG8_SCHED;
            PG8_LDB(B0, 1, 0); PG8_LDB(B1, 1, 1); PG8_SCHED; PG8_LDA(At, 1, 0); PG8_STAGE(PG8_SA(0, 1), a2 + hstep, voffA);
            PG8_WAIT_V(8); PG8_WAIT_L(0); PG8_BAR; PG8_MMA(0, 0, At, B0); PG8_MMA(0, 1, At, B1); PG8_BAR; PG8_SCHED;
            PG8_LDA(At, 1, 1); PG8_STAGE(PG8_SB(1, 0), b3, voffB); PG8_STAGE(PG8_SB(1, 1), b3 + hstep, voffB); PG8_STAGE(PG8_SA(1, 0), a3, voffA);
            PG8_WAIT_V(8); PG8_WAIT_L(0); PG8_BAR; PG8_MMA(1, 0, At, B0); PG8_MMA(1, 1, At, B1); PG8_BAR; PG8_SCHED;
            } else {
            PG8_LDB(B0, 0, 0); PG8_SCHED; PG8_LDA(At, 0, 0); PG8_STAGE(PG8_SA(1, 1), a1 + hstep, voffA);
            PG8_WAIT_L(8); PG8_BAR; PG8_WAIT_L(0); PG8_MMA(0, 0, At, B0); PG8_BAR; PG8_SCHED;
            PG8_LDB(B1, 0, 1); PG8_STAGE(PG8_SB(0, 0), b2, voffB);
            PG8_BAR; PG8_WAIT_L(0); PG8_MMA(0, 1, At, B1); PG8_BAR;
            PG8_LDA(At, 0, 1); PG8_STAGE(PG8_SA(0, 0), a2, voffA);
            PG8_BAR; PG8_WAIT_L(0); PG8_MMA(1, 0, At, B0); PG8_BAR; PG8_SCHED;
            PG8_STAGE(PG8_SB(0, 1), b2 + hstep, voffB);
            PG8_WAIT_V(6); PG8_BAR; PG8_MMA(1, 1, At, B1); PG8_BAR;
            PG8_LDB(B0, 1, 0); PG8_SCHED; PG8_LDA(At, 1, 0); PG8_STAGE(PG8_SA(0, 1), a2 + hstep, voffA);
            PG8_WAIT_L(8); PG8_BAR; PG8_WAIT_L(0); PG8_MMA(0, 0, At, B0); PG8_BAR; PG8_SCHED;
            PG8_LDB(B1, 1, 1); PG8_STAGE(PG8_SB(1, 0), b3, voffB);
            PG8_BAR; PG8_WAIT_L(0); PG8_MMA(0, 1, At, B1); PG8_BAR;
            PG8_LDA(At, 1, 1); PG8_STAGE(PG8_SA(1, 0), a3, voffA);
            PG8_BAR; PG8_WAIT_L(0); PG8_MMA(1, 0, At, B0); PG8_BAR; PG8_SCHED;
            PG8_STAGE(PG8_SB(1, 1), b3 + hstep, voffB);
            PG8_WAIT_V(6); PG8_BAR; PG8_MMA(1, 1, At, B1); PG8_BAR;
            }
        }
        if constexpr (ALIGN_EPI) { if (wr == 0) PG8_BAR; }
        if constexpr (!Epi::AFTER_DRAIN) { E(acc, cur, wr, wc, fr, fq); S.done(cur); }
        if (!has_next) break;
#pragma unroll
        for (int a = 0; a < 2; ++a)
#pragma unroll
            for (int b = 0; b < 2; ++b)
#pragma unroll
                for (int m = 0; m < 4; ++m)
#pragma unroll
                    for (int n = 0; n < 2; ++n) acc[a][b][m][n] = (f32x4){0.f, 0.f, 0.f, 0.f};
        cur = nxt; cA = nA; cB = nB; ++ui;
        if constexpr (ALIGN_EPI) { if (wr == 1) PG8_BAR; }
    }
    PG8_WAIT_V(0);
    if constexpr (!ALIGN_EPI) { if (wr == 0) PG8_BAR; }
    PG8_BAR;
    if constexpr (Epi::AFTER_DRAIN) { E.fused(acc, cur, wr, wc, fr, fq, lds, wid, lane); S.done(cur); }
#undef PG8_SA
#undef PG8_SB
#undef PG8_STAGE
#undef PG8_LDA
#undef PG8_LDB
#undef PG8_MMA
#undef PG8_WAIT_V
#undef PG8_WAIT_L
#undef PG8_BAR
#undef PG8_SCHED
}
}

#include <hip/hip_cooperative_groups.h>
namespace cg = cooperative_groups;

#define DI __device__ __forceinline__
#define LAS __attribute__((address_space(3)))
typedef unsigned short bf16_t;
typedef short bf16x8 __attribute__((ext_vector_type(8)));
typedef float f32x4 __attribute__((ext_vector_type(4)));
typedef float f32x2 __attribute__((ext_vector_type(2)));
typedef float f32x16 __attribute__((ext_vector_type(16)));
typedef unsigned u32x4 __attribute__((ext_vector_type(4)));
typedef unsigned u32x2 __attribute__((ext_vector_type(2)));
typedef __bf16 bf16v2 __attribute__((ext_vector_type(2)));

#define MFMA32(a, b, c) __builtin_amdgcn_mfma_f32_32x32x16_bf16((a), (b), (c), 0, 0, 0)
#define MFMA16(a, b, c) __builtin_amdgcn_mfma_f32_16x16x32_bf16((a), (b), (c), 0, 0, 0)
#define LDS_WAIT() asm volatile("s_waitcnt lgkmcnt(0)" ::: "memory")

constexpr int NB = 2, S = 16384, D = 2048, M = NB * S, NLAYER = 2;
constexpr int NPROJ = 3120, NP = 3328;
constexpr int C_QA = 0, C_QB = 1024, C_KC = 2048, C_VC = 2176, C_KS = 2304, C_VS = 2432, C_KW = 2560, C_VW = 2688, C_KB = 2816, C_VB = 2944, C_GATE = 3072;
constexpr int NCP = 1024;
constexpr int NEXP = 16384;
constexpr float NEGF = -1e30f;

constexpr size_t MiB = 1u << 20;
constexpr size_t WS_WIN = 0;
constexpr size_t WS_WOUT = 28 * MiB;
constexpr size_t WS_WQ = 46 * MiB;
constexpr size_t WS_CW1 = 64 * MiB;
constexpr size_t WS_SUBK = 67 * MiB;
constexpr size_t WS_KC = 68 * MiB;
constexpr size_t WS_VCT = 69 * MiB;
constexpr size_t WS_VST = 70 * MiB;
constexpr size_t WS_VWT = 78 * MiB;
constexpr size_t WS_VBT = 86 * MiB;
constexpr size_t WS_IDX = 96 * MiB;
constexpr size_t WS_GATE = 112 * MiB;
constexpr size_t WS_GSUM = 94 * MiB;
constexpr size_t WS_U = 128 * MiB;
constexpr size_t WS_V = 256 * MiB;
constexpr size_t WS_KSF = 192 * MiB, WS_KWF = 200 * MiB, WS_KBF = 208 * MiB;
constexpr size_t WS_KMAX = 95 * MiB + 65536;
constexpr size_t WS_RSS = 192 * MiB + 24 * MiB;
constexpr size_t WS_XN = 384 * MiB;
constexpr size_t WS_O = 512 * MiB;
constexpr size_t WS_Q2 = 640 * MiB;
constexpr size_t WS_P = 768 * MiB;
constexpr size_t WS_END = 1000 * MiB;

constexpr int LDS_BYTES = 139264;
constexpr int NTHREADS = 512;

struct Args {
    const float* x; const float* attn_norm; const float* w_in; const float* cmp_pos_k; const float* cmp_w1_k; const float* cmp_w2_k;
    const float* cmp_pos_v; const float* cmp_w1_v; const float* cmp_w2_v; const float* sinks; const float* w_out; const float* ffn_norm;
    const float* peer_wq; const float* peer_subkeys; const float* peer_u; const float* peer_v; const float* rel_bias; const float* final_norm;
    float* out; unsigned char* ws; int ph_lo, ph_hi;
};

DI unsigned f2bf(float f) { unsigned u = __builtin_bit_cast(unsigned, f); return (u + 0x7fffu + ((u >> 16) & 1u)) >> 16; }
DI unsigned pk2(float lo, float hi) { const f32x2 v = {lo, hi}; return __builtin_bit_cast(unsigned, __builtin_convertvector(v, bf16v2)); }
DI float bflo(unsigned w) { return __builtin_bit_cast(float, w << 16); }
DI float bfhi(unsigned w) { return __builtin_bit_cast(float, w & 0xffff0000u); }
DI float bf2f(bf16_t v) { return __builtin_bit_cast(float, (unsigned)v << 16); }
DI float wave_sum(float v) {
#pragma unroll
    for (int o = 1; o < 64; o <<= 1) v += __shfl_xor(v, o);
    return v;
}
DI float gelu_tanh(float x) {
    const float y = 0.7978845608028654f * (x + 0.044715f * x * x * x);
    const float t = __expf(2.f * y);
    const float th = 1.f - 2.f / (t + 1.f);
    return 0.5f * x * (1.f + th);
}
DI float sigmoidf_(float x) { return 1.f / (1.f + __expf(-x)); }
DI int crow(int r, int hi) { return (r & 3) + 8 * (r >> 2) + 4 * hi; }
DI int rel_bucket(int d) {
    const float lf = __log2f((float)(d < 1 ? 1 : d));
    int b = 16 + (int)((lf - 4.0f) * (16.0f / 7.0f));
    b = b > 31 ? 31 : b;
    return d < 16 ? d : b;
}
DI bf16x8 pack8(float a0, float a1, float a2, float a3, float a4, float a5, float a6, float a7) {
    u32x4 p; p.x = pk2(a0, a1); p.y = pk2(a2, a3); p.z = pk2(a4, a5); p.w = pk2(a6, a7);
    return __builtin_bit_cast(bf16x8, p);
}

DI int win_srccol(int n) {
    if (n < 1024) return n;
    if (n < 2048) return 1840 + (n - 1024);
    if (n < 2816) return 1024 + (n - 2048);
    if (n < 3072) return 2864 + (n - 2816);
    if (n < 3120) return 1792 + (n - 3072);
    return -1;
}
template <bool WIN>
DI void transpose_item(const float* W, int K, int Nsrc, bf16_t* WT, int k0, int n0, LAS float* scr, int lane, const float* gk = nullptr) {
    const int nd = n0 + (lane & 31);
    const int ns = WIN ? win_srccol(nd) : nd;
#pragma unroll 8
    for (int i = 0; i < 32; ++i) { const int kk = 2 * i + (lane >> 5); scr[kk * 33 + (lane & 31)] = (ns >= 0 ? W[(size_t)(k0 + kk) * Nsrc + ns] : 0.f) * (gk ? gk[k0 + kk] : 1.f); }
    LDS_WAIT();
    const int c = lane & 7;
#pragma unroll
    for (int j = 0; j < 4; ++j) { const int n = (lane >> 3) + 8 * j; const LAS float* s = scr + (8 * c) * 33 + n;
        u32x4 o; o.x = pk2(s[0 * 33], s[1 * 33]); o.y = pk2(s[2 * 33], s[3 * 33]); o.z = pk2(s[4 * 33], s[5 * 33]); o.w = pk2(s[6 * 33], s[7 * 33]);
        *(u32x4*)(WT + (size_t)(n0 + n) * K + k0 + 8 * c) = o; }
    LDS_WAIT();
}
template <bool WIN>
DI void transpose_matrix(const float* W, int K, int Nsrc, int Ndst, bf16_t* WT, LAS float* scr, int lane, int gw, int NGW, const float* gk = nullptr) {
    const int nblk = Ndst / 32, nitems = (K / 64) * nblk;
    for (int it = gw; it < nitems; it += NGW) transpose_item<WIN>(W, K, Nsrc, WT, 64 * (it / nblk), 32 * (it % nblk), scr, lane, gk);
}
DI void convert_rows(const float* src, bf16_t* dst, size_t n8, size_t gt, size_t ngt) {
    for (size_t i = gt; i < n8; i += ngt) {
        const f32x4 a = ((const f32x4*)src)[2 * i], b = ((const f32x4*)src)[2 * i + 1];
        u32x4 o; o.x = pk2(a.x, a.y); o.y = pk2(a.z, a.w); o.z = pk2(b.x, b.y); o.w = pk2(b.z, b.w);
        ((u32x4*)dst)[i] = o;
    }
}
constexpr float U_SCALE = 512.f, V_SCALE = 64.f;
DI void convert_rows_fp8(const float* src, unsigned char* dst, size_t n16, float scale, size_t gt, size_t ngt, const float* gnorm = nullptr) {
    for (size_t i = gt; i < n16; i += ngt) {
        f32x4 a = ((const f32x4*)src)[4 * i] * scale, b = ((const f32x4*)src)[4 * i + 1] * scale, c = ((const f32x4*)src)[4 * i + 2] * scale, d = ((const f32x4*)src)[4 * i + 3] * scale;
        if (gnorm) { const f32x4* gp = (const f32x4*)(gnorm + ((16 * i) / ((size_t)NEXP * D)) * D + (16 * i) % D); a = a * gp[0]; b = b * gp[1]; c = c * gp[2]; d = d * gp[3]; }
        u32x4 o;
        o.x = (unsigned)__builtin_amdgcn_cvt_pk_fp8_f32(a.z, a.w, __builtin_amdgcn_cvt_pk_fp8_f32(a.x, a.y, 0, false), true);
        o.y = (unsigned)__builtin_amdgcn_cvt_pk_fp8_f32(b.z, b.w, __builtin_amdgcn_cvt_pk_fp8_f32(b.x, b.y, 0, false), true);
        o.z = (unsigned)__builtin_amdgcn_cvt_pk_fp8_f32(c.z, c.w, __builtin_amdgcn_cvt_pk_fp8_f32(c.x, c.y, 0, false), true);
        o.w = (unsigned)__builtin_amdgcn_cvt_pk_fp8_f32(d.z, d.w, __builtin_amdgcn_cvt_pk_fp8_f32(d.x, d.y, 0, false), true);
        ((u32x4*)dst)[i] = o;
    }
}
DI void phase_prologue(const Args& a, LAS unsigned char* lds) {
    const int tid = opaque_tid(), lane = tid & 63, wave = tid >> 6;
    if (blockIdx.x == 0 && tid < 32) ((unsigned*)(a.ws + WS_KMAX))[tid] = 0u;
    const int gw = blockIdx.x * 8 + wave, NGW = gridDim.x * 8;
    LAS float* scr = (LAS float*)(lds + wave * 8448);
    unsigned char* ws = a.ws;
    for (int l = 0; l < NLAYER; ++l) {
        transpose_matrix<true>(a.w_in + (size_t)l * D * NPROJ, D, NPROJ, NP, (bf16_t*)(ws + WS_WIN) + (size_t)l * NP * D, scr, lane, gw, NGW);
        transpose_matrix<false>(a.w_out + (size_t)l * D * D, D, D, D, (bf16_t*)(ws + WS_WOUT) + (size_t)l * D * D, scr, lane, gw, NGW);
        transpose_matrix<false>(a.peer_wq + (size_t)l * D * D, D, D, D, (bf16_t*)(ws + WS_WQ) + (size_t)l * D * D, scr, lane, gw, NGW, a.ffn_norm + (size_t)l * D);
        transpose_matrix<false>(a.cmp_w1_k + (size_t)l * 2048 * 128, 2048, 128, 128, (bf16_t*)(ws + WS_CW1) + (size_t)(l * 2 + 0) * 128 * 2048, scr, lane, gw, NGW);
        transpose_matrix<false>(a.cmp_w1_v + (size_t)l * 2048 * 128, 2048, 128, 128, (bf16_t*)(ws + WS_CW1) + (size_t)(l * 2 + 1) * 128 * 2048, scr, lane, gw, NGW);
    }
    const size_t gt = (size_t)blockIdx.x * NTHREADS + tid, ngt = (size_t)gridDim.x * NTHREADS;
    convert_rows_fp8(a.peer_u, ws + WS_U, (size_t)NLAYER * NEXP * D / 16, U_SCALE, gt, ngt, a.ffn_norm);
    convert_rows_fp8(a.peer_v, ws + WS_V, (size_t)NLAYER * NEXP * D / 16, V_SCALE, gt, ngt);
    convert_rows(a.peer_subkeys, (bf16_t*)(ws + WS_SUBK), (size_t)NLAYER * 2 * 128 * 128 / 8, gt, ngt);
}

DI void phase_rms_bf16(const float* X, const float* g, bf16_t* XN) {
    const int tid = opaque_tid(), lane = tid & 63, wave = tid >> 6;
    const int gw = blockIdx.x * 8 + wave, NGW = gridDim.x * 8;
    f32x4 gv[8];
#pragma unroll
    for (int j = 0; j < 8; ++j) gv[j] = ((const f32x4*)g)[lane + 64 * j];
    for (int m = gw; m < M; m += NGW) {
        const f32x4* xr = (const f32x4*)(X + (size_t)m * D);
        f32x4 v[8]; float s = 0.f;
#pragma unroll
        for (int j = 0; j < 8; ++j) { v[j] = xr[lane + 64 * j]; s += (v[j].x * v[j].x + v[j].y * v[j].y) + (v[j].z * v[j].z + v[j].w * v[j].w); }
        const float rstd = rsqrtf(wave_sum(s) * (1.f / D) + 1e-6f);
        u32x2* o8 = (u32x2*)(XN + (size_t)m * D);
#pragma unroll
        for (int j = 0; j < 8; ++j) { const f32x4 y = v[j] * rstd * gv[j]; u32x2 w; w.x = pk2(y.x, y.y); w.y = pk2(y.z, y.w); o8[lane + 64 * j] = w; }
    }
}
DI void phase_rms_final(float* X, const float* g) {
    const int tid = opaque_tid(), lane = tid & 63, wave = tid >> 6;
    const int gw = blockIdx.x * 8 + wave, NGW = gridDim.x * 8;
    f32x4 gv[8];
#pragma unroll
    for (int j = 0; j < 8; ++j) gv[j] = ((const f32x4*)g)[lane + 64 * j];
    for (int m = gw; m < M; m += NGW) {
        f32x4* xr = (f32x4*)(X + (size_t)m * D);
        f32x4 v[8]; float s = 0.f;
#pragma unroll
        for (int j = 0; j < 8; ++j) { v[j] = xr[lane + 64 * j]; s += (v[j].x * v[j].x + v[j].y * v[j].y) + (v[j].z * v[j].z + v[j].w * v[j].w); }
        const float rstd = rsqrtf(wave_sum(s) * (1.f / D) + 1e-6f);
#pragma unroll
        for (int j = 0; j < 8; ++j) xr[lane + 64 * j] = v[j] * rstd * gv[j];
    }
}

struct EpiResid {
    static constexpr bool PERM = false, AFTER_DRAIN = false;
    const float* base; float* out; int ldc; bf16_t* hb; float* rss;
    DI void operator()(const pg8::f32x4 (&acc)[2][2][4][2], const pg8::Unit& u, int wr, int wc, int fr, int fq) const {
        const int col0 = u.pn * pg8::BM + wc * 32 + 4 * fq;
#pragma unroll
        for (int ai = 0; ai < 2; ++ai)
#pragma unroll
            for (int m = 0; m < 4; ++m) {
                const int row = u.pm * pg8::BM + ai * pg8::HALF + wr * 64 + m * 16 + fr;
                const size_t off = (size_t)row * ldc + col0;
                float ssq = 0.f;
#pragma unroll
                for (int bj = 0; bj < 2; ++bj)
#pragma unroll
                    for (int n = 0; n < 2; ++n) { const size_t o = off + bj * pg8::HALF + n * 16; const pg8::f32x4 bs = *(const pg8::f32x4*)(base + o); const pg8::f32x4 v = bs + acc[ai][bj][m][n];
                        *(pg8::f32x4*)(out + o) = v; ssq += (v[0] * v[0] + v[1] * v[1]) + (v[2] * v[2] + v[3] * v[3]);
                        u32x2 w; w.x = pk2(v[0], v[1]); w.y = pk2(v[2], v[3]); *(u32x2*)(hb + o) = w; }
                ssq += __shfl_xor(ssq, 16); ssq += __shfl_xor(ssq, 32);
                if (fq == 0) rss[(size_t)row * 32 + u.pn * 4 + wc] = ssq;
                asm volatile("" ::: "memory");
            }
    }
};
struct EpiBf16RS {
    static constexpr bool PERM = true, AFTER_DRAIN = false;
    bf16_t* O; int ldc; const float* rss;
    DI void operator()(const pg8::f32x4 (&acc)[2][2][4][2], const pg8::Unit& u, int wr, int wc, int fr, int fq) const {
        const int row0 = u.pm * pg8::BM + wr * 64 + fr, col0 = u.pn * pg8::BM + wc * 32 + 8 * fq;
#pragma unroll
        for (int ai = 0; ai < 2; ++ai)
#pragma unroll
            for (int m = 0; m < 4; ++m) {
                const int row = row0 + ai * pg8::HALF + m * 16;
                float sc = 1.f;
                if (rss) { const pg8::f32x4* rp = (const pg8::f32x4*)(rss + (size_t)row * 32); pg8::f32x4 t = rp[0];
#pragma unroll
                    for (int j = 1; j < 8; ++j) t += rp[j];
                    sc = rsqrtf(((t[0] + t[1]) + (t[2] + t[3])) * (1.f / D) + 1e-6f); }
                bf16_t* rowp = O + (size_t)row * ldc + col0;
#pragma unroll
                for (int bj = 0; bj < 2; ++bj) { const pg8::f32x4 v0 = acc[ai][bj][m][0] * sc, v1 = acc[ai][bj][m][1] * sc;
                    u32x4 w; w.x = pk2(v0[0], v0[1]); w.y = pk2(v0[2], v0[3]); w.z = pk2(v1[0], v1[1]); w.w = pk2(v1[2], v1[3]);
                    *(u32x4*)(rowp + bj * pg8::HALF) = w; }
            }
    }
};

DI void phase_prep(const Args& a, int layer, LAS unsigned char* lds) {
    const int tid = opaque_tid(), lane = tid & 63, wave = tid >> 6;
    const int gw = blockIdx.x * 8 + wave, NGW = gridDim.x * 8;
    unsigned char* ws = a.ws;
    const bf16_t* P = (const bf16_t*)(ws + WS_P);
    {
        LAS bf16_t* scr = (LAS bf16_t*)(lds + wave * 9216);
        for (int it = gw; it < 6 * 4 * 256; it += NGW) {
            const int which = it / 1024, bg = (it / 256) & 3, st = it & 255, b = bg >> 1, g = bg & 1;
            if (which >= 3) {
                const int srccol = (which == 3 ? C_KS : which == 4 ? C_KW : C_KB) + g * 64;
                bf16_t* dst = (bf16_t*)(ws + (which == 3 ? WS_KSF : which == 4 ? WS_KWF : WS_KBF)) + (size_t)bg * 64 * S + (size_t)st * 4096;
                float rmax = 0.f;
#pragma unroll
                for (int i = 0; i < 8; ++i) { const int tok = i * 8 + (lane >> 3), q = lane & 7;
                    const u32x4 v = *(const u32x4*)(P + (size_t)(b * S + st * 64 + tok) * NP + srccol + q * 8);
                    const int pos = which == 3 ? (((tok >> 4) * 2 + (q >> 2)) * 64 + (q & 3) * 16 + (tok & 15))
                                               : ((tok >> 5) * 256 + (q >> 1) * 64 + (q & 1) * 32 + (tok & 31));
                    *(u32x4*)(dst + pos * 8) = v;
                    float ss = bflo(v.x) * bflo(v.x) + bfhi(v.x) * bfhi(v.x) + bflo(v.y) * bflo(v.y) + bfhi(v.y) * bfhi(v.y)
                             + bflo(v.z) * bflo(v.z) + bfhi(v.z) * bfhi(v.z) + bflo(v.w) * bflo(v.w) + bfhi(v.w) * bfhi(v.w);
                    ss += __shfl_xor(ss, 1); ss += __shfl_xor(ss, 2); ss += __shfl_xor(ss, 4);
                    rmax = fmaxf(rmax, ss); }
                rmax = fmaxf(rmax, __shfl_xor(rmax, 8)); rmax = fmaxf(rmax, __shfl_xor(rmax, 16)); rmax = fmaxf(rmax, __shfl_xor(rmax, 32));
                if (lane == 0) atomicMax((unsigned*)(ws + WS_KMAX) + (layer * 4 + (which - 3)) * 4 + bg, __builtin_bit_cast(unsigned, rmax));
                continue;
            }
            const int srccol = (which == 0 ? C_VS : which == 1 ? C_VW : C_VB) + g * 64;
            bf16_t* dst = (bf16_t*)(ws + (which == 0 ? WS_VST : which == 1 ? WS_VWT : WS_VBT)) + (size_t)bg * 64 * S + (size_t)st * 4096;
#pragma unroll
            for (int i = 0; i < 8; ++i) { const int tok = i * 8 + (lane >> 3), ch = lane & 7;
                const u32x4 v = *(const u32x4*)(P + (size_t)(b * S + st * 64 + tok) * NP + srccol + ch * 8);
                *(LAS u32x4*)(scr + tok * 72 + ch * 8) = v; }
            LDS_WAIT();
#pragma unroll
            for (int f = 0; f < 8; ++f) {
                int d, kb0, kstep;
                if (which == 0) { const int j = f >> 2, dt = f & 3, hh = lane & 15, qd = lane >> 4; d = 16 * dt + hh; kb0 = 16 * j + 4 * qd; kstep = 32; }
                else { const int tl = f >> 2, j = (f >> 1) & 1, dt = f & 1, c = lane & 31, hi = lane >> 5; d = dt * 32 + c; kb0 = tl * 32 + 16 * j + 4 * hi; kstep = 8; }
                unsigned e[8];
#pragma unroll
                for (int i = 0; i < 8; ++i) e[i] = scr[(kb0 + (i & 3) + kstep * (i >> 2)) * 72 + d];
                u32x4 o; o.x = e[0] | (e[1] << 16); o.y = e[2] | (e[3] << 16); o.z = e[4] | (e[5] << 16); o.w = e[6] | (e[7] << 16);
                *(u32x4*)(dst + (f * 64 + lane) * 8) = o;
            }
            LDS_WAIT();
        }
    }
    {
        const bf16_t* XN = (const bf16_t*)(ws + WS_XN);
        const bf16_t* wg = (const bf16_t*)(ws + WS_WIN) + (size_t)layer * NP * D + (size_t)C_GATE * D;
        bf16_t* Pw = (bf16_t*)(ws + WS_P);
        const int c = lane & 31, hi = lane >> 5;
        for (int it = NGW - 1 - gw; it < M / 32; it += NGW) {
            const bf16_t* ar = XN + (size_t)(it * 32 + c) * D + hi * 8;
            const bf16_t* b0 = wg + (size_t)c * D + hi * 8, *b1 = wg + (size_t)(32 + c) * D + hi * 8;
            f32x16 a0, a1;
#pragma unroll
            for (int r = 0; r < 16; ++r) { a0[r] = 0.f; a1[r] = 0.f; }
#pragma unroll 8
            for (int kk = 0; kk < 128; ++kk) {
                const bf16x8 af = *(const bf16x8*)(ar + kk * 16);
                a0 = MFMA32(af, *(const bf16x8*)(b0 + kk * 16), a0);
                a1 = MFMA32(af, *(const bf16x8*)(b1 + kk * 16), a1);
            }
#pragma unroll
            for (int r = 0; r < 16; ++r) {
                bf16_t* pr = Pw + (size_t)(it * 32 + crow(r, hi)) * NP + C_GATE;
                pr[c] = (bf16_t)f2bf(a0[r]);
                if (c < 16) pr[32 + c] = (bf16_t)f2bf(a1[r]);
            }
        }
    }
    __syncthreads();
    {
        LAS float* H = (LAS float*)lds;
        const int c = lane & 31, hi = lane >> 5, rg = wave >> 2, nt = wave & 3;
        for (int it = blockIdx.x; it < 128; it += gridDim.x) {
            const int kv = it >> 6, bg = (it >> 4) & 3, rt = it & 15, b = bg >> 1, g = bg & 1;
            const float* pos = (kv ? a.cmp_pos_v : a.cmp_pos_k) + (size_t)layer * 32 * 64;
            const bf16_t* w1t = (const bf16_t*)(ws + WS_CW1) + (size_t)(layer * 2 + kv) * 128 * 2048;
            const float* w2 = (kv ? a.cmp_w2_v : a.cmp_w2_k) + (size_t)layer * 128 * 64;
            int irow = rt * 64 + rg * 32 + c; irow = irow > 1022 ? 1022 : irow;
            const bf16_t* src = P + (size_t)(b * S + 16 * irow) * NP + (kv ? C_VC : C_KC) + g * 64;
            const bf16_t* bsrc = w1t + (size_t)(nt * 32 + c) * 2048 + hi * 8;
            f32x16 acc;
#pragma unroll
            for (int r = 0; r < 16; ++r) acc[r] = 0.f;
#pragma unroll 4
            for (int kk = 0; kk < 128; ++kk) {
                const int tok = kk >> 2, d = (kk & 3) * 16 + hi * 8;
                const u32x4 sv = *(const u32x4*)(src + (size_t)tok * NP + d);
                const f32x4 p0 = *(const f32x4*)(pos + tok * 64 + d), p1 = *(const f32x4*)(pos + tok * 64 + d + 4);
                const bf16x8 af = pack8(bflo(sv.x) + p0.x, bfhi(sv.x) + p0.y, bflo(sv.y) + p0.z, bfhi(sv.y) + p0.w,
                                        bflo(sv.z) + p1.x, bfhi(sv.z) + p1.y, bflo(sv.w) + p1.z, bfhi(sv.w) + p1.w);
                const bf16x8 bf = *(const bf16x8*)(bsrc + kk * 16);
                acc = MFMA32(af, bf, acc);
            }
#pragma unroll
            for (int r = 0; r < 16; ++r) H[(rg * 32 + crow(r, hi)) * 129 + nt * 32 + c] = gelu_tanh(acc[r]);
            __syncthreads();
            {
                const int i = tid >> 3, dc = (tid & 7) * 8;
                float o[8];
#pragma unroll
                for (int e = 0; e < 8; ++e) o[e] = 0.f;
                for (int n = 0; n < 128; ++n) {
                    const float hv = H[i * 129 + n];
                    const f32x4 wa = *(const f32x4*)(w2 + n * 64 + dc), wb = *(const f32x4*)(w2 + n * 64 + dc + 4);
                    o[0] += hv * wa.x; o[1] += hv * wa.y; o[2] += hv * wa.z; o[3] += hv * wa.w;
                    o[4] += hv * wb.x; o[5] += hv * wb.y; o[6] += hv * wb.z; o[7] += hv * wb.w;
                }
                const int ig = rt * 64 + i;
                if (ig > 1022) {
#pragma unroll
                    for (int e = 0; e < 8; ++e) o[e] = 0.f;
                }
                if (kv == 0) {
                    u32x4 w; w.x = pk2(o[0], o[1]); w.y = pk2(o[2], o[3]); w.z = pk2(o[4], o[5]); w.w = pk2(o[6], o[7]);
                    float ss = bflo(w.x) * bflo(w.x) + bfhi(w.x) * bfhi(w.x) + bflo(w.y) * bflo(w.y) + bfhi(w.y) * bfhi(w.y)
                             + bflo(w.z) * bflo(w.z) + bfhi(w.z) * bfhi(w.z) + bflo(w.w) * bflo(w.w) + bfhi(w.w) * bfhi(w.w);
                    ss += __shfl_xor(ss, 1); ss += __shfl_xor(ss, 2); ss += __shfl_xor(ss, 4);
                    ss = fmaxf(ss, __shfl_xor(ss, 8)); ss = fmaxf(ss, __shfl_xor(ss, 16)); ss = fmaxf(ss, __shfl_xor(ss, 32));
                    if (lane == 0) atomicMax((unsigned*)(ws + WS_KMAX) + (layer * 4 + 3) * 4 + bg, __builtin_bit_cast(unsigned, ss));
                    const int q = dc >> 3;
                    *(u32x4*)((bf16_t*)(ws + WS_KC) + (size_t)bg * NCP * 64 + (size_t)(ig >> 5) * 2048 + ((q >> 1) * 64 + (q & 1) * 32 + (ig & 31)) * 8) = w;
                } else {
                    const int kk5 = ig & 31, jj = kk5 >> 4, rem = kk5 & 15, hh1 = (rem >> 2) & 1, ii = (rem >> 3) * 4 + (rem & 3);
                    bf16_t* vt = (bf16_t*)(ws + WS_VCT) + (size_t)bg * 64 * NCP + (size_t)(ig >> 5) * 2048 + ii;
#pragma unroll
                    for (int e = 0; e < 8; ++e) { const int dd = dc + e; vt[((jj * 2 + (dd >> 5)) * 64 + hh1 * 32 + (dd & 31)) * 8] = (bf16_t)f2bf(o[e]); }
                }
            }
            __syncthreads();
        }
    }
}

constexpr float LOG2E = 1.4426950408889634f, SC2 = 0.125f * 1.4426950408889634f;
DI float ex2(float x) { return __builtin_amdgcn_exp2f(x); }
DI void loadK32(const bf16_t* kt, int lane, bf16x8 (&k)[4]) {
#pragma unroll
    for (int kk = 0; kk < 4; ++kk) k[kk] = *(const bf16x8*)(kt + (kk * 64 + lane) * 8);
}
DI f32x16 qk32r(const bf16x8 (&k)[4], const bf16x8 (&q)[4]) {
    f32x16 s;
#pragma unroll
    for (int r = 0; r < 16; ++r) s[r] = 0.f;
#pragma unroll
    for (int kk = 0; kk < 4; ++kk) s = MFMA32(k[kk], q[kk], s);
    return s;
}
DI void loadV32(const bf16_t* vt, int lane, bf16x8 (&v)[2][2]) {
#pragma unroll
    for (int j = 0; j < 2; ++j)
#pragma unroll
        for (int dt = 0; dt < 2; ++dt) v[j][dt] = *(const bf16x8*)(vt + ((j * 2 + dt) * 64 + lane) * 8);
}
DI void pv32r(const f32x16& p, const bf16x8 (&v)[2][2], f32x16& o0, f32x16& o1) {
#pragma unroll
    for (int j = 0; j < 2; ++j) {
        const bf16x8 pb = pack8(p[8 * j], p[8 * j + 1], p[8 * j + 2], p[8 * j + 3], p[8 * j + 4], p[8 * j + 5], p[8 * j + 6], p[8 * j + 7]);
        o0 = MFMA32(v[j][0], pb, o0);
        o1 = MFMA32(v[j][1], pb, o1);
    }
}
template <bool MASKED>
DI bool softmax32(f32x16& s, unsigned vm, float& m, float& l, float& alpha) {
    float sum = 0.f;
#pragma unroll
    for (int r = 0; r < 16; ++r) { float p = ex2(s[r] - m); if (MASKED) p = ((vm >> r) & 1u) ? p : 0.f; s[r] = p; sum += p; }
    l += sum; alpha = 1.f;
    return false;
}
DI float sum8_dpp(float v) {
    v += __builtin_bit_cast(float, __builtin_amdgcn_update_dpp(0, __builtin_bit_cast(int, v), 0xB1, 0xF, 0xF, false));
    v += __builtin_bit_cast(float, __builtin_amdgcn_update_dpp(0, __builtin_bit_cast(int, v), 0x4E, 0xF, 0xF, false));
    v += __builtin_bit_cast(float, __builtin_amdgcn_update_dpp(0, __builtin_bit_cast(int, v), 0x141, 0xF, 0xF, false));
    return v;
}
DI float sumsq8(const bf16x8 v) { const u32x4 w = __builtin_bit_cast(u32x4, v);
    return bflo(w.x) * bflo(w.x) + bfhi(w.x) * bfhi(w.x) + bflo(w.y) * bflo(w.y) + bfhi(w.y) * bfhi(w.y) + bflo(w.z) * bflo(w.z) + bfhi(w.z) * bfhi(w.z) + bflo(w.w) * bflo(w.w) + bfhi(w.w) * bfhi(w.w); }
DI unsigned logits_cmp(f32x16& s, int key0, int qpos, int hi, const LAS float* bias_h) {
    unsigned vm = 0u;
#pragma unroll
    for (int r = 0; r < 16; ++r) {
        const int dist = qpos - (16 * (key0 + crow(r, hi)) + 31);
        const bool valid = dist >= 0;
        const float bb = bias_h[rel_bucket(dist < 0 ? 0 : dist)];
        s[r] = valid ? s[r] * SC2 + bb : NEGF;
        vm |= valid ? (1u << r) : 0u;
    }
    return vm;
}

constexpr int AW_IMP = 0, AW_OLDS = 4128, AW_SEL = 4128 + 8320, AW_NSEL = AW_SEL + 256, AW_BYTES = 12800;
constexpr int ATT_BIAS_OFF = 8 * AW_BYTES;
constexpr int LUTW_STRIDE = 612, LUTB_STRIDE = 228;
constexpr int ATT_LUTW_OFF = ATT_BIAS_OFF + 4096, ATT_LUTB_OFF = ATT_LUTW_OFF + 8 * LUTW_STRIDE * 4, ATT_LDS_END = ATT_LUTB_OFF + 8 * LUTB_STRIDE * 4;
static_assert(ATT_LDS_END <= LDS_BYTES, "attention LDS map");

template <int W>
DI void window_branch(const bf16_t* Kf  , const bf16_t* Vf  , int lane,
                      const bf16x8 (&qf)[4], const LAS float* lut_h  , int q0, int qpos, int c, int hi,
                      float& m, float& l, f32x16& o0, f32x16& o1) {
    const int kd = q0 & ~31;
    int kstart = q0 - (W - 1); kstart = kstart < 0 ? 0 : kstart; kstart &= ~31;
    bf16x8 kc[4];
    loadK32(Kf + (size_t)(kd >> 5) * 2048, lane, kc);
    const float sini = -m * (1.f / SC2);
#pragma unroll 1
    for (int key0 = kd; key0 >= kstart; key0 -= 32) {
        bf16x8 vf[2][2], kn[4];
        loadV32(Vf + (size_t)(key0 >> 5) * 2048, lane, vf);
        const int nk = key0 - 32 >= kstart ? key0 - 32 : key0;
        loadK32(Kf + (size_t)(nk >> 5) * 2048, lane, kn);
        f32x16 s;
#pragma unroll
        for (int r = 0; r < 16; ++r) s[r] = sini;
#pragma unroll
        for (int kk = 0; kk < 4; ++kk) s = MFMA32(kc[kk], qf[kk], s);
        const LAS float* pt = lut_h + (qpos - key0 - 4 * hi - 27);
        float sum = 0.f;
#pragma unroll
        for (int r = 0; r < 16; ++r) { const float p = ex2(s[r] * SC2 + pt[27 - ((r & 3) + 8 * (r >> 2))]); s[r] = p; sum += p; }
        l += sum;
        pv32r(s, vf, o0, o1);
#pragma unroll
        for (int kk = 0; kk < 4; ++kk) kc[kk] = kn[kk];
    }
}

DI void phase_attn(const Args& a, int layer, LAS unsigned char* lds) {
    const int tid = opaque_tid(), lane = tid & 63, wave = tid >> 6;
    unsigned char* ws = a.ws;
    const bf16_t* P = (const bf16_t*)(ws + WS_P);
    bf16_t* O = (bf16_t*)(ws + WS_O);
    const int bg = blockIdx.x & 3, b = bg >> 1, g = bg & 1, wq = blockIdx.x >> 2, nwq = gridDim.x >> 2;
    LAS float* bias = (LAS float*)(lds + ATT_BIAS_OFF);
    LAS float* lutW = (LAS float*)(lds + ATT_LUTW_OFF);
    LAS float* lutB = (LAS float*)(lds + ATT_LUTB_OFF);
    for (int i = tid; i < 1024; i += NTHREADS) bias[i] = a.rel_bias[(i & 31) * 32 + (i >> 5)] * LOG2E;
    for (int i = tid; i < 8 * LUTW_STRIDE; i += NTHREADS) { const int hh = i / LUTW_STRIDE, dist = i % LUTW_STRIDE - 32;
        lutW[i] = (dist >= 0 && dist < 512) ? a.rel_bias[rel_bucket(dist) * 32 + g * 8 + hh] * LOG2E : NEGF; }
    for (int i = tid; i < 8 * LUTB_STRIDE; i += NTHREADS) { const int hh = i / LUTB_STRIDE, dist = i % LUTB_STRIDE - 32;
        lutB[i] = (dist >= 0 && dist < 128) ? a.rel_bias[rel_bucket(dist) * 32 + 16 + g * 8 + hh] * LOG2E : NEGF; }
    __syncthreads();
    LAS unsigned char* wl = lds + wave * AW_BYTES;
    LAS float* imp = (LAS float*)(wl + AW_IMP);
    LAS float* olds = (LAS float*)(wl + AW_OLDS);
    LAS int* sel = (LAS int*)(wl + AW_SEL);
    LAS int* nsel = (LAS int*)(wl + AW_NSEL);
    const int c = lane & 31, hi = lane >> 5, ql = c >> 3, h = c & 7;
    const bf16_t* Pb = P + (size_t)b * S * NP;
    const bf16_t* kcb = (const bf16_t*)(ws + WS_KC) + (size_t)bg * NCP * 64;
    const bf16_t* vct = (const bf16_t*)(ws + WS_VCT) + (size_t)bg * 64 * NCP;
    const bf16_t* vst = (const bf16_t*)(ws + WS_VST) + (size_t)bg * 64 * S;
    const bf16_t* vwt = (const bf16_t*)(ws + WS_VWT) + (size_t)bg * 64 * S;
    const bf16_t* kwf = (const bf16_t*)(ws + WS_KWF) + (size_t)bg * 64 * S;
    const bf16_t* kbf = (const bf16_t*)(ws + WS_KBF) + (size_t)bg * 64 * S;
    const bf16_t* ksf = (const bf16_t*)(ws + WS_KSF) + (size_t)bg * 64 * S;
    const bf16_t* vbt = (const bf16_t*)(ws + WS_VBT) + (size_t)bg * 64 * S;
    const float sinkv = a.sinks[layer * 16 + g * 8 + h] * LOG2E;
    const LAS float* bias_a = bias + (g * 8 + h) * 32;
    const float b31 = bias_a[31];
    const unsigned* kmx = (const unsigned*)(ws + WS_KMAX) + layer * 16 + bg;
    const float knS = sqrtf(__builtin_bit_cast(float, kmx[0])) * SC2, knW = sqrtf(__builtin_bit_cast(float, kmx[4])) * SC2;
    const float knB = sqrtf(__builtin_bit_cast(float, kmx[8])) * SC2, knC = sqrtf(__builtin_bit_cast(float, kmx[12])) * SC2;
    float bmaxA = bias_a[0], bmaxB = bias[(16 + g * 8 + h) * 32];
    for (int k = 1; k < 32; ++k) { bmaxA = fmaxf(bmaxA, bias_a[k]); bmaxB = fmaxf(bmaxB, bias[(16 + g * 8 + h) * 32 + k]); }
    bmaxA += 0.01f; bmaxB += 0.01f;

#pragma unroll 1
    for (int qt0 = wq; qt0 < S / 32 && wq < nwq; qt0 += nwq) {
        const int rnd = qt0 / nwq, qt32 = ((rnd & 1) && (rnd + 1) * nwq <= S / 32) ? rnd * nwq + (nwq - 1 - wq) : qt0;
        const int q0 = qt32 * 32 + wave * 4;
        const int qpos = q0 + ql;
        const size_t mrow = (size_t)(b * S + qpos);
        const bf16_t* prow = P + mrow * NP;
        {
            bf16x8 qf[4];
#pragma unroll
            for (int kk = 0; kk < 4; ++kk) qf[kk] = *(const bf16x8*)(prow + C_QB + (g * 8 + h) * 64 + kk * 16 + hi * 8);
            float qn2 = sumsq8(qf[0]) + sumsq8(qf[1]) + sumsq8(qf[2]) + sumsq8(qf[3]); qn2 += __shfl_xor(qn2, 32);
            float m = sqrtf(qn2) * knB + bmaxB, l = hi == 0 ? ex2(sinkv - m) : 0.f;
            f32x16 o0, o1;
#pragma unroll
            for (int r = 0; r < 16; ++r) { o0[r] = 0.f; o1[r] = 0.f; }
            window_branch<128>(kbf, vbt, lane, qf, lutB + h * LUTB_STRIDE + 32, q0, qpos, c, hi, m, l, o0, o1);
            const float lt = l + __shfl_xor(l, 32), inv = 1.f / lt;
            bf16_t* orow = O + mrow * D + 1024 + (g * 8 + h) * 64;
#pragma unroll
            for (int dt = 0; dt < 2; ++dt)
#pragma unroll
                for (int q4 = 0; q4 < 4; ++q4) {
                    const f32x16& oo = dt ? o1 : o0;
                    u32x2 w; w.x = pk2(oo[4 * q4] * inv, oo[4 * q4 + 1] * inv); w.y = pk2(oo[4 * q4 + 2] * inv, oo[4 * q4 + 3] * inv);
                    *(u32x2*)(orow + dt * 32 + 8 * q4 + 4 * hi) = w;
                }
        }
        const float gt0 = sigmoidf_(bf2f(prow[C_GATE + (g * 8 + h) * 3 + 0]));
        bf16x8 qfa[4];
#pragma unroll
        for (int kk = 0; kk < 4; ++kk) qfa[kk] = *(const bf16x8*)(prow + C_QA + (g * 8 + h) * 64 + kk * 16 + hi * 8);
        float qnA; { float qn2 = sumsq8(qfa[0]) + sumsq8(qfa[1]) + sumsq8(qfa[2]) + sumsq8(qfa[3]); qn2 += __shfl_xor(qn2, 32); qnA = sqrtf(qn2); }
        for (int i = lane; i < 4 * 257; i += 64) imp[i] = 0.f;
        const int ntile = (q0 + 3) / 512 + 1;
        const int nfast = q0 >= 2040 ? (q0 - 2040) / 512 + 1 : 0;
        {
            float m = qnA * knC + bmaxA, l = 0.f;
            {
                bf16x8 kc[4];
                loadK32(kcb, lane, kc);
#pragma unroll 1
                for (int t = 0; t < ntile; ++t) {
                    bf16x8 kn[4];
                    const int tn = t + 1 < ntile ? t + 1 : t;
                    loadK32(kcb + (size_t)tn * 2048, lane, kn);
                    f32x16 s = qk32r(kc, qfa);
                    float alpha;
                    if (t < nfast) {
#pragma unroll
                        for (int r = 0; r < 16; ++r) s[r] = s[r] * SC2 + b31;
                        (void)softmax32<false>(s, 0u, m, l, alpha);
                    } else {
                        const unsigned vm = logits_cmp(s, t * 32, qpos, hi, bias_a);
                        (void)softmax32<true>(s, vm, m, l, alpha);
                    }
#pragma unroll
                    for (int kk = 0; kk < 4; ++kk) kc[kk] = kn[kk];
                }
            }
            const float lt = l + __shfl_xor(l, 32), inv = lt > 0.f ? 1.f / lt : 0.f;
            f32x16 o0, o1;
#pragma unroll
            for (int r = 0; r < 16; ++r) { o0[r] = 0.f; o1[r] = 0.f; }
            LDS_WAIT();
            bf16x8 kc[4];
            loadK32(kcb, lane, kc);
#pragma unroll 1
            for (int t = 0; t < ntile; ++t) {
                bf16x8 vf[2][2], kn[4];
                loadV32(vct + (size_t)t * 2048, lane, vf);
                const int tn = t + 1 < ntile ? t + 1 : t;
                loadK32(kcb + (size_t)tn * 2048, lane, kn);
                f32x16 s = qk32r(kc, qfa);
                if (t < nfast) {
#pragma unroll
                    for (int r = 0; r < 16; ++r) s[r] = ex2(s[r] * SC2 + (b31 - m)) * inv;
                } else {
                    const unsigned vm = logits_cmp(s, t * 32, qpos, hi, bias_a);
#pragma unroll
                    for (int r = 0; r < 16; ++r) s[r] = ((vm >> r) & 1u) ? ex2(s[r] - m) * inv : 0.f;
                }
#pragma unroll
                for (int grp = 0; grp < 4; ++grp) {
                    float wa = 2.f * (s[4 * grp] + s[4 * grp + 1] + s[4 * grp + 2]) + s[4 * grp + 3], wb = s[4 * grp + 3];
                    wa = sum8_dpp(wa); wb = sum8_dpp(wb);
                    const int j = t * 8 + 2 * grp + hi;
                    if (h == 0) {
                        (void)__hip_atomic_fetch_add(imp + ql * 257 + j, wa, __ATOMIC_RELAXED, __HIP_MEMORY_SCOPE_WORKGROUP);
                        (void)__hip_atomic_fetch_add(imp + ql * 257 + j + 1, wb, __ATOMIC_RELAXED, __HIP_MEMORY_SCOPE_WORKGROUP);
                    }
                }
                pv32r(s, vf, o0, o1);
#pragma unroll
                for (int kk = 0; kk < 4; ++kk) kc[kk] = kn[kk];
            }
#pragma unroll
            for (int r = 0; r < 16; ++r) { olds[c * 65 + crow(r, hi)] = gt0 * o0[r]; olds[c * 65 + 32 + crow(r, hi)] = gt0 * o1[r]; }
        }
        LDS_WAIT();
        {
            const int tq = lane >> 4, sub = lane & 15;
            const int qp = q0 + tq, cb = qp >> 6;
            float v[16];
#pragma unroll
            for (int i = 0; i < 16; ++i) { const int j = sub + 16 * i; v[i] = (j >= 1 && j <= cb - 2) ? imp[tq * 257 + j] : -1.f; }
            int n = (cb < 2 ? cb : 2) + 1;
            if (sub == 0) {
                sel[tq * 16 + 0] = 0;
                if (cb >= 1) sel[tq * 16 + n - 1] = cb;
                if (cb >= 2) sel[tq * 16 + 1] = cb - 1;
            }
#pragma unroll 1
            for (int k = 0; k < 13; ++k) {
                float bv = v[0]; int bj = sub;
#pragma unroll
                for (int i = 1; i < 16; ++i) { if (v[i] > bv) { bv = v[i]; bj = sub + 16 * i; } }
#pragma unroll
                for (int off = 1; off < 16; off <<= 1) {
                    const float ov = __shfl_xor(bv, off); const int oj = __shfl_xor(bj, off);
                    if (ov > bv || (ov == bv && oj < bj)) { bv = ov; bj = oj; }
                }
                if (bv >= 0.f) {
                    if (sub == 0) sel[tq * 16 + n] = bj;
                    n += 1;
#pragma unroll
                    for (int i = 0; i < 16; ++i) { if (bj == sub + 16 * i) v[i] = -1.f; }
                }
            }
            if (sub == 0) nsel[tq] = n;
        }
        LDS_WAIT();
        {
            const int hh = lane & 15, qd = lane >> 4, hd = hh & 7;
            const LAS float* bias_s = bias + (g * 8 + hd) * 32;
            const float b31s = bias_s[31];

#pragma unroll 1
            for (int qi = 0; qi < 4; ++qi) {
                const int qp = q0 + qi;
                const bf16_t* pr = Pb + (size_t)qp * NP;
                bf16x8 qf[2];
#pragma unroll
                for (int kk = 0; kk < 2; ++kk) qf[kk] = *(const bf16x8*)(pr + C_QA + (g * 8 + hd) * 64 + kk * 32 + qd * 8);
                float qs2 = sumsq8(qf[0]) + sumsq8(qf[1]); qs2 += __shfl_xor(qs2, 16); qs2 += __shfl_xor(qs2, 32);
                const float m = sqrtf(qs2) * knS + bmaxA; float l = 0.f;
                const bool lowc = hh < 8;
                const bf16x8 zero8 = {0, 0, 0, 0, 0, 0, 0, 0};
                bf16x8 qlo[2], qhi[2];
#pragma unroll
                for (int kk = 0; kk < 2; ++kk) { qlo[kk] = lowc ? qf[kk] : zero8; qhi[kk] = lowc ? zero8 : qf[kk]; }
                const int hs = hh >> 3;
                f32x4 o[4];
#pragma unroll
                for (int dt = 0; dt < 4; ++dt) o[dt] = (f32x4){0.f, 0.f, 0.f, 0.f};
                const int ns = __builtin_amdgcn_readfirstlane(nsel[qi]);
                int jb = __builtin_amdgcn_readfirstlane(sel[qi * 16]);
                bf16x8 ka[4][2];
#pragma unroll
                for (int t = 0; t < 4; ++t)
#pragma unroll
                    for (int kk = 0; kk < 2; ++kk) ka[t][kk] = *(const bf16x8*)(ksf + (size_t)jb * 4096 + ((t * 2 + kk) * 64 + lane) * 8);
#pragma unroll 1
                for (int k = 0; k < ns; ++k) {
                    bf16x8 va[2][4], kn[4][2];
#pragma unroll
                    for (int j = 0; j < 2; ++j)
#pragma unroll
                        for (int dt = 0; dt < 4; ++dt) va[j][dt] = *(const bf16x8*)(vst + (size_t)jb * 4096 + ((j * 4 + dt) * 64 + lane) * 8);
                    const int jn = __builtin_amdgcn_readfirstlane(sel[qi * 16 + (k + 1 < ns ? k + 1 : k)]);
#pragma unroll
                    for (int t = 0; t < 4; ++t)
#pragma unroll
                        for (int kk = 0; kk < 2; ++kk) kn[t][kk] = *(const bf16x8*)(ksf + (size_t)jn * 4096 + ((t * 2 + kk) * 64 + lane) * 8);
                    f32x4 s[2];
#pragma unroll
                    for (int u = 0; u < 2; ++u) {
                        s[u] = (f32x4){0.f, 0.f, 0.f, 0.f};
#pragma unroll
                        for (int kk = 0; kk < 2; ++kk) { s[u] = MFMA16(ka[2 * u][kk], qlo[kk], s[u]); s[u] = MFMA16(ka[2 * u + 1][kk], qhi[kk], s[u]); }
                    }
                    if (qp - (jb * 64 + 63) >= 1513) {
                        const float cst = b31s - m;
#pragma unroll
                        for (int u = 0; u < 2; ++u)
#pragma unroll
                            for (int r = 0; r < 4; ++r) s[u][r] = s[u][r] * SC2 + cst;
                    } else {
#pragma unroll
                        for (int u = 0; u < 2; ++u)
#pragma unroll
                            for (int r = 0; r < 4; ++r) {
                                const int dist = qp - (jb * 64 + 16 * (2 * u + hs) + 4 * qd + r);
                                const float bb = bias_s[rel_bucket(dist < 0 ? 0 : dist)];
                                s[u][r] = dist >= 0 ? s[u][r] * SC2 + (bb - m) : NEGF;
                            }
                    }
                    float sum = 0.f;
#pragma unroll
                    for (int u = 0; u < 2; ++u)
#pragma unroll
                        for (int r = 0; r < 4; ++r) { const float p = ex2(s[u][r]); s[u][r] = p; sum += p; }
                    l += sum;
                    {
                        const bf16x8 p8 = pack8(s[0][0], s[0][1], s[0][2], s[0][3], s[1][0], s[1][1], s[1][2], s[1][3]);
                        const bf16x8 plo = lowc ? p8 : zero8, phi = lowc ? zero8 : p8;
#pragma unroll
                        for (int dt = 0; dt < 4; ++dt) { o[dt] = MFMA16(va[0][dt], plo, o[dt]); o[dt] = MFMA16(va[1][dt], phi, o[dt]); }
                    }
                    jb = jn;
#pragma unroll
                    for (int t = 0; t < 4; ++t)
#pragma unroll
                        for (int kk = 0; kk < 2; ++kk) ka[t][kk] = kn[t][kk];
                }
                float lt = l + __shfl_xor(l, 16); lt += __shfl_xor(lt, 32); lt += __shfl_xor(lt, 8);
#pragma unroll
                for (int dt = 0; dt < 4; ++dt)
#pragma unroll
                    for (int r = 0; r < 4; ++r) o[dt][r] += __shfl_xor(o[dt][r], 8);
                const float gt1 = sigmoidf_(bf2f(Pb[(size_t)qp * NP + C_GATE + (g * 8 + hd) * 3 + 1]));
                const float inv = lt > 0.f ? gt1 / lt : 0.f;
                if (hh < 8) {
#pragma unroll
                    for (int dt = 0; dt < 4; ++dt)
#pragma unroll
                        for (int r = 0; r < 4; ++r) olds[(qi * 8 + hh) * 65 + 16 * dt + 4 * qd + r] += o[dt][r] * inv;
                }
            }
        }
        LDS_WAIT();
        {
            int lw = lane; asm volatile("" : "+v"(lw));
            const int c = lw & 31, hi = lw >> 5, h = c & 7, qpos = q0 + (c >> 3);
            const size_t mrow = (size_t)(b * S + qpos);
            const bf16_t* prow = P + mrow * NP;
            const float gt2 = sigmoidf_(bf2f(prow[C_GATE + (g * 8 + h) * 3 + 2]));
            bf16x8 qfw[4];
#pragma unroll
            for (int kk = 0; kk < 4; ++kk) qfw[kk] = *(const bf16x8*)(prow + C_QA + (g * 8 + h) * 64 + kk * 16 + hi * 8);
            float qnW; { float qn2 = sumsq8(qfw[0]) + sumsq8(qfw[1]) + sumsq8(qfw[2]) + sumsq8(qfw[3]); qn2 += __shfl_xor(qn2, 32); qnW = sqrtf(qn2); }
            float m = qnW * knW + bmaxA, l = 0.f;
            f32x16 o0, o1;
#pragma unroll
            for (int r = 0; r < 16; ++r) { o0[r] = 0.f; o1[r] = 0.f; }
            window_branch<512>(kwf, vwt, lw, qfw, lutW + h * LUTW_STRIDE + 32, q0, qpos, c, hi, m, l, o0, o1);
            const float lt = l + __shfl_xor(l, 32), inv = lt > 0.f ? gt2 / lt : 0.f;
            bf16_t* orow = O + mrow * D + (g * 8 + h) * 64;
#pragma unroll
            for (int dt = 0; dt < 2; ++dt)
#pragma unroll
                for (int q4 = 0; q4 < 4; ++q4) {
                    const f32x16& oo = dt ? o1 : o0;
                    const int d0 = dt * 32 + 8 * q4 + 4 * hi;
                    const float e0 = oo[4 * q4] * inv + olds[c * 65 + d0], e1 = oo[4 * q4 + 1] * inv + olds[c * 65 + d0 + 1];
                    const float e2 = oo[4 * q4 + 2] * inv + olds[c * 65 + d0 + 2], e3 = oo[4 * q4 + 3] * inv + olds[c * 65 + d0 + 3];
                    u32x2 w; w.x = pk2(e0, e1); w.y = pk2(e2, e3);
                    *(u32x2*)(orow + d0) = w;
                }
        }
        LDS_WAIT();
    }
}

DI unsigned ordf(float f) { const unsigned u = __builtin_bit_cast(unsigned, f); return (u & 0x80000000u) ? ~u : (u | 0x80000000u); }
DI float unordf(unsigned k) { const unsigned u = (k & 0x80000000u) ? (k & 0x7fffffffu) : ~k; return __builtin_bit_cast(float, u); }

DI void peer_half_topk(const bf16_t* qrow  , const bf16_t* subk  , int hi, int lane, LAS unsigned* ltop) {
    unsigned keys[64];
    asm volatile("" : "+v"(subk));
#pragma unroll
    for (int rt = 0; rt < 4; ++rt) {
        f32x16 acc;
#pragma unroll
        for (int r = 0; r < 16; ++r) acc[r] = 0.f;
#pragma unroll
        for (int kk = 0; kk < 8; ++kk) {
            const bf16x8 af = *(const bf16x8*)(subk + (size_t)(rt * 32) * 128 + kk * 16);
            const bf16x8 bf = *(const bf16x8*)(qrow + kk * 16);
            acc = MFMA32(af, bf, acc);
        }
#pragma unroll
        for (int r = 0; r < 16; ++r) { const int n = rt * 32 + crow(r, hi); keys[rt * 16 + r] = (ordf(acc[r]) & ~0x7Fu) | (unsigned)(127 - n); }
    }
#pragma unroll 1
    for (int k = 0; k < 16; ++k) {
        unsigned mx = keys[0];
#pragma unroll
        for (int i = 1; i < 64; ++i) mx = mx > keys[i] ? mx : keys[i];
        const unsigned om = (unsigned)__shfl_xor((int)mx, 32);
        mx = mx > om ? mx : om;
        ltop[k * 64 + lane] = mx;
#pragma unroll
        for (int i = 0; i < 64; ++i) keys[i] = keys[i] == mx ? 0u : keys[i];
    }
}

DI void phase_peer_select(const Args& a, int layer, LAS unsigned char* lds) {
    const int tid = opaque_tid(), lane = tid & 63, wave = tid >> 6;
    const int gw = blockIdx.x * 8 + wave, NGW = gridDim.x * 8;
    unsigned char* ws = a.ws;
    const bf16_t* Q2 = (const bf16_t*)(ws + WS_Q2);
    const bf16_t* subk = (const bf16_t*)(ws + WS_SUBK) + (size_t)layer * 2 * 128 * 128;
    int* IDX = (int*)(ws + WS_IDX);
    float* GATE = (float*)(ws + WS_GATE);
    LAS unsigned* lt1 = (LAS unsigned*)(lds + wave * 8192);
    LAS unsigned* lt2 = lt1 + 1024;
    const int c = lane & 31, hi = lane >> 5, tl = c >> 3, h = c & 7;
#pragma unroll 1
    for (int unit = gw; unit < M / 4; unit += NGW) {
        const size_t m = (size_t)unit * 4 + tl;
        const bf16_t* qrow = Q2 + m * D + h * 256 + hi * 8;
        peer_half_topk(qrow, subk + (size_t)c * 128 + hi * 8, hi, lane, lt1);
        peer_half_topk(qrow + 128, subk + 128 * 128 + (size_t)c * 128 + hi * 8, hi, lane, lt2);
        LDS_WAIT();
        unsigned t1[16], t2[16];
#pragma unroll
        for (int i = 0; i < 16; ++i) { t1[i] = lt1[i * 64 + lane]; t2[i] = lt2[i * 64 + lane]; }
        unsigned ck[16][16];
#pragma unroll
        for (int x = 0; x < 16; ++x)
#pragma unroll
            for (int y = 0; y < 16; ++y)
                if ((x + 1) * (y + 1) <= 16) ck[x][y] = (ordf(unordf(t1[x] & ~0x7Fu) + unordf(t2[y] & ~0x7Fu)) & ~0xFFu) | (unsigned)(255 - (x * 16 + y));
        const float scmax = unordf(ck[0][0] & ~0xFFu);
        int* ip = IDX + m * 128 + h * 16; float* gp = GATE + m * 128 + h * 16;
        float sum = 0.f;
#pragma unroll 1
        for (int k = 0; k < 16; ++k) {
            unsigned mx = 0u;
#pragma unroll
            for (int x = 0; x < 16; ++x)
#pragma unroll
                for (int y = 0; y < 16; ++y)
                    if ((x + 1) * (y + 1) <= 16) mx = mx > ck[x][y] ? mx : ck[x][y];
#pragma unroll
            for (int x = 0; x < 16; ++x)
#pragma unroll
                for (int y = 0; y < 16; ++y)
                    if ((x + 1) * (y + 1) <= 16) ck[x][y] = ck[x][y] == mx ? 0u : ck[x][y];
            const int ci = 255 - (int)(mx & 0xFFu);
            const int e = (int)(127u - (lt1[(ci >> 4) * 64 + lane] & 0x7Fu)) * 128 + (int)(127u - (lt2[(ci & 15) * 64 + lane] & 0x7Fu));
            const float ek = __expf(unordf(mx & ~0xFFu) - scmax);
            sum += ek;
            if (hi == 0) { ip[k] = e; gp[k] = ek; }
        }
        if (hi == 0) ((float*)(ws + WS_GSUM))[m * 8 + h] = 1.f / sum;
        LDS_WAIT();
    }
}

#define FP8_LO(w) __builtin_amdgcn_cvt_pk_f32_fp8((int)(w), false)
#define FP8_HI(w) __builtin_amdgcn_cvt_pk_f32_fp8((int)(w), true)
DI float dot16(const float (&x)[32], int o, const u32x4 w) {
    const f32x2 a0 = FP8_LO(w.x), a1 = FP8_HI(w.x), a2 = FP8_LO(w.y), a3 = FP8_HI(w.y), a4 = FP8_LO(w.z), a5 = FP8_HI(w.z), a6 = FP8_LO(w.w), a7 = FP8_HI(w.w);
    return (x[o + 0] * a0.x + x[o + 1] * a0.y + x[o + 2] * a1.x + x[o + 3] * a1.y) + (x[o + 4] * a2.x + x[o + 5] * a2.y + x[o + 6] * a3.x + x[o + 7] * a3.y)
         + (x[o + 8] * a4.x + x[o + 9] * a4.y + x[o + 10] * a5.x + x[o + 11] * a5.y) + (x[o + 12] * a6.x + x[o + 13] * a6.y + x[o + 14] * a7.x + x[o + 15] * a7.y);
}
DI float dot16p(const u32x4 xa, const u32x4 xb, const u32x4 w) {
    const f32x2 a0 = FP8_LO(w.x), a1 = FP8_HI(w.x), a2 = FP8_LO(w.y), a3 = FP8_HI(w.y), a4 = FP8_LO(w.z), a5 = FP8_HI(w.z), a6 = FP8_LO(w.w), a7 = FP8_HI(w.w);
    return (bflo(xa.x) * a0.x + bfhi(xa.x) * a0.y + bflo(xa.y) * a1.x + bfhi(xa.y) * a1.y) + (bflo(xa.z) * a2.x + bfhi(xa.z) * a2.y + bflo(xa.w) * a3.x + bfhi(xa.w) * a3.y)
         + (bflo(xb.x) * a4.x + bfhi(xb.x) * a4.y + bflo(xb.y) * a5.x + bfhi(xb.y) * a5.y) + (bflo(xb.z) * a6.x + bfhi(xb.z) * a6.y + bflo(xb.w) * a7.x + bfhi(xb.w) * a7.y);
}
DI void axpy16(float (&acc)[32], int o, float g, const u32x4 w) {
    const f32x2 a0 = FP8_LO(w.x), a1 = FP8_HI(w.x), a2 = FP8_LO(w.y), a3 = FP8_HI(w.y), a4 = FP8_LO(w.z), a5 = FP8_HI(w.z), a6 = FP8_LO(w.w), a7 = FP8_HI(w.w);
    acc[o + 0] += g * a0.x; acc[o + 1] += g * a0.y; acc[o + 2] += g * a1.x; acc[o + 3] += g * a1.y; acc[o + 4] += g * a2.x; acc[o + 5] += g * a2.y; acc[o + 6] += g * a3.x; acc[o + 7] += g * a3.y;
    acc[o + 8] += g * a4.x; acc[o + 9] += g * a4.y; acc[o + 10] += g * a5.x; acc[o + 11] += g * a5.y; acc[o + 12] += g * a6.x; acc[o + 13] += g * a6.y; acc[o + 14] += g * a7.x; acc[o + 15] += g * a7.y;
}
DI void gat_load8(const unsigned char* base, int idlo, int idhi, int g4, unsigned lo16, u32x4 (&buf)[8]) {
    const int ids = g4 < 16 ? idlo : idhi, e0 = (g4 & 15) * 4;
#pragma unroll
    for (int j = 0; j < 4; ++j) { const unsigned of = (unsigned)__shfl(ids, e0 + j) * (unsigned)D + lo16; buf[2 * j] = *(const u32x4*)(base + of); buf[2 * j + 1] = *(const u32x4*)(base + of + 1024u); }
}
DI float dots4(const u32x4 (&xp)[4], const u32x4 b0, const u32x4 b1, const u32x4 b2, const u32x4 b3, const u32x4 b4, const u32x4 b5, const u32x4 b6, const u32x4 b7, int lane) {
    const float d0 = dot16p(xp[0], xp[1], b0) + dot16p(xp[2], xp[3], b1); __builtin_amdgcn_sched_barrier(0);
    const float d1 = dot16p(xp[0], xp[1], b2) + dot16p(xp[2], xp[3], b3); __builtin_amdgcn_sched_barrier(0);
    const float d2 = dot16p(xp[0], xp[1], b4) + dot16p(xp[2], xp[3], b5); __builtin_amdgcn_sched_barrier(0);
    const float d3 = dot16p(xp[0], xp[1], b6) + dot16p(xp[2], xp[3], b7); __builtin_amdgcn_sched_barrier(0);
    const bool p1 = lane & 1, p2 = lane & 2;
    const float b0s = (p1 ? d1 : d0) + __shfl_xor(p1 ? d0 : d1, 1);
    const float b1s = (p1 ? d3 : d2) + __shfl_xor(p1 ? d2 : d3, 1);
    float cs = (p2 ? b1s : b0s) + __shfl_xor(p2 ? b0s : b1s, 2);
    cs += __shfl_xor(cs, 4); cs += __shfl_xor(cs, 8); cs += __shfl_xor(cs, 16); cs += __shfl_xor(cs, 32);
    return cs;
}
DI void phase_peer_u(const Args& a, int layer) {
    const int tid = opaque_tid(), lane = tid & 63, wave = tid >> 6;
    const int gw = blockIdx.x * 8 + wave, NGW = gridDim.x * 8;
    unsigned char* ws = a.ws;
    const bf16_t* XN = (const bf16_t*)(ws + WS_XN);
    const unsigned char* U = ws + WS_U + (size_t)layer * NEXP * D;
    const unsigned lo16 = (unsigned)lane * 16u;
    const int* IDX = (const int*)(ws + WS_IDX);
    float* GATE = (float*)(ws + WS_GATE);
    const float* GSUM = (const float*)(ws + WS_GSUM);
    int m = gw;
    if (m < M) {
        int idA = IDX[(size_t)m * 128 + lane], idB = IDX[(size_t)m * 128 + 64 + lane];
        u32x4 xp[4];
#pragma unroll
        for (int q = 0; q < 4; ++q) xp[q] = *(const u32x4*)(XN + (size_t)m * D + (q >> 1) * 1024 + lane * 16 + (q & 1) * 8);
        u32x4 cur[8];
        gat_load8(U, idA, idB, 0, lo16, cur);
#pragma unroll 1
        for (; m < M; m += NGW) {
            const int mn = m + NGW < M ? m + NGW : m;
            const int idAn = IDX[(size_t)mn * 128 + lane], idBn = IDX[(size_t)mn * 128 + 64 + lane];
            u32x4 xpn[4];
#pragma unroll
            for (int q = 0; q < 4; ++q) xpn[q] = *(const u32x4*)(XN + (size_t)mn * D + (q >> 1) * 1024 + lane * 16 + (q & 1) * 8);
            const float glA = GATE[(size_t)m * 128 + lane] * GSUM[(size_t)m * 8 + (lane >> 4)] * (1.f / V_SCALE);
            const float glB = GATE[(size_t)m * 128 + 64 + lane] * GSUM[(size_t)m * 8 + 4 + (lane >> 4)] * (1.f / V_SCALE);
            float ghA = 0.f, ghB = 0.f;
            const float rstdu = __builtin_bit_cast(float, __builtin_amdgcn_readfirstlane(__builtin_bit_cast(int, rsqrtf(wave_sum(lane < 32 ? ((const float*)(ws + WS_RSS))[((size_t)layer * M + m) * 32 + lane] : 0.f) * (1.f / D) + 1e-6f) * (1.f / U_SCALE))));
#pragma unroll 1
            for (int g4 = 0; g4 < 32; ++g4) {
                u32x4 nxt[8];
                if (g4 < 31) gat_load8(U, idA, idB, g4 + 1, lo16, nxt); else gat_load8(U, idAn, idBn, 0, lo16, nxt);
                const float c0 = dots4(xp, cur[0], cur[1], cur[2], cur[3], cur[4], cur[5], cur[6], cur[7], lane);
                const float hv = gelu_tanh(c0 * rstdu);
                const bool mine = (lane >> 2) == (g4 & 15);
                if (g4 < 16) ghA = mine ? hv * glA : ghA; else ghB = mine ? hv * glB : ghB;
#pragma unroll
                for (int j = 0; j < 8; ++j) cur[j] = nxt[j];
            }
            GATE[(size_t)m * 128 + lane] = ghA; GATE[(size_t)m * 128 + 64 + lane] = ghB;
            idA = idAn; idB = idBn;
#pragma unroll
            for (int q = 0; q < 4; ++q) xp[q] = xpn[q];
        }
    }
}
DI void phase_peer_v(const Args& a, int layer) {
    const int tid = opaque_tid(), lane = tid & 63, wave = tid >> 6;
    const int gw = blockIdx.x * 8 + wave, NGW = gridDim.x * 8;
    unsigned char* ws = a.ws;
    const unsigned char* V = ws + WS_V + (size_t)layer * NEXP * D;
    const unsigned lo16 = (unsigned)lane * 16u;
    const int* IDX = (const int*)(ws + WS_IDX);
    const float* GH = (const float*)(ws + WS_GATE);
    int m = gw;
    if (m < M) {
        int idA = IDX[(size_t)m * 128 + lane], idB = IDX[(size_t)m * 128 + 64 + lane];
        u32x4 cur[8];
        gat_load8(V, idA, idB, 0, lo16, cur);
#pragma unroll 1
        for (; m < M; m += NGW) {
            const int mn = m + NGW < M ? m + NGW : m;
            const int idAn = IDX[(size_t)mn * 128 + lane], idBn = IDX[(size_t)mn * 128 + 64 + lane];
            const float ghA = GH[(size_t)m * 128 + lane], ghB = GH[(size_t)m * 128 + 64 + lane];
            float acc[32];
#pragma unroll
            for (int i = 0; i < 32; ++i) acc[i] = 0.f;
#pragma unroll 1
            for (int g4 = 0; g4 < 32; ++g4) {
                u32x4 nxt[8];
                if (g4 < 31) gat_load8(V, idA, idB, g4 + 1, lo16, nxt); else gat_load8(V, idAn, idBn, 0, lo16, nxt);
                const float ghs = g4 < 16 ? ghA : ghB;
#pragma unroll
                for (int j = 0; j < 4; ++j) { const float gv = __shfl(ghs, (g4 & 15) * 4 + j); axpy16(acc, 0, gv, cur[2 * j]); axpy16(acc, 16, gv, cur[2 * j + 1]); __builtin_amdgcn_sched_barrier(0); }
#pragma unroll
                for (int j = 0; j < 8; ++j) cur[j] = nxt[j];
            }
            idA = idAn; idB = idBn;
            float ss = 0.f;
#pragma unroll
            for (int q = 0; q < 4; ++q) {
                const f32x4* hp = (const f32x4*)(a.out + (size_t)m * D + (q >> 1) * 1024 + lane * 16 + (q & 1) * 8);
                const f32x4 h0 = hp[0], h1 = hp[1];
                acc[q * 8 + 0] += h0.x; acc[q * 8 + 1] += h0.y; acc[q * 8 + 2] += h0.z; acc[q * 8 + 3] += h0.w;
                acc[q * 8 + 4] += h1.x; acc[q * 8 + 5] += h1.y; acc[q * 8 + 6] += h1.z; acc[q * 8 + 7] += h1.w;
#pragma unroll
                for (int e = 0; e < 8; ++e) ss += acc[q * 8 + e] * acc[q * 8 + e];
                __builtin_amdgcn_sched_barrier(0);
            }
            const float rstd = rsqrtf(wave_sum(ss) * (1.f / D) + 1e-6f);
            const float* gn = layer + 1 < NLAYER ? a.attn_norm + (size_t)(layer + 1) * D : a.final_norm;
            asm volatile("" : "+s"(gn));
#pragma unroll
            for (int q = 0; q < 4; ++q) {
                const int col = (q >> 1) * 1024 + lane * 16 + (q & 1) * 8;
                const f32x4 g0 = *(const f32x4*)(gn + col), g1 = *(const f32x4*)(gn + col + 4);
                f32x4 h0, h1;
                h0.x = acc[q * 8 + 0]; h0.y = acc[q * 8 + 1]; h0.z = acc[q * 8 + 2]; h0.w = acc[q * 8 + 3];
                h1.x = acc[q * 8 + 4]; h1.y = acc[q * 8 + 5]; h1.z = acc[q * 8 + 6]; h1.w = acc[q * 8 + 7];
                const f32x4 y0 = h0 * rstd * g0, y1 = h1 * rstd * g1;
                f32x4* hp = (f32x4*)(a.out + (size_t)m * D + col);
                if (layer + 1 < NLAYER) {
                    hp[0] = h0; hp[1] = h1;
                    u32x4 w; w.x = pk2(y0.x, y0.y); w.y = pk2(y0.z, y0.w); w.z = pk2(y1.x, y1.y); w.w = pk2(y1.z, y1.w);
                    *(u32x4*)((bf16_t*)(ws + WS_XN) + (size_t)m * D + col) = w;
                } else { hp[0] = y0; hp[1] = y1; }
                __builtin_amdgcn_sched_barrier(0);
            }
        }
    }
}

constexpr size_t WS_BAR = 95 * MiB;
#define XB_TMO      128
#define XB_XCNT(j)  (256  + 64 * (j))
#define XB_XSUB(j)  (1280 + 64 * (j))
#define XB_XGEN(j)  (2304 + 64 * (j))
#define XB_TOP      3328
#define XB_TOPGEN   3392
#define XCD_BAR_WORDS 3456
#define XB_SPIN_CAP (1u << 18)

__device__ __forceinline__ unsigned xb_ld(unsigned* p)              { return __hip_atomic_load(p, __ATOMIC_RELAXED, __HIP_MEMORY_SCOPE_AGENT); }
__device__ __forceinline__ unsigned xb_add(unsigned* p, unsigned v) { return __hip_atomic_fetch_add(p, v, __ATOMIC_RELAXED, __HIP_MEMORY_SCOPE_AGENT); }
__device__ __forceinline__ unsigned xb_xcc_id() { return (unsigned)__builtin_amdgcn_s_getreg((3 << 11) | 20) & 0xFu; }
#define XB_SPIN(cond, bar) do { unsigned _sp = 0; while (cond) { __builtin_amdgcn_s_sleep(1); \
    if ((++_sp & 255u) == 0u) { if (xb_ld(&(bar)[XB_TMO])) break; if (_sp > XB_SPIN_CAP) { atomicAdd(&(bar)[XB_TMO], 1u); break; } } } } while (0)

struct XcdBarrier {
    unsigned* bar; unsigned x;
    volatile LAS unsigned* st;
};

__device__ __forceinline__ XcdBarrier xcd_barrier_post(unsigned* bar, volatile LAS unsigned* st) {
    XcdBarrier b; b.bar = bar; b.x = xb_xcc_id(); b.st = st;
    if (threadIdx.x == 0) (void)xb_add(&bar[XB_XCNT(b.x)], 1u);
    return b;
}
__device__ __forceinline__ void xcd_barrier_complete(unsigned* bar, unsigned x, unsigned& nloc, unsigned& nx) {
    const unsigned G = gridDim.x * gridDim.y * gridDim.z;
    unsigned sum, cnt, mine, sp = 0u;
    for (;;) {
        sum = 0u; cnt = 0u; mine = 0u;
#pragma unroll
        for (unsigned j = 0; j < 16; ++j) { const unsigned c = xb_ld(&bar[XB_XCNT(j)]); sum += c; cnt += (c > 0u) ? 1u : 0u; mine = (j == x) ? c : mine; }
        if (sum == G) break;
        __builtin_amdgcn_s_sleep(1);
        if ((++sp & 255u) == 0u) { if (xb_ld(&bar[XB_TMO])) break; if (sp > XB_SPIN_CAP) { atomicAdd(&bar[XB_TMO], 1u); break; } }
    }
    nloc = mine > 0u ? mine : 1u; nx = cnt > 0u ? cnt : 1u;
}

__device__ __forceinline__ void xcd_barrier(const XcdBarrier& b) {
    asm volatile("s_waitcnt vmcnt(0)" ::: "memory");
    __syncthreads();
    if (threadIdx.x == 0) {
        unsigned* bar = b.bar;
        __builtin_amdgcn_s_waitcnt(0);
        unsigned nloc = b.st[0], nx = b.st[1];
        if (nloc == 0u) { xcd_barrier_complete(bar, b.x, nloc, nx); b.st[0] = nloc; b.st[1] = nx; }
        const unsigned old = xb_add(&bar[XB_XSUB(b.x)], 1u);
        const unsigned gen = old / nloc;
        if (old + 1u == (gen + 1u) * nloc) {
            __builtin_amdgcn_fence(__ATOMIC_RELEASE, "agent");
            asm volatile("s_waitcnt vmcnt(0)" ::: "memory");
            const unsigned og = xb_add(&bar[XB_TOP], 1u);
            const unsigned tg = og / nx;
            if (og + 1u == (tg + 1u) * nx) xb_add(&bar[XB_TOPGEN], 1u);
            else XB_SPIN(xb_ld(&bar[XB_TOPGEN]) == tg, bar);
            __builtin_amdgcn_fence(__ATOMIC_ACQUIRE, "agent");
            xb_add(&bar[XB_XGEN(b.x)], 1u);
            asm volatile("s_waitcnt vmcnt(0)" ::: "memory");
        } else {
            XB_SPIN(xb_ld(&bar[XB_XGEN(b.x)]) == gen, bar);
            __builtin_amdgcn_fence(__ATOMIC_ACQUIRE, "agent");
            asm volatile("s_waitcnt vmcnt(0)" ::: "memory");
        }
    }
    __syncthreads();
}

constexpr int NPHASE = 22, PH_PER_LAYER = 10;
template <int KIND>
DI void run_phase(const Args& a, int layer, LAS unsigned char* lds) {
    unsigned char* ws = a.ws;
    if constexpr (KIND == 0) { phase_prologue(a, lds); phase_rms_bf16(a.x, a.attn_norm, (bf16_t*)(ws + WS_XN)); }
    if constexpr (KIND == 1) phase_rms_bf16(layer == 0 ? a.x : a.out, a.attn_norm + (size_t)layer * D, (bf16_t*)(ws + WS_XN));
    if constexpr (KIND == 2 || KIND == 7) {
        const bool inproj = KIND == 2;
        const int N = inproj ? C_GATE : D, ldw = inproj ? NP : D;
        pg8::Gemm g{(const bf16_t*)(ws + WS_XN), (const bf16_t*)(ws + (inproj ? WS_WIN : WS_WQ)) + (size_t)layer * ldw * D, M, N, D};
        pg8::StaticOrder So; So.init(M, N, (int)gridDim.x, (int)blockIdx.x);
        EpiBf16RS E{(bf16_t*)(ws + (inproj ? WS_P : WS_Q2)), ldw, inproj ? nullptr : (const float*)(ws + WS_RSS) + (size_t)layer * M * 32};
        pg8::gemm_phase<EpiBf16RS, pg8::StaticOrder, true, true>(lds, g, So, E);
    }
    if constexpr (KIND == 3) phase_prep(a, layer, lds);
    if constexpr (KIND == 4) phase_attn(a, layer, lds);
    if constexpr (KIND == 5) {
        pg8::Gemm g{(const bf16_t*)(ws + WS_O), (const bf16_t*)(ws + WS_WOUT) + (size_t)layer * D * D, M, D, D};
        pg8::StaticOrder So; So.init(M, D, (int)gridDim.x, (int)blockIdx.x);
        EpiResid E{layer == 0 ? a.x : a.out, a.out, D, (bf16_t*)(ws + WS_XN), (float*)(ws + WS_RSS) + (size_t)layer * M * 32};
        pg8::gemm_phase<EpiResid, pg8::StaticOrder, true, true>(lds, g, So, E);
    }
    if constexpr (KIND == 6) phase_rms_bf16(a.out, a.ffn_norm + (size_t)layer * D, (bf16_t*)(ws + WS_XN));
    if constexpr (KIND == 8) phase_peer_select(a, layer, lds);
    if constexpr (KIND == 9) phase_peer_u(a, layer);
    if constexpr (KIND == 14) phase_peer_v(a, layer);
    if constexpr (KIND == 10) phase_rms_final(a.out, a.final_norm);
}

#ifndef MK_PER_PHASE
#define MK_PER_PHASE 0
#endif

#if MK_PER_PHASE
template <int KIND>
__global__ void __launch_bounds__(NTHREADS, 2) k_phase(Args a, int layer) {
    extern __shared__ __attribute__((aligned(16))) unsigned char lds_raw[];
    run_phase<KIND>(a, layer, (LAS unsigned char*)lds_raw);
}
template <int KIND> static void launch_phase(const Args& a, int layer, int grid, hipStream_t stream) {
    static bool attr = false;
    if (!attr) { (void)hipFuncSetAttribute((const void*)k_phase<KIND>, hipFuncAttributeMaxDynamicSharedMemorySize, LDS_BYTES); attr = true; }
    hipLaunchKernelGGL(k_phase<KIND>, dim3(grid), dim3(NTHREADS), LDS_BYTES, stream, a, layer);
}
#else
__global__ void __launch_bounds__(NTHREADS, 2) hybrid_fwd(Args a) {
    extern __shared__ __attribute__((aligned(16))) unsigned char lds_raw[];
    LAS unsigned char* lds = (LAS unsigned char*)lds_raw;
    volatile LAS unsigned* bst = (volatile LAS unsigned*)(lds + LDS_BYTES - 16);
    if (threadIdx.x < 4) bst[threadIdx.x] = 0u;
    __syncthreads();
    const XcdBarrier xbar = xcd_barrier_post((unsigned*)(a.ws + WS_BAR), bst);
    bool first_seam = true;
#pragma unroll 1
    for (int ph = a.ph_lo; ph < a.ph_hi; ++ph) {
        if (ph == NPHASE - 1 || ph == 1 + PH_PER_LAYER || ph == 1 || ph == 6 || ph == 6 + PH_PER_LAYER) continue;
        if (ph == 0) run_phase<0>(a, 0, lds);
        else if (ph == NPHASE - 1) run_phase<10>(a, 0, lds);
        else {
            const int layer = (ph - 1) / PH_PER_LAYER, k = (ph - 1) % PH_PER_LAYER;
            if (k == 0) run_phase<1>(a, layer, lds);
            else if (k == 1) run_phase<2>(a, layer, lds);
            else if (k == 2) run_phase<3>(a, layer, lds);
            else if (k == 3) run_phase<4>(a, layer, lds);
            else if (k == 4) run_phase<5>(a, layer, lds);
            else if (k == 5) run_phase<6>(a, layer, lds);
            else if (k == 6) run_phase<7>(a, layer, lds);
            else if (k == 7) run_phase<8>(a, layer, lds);
            else if (k == 8) run_phase<9>(a, layer, lds);
            else run_phase<14>(a, layer, lds);
        }
        if (ph + 1 < a.ph_hi) { if (first_seam) { cg::this_grid().sync(); first_seam = false; } else xcd_barrier(xbar); }
    }
}
#endif

extern "C" void kernel_launch(void* const* d_in, const int* in_sizes, int n_in, void* d_out, int out_size, void* d_ws, size_t ws_size, hipStream_t stream) {
    static int grid = 0;
    if (grid == 0) {
        if (n_in != 18 || out_size != M * D || ws_size < WS_END) { fprintf(stderr, "kernel_launch: unexpected shapes (n_in %d, out %d, ws %zu)\n", n_in, out_size, ws_size); grid = -1; return; }
        int dev = 0, cus = 0;
        if (hipGetDevice(&dev) != hipSuccess || hipDeviceGetAttribute(&cus, hipDeviceAttributeMultiprocessorCount, dev) != hipSuccess) { grid = -1; return; }
#if !MK_PER_PHASE
        if (hipFuncSetAttribute((const void*)hybrid_fwd, hipFuncAttributeMaxDynamicSharedMemorySize, LDS_BYTES) != hipSuccess) { fprintf(stderr, "kernel_launch: hipFuncSetAttribute failed\n"); grid = -1; return; }
        int per_cu = 0;
        if (hipOccupancyMaxActiveBlocksPerMultiprocessor(&per_cu, (const void*)hybrid_fwd, NTHREADS, LDS_BYTES) != hipSuccess || per_cu < 1) fprintf(stderr, "kernel_launch: occupancy query says %d\n", per_cu);
        (void)hipGetLastError();
#endif
        grid = cus;
    }
    if (grid < 0) return;
    Args a{};
    a.x = (const float*)d_in[0]; a.attn_norm = (const float*)d_in[1]; a.w_in = (const float*)d_in[2]; a.cmp_pos_k = (const float*)d_in[3];
    a.cmp_w1_k = (const float*)d_in[4]; a.cmp_w2_k = (const float*)d_in[5]; a.cmp_pos_v = (const float*)d_in[6]; a.cmp_w1_v = (const float*)d_in[7];
    a.cmp_w2_v = (const float*)d_in[8]; a.sinks = (const float*)d_in[9]; a.w_out = (const float*)d_in[10]; a.ffn_norm = (const float*)d_in[11];
    a.peer_wq = (const float*)d_in[12]; a.peer_subkeys = (const float*)d_in[13]; a.peer_u = (const float*)d_in[14]; a.peer_v = (const float*)d_in[15];
    a.rel_bias = (const float*)d_in[16]; a.final_norm = (const float*)d_in[17];
    a.out = (float*)d_out; a.ws = (unsigned char*)d_ws;
    a.ph_lo = 0; a.ph_hi = NPHASE;
#if MK_PER_PHASE
    launch_phase<0>(a, 0, grid, stream);
    for (int l = 0; l < NLAYER; ++l) {
        launch_phase<2>(a, l, grid, stream); launch_phase<3>(a, l, grid, stream);
        launch_phase<4>(a, l, grid, stream); launch_phase<5>(a, l, grid, stream);
        launch_phase<7>(a, l, grid, stream); launch_phase<8>(a, l, grid, stream); launch_phase<9>(a, l, grid, stream); launch_phase<14>(a, l, grid, stream);
    }
#else
    (void)hipMemsetAsync((unsigned char*)d_ws + WS_BAR, 0, 16384, stream);
    void* args[] = {&a};
    const hipError_t e = hipLaunchCooperativeKernel((const void*)hybrid_fwd, dim3(grid), dim3(NTHREADS), args, LDS_BYTES, stream);
    if (e != hipSuccess) fprintf(stderr, "kernel_launch: cooperative launch failed: %s (grid %d)\n", hipGetErrorString(e), grid);
#endif
}
```

```cpp
#include <hip/hip_runtime.h>
#include <cstdio>
#include <cstdint>
__device__ __forceinline__ int opaque_tid() { int t = threadIdx.x; asm volatile("" : "+v"(t)); return t; }
namespace pg8 {
#define PG8_LAS __attribute__((address_space(3)))
typedef unsigned short bf16_t;
typedef short bf16x8 __attribute__((ext_vector_type(8)));
typedef float f32x4 __attribute__((ext_vector_type(4)));
typedef unsigned u32x4 __attribute__((ext_vector_type(4)));
constexpr int BM = 256, BK = 64, HALF = 128, HTB = HALF * BK * 2  , STAGE_BYTES = 8 * HTB, NXCD = 8, WGM = 8;

__host__ __device__ __forceinline__ int lds_byte(int r, int c) { const int st = (r >> 4) * 2 + (c >> 5), rr = r & 15, cc = c & 31, ob = rr * 64 + cc * 2; return st * 1024 + (ob ^ (((ob >> 9) & 1) << 5)); }
__host__ __device__ __forceinline__ void stage_rc(int b, int& R, int& C) { const int st = b / 1024, sb = b % 1024, swz = sb ^ (((sb >> 9) & 1) << 5); R = (st >> 1) * 16 + swz / 64; C = (st & 1) * 32 + (swz % 64) / 2; }
__host__ __device__ __forceinline__ int perm32(int rho) { const int n = rho >> 4, i = rho & 15; return 8 * (i >> 2) + 4 * n + (i & 3); }

struct Unit { int pm, pn; };
struct Gemm { const bf16_t* A; const bf16_t* Bt; int M, N, K; };

struct StaticOrder {
    int nM, nN, nwg, G, c;
    __host__ __device__ void init(int M, int N, int G_, int c_) { nM = M / BM; nN = N / BM; nwg = nM * nN; G = G_; c = c_; }
    __host__ __device__ bool next(int i, Unit& u) const {
        const long L = (long)i * G + c; if (L >= nwg) return false;
        int wgid = (int)L; { const int q = nwg / NXCD, r = nwg % NXCD, xcd = wgid % NXCD, off = wgid / NXCD; wgid = (xcd < r ? xcd * (q + 1) : r * (q + 1) + (xcd - r) * q) + off; }
        const int nig = WGM * nN, gid = wgid / nig, fm = gid * WGM, gsz = (nM - fm) < WGM ? (nM - fm) : WGM;
        u.pm = fm + ((wgid % nig) % gsz); u.pn = (wgid % nig) / gsz; return true;
    }
    __device__ __forceinline__ void a_ready(const Unit&) const {}
    __device__ __forceinline__ void done(const Unit&) const {}
};

__device__ __forceinline__ unsigned cvt_pk_bf16(float lo, float hi) { unsigned r; asm volatile("v_cvt_pk_bf16_f32 %0, %1, %2" : "=v"(r) : "v"(lo), "v"(hi)); return r; }
typedef float f32x2 __attribute__((ext_vector_type(2)));
__device__ __forceinline__ f32x2 gelu_pk(f32x2 v) {
    const f32x2 av = __builtin_elementwise_abs(v), d = av * 0.2316418882f + 1.0f;
    f32x2 t; t.x = __builtin_amdgcn_rcpf(d.x); t.y = __builtin_amdgcn_rcpf(d.y);
    f32x2 q = t * 0.5307027145f + (-0.7265760135f); q = q * t + 0.7107068705f; q = q * t + (-0.142248368f); q = q * t + 0.127414796f; q = q * t;
    const f32x2 s = (v * v) * (-0.72134752044f);
    f32x2 e; e.x = __builtin_amdgcn_exp2f(s.x); e.y = __builtin_amdgcn_exp2f(s.y);
    const f32x2 m = v * (q * e), r = v - m;
    f32x2 o; o.x = v.x < 0.f ? m.x : r.x; o.y = v.y < 0.f ? m.y : r.y; return o;
}

template <int ACT  > struct EpiBf16 {
    static constexpr bool PERM = true, AFTER_DRAIN = false; static_assert(ACT == 0 || ACT == 1, "EpiBf16: ACT is 0 (none) or 1 (gelu_pk)");
    bf16_t* O; int ldc; const float* bias; int split_cols; size_t split_stride; float scale0;
    __device__ __forceinline__ void operator()(const f32x4 (&acc)[2][2][4][2], const Unit& u, int wr, int wc, int fr, int fq) const {
        const int row0 = u.pm * BM + wr * 64 + fr; int colt = u.pn * BM; bf16_t* base = O;
        float sc = 1.f; if (split_cols) { const int t = colt / split_cols; base += (size_t)t * split_stride; colt -= t * split_cols; if (t == 0) sc = scale0; }
        const int col0 = colt + wc * 32 + 8 * fq, bcol0 = u.pn * BM + wc * 32 + 8 * fq;
        f32x4 bv[2][2];
#pragma unroll
        for (int bj = 0; bj < 2; ++bj)
#pragma unroll
            for (int n = 0; n < 2; ++n) bv[bj][n] = bias ? *(const f32x4*)(bias + bcol0 + bj * HALF + 4 * n) : (f32x4){0.f, 0.f, 0.f, 0.f};
#pragma unroll
        for (int ai = 0; ai < 2; ++ai)
#pragma unroll
            for (int m = 0; m < 4; ++m) { bf16_t* rowp = base + (size_t)(row0 + ai * HALF + m * 16) * ldc + col0;
#pragma unroll
                for (int bj = 0; bj < 2; ++bj) { f32x4 v0 = acc[ai][bj][m][0] + bv[bj][0], v1 = acc[ai][bj][m][1] + bv[bj][1];
                    if (ACT == 1) { f32x2 a = gelu_pk((f32x2){v0[0], v0[1]}), b = gelu_pk((f32x2){v0[2], v0[3]}), c = gelu_pk((f32x2){v1[0], v1[1]}), d = gelu_pk((f32x2){v1[2], v1[3]});
                        v0 = (f32x4){a.x, a.y, b.x, b.y}; v1 = (f32x4){c.x, c.y, d.x, d.y}; }
                    v0 = v0 * sc; v1 = v1 * sc; u32x4 w; w.x = cvt_pk_bf16(v0[0], v0[1]); w.y = cvt_pk_bf16(v0[2], v0[3]); w.z = cvt_pk_bf16(v1[0], v1[1]); w.w = cvt_pk_bf16(v1[2], v1[3]);
                    *(u32x4*)(rowp + bj * HALF) = w; } }
    }
};
template <class Epi, class Sched, bool ALIGN_EPI = false, bool SP2 = false>
__device__ __forceinline__ void gemm_phase(PG8_LAS unsigned char* lds, const Gemm g, const Sched& S, const Epi& E) {
    const int tid = opaque_tid(), wid = __builtin_amdgcn_readfirstlane(tid >> 6), lane = tid & 63, wr = wid >> 2, wc = wid & 3, fr = lane & 15, fq = lane >> 4;
    const int K = g.K, nt = K / BK;
    unsigned voffA[2], voffB[2];
#pragma unroll
    for (int i = 0; i < 2; ++i) { int R, C; stage_rc(tid * 16 + i * 8192, R, C); const int Rb = Epi::PERM ? ((R & ~31) + perm32(R & 31)) : R;
        voffA[i] = (unsigned)(R * K + C) * 2u; voffB[i] = (unsigned)(Rb * K + C) * 2u; }
    const size_t kstep = (size_t)(BK * 2);
    const size_t hstep = (size_t)HALF * K * 2;
    const size_t tstep = 2 * hstep;
    const unsigned ldsw = (unsigned)wid * 1024u;
    const int aoff = lds_byte(wr * 64 + fr, fq * 8), boff = lds_byte(wc * 32 + fr, fq * 8);
#define PG8_SA(b, h) (((b) * 2 + (h)) * HTB)
#define PG8_SB(b, h) ((4 + (b) * 2 + (h)) * HTB)
#define PG8_STAGE(bufoff, gbase, voff) do { _Pragma("unroll") for (int _i = 0; _i < 2; ++_i) \
        __builtin_amdgcn_global_load_lds((const unsigned*)((const char*)(gbase) + (voff)[_i]), (PG8_LAS unsigned*)(lds + (bufoff) + ldsw + _i * 8192), 16, 0, 0); } while (0)
#define PG8_LDA(dst, b, h) do { _Pragma("unroll") for (int m = 0; m < 4; ++m) _Pragma("unroll") for (int k = 0; k < 2; ++k) dst[m][k] = *(const PG8_LAS bf16x8*)(lds + PG8_SA(b, h) + aoff + m * 2048 + k * 1024); } while (0)
#define PG8_LDB(dst, b, h) do { _Pragma("unroll") for (int n = 0; n < 2; ++n) _Pragma("unroll") for (int k = 0; k < 2; ++k) dst[n][k] = *(const PG8_LAS bf16x8*)(lds + PG8_SB(b, h) + boff + n * 2048 + k * 1024); } while (0)
#define PG8_MMA(ai, bj, At, Bt) do { __builtin_amdgcn_s_setprio(1); _Pragma("unroll") for (int m = 0; m < 4; ++m) _Pragma("unroll") for (int n = 0; n < 2; ++n) _Pragma("unroll") for (int k = 0; k < 2; ++k) \
        acc[ai][bj][m][n] = __builtin_amdgcn_mfma_f32_16x16x32_bf16(Bt[n][k], At[m][k], acc[ai][bj][m][n], 0, 0, 0); __builtin_amdgcn_s_setprio(0); } while (0)
#define PG8_WAIT_V(n) asm volatile("s_waitcnt vmcnt(" #n ")" ::: "memory")
#define PG8_WAIT_L(n) asm volatile("s_waitcnt lgkmcnt(" #n ")" ::: "memory")
#define PG8_BAR __builtin_amdgcn_s_barrier()
#define PG8_SCHED __builtin_amdgcn_sched_barrier(0)
    Unit cur, nxt; int ui = 0;
    if (!S.next(0, cur)) return;
    f32x4 acc[2][2][4][2];
#pragma unroll
    for (int a = 0; a < 2; ++a)
#pragma unroll
        for (int b = 0; b < 2; ++b)
#pragma unroll
            for (int m = 0; m < 4; ++m)
#pragma unroll
                for (int n = 0; n < 2; ++n) acc[a][b][m][n] = (f32x4){0.f, 0.f, 0.f, 0.f};
    bf16x8 At[4][2], B0[2][2], B1[2][2];
    const char* cA = (const char*)g.A + (size_t)cur.pm * tstep; const char* cB = (const char*)g.Bt + (size_t)cur.pn * tstep;
    S.a_ready(cur);
    if constexpr (SP2) {
        PG8_STAGE(PG8_SB(0, 0), cB, voffB); PG8_STAGE(PG8_SB(0, 1), cB + hstep, voffB); PG8_STAGE(PG8_SA(0, 0), cA, voffA); PG8_STAGE(PG8_SA(0, 1), cA + hstep, voffA);
        if (wr == 1) PG8_BAR;
        PG8_WAIT_V(2); PG8_BAR;
        PG8_STAGE(PG8_SB(1, 0), cB + kstep, voffB); PG8_STAGE(PG8_SA(1, 0), cA + kstep, voffA); PG8_STAGE(PG8_SB(1, 1), cB + hstep + kstep, voffB);
        PG8_WAIT_V(6); PG8_BAR;
    } else {
        PG8_STAGE(PG8_SB(0, 0), cB, voffB); PG8_STAGE(PG8_SA(0, 0), cA, voffA); PG8_STAGE(PG8_SB(0, 1), cB + hstep, voffB); PG8_STAGE(PG8_SA(0, 1), cA + hstep, voffA);
        if (wr == 1) PG8_BAR;
        PG8_WAIT_V(4); PG8_BAR;
        PG8_STAGE(PG8_SB(1, 0), cB + kstep, voffB); PG8_STAGE(PG8_SA(1, 0), cA + kstep, voffA); PG8_STAGE(PG8_SB(1, 1), cB + hstep + kstep, voffB);
        PG8_WAIT_V(6); PG8_BAR;
    }
    for (;;) {
        const bool has_next = S.next(ui + 1, nxt);
        const char* nA = has_next ? (const char*)g.A + (size_t)nxt.pm * tstep : cA; const char* nB = has_next ? (const char*)g.Bt + (size_t)nxt.pn * tstep : cB;
        for (int t = 0; t < nt; t += 2) {
            const bool last = (t == nt - 2);
            const char* a1 = cA + (size_t)(t + 1) * kstep;
            const char* a2 = last ? nA : cA + (size_t)(t + 2) * kstep; const char* b2 = last ? nB : cB + (size_t)(t + 2) * kstep;
            const char* a3 = a2 + kstep; const char* b3 = b2 + kstep;
            if (last && has_next) S.a_ready(nxt);
            if constexpr (SP2) {
            PG8_LDB(B0, 0, 0); PG8_LDB(B1, 0, 1); PG8_SCHED; PG8_LDA(At, 0, 0); PG8_STAGE(PG8_SA(1, 1), a1 + hstep, voffA);
            PG8_WAIT_V(8); PG8_WAIT_L(0); PG8_BAR; PG8_MMA(0, 0, At, B0); PG8_MMA(0, 1, At, B1); PG8_BAR; PG8_SCHED;
            PG8_LDA(At, 0, 1); PG8_STAGE(PG8_SB(0, 0), b2, voffB); PG8_STAGE(PG8_SB(0, 1), b2 + hstep, voffB); PG8_STAGE(PG8_SA(0, 0), a2, voffA);
            PG8_WAIT_V(8); PG8_WAIT_L(0); PG8_BAR; PG8_MMA(1, 0, At, B0); PG8_MMA(1, 1, At, B1); PG8_BAR; PG8_SCHED;
            PG8_LDB(B0, 1, 0); PG8_LDB(B1, 1, 1); PG8_SCHED; PG8_LDA(At, 1, 0); PG8_STAGE(PG8_SA(0, 1), a2 + hstep, voffA);
            PG8_WAIT_V(8); PG8_WAIT_L(0); PG8_BAR; PG8_MMA(0, 0, At, B0); PG8_MMA(0, 1, At, B1); PG8_BAR; PG8_SCHED;
            PG8_LDA(At, 1, 1); PG8_STAGE(PG8_SB(1, 0), b3, voffB); PG8_STAGE(PG8_SB(1, 1), b3 + hstep, voffB); PG8_STAGE(PG8_SA(1, 0), a3, voffA);
            PG8_WAIT_V(8); PG8_WAIT_L(0); PG8_BAR; PG8_MMA(1, 0, At, B0); PG8_MMA(1, 1, At, B1); PG8_BAR; PG8_SCHED;
            } else {
            PG8_LDB(B0, 0, 0); PG8_SCHED; PG8_LDA(At, 0, 0); PG8_STAGE(PG8_SA(1, 1), a1 + hstep, voffA);
            PG8_WAIT_L(8); PG8_BAR; PG8_WAIT_L(0); PG8_MMA(0, 0, At, B0); PG8_BAR; PG8_SCHED;
            PG8_LDB(B1, 0, 1); PG8_STAGE(PG8_SB(0, 0), b2, voffB);
            PG8_BAR; PG8_WAIT_L(0); PG8_MMA(0, 1, At, B1); PG8_BAR;
            PG8_LDA(At, 0, 1); PG8_STAGE(PG8_SA(0, 0), a2, voffA);
            PG8_BAR; PG8_WAIT_L(0); PG8_MMA(1, 0, At, B0); PG8_BAR; PG8_SCHED;
            PG8_STAGE(PG8_SB(0, 1), b2 + hstep, voffB);
            PG8_WAIT_V(6); PG8_BAR; PG8_MMA(1, 1, At, B1); PG8_BAR;
            PG8_LDB(B0, 1, 0); PG8_SCHED; PG8_LDA(At, 1, 0); PG8_STAGE(PG8_SA(0, 1), a2 + hstep, voffA);
            PG8_WAIT_L(8); PG8_BAR; PG8_WAIT_L(0); PG8_MMA(0, 0, At, B0); PG8_BAR; PG8_SCHED;
            PG8_LDB(B1, 1, 1); PG8_STAGE(PG8_SB(1, 0), b3, voffB);
            PG8_BAR; PG8_WAIT_L(0); PG8_MMA(0, 1, At, B1); PG8_BAR;
            PG8_LDA(At, 1, 1); PG8_STAGE(PG8_SA(1, 0), a3, voffA);
            PG8_BAR; PG8_WAIT_L(0); PG8_MMA(1, 0, At, B0); PG8_BAR; PG8_SCHED;
            PG8_STAGE(PG8_SB(1, 1), b3 + hstep, voffB);
            PG8_WAIT_V(6); PG8_BAR; PG8_MMA(1, 1, At, B1); PG8_BAR;
            }
        }
        if constexpr (ALIGN_EPI) { if (wr == 0) PG8_BAR; }
        if constexpr (!Epi::AFTER_DRAIN) { E(acc, cur, wr, wc, fr, fq); S.done(cur); }
        if (!has_next) break;
#pragma unroll
        for (int a = 0; a < 2; ++a)
#pragma unroll
            for (int b = 0; b < 2; ++b)
#pragma unroll
                for (int m = 0; m < 4; ++m)
#pragma unroll
                    for (int n = 0; n < 2; ++n) acc[a][b][m][n] = (f32x4){0.f, 0.f, 0.f, 0.f};
        cur = nxt; cA = nA; cB = nB; ++ui;
        if constexpr (ALIGN_EPI) { if (wr == 1) PG8_BAR; }
    }
    PG8_WAIT_V(0);
    if constexpr (!ALIGN_EPI) { if (wr == 0) PG8_BAR; }
    PG8_BAR;
    if constexpr (Epi::AFTER_DRAIN) { E.fused(acc, cur, wr, wc, fr, fq, lds, wid, lane); S.done(cur); }
#undef PG8_SA
#undef PG8_SB
#undef PG8_STAGE
#undef PG8_LDA
#undef PG8_LDB
#undef PG8_MMA
#undef PG8_WAIT_V
#undef PG8_WAIT_L
#undef PG8_BAR
#undef PG8_SCHED
}
}

#include <hip/hip_cooperative_groups.h>
namespace cg = cooperative_groups;

#define DI __device__ __forceinline__
#define LAS __attribute__((address_space(3)))
typedef unsigned short bf16_t;
typedef short bf16x8 __attribute__((ext_vector_type(8)));
typedef float f32x4 __attribute__((ext_vector_type(4)));
typedef float f32x2 __attribute__((ext_vector_type(2)));
typedef float f32x16 __attribute__((ext_vector_type(16)));
typedef unsigned u32x4 __attribute__((ext_vector_type(4)));
typedef unsigned u32x2 __attribute__((ext_vector_type(2)));
typedef __bf16 bf16v2 __attribute__((ext_vector_type(2)));

#define MFMA32(a, b, c) __builtin_amdgcn_mfma_f32_32x32x16_bf16((a), (b), (c), 0, 0, 0)
#define MFMA16(a, b, c) __builtin_amdgcn_mfma_f32_16x16x32_bf16((a), (b), (c), 0, 0, 0)
#define LDS_WAIT() asm volatile("s_waitcnt lgkmcnt(0)" ::: "memory")

constexpr int NB = 2, S = 16384, D = 2048, M = NB * S, NLAYER = 2;
constexpr int NPROJ = 3120, NP = 3328;
constexpr int C_QA = 0, C_QB = 1024, C_KC = 2048, C_VC = 2176, C_KS = 2304, C_VS = 2432, C_KW = 2560, C_VW = 2688, C_KB = 2816, C_VB = 2944, C_GATE = 3072;
constexpr int NCP = 1024;
constexpr int NEXP = 16384;
constexpr float NEGF = -1e30f;

constexpr size_t MiB = 1u << 20;
constexpr size_t WS_WIN = 0;
constexpr size_t WS_WOUT = 28 * MiB;
constexpr size_t WS_WQ = 46 * MiB;
constexpr size_t WS_CW1 = 64 * MiB;
constexpr size_t WS_SUBK = 67 * MiB;
constexpr size_t WS_KC = 68 * MiB;
constexpr size_t WS_VCT = 69 * MiB;
constexpr size_t WS_VST = 70 * MiB;
constexpr size_t WS_VWT = 78 * MiB;
constexpr size_t WS_VBT = 86 * MiB;
constexpr size_t WS_IDX = 96 * MiB;
constexpr size_t WS_GATE = 112 * MiB;
constexpr size_t WS_GSUM = 94 * MiB;
constexpr size_t WS_U = 128 * MiB;
constexpr size_t WS_V = 256 * MiB;
constexpr size_t WS_KSF = 192 * MiB, WS_KWF = 200 * MiB, WS_KBF = 208 * MiB;
constexpr size_t WS_KMAX = 95 * MiB + 65536;
constexpr size_t WS_RSS = 192 * MiB + 24 * MiB;
constexpr size_t WS_XN = 384 * MiB;
constexpr size_t WS_O = 512 * MiB;
constexpr size_t WS_Q2 = 640 * MiB;
constexpr size_t WS_P = 768 * MiB;
constexpr size_t WS_END = 1000 * MiB;

constexpr int LDS_BYTES = 139264;
constexpr int NTHREADS = 512;

struct Args {
    const float* x; const float* attn_norm; const float* w_in; const float* cmp_pos_k; const float* cmp_w1_k; const float* cmp_w2_k;
    const float* cmp_pos_v; const float* cmp_w1_v; const float* cmp_w2_v; const float* sinks; const float* w_out; const float* ffn_norm;
    const float* peer_wq; const float* peer_subkeys; const float* peer_u; const float* peer_v; const float* rel_bias; const float* final_norm;
    float* out; unsigned char* ws; int ph_lo, ph_hi;
};

DI unsigned f2bf(float f) { unsigned u = __builtin_bit_cast(unsigned, f); return (u + 0x7fffu + ((u >> 16) & 1u)) >> 16; }
DI unsigned pk2(float lo, float hi) { const f32x2 v = {lo, hi}; return __builtin_bit_cast(unsigned, __builtin_convertvector(v, bf16v2)); }
DI float bflo(unsigned w) { return __builtin_bit_cast(float, w << 16); }
DI float bfhi(unsigned w) { return __builtin_bit_cast(float, w & 0xffff0000u); }
DI float bf2f(bf16_t v) { return __builtin_bit_cast(float, (unsigned)v << 16); }
DI float wave_sum(float v) {
#pragma unroll
    for (int o = 1; o < 64; o <<= 1) v += __shfl_xor(v, o);
    return v;
}
DI float gelu_tanh(float x) {
    const float y = 0.7978845608028654f * (x + 0.044715f * x * x * x);
    const float t = __expf(2.f * y);
    const float th = 1.f - 2.f / (t + 1.f);
    return 0.5f * x * (1.f + th);
}
DI float sigmoidf_(float x) { return 1.f / (1.f + __expf(-x)); }
DI int crow(int r, int hi) { return (r & 3) + 8 * (r >> 2) + 4 * hi; }
DI int rel_bucket(int d) {
    const float lf = __log2f((float)(d < 1 ? 1 : d));
    int b = 16 + (int)((lf - 4.0f) * (16.0f / 7.0f));
    b = b > 31 ? 31 : b;
    return d < 16 ? d : b;
}
DI bf16x8 pack8(float a0, float a1, float a2, float a3, float a4, float a5, float a6, float a7) {
    u32x4 p; p.x = pk2(a0, a1); p.y = pk2(a2, a3); p.z = pk2(a4, a5); p.w = pk2(a6, a7);
    return __builtin_bit_cast(bf16x8, p);
}

DI int win_srccol(int n) {
    if (n < 1024) return n;
    if (n < 2048) return 1840 + (n - 1024);
    if (n < 2816) return 1024 + (n - 2048);
    if (n < 3072) return 2864 + (n - 2816);
    if (n < 3120) return 1792 + (n - 3072);
    return -1;
}
template <bool WIN>
DI void transpose_item(const float* W, int K, int Nsrc, bf16_t* WT, int k0, int n0, LAS float* scr, int lane, const float* gk = nullptr) {
    const int nd = n0 + (lane & 31);
    const int ns = WIN ? win_srccol(nd) : nd;
#pragma unroll 8
    for (int i = 0; i < 32; ++i) { const int kk = 2 * i + (lane >> 5); scr[kk * 33 + (lane & 31)] = (ns >= 0 ? W[(size_t)(k0 + kk) * Nsrc + ns] : 0.f) * (gk ? gk[k0 + kk] : 1.f); }
    LDS_WAIT();
    const int c = lane & 7;
#pragma unroll
    for (int j = 0; j < 4; ++j) { const int n = (lane >> 3) + 8 * j; const LAS float* s = scr + (8 * c) * 33 + n;
        u32x4 o; o.x = pk2(s[0 * 33], s[1 * 33]); o.y = pk2(s[2 * 33], s[3 * 33]); o.z = pk2(s[4 * 33], s[5 * 33]); o.w = pk2(s[6 * 33], s[7 * 33]);
        *(u32x4*)(WT + (size_t)(n0 + n) * K + k0 + 8 * c) = o; }
    LDS_WAIT();
}
template <bool WIN>
DI void transpose_matrix(const float* W, int K, int Nsrc, int Ndst, bf16_t* WT, LAS float* scr, int lane, int gw, int NGW, const float* gk = nullptr) {
    const int nblk = Ndst / 32, nitems = (K / 64) * nblk;
    for (int it = gw; it < nitems; it += NGW) transpose_item<WIN>(W, K, Nsrc, WT, 64 * (it / nblk), 32 * (it % nblk), scr, lane, gk);
}
DI void convert_rows(const float* src, bf16_t* dst, size_t n8, size_t gt, size_t ngt) {
    for (size_t i = gt; i < n8; i += ngt) {
        const f32x4 a = ((const f32x4*)src)[2 * i], b = ((const f32x4*)src)[2 * i + 1];
        u32x4 o; o.x = pk2(a.x, a.y); o.y = pk2(a.z, a.w); o.z = pk2(b.x, b.y); o.w = pk2(b.z, b.w);
        ((u32x4*)dst)[i] = o;
    }
}
constexpr float U_SCALE = 512.f, V_SCALE = 64.f;
DI void convert_rows_fp8(const float* src, unsigned char* dst, size_t n16, float scale, size_t gt, size_t ngt, const float* gnorm = nullptr) {
    for (size_t i = gt; i < n16; i += ngt) {
        f32x4 a = ((const f32x4*)src)[4 * i] * scale, b = ((const f32x4*)src)[4 * i + 1] * scale, c = ((const f32x4*)src)[4 * i + 2] * scale, d = ((const f32x4*)src)[4 * i + 3] * scale;
        if (gnorm) { const f32x4* gp = (const f32x4*)(gnorm + ((16 * i) / ((size_t)NEXP * D)) * D + (16 * i) % D); a = a * gp[0]; b = b * gp[1]; c = c * gp[2]; d = d * gp[3]; }
        u32x4 o;
        o.x = (unsigned)__builtin_amdgcn_cvt_pk_fp8_f32(a.z, a.w, __builtin_amdgcn_cvt_pk_fp8_f32(a.x, a.y, 0, false), true);
        o.y = (unsigned)__builtin_amdgcn_cvt_pk_fp8_f32(b.z, b.w, __builtin_amdgcn_cvt_pk_fp8_f32(b.x, b.y, 0, false), true);
        o.z = (unsigned)__builtin_amdgcn_cvt_pk_fp8_f32(c.z, c.w, __builtin_amdgcn_cvt_pk_fp8_f32(c.x, c.y, 0, false), true);
        o.w = (unsigned)__builtin_amdgcn_cvt_pk_fp8_f32(d.z, d.w, __builtin_amdgcn_cvt_pk_fp8_f32(d.x, d.y, 0, false), true);
        ((u32x4*)dst)[i] = o;
    }
}
DI void phase_prologue(const Args& a, LAS unsigned char* lds) {
    const int tid = opaque_tid(), lane = tid & 63, wave = tid >> 6;
    if (blockIdx.x == 0 && tid < 32) ((unsigned*)(a.ws + WS_KMAX))[tid] = 0u;
    const int gw = blockIdx.x * 8 + wave, NGW = gridDim.x * 8;
    LAS float* scr = (LAS float*)(lds + wave * 8448);
    unsigned char* ws = a.ws;
    for (int l = 0; l < NLAYER; ++l) {
        transpose_matrix<true>(a.w_in + (size_t)l * D * NPROJ, D, NPROJ, NP, (bf16_t*)(ws + WS_WIN) + (size_t)l * NP * D, scr, lane, gw, NGW);
        transpose_matrix<false>(a.w_out + (size_t)l * D * D, D, D, D, (bf16_t*)(ws + WS_WOUT) + (size_t)l * D * D, scr, lane, gw, NGW);
        transpose_matrix<false>(a.peer_wq + (size_t)l * D * D, D, D, D, (bf16_t*)(ws + WS_WQ) + (size_t)l * D * D, scr, lane, gw, NGW, a.ffn_norm + (size_t)l * D);
        transpose_matrix<false>(a.cmp_w1_k + (size_t)l * 2048 * 128, 2048, 128, 128, (bf16_t*)(ws + WS_CW1) + (size_t)(l * 2 + 0) * 128 * 2048, scr, lane, gw, NGW);
        transpose_matrix<false>(a.cmp_w1_v + (size_t)l * 2048 * 128, 2048, 128, 128, (bf16_t*)(ws + WS_CW1) + (size_t)(l * 2 + 1) * 128 * 2048, scr, lane, gw, NGW);
    }
    const size_t gt = (size_t)blockIdx.x * NTHREADS + tid, ngt = (size_t)gridDim.x * NTHREADS;
    convert_rows_fp8(a.peer_u, ws + WS_U, (size_t)NLAYER * NEXP * D / 16, U_SCALE, gt, ngt, a.ffn_norm);
    convert_rows_fp8(a.peer_v, ws + WS_V, (size_t)NLAYER * NEXP * D / 16, V_SCALE, gt, ngt);
    convert_rows(a.peer_subkeys, (bf16_t*)(ws + WS_SUBK), (size_t)NLAYER * 2 * 128 * 128 / 8, gt, ngt);
}

DI void phase_rms_bf16(const float* X, const float* g, bf16_t* XN) {
    const int tid = opaque_tid(), lane = tid & 63, wave = tid >> 6;
    const int gw = blockIdx.x * 8 + wave, NGW = gridDim.x * 8;
    f32x4 gv[8];
#pragma unroll
    for (int j = 0; j < 8; ++j) gv[j] = ((const f32x4*)g)[lane + 64 * j];
    for (int m = gw; m < M; m += NGW) {
        const f32x4* xr = (const f32x4*)(X + (size_t)m * D);
        f32x4 v[8]; float s = 0.f;
#pragma unroll
        for (int j = 0; j < 8; ++j) { v[j] = xr[lane + 64 * j]; s += (v[j].x * v[j].x + v[j].y * v[j].y) + (v[j].z * v[j].z + v[j].w * v[j].w); }
        const float rstd = rsqrtf(wave_sum(s) * (1.f / D) + 1e-6f);
        u32x2* o8 = (u32x2*)(XN + (size_t)m * D);
#pragma unroll
        for (int j = 0; j < 8; ++j) { const f32x4 y = v[j] * rstd * gv[j]; u32x2 w; w.x = pk2(y.x, y.y); w.y = pk2(y.z, y.w); o8[lane + 64 * j] = w; }
    }
}
DI void phase_rms_final(float* X, const float* g) {
    const int tid = opaque_tid(), lane = tid & 63, wave = tid >> 6;
    const int gw = blockIdx.x * 8 + wave, NGW = gridDim.x * 8;
    f32x4 gv[8];
#pragma unroll
    for (int j = 0; j < 8; ++j) gv[j] = ((const f32x4*)g)[lane + 64 * j];
    for (int m = gw; m < M; m += NGW) {
        f32x4* xr = (f32x4*)(X + (size_t)m * D);
        f32x4 v[8]; float s = 0.f;
#pragma unroll
        for (int j = 0; j < 8; ++j) { v[j] = xr[lane + 64 * j]; s += (v[j].x * v[j].x + v[j].y * v[j].y) + (v[j].z * v[j].z + v[j].w * v[j].w); }
        const float rstd = rsqrtf(wave_sum(s) * (1.f / D) + 1e-6f);
#pragma unroll
        for (int j = 0; j < 8; ++j) xr[lane + 64 * j] = v[j] * rstd * gv[j];
    }
}

struct EpiResid {
    static constexpr bool PERM = false, AFTER_DRAIN = false;
    const float* base; float* out; int ldc; bf16_t* hb; float* rss;
    DI void operator()(const pg8::f32x4 (&acc)[2][2][4][2], const pg8::Unit& u, int wr, int wc, int fr, int fq) const {
        const int col0 = u.pn * pg8::BM + wc * 32 + 4 * fq;
#pragma unroll
        for (int ai = 0; ai < 2; ++ai)
#pragma unroll
            for (int m = 0; m < 4; ++m) {
                const int row = u.pm * pg8::BM + ai * pg8::HALF + wr * 64 + m * 16 + fr;
                const size_t off = (size_t)row * ldc + col0;
                float ssq = 0.f;
#pragma unroll
                for (int bj = 0; bj < 2; ++bj)
#pragma unroll
                    for (int n = 0; n < 2; ++n) { const size_t o = off + bj * pg8::HALF + n * 16; const pg8::f32x4 bs = *(const pg8::f32x4*)(base + o); const pg8::f32x4 v = bs + acc[ai][bj][m][n];
                        *(pg8::f32x4*)(out + o) = v; ssq += (v[0] * v[0] + v[1] * v[1]) + (v[2] * v[2] + v[3] * v[3]);
                        u32x2 w; w.x = pk2(v[0], v[1]); w.y = pk2(v[2], v[3]); *(u32x2*)(hb + o) = w; }
                ssq += __shfl_xor(ssq, 16); ssq += __shfl_xor(ssq, 32);
                if (fq == 0) rss[(size_t)row * 32 + u.pn * 4 + wc] = ssq;
                asm volatile("" ::: "memory");
            }
    }
};
struct EpiBf16RS {
    static constexpr bool PERM = true, AFTER_DRAIN = false;
    bf16_t* O; int ldc; const float* rss;
    DI void operator()(const pg8::f32x4 (&acc)[2][2][4][2], const pg8::Unit& u, int wr, int wc, int fr, int fq) const {
        const int row0 = u.pm * pg8::BM + wr * 64 + fr, col0 = u.pn * pg8::BM + wc * 32 + 8 * fq;
#pragma unroll
        for (int ai = 0; ai < 2; ++ai)
#pragma unroll
            for (int m = 0; m < 4; ++m) {
                const int row = row0 + ai * pg8::HALF + m * 16;
                float sc = 1.f;
                if (rss) { const pg8::f32x4* rp = (const pg8::f32x4*)(rss + (size_t)row * 32); pg8::f32x4 t = rp[0];
#pragma unroll
                    for (int j = 1; j < 8; ++j) t += rp[j];
                    sc = rsqrtf(((t[0] + t[1]) + (t[2] + t[3])) * (1.f / D) + 1e-6f); }
                bf16_t* rowp = O + (size_t)row * ldc + col0;
#pragma unroll
                for (int bj = 0; bj < 2; ++bj) { const pg8::f32x4 v0 = acc[ai][bj][m][0] * sc, v1 = acc[ai][bj][m][1] * sc;
                    u32x4 w; w.x = pk2(v0[0], v0[1]); w.y = pk2(v0[2], v0[3]); w.z = pk2(v1[0], v1[1]); w.w = pk2(v1[2], v1[3]);
                    *(u32x4*)(rowp + bj * pg8::HALF) = w; }
            }
    }
};

DI void phase_prep(const Args& a, int layer, LAS unsigned char* lds) {
    const int tid = opaque_tid(), lane = tid & 63, wave = tid >> 6;
    const int gw = blockIdx.x * 8 + wave, NGW = gridDim.x * 8;
    unsigned char* ws = a.ws;
    const bf16_t* P = (const bf16_t*)(ws + WS_P);
    {
        LAS bf16_t* scr = (LAS bf16_t*)(lds + wave * 9216);
        for (int it = gw; it < 6 * 4 * 256; it += NGW) {
            const int which = it / 1024, bg = (it / 256) & 3, st = it & 255, b = bg >> 1, g = bg & 1;
            if (which >= 3) {
                const int srccol = (which == 3 ? C_KS : which == 4 ? C_KW : C_KB) + g * 64;
                bf16_t* dst = (bf16_t*)(ws + (which == 3 ? WS_KSF : which == 4 ? WS_KWF : WS_KBF)) + (size_t)bg * 64 * S + (size_t)st * 4096;
                float rmax = 0.f;
#pragma unroll
                for (int i = 0; i < 8; ++i) { const int tok = i * 8 + (lane >> 3), q = lane & 7;
                    const u32x4 v = *(const u32x4*)(P + (size_t)(b * S + st * 64 + tok) * NP + srccol + q * 8);
                    const int pos = which == 3 ? (((tok >> 4) * 2 + (q >> 2)) * 64 + (q & 3) * 16 + (tok & 15))
                                               : ((tok >> 5) * 256 + (q >> 1) * 64 + (q & 1) * 32 + (tok & 31));
                    *(u32x4*)(dst + pos * 8) = v;
                    float ss = bflo(v.x) * bflo(v.x) + bfhi(v.x) * bfhi(v.x) + bflo(v.y) * bflo(v.y) + bfhi(v.y) * bfhi(v.y)
                             + bflo(v.z) * bflo(v.z) + bfhi(v.z) * bfhi(v.z) + bflo(v.w) * bflo(v.w) + bfhi(v.w) * bfhi(v.w);
                    ss += __shfl_xor(ss, 1); ss += __shfl_xor(ss, 2); ss += __shfl_xor(ss, 4);
                    rmax = fmaxf(rmax, ss); }
                rmax = fmaxf(rmax, __shfl_xor(rmax, 8)); rmax = fmaxf(rmax, __shfl_xor(rmax, 16)); rmax = fmaxf(rmax, __shfl_xor(rmax, 32));
                if (lane == 0) atomicMax((unsigned*)(ws + WS_KMAX) + (layer * 4 + (which - 3)) * 4 + bg, __builtin_bit_cast(unsigned, rmax));
                continue;
            }
            const int srccol = (which == 0 ? C_VS : which == 1 ? C_VW : C_VB) + g * 64;
            bf16_t* dst = (bf16_t*)(ws + (which == 0 ? WS_VST : which == 1 ? WS_VWT : WS_VBT)) + (size_t)bg * 64 * S + (size_t)st * 4096;
#pragma unroll
            for (int i = 0; i < 8; ++i) { const int tok = i * 8 + (lane >> 3), ch = lane & 7;
                const u32x4 v = *(const u32x4*)(P + (size_t)(b * S + st * 64 + tok) * NP + srccol + ch * 8);
                *(LAS u32x4*)(scr + tok * 72 + ch * 8) = v; }
            LDS_WAIT();
#pragma unroll
            for (int f = 0; f < 8; ++f) {
                int d, kb0, kstep;
                if (which == 0) { const int j = f >> 2, dt = f & 3, hh = lane & 15, qd = lane >> 4; d = 16 * dt + hh; kb0 = 16 * j + 4 * qd; kstep = 32; }
                else { const int tl = f >> 2, j = (f >> 1) & 1, dt = f & 1, c = lane & 31, hi = lane >> 5; d = dt * 32 + c; kb0 = tl * 32 + 16 * j + 4 * hi; kstep = 8; }
                unsigned e[8];
#pragma unroll
                for (int i = 0; i < 8; ++i) e[i] = scr[(kb0 + (i & 3) + kstep * (i >> 2)) * 72 + d];
                u32x4 o; o.x = e[0] | (e[1] << 16); o.y = e[2] | (e[3] << 16); o.z = e[4] | (e[5] << 16); o.w = e[6] | (e[7] << 16);
                *(u32x4*)(dst + (f * 64 + lane) * 8) = o;
            }
            LDS_WAIT();
        }
    }
    {
        const bf16_t* XN = (const bf16_t*)(ws + WS_XN);
        const bf16_t* wg = (const bf16_t*)(ws + WS_WIN) + (size_t)layer * NP * D + (size_t)C_GATE * D;
        bf16_t* Pw = (bf16_t*)(ws + WS_P);
        const int c = lane & 31, hi = lane >> 5;
        for (int it = NGW - 1 - gw; it < M / 32; it += NGW) {
            const bf16_t* ar = XN + (size_t)(it * 32 + c) * D + hi * 8;
            const bf16_t* b0 = wg + (size_t)c * D + hi * 8, *b1 = wg + (size_t)(32 + c) * D + hi * 8;
            f32x16 a0, a1;
#pragma unroll
            for (int r = 0; r < 16; ++r) { a0[r] = 0.f; a1[r] = 0.f; }
#pragma unroll 8
            for (int kk = 0; kk < 128; ++kk) {
                const bf16x8 af = *(const bf16x8*)(ar + kk * 16);
                a0 = MFMA32(af, *(const bf16x8*)(b0 + kk * 16), a0);
                a1 = MFMA32(af, *(const bf16x8*)(b1 + kk * 16), a1);
            }
#pragma unroll
            for (int r = 0; r < 16; ++r) {
                bf16_t* pr = Pw + (size_t)(it * 32 + crow(r, hi)) * NP + C_GATE;
                pr[c] = (bf16_t)f2bf(a0[r]);
                if (c < 16) pr[32 + c] = (bf16_t)f2bf(a1[r]);
            }
        }
    }
    __syncthreads();
    {
        LAS float* H = (LAS float*)lds;
        const int c = lane & 31, hi = lane >> 5, rg = wave >> 2, nt = wave & 3;
        for (int it = blockIdx.x; it < 128; it += gridDim.x) {
            const int kv = it >> 6, bg = (it >> 4) & 3, rt = it & 15, b = bg >> 1, g = bg & 1;
            const float* pos = (kv ? a.cmp_pos_v : a.cmp_pos_k) + (size_t)layer * 32 * 64;
            const bf16_t* w1t = (const bf16_t*)(ws + WS_CW1) + (size_t)(layer * 2 + kv) * 128 * 2048;
            const float* w2 = (kv ? a.cmp_w2_v : a.cmp_w2_k) + (size_t)layer * 128 * 64;
            int irow = rt * 64 + rg * 32 + c; irow = irow > 1022 ? 1022 : irow;
            const bf16_t* src = P + (size_t)(b * S + 16 * irow) * NP + (kv ? C_VC : C_KC) + g * 64;
            const bf16_t* bsrc = w1t + (size_t)(nt * 32 + c) * 2048 + hi * 8;
            f32x16 acc;
#pragma unroll
            for (int r = 0; r < 16; ++r) acc[r] = 0.f;
#pragma unroll 4
            for (int kk = 0; kk < 128; ++kk) {
                const int tok = kk >> 2, d = (kk & 3) * 16 + hi * 8;
                const u32x4 sv = *(const u32x4*)(src + (size_t)tok * NP + d);
                const f32x4 p0 = *(const f32x4*)(pos + tok * 64 + d), p1 = *(const f32x4*)(pos + tok * 64 + d + 4);
                const bf16x8 af = pack8(bflo(sv.x) + p0.x, bfhi(sv.x) + p0.y, bflo(sv.y) + p0.z, bfhi(sv.y) + p0.w,
                                        bflo(sv.z) + p1.x, bfhi(sv.z) + p1.y, bflo(sv.w) + p1.z, bfhi(sv.w) + p1.w);
                const bf16x8 bf = *(const bf16x8*)(bsrc + kk * 16);
                acc = MFMA32(af, bf, acc);
            }
#pragma unroll
            for (int r = 0; r < 16; ++r) H[(rg * 32 + crow(r, hi)) * 129 + nt * 32 + c] = gelu_tanh(acc[r]);
            __syncthreads();
            {
                const int i = tid >> 3, dc = (tid & 7) * 8;
                float o[8];
#pragma unroll
                for (int e = 0; e < 8; ++e) o[e] = 0.f;
                for (int n = 0; n < 128; ++n) {
                    const float hv = H[i * 129 + n];
                    const f32x4 wa = *(const f32x4*)(w2 + n * 64 + dc), wb = *(const f32x4*)(w2 + n * 64 + dc + 4);
                    o[0] += hv * wa.x; o[1] += hv * wa.y; o[2] += hv * wa.z; o[3] += hv * wa.w;
                    o[4] += hv * wb.x; o[5] += hv * wb.y; o[6] += hv * wb.z; o[7] += hv * wb.w;
                }
                const int ig = rt * 64 + i;
                if (ig > 1022) {
#pragma unroll
                    for (int e = 0; e < 8; ++e) o[e] = 0.f;
                }
                if (kv == 0) {
                    u32x4 w; w.x = pk2(o[0], o[1]); w.y = pk2(o[2], o[3]); w.z = pk2(o[4], o[5]); w.w = pk2(o[6], o[7]);
                    float ss = bflo(w.x) * bflo(w.x) + bfhi(w.x) * bfhi(w.x) + bflo(w.y) * bflo(w.y) + bfhi(w.y) * bfhi(w.y)
                             + bflo(w.z) * bflo(w.z) + bfhi(w.z) * bfhi(w.z) + bflo(w.w) * bflo(w.w) + bfhi(w.w) * bfhi(w.w);
                    ss += __shfl_xor(ss, 1); ss += __shfl_xor(ss, 2); ss += __shfl_xor(ss, 4);
                    ss = fmaxf(ss, __shfl_xor(ss, 8)); ss = fmaxf(ss, __shfl_xor(ss, 16)); ss = fmaxf(ss, __shfl_xor(ss, 32));
                    if (lane == 0) atomicMax((unsigned*)(ws + WS_KMAX) + (layer * 4 + 3) * 4 + bg, __builtin_bit_cast(unsigned, ss));
                    const int q = dc >> 3;
                    *(u32x4*)((bf16_t*)(ws + WS_KC) + (size_t)bg * NCP * 64 + (size_t)(ig >> 5) * 2048 + ((q >> 1) * 64 + (q & 1) * 32 + (ig & 31)) * 8) = w;
                } else {
                    const int kk5 = ig & 31, jj = kk5 >> 4, rem = kk5 & 15, hh1 = (rem >> 2) & 1, ii = (rem >> 3) * 4 + (rem & 3);
                    bf16_t* vt = (bf16_t*)(ws + WS_VCT) + (size_t)bg * 64 * NCP + (size_t)(ig >> 5) * 2048 + ii;
#pragma unroll
                    for (int e = 0; e < 8; ++e) { const int dd = dc + e; vt[((jj * 2 + (dd >> 5)) * 64 + hh1 * 32 + (dd & 31)) * 8] = (bf16_t)f2bf(o[e]); }
                }
            }
            __syncthreads();
        }
    }
}

constexpr float LOG2E = 1.4426950408889634f, SC2 = 0.125f * 1.4426950408889634f;
DI float ex2(float x) { return __builtin_amdgcn_exp2f(x); }
DI void loadK32(const bf16_t* kt, int lane, bf16x8 (&k)[4]) {
#pragma unroll
    for (int kk = 0; kk < 4; ++kk) k[kk] = *(const bf16x8*)(kt + (kk * 64 + lane) * 8);
}
DI f32x16 qk32r(const bf16x8 (&k)[4], const bf16x8 (&q)[4]) {
    f32x16 s;
#pragma unroll
    for (int r = 0; r < 16; ++r) s[r] = 0.f;
#pragma unroll
    for (int kk = 0; kk < 4; ++kk) s = MFMA32(k[kk], q[kk], s);
    return s;
}
DI void loadV32(const bf16_t* vt, int lane, bf16x8 (&v)[2][2]) {
#pragma unroll
    for (int j = 0; j < 2; ++j)
#pragma unroll
        for (int dt = 0; dt < 2; ++dt) v[j][dt] = *(const bf16x8*)(vt + ((j * 2 + dt) * 64 + lane) * 8);
}
DI void pv32r(const f32x16& p, const bf16x8 (&v)[2][2], f32x16& o0, f32x16& o1) {
#pragma unroll
    for (int j = 0; j < 2; ++j) {
        const bf16x8 pb = pack8(p[8 * j], p[8 * j + 1], p[8 * j + 2], p[8 * j + 3], p[8 * j + 4], p[8 * j + 5], p[8 * j + 6], p[8 * j + 7]);
        o0 = MFMA32(v[j][0], pb, o0);
        o1 = MFMA32(v[j][1], pb, o1);
    }
}
template <bool MASKED>
DI bool softmax32(f32x16& s, unsigned vm, float& m, float& l, float& alpha) {
    float sum = 0.f;
#pragma unroll
    for (int r = 0; r < 16; ++r) { float p = ex2(s[r] - m); if (MASKED) p = ((vm >> r) & 1u) ? p : 0.f; s[r] = p; sum += p; }
    l += sum; alpha = 1.f;
    return false;
}
#define DPPF(v, ctrl) __builtin_bit_cast(float, __builtin_amdgcn_update_dpp(0, __builtin_bit_cast(int, (v)), (ctrl), 0xF, 0xF, false))
#define DPPI(v, ctrl) __builtin_amdgcn_update_dpp(0, (v), (ctrl), 0xF, 0xF, false)
DI float sum8_dpp(float v) {
    v += __builtin_bit_cast(float, __builtin_amdgcn_update_dpp(0, __builtin_bit_cast(int, v), 0xB1, 0xF, 0xF, false));
    v += __builtin_bit_cast(float, __builtin_amdgcn_update_dpp(0, __builtin_bit_cast(int, v), 0x4E, 0xF, 0xF, false));
    v += __builtin_bit_cast(float, __builtin_amdgcn_update_dpp(0, __builtin_bit_cast(int, v), 0x141, 0xF, 0xF, false));
    return v;
}
DI float sumsq8(const bf16x8 v) { const u32x4 w = __builtin_bit_cast(u32x4, v);
    return bflo(w.x) * bflo(w.x) + bfhi(w.x) * bfhi(w.x) + bflo(w.y) * bflo(w.y) + bfhi(w.y) * bfhi(w.y) + bflo(w.z) * bflo(w.z) + bfhi(w.z) * bfhi(w.z) + bflo(w.w) * bflo(w.w) + bfhi(w.w) * bfhi(w.w); }
DI unsigned logits_cmp(f32x16& s, int key0, int qpos, int hi, const LAS float* bias_h) {
    unsigned vm = 0u;
#pragma unroll
    for (int r = 0; r < 16; ++r) {
        const int dist = qpos - (16 * (key0 + crow(r, hi)) + 31);
        const bool valid = dist >= 0;
        const float bb = bias_h[rel_bucket(dist < 0 ? 0 : dist)];
        s[r] = valid ? s[r] * SC2 + bb : NEGF;
        vm |= valid ? (1u << r) : 0u;
    }
    return vm;
}

constexpr int AW_IMP = 0, AW_OLDS = 4128, AW_SEL = 4128 + 8320, AW_NSEL = AW_SEL + 256, AW_BYTES = 12800;
constexpr int ATT_BIAS_OFF = 8 * AW_BYTES;
constexpr int LUTW_STRIDE = 612, LUTB_STRIDE = 228;
constexpr int ATT_LUTW_OFF = ATT_BIAS_OFF + 4096, ATT_LUTB_OFF = ATT_LUTW_OFF + 8 * LUTW_STRIDE * 4, ATT_LDS_END = ATT_LUTB_OFF + 8 * LUTB_STRIDE * 4;
static_assert(ATT_LDS_END <= LDS_BYTES, "attention LDS map");

template <int W>
DI void window_branch(const bf16_t* Kf  , const bf16_t* Vf  , int lane,
                      const bf16x8 (&qf)[4], const LAS float* lut_h  , int q0, int qpos, int c, int hi,
                      float& m, float& l, f32x16& o0, f32x16& o1) {
    const int kd = q0 & ~31;
    int kstart = q0 - (W - 1); kstart = kstart < 0 ? 0 : kstart; kstart &= ~31;
    bf16x8 kc[4];
    loadK32(Kf + (size_t)(kd >> 5) * 2048, lane, kc);
    const float sini = -m * (1.f / SC2);
#pragma unroll 1
    for (int key0 = kd; key0 >= kstart; key0 -= 32) {
        bf16x8 vf[2][2], kn[4];
        loadV32(Vf + (size_t)(key0 >> 5) * 2048, lane, vf);
        const int nk = key0 - 32 >= kstart ? key0 - 32 : key0;
        loadK32(Kf + (size_t)(nk >> 5) * 2048, lane, kn);
        f32x16 s;
#pragma unroll
        for (int r = 0; r < 16; ++r) s[r] = sini;
#pragma unroll
        for (int kk = 0; kk < 4; ++kk) s = MFMA32(kc[kk], qf[kk], s);
        const LAS float* pt = lut_h + (qpos - key0 - 4 * hi - 27);
        float sum = 0.f;
#pragma unroll
        for (int r = 0; r < 16; ++r) { const float p = ex2(s[r] * SC2 + pt[27 - ((r & 3) + 8 * (r >> 2))]); s[r] = p; sum += p; }
        l += sum;
        pv32r(s, vf, o0, o1);
#pragma unroll
        for (int kk = 0; kk < 4; ++kk) kc[kk] = kn[kk];
    }
}

DI void phase_attn(const Args& a, int layer, LAS unsigned char* lds) {
    const int tid = opaque_tid(), lane = tid & 63, wave = tid >> 6;
    unsigned char* ws = a.ws;
    const bf16_t* P = (const bf16_t*)(ws + WS_P);
    bf16_t* O = (bf16_t*)(ws + WS_O);
    const int bg = blockIdx.x & 3, b = bg >> 1, g = bg & 1, wq = blockIdx.x >> 2, nwq = gridDim.x >> 2;
    LAS float* bias = (LAS float*)(lds + ATT_BIAS_OFF);
    LAS float* lutW = (LAS float*)(lds + ATT_LUTW_OFF);
    LAS float* lutB = (LAS float*)(lds + ATT_LUTB_OFF);
    for (int i = tid; i < 1024; i += NTHREADS) bias[i] = a.rel_bias[(i & 31) * 32 + (i >> 5)] * LOG2E;
    for (int i = tid; i < 8 * LUTW_STRIDE; i += NTHREADS) { const int hh = i / LUTW_STRIDE, dist = i % LUTW_STRIDE - 32;
        lutW[i] = (dist >= 0 && dist < 512) ? a.rel_bias[rel_bucket(dist) * 32 + g * 8 + hh] * LOG2E : NEGF; }
    for (int i = tid; i < 8 * LUTB_STRIDE; i += NTHREADS) { const int hh = i / LUTB_STRIDE, dist = i % LUTB_STRIDE - 32;
        lutB[i] = (dist >= 0 && dist < 128) ? a.rel_bias[rel_bucket(dist) * 32 + 16 + g * 8 + hh] * LOG2E : NEGF; }
    __syncthreads();
    LAS unsigned char* wl = lds + wave * AW_BYTES;
    LAS float* imp = (LAS float*)(wl + AW_IMP);
    LAS float* olds = (LAS float*)(wl + AW_OLDS);
    LAS int* sel = (LAS int*)(wl + AW_SEL);
    LAS int* nsel = (LAS int*)(wl + AW_NSEL);
    const int c = lane & 31, hi = lane >> 5, ql = c >> 3, h = c & 7;
    const bf16_t* Pb = P + (size_t)b * S * NP;
    const bf16_t* kcb = (const bf16_t*)(ws + WS_KC) + (size_t)bg * NCP * 64;
    const bf16_t* vct = (const bf16_t*)(ws + WS_VCT) + (size_t)bg * 64 * NCP;
    const bf16_t* vst = (const bf16_t*)(ws + WS_VST) + (size_t)bg * 64 * S;
    const bf16_t* vwt = (const bf16_t*)(ws + WS_VWT) + (size_t)bg * 64 * S;
    const bf16_t* kwf = (const bf16_t*)(ws + WS_KWF) + (size_t)bg * 64 * S;
    const bf16_t* kbf = (const bf16_t*)(ws + WS_KBF) + (size_t)bg * 64 * S;
    const bf16_t* ksf = (const bf16_t*)(ws + WS_KSF) + (size_t)bg * 64 * S;
    const bf16_t* vbt = (const bf16_t*)(ws + WS_VBT) + (size_t)bg * 64 * S;
    const float sinkv = a.sinks[layer * 16 + g * 8 + h] * LOG2E;
    const LAS float* bias_a = bias + (g * 8 + h) * 32;
    const float b31 = bias_a[31];
    const unsigned* kmx = (const unsigned*)(ws + WS_KMAX) + layer * 16 + bg;
    const float knS = sqrtf(__builtin_bit_cast(float, kmx[0])) * SC2, knW = sqrtf(__builtin_bit_cast(float, kmx[4])) * SC2;
    const float knB = sqrtf(__builtin_bit_cast(float, kmx[8])) * SC2, knC = sqrtf(__builtin_bit_cast(float, kmx[12])) * SC2;
    float bmaxA = bias_a[0], bmaxB = bias[(16 + g * 8 + h) * 32];
    for (int k = 1; k < 32; ++k) { bmaxA = fmaxf(bmaxA, bias_a[k]); bmaxB = fmaxf(bmaxB, bias[(16 + g * 8 + h) * 32 + k]); }
    bmaxA += 0.01f; bmaxB += 0.01f;

#pragma unroll 1
    for (int qt0 = wq; qt0 < S / 32 && wq < nwq; qt0 += nwq) {
        const int rnd = qt0 / nwq, qt32 = ((rnd & 1) && (rnd + 1) * nwq <= S / 32) ? rnd * nwq + (nwq - 1 - wq) : qt0;
        const int q0 = qt32 * 32 + wave * 4;
        const int qpos = q0 + ql;
        const size_t mrow = (size_t)(b * S + qpos);
        const bf16_t* prow = P + mrow * NP;
        {
            bf16x8 qf[4];
#pragma unroll
            for (int kk = 0; kk < 4; ++kk) qf[kk] = *(const bf16x8*)(prow + C_QB + (g * 8 + h) * 64 + kk * 16 + hi * 8);
            float qn2 = sumsq8(qf[0]) + sumsq8(qf[1]) + sumsq8(qf[2]) + sumsq8(qf[3]); qn2 += __shfl_xor(qn2, 32);
            float m = sqrtf(qn2) * knB + bmaxB, l = hi == 0 ? ex2(sinkv - m) : 0.f;
            f32x16 o0, o1;
#pragma unroll
            for (int r = 0; r < 16; ++r) { o0[r] = 0.f; o1[r] = 0.f; }
            window_branch<128>(kbf, vbt, lane, qf, lutB + h * LUTB_STRIDE + 32, q0, qpos, c, hi, m, l, o0, o1);
            const float lt = l + __shfl_xor(l, 32), inv = 1.f / lt;
            bf16_t* orow = O + mrow * D + 1024 + (g * 8 + h) * 64;
#pragma unroll
            for (int dt = 0; dt < 2; ++dt)
#pragma unroll
                for (int q4 = 0; q4 < 4; ++q4) {
                    const f32x16& oo = dt ? o1 : o0;
                    u32x2 w; w.x = pk2(oo[4 * q4] * inv, oo[4 * q4 + 1] * inv); w.y = pk2(oo[4 * q4 + 2] * inv, oo[4 * q4 + 3] * inv);
                    *(u32x2*)(orow + dt * 32 + 8 * q4 + 4 * hi) = w;
                }
        }
        const float gt0 = sigmoidf_(bf2f(prow[C_GATE + (g * 8 + h) * 3 + 0]));
        bf16x8 qfa[4];
#pragma unroll
        for (int kk = 0; kk < 4; ++kk) qfa[kk] = *(const bf16x8*)(prow + C_QA + (g * 8 + h) * 64 + kk * 16 + hi * 8);
        float qnA; { float qn2 = sumsq8(qfa[0]) + sumsq8(qfa[1]) + sumsq8(qfa[2]) + sumsq8(qfa[3]); qn2 += __shfl_xor(qn2, 32); qnA = sqrtf(qn2); }
        for (int i = lane; i < 4 * 257; i += 64) imp[i] = 0.f;
        const int ntile = (q0 + 3) / 512 + 1;
        const int nfast = q0 >= 2040 ? (q0 - 2040) / 512 + 1 : 0;
        {
            float m = qnA * knC + bmaxA, l = 0.f;
            {
                bf16x8 kc[4];
                loadK32(kcb, lane, kc);
#pragma unroll 1
                for (int t = 0; t < ntile; ++t) {
                    bf16x8 kn[4];
                    const int tn = t + 1 < ntile ? t + 1 : t;
                    loadK32(kcb + (size_t)tn * 2048, lane, kn);
                    f32x16 s = qk32r(kc, qfa);
                    float alpha;
                    if (t < nfast) {
#pragma unroll
                        for (int r = 0; r < 16; ++r) s[r] = s[r] * SC2 + b31;
                        (void)softmax32<false>(s, 0u, m, l, alpha);
                    } else {
                        const unsigned vm = logits_cmp(s, t * 32, qpos, hi, bias_a);
                        (void)softmax32<true>(s, vm, m, l, alpha);
                    }
#pragma unroll
                    for (int kk = 0; kk < 4; ++kk) kc[kk] = kn[kk];
                }
            }
            const float lt = l + __shfl_xor(l, 32), inv = lt > 0.f ? 1.f / lt : 0.f;
            f32x16 o0, o1;
#pragma unroll
            for (int r = 0; r < 16; ++r) { o0[r] = 0.f; o1[r] = 0.f; }
            LDS_WAIT();
            bf16x8 kc[4];
            loadK32(kcb, lane, kc);
#pragma unroll 1
            for (int t = 0; t < ntile; ++t) {
                bf16x8 vf[2][2], kn[4];
                loadV32(vct + (size_t)t * 2048, lane, vf);
                const int tn = t + 1 < ntile ? t + 1 : t;
                loadK32(kcb + (size_t)tn * 2048, lane, kn);
                f32x16 s = qk32r(kc, qfa);
                if (t < nfast) {
#pragma unroll
                    for (int r = 0; r < 16; ++r) s[r] = ex2(s[r] * SC2 + (b31 - m)) * inv;
                } else {
                    const unsigned vm = logits_cmp(s, t * 32, qpos, hi, bias_a);
#pragma unroll
                    for (int r = 0; r < 16; ++r) s[r] = ((vm >> r) & 1u) ? ex2(s[r] - m) * inv : 0.f;
                }
#pragma unroll
                for (int grp = 0; grp < 4; ++grp) {
                    float wa = 2.f * (s[4 * grp] + s[4 * grp + 1] + s[4 * grp + 2]) + s[4 * grp + 3], wb = s[4 * grp + 3];
                    wa = sum8_dpp(wa); wb = sum8_dpp(wb);
                    const int j = t * 8 + 2 * grp + hi;
                    if (h == 0) {
                        (void)__hip_atomic_fetch_add(imp + ql * 257 + j, wa, __ATOMIC_RELAXED, __HIP_MEMORY_SCOPE_WORKGROUP);
                        (void)__hip_atomic_fetch_add(imp + ql * 257 + j + 1, wb, __ATOMIC_RELAXED, __HIP_MEMORY_SCOPE_WORKGROUP);
                    }
                }
                pv32r(s, vf, o0, o1);
#pragma unroll
                for (int kk = 0; kk < 4; ++kk) kc[kk] = kn[kk];
            }
#pragma unroll
            for (int r = 0; r < 16; ++r) { olds[c * 65 + crow(r, hi)] = gt0 * o0[r]; olds[c * 65 + 32 + crow(r, hi)] = gt0 * o1[r]; }
        }
        LDS_WAIT();
        {
            const int tq = lane >> 4, sub = lane & 15;
            const int qp = q0 + tq, cb = qp >> 6;
            float v[16];
#pragma unroll
            for (int i = 0; i < 16; ++i) { const int j = sub + 16 * i; v[i] = (j >= 1 && j <= cb - 2) ? imp[tq * 257 + j] : -1.f; }
            int n = (cb < 2 ? cb : 2) + 1;
            if (sub == 0) {
                sel[tq * 16 + 0] = 0;
                if (cb >= 1) sel[tq * 16 + n - 1] = cb;
                if (cb >= 2) sel[tq * 16 + 1] = cb - 1;
            }
#pragma unroll 1
            for (int k = 0; k < 13; ++k) {
                float bv = v[0]; int bj = sub;
#pragma unroll
                for (int i = 1; i < 16; ++i) { if (v[i] > bv) { bv = v[i]; bj = sub + 16 * i; } }
                { const float ov = DPPF(bv, 0xB1); const int oj = DPPI(bj, 0xB1); if (ov > bv || (ov == bv && oj < bj)) { bv = ov; bj = oj; } }
                { const float ov = DPPF(bv, 0x4E); const int oj = DPPI(bj, 0x4E); if (ov > bv || (ov == bv && oj < bj)) { bv = ov; bj = oj; } }
                { const float ov = DPPF(bv, 0x141); const int oj = DPPI(bj, 0x141); if (ov > bv || (ov == bv && oj < bj)) { bv = ov; bj = oj; } }
                { const float ov = DPPF(bv, 0x140); const int oj = DPPI(bj, 0x140); if (ov > bv || (ov == bv && oj < bj)) { bv = ov; bj = oj; } }
                if (bv >= 0.f) {
                    if (sub == 0) sel[tq * 16 + n] = bj;
                    n += 1;
#pragma unroll
                    for (int i = 0; i < 16; ++i) { if (bj == sub + 16 * i) v[i] = -1.f; }
                }
            }
            if (sub == 0) nsel[tq] = n;
        }
        LDS_WAIT();
        {
            const int hh = lane & 15, qd = lane >> 4, hd = hh & 7;
            const LAS float* bias_s = bias + (g * 8 + hd) * 32;
            const float b31s = bias_s[31];

#pragma unroll 1
            for (int qi = 0; qi < 4; ++qi) {
                const int qp = q0 + qi;
                const bf16_t* pr = Pb + (size_t)qp * NP;
                bf16x8 qf[2];
#pragma unroll
                for (int kk = 0; kk < 2; ++kk) qf[kk] = *(const bf16x8*)(pr + C_QA + (g * 8 + hd) * 64 + kk * 32 + qd * 8);
                float qs2 = sumsq8(qf[0]) + sumsq8(qf[1]); qs2 += __shfl_xor(qs2, 16); qs2 += __shfl_xor(qs2, 32);
                const float m = sqrtf(qs2) * knS + bmaxA; float l = 0.f;
                const bool lowc = hh < 8;
                const bf16x8 zero8 = {0, 0, 0, 0, 0, 0, 0, 0};
                bf16x8 qlo[2], qhi[2];
#pragma unroll
                for (int kk = 0; kk < 2; ++kk) { qlo[kk] = lowc ? qf[kk] : zero8; qhi[kk] = lowc ? zero8 : qf[kk]; }
                const int hs = hh >> 3;
                f32x4 o[4];
#pragma unroll
                for (int dt = 0; dt < 4; ++dt) o[dt] = (f32x4){0.f, 0.f, 0.f, 0.f};
                const int ns = __builtin_amdgcn_readfirstlane(nsel[qi]);
                int jb = __builtin_amdgcn_readfirstlane(sel[qi * 16]);
                bf16x8 ka[4][2];
#pragma unroll
                for (int t = 0; t < 4; ++t)
#pragma unroll
                    for (int kk = 0; kk < 2; ++kk) ka[t][kk] = *(const bf16x8*)(ksf + (size_t)jb * 4096 + ((t * 2 + kk) * 64 + lane) * 8);
#pragma unroll 1
                for (int k = 0; k < ns; ++k) {
                    bf16x8 va[2][4], kn[4][2];
#pragma unroll
                    for (int j = 0; j < 2; ++j)
#pragma unroll
                        for (int dt = 0; dt < 4; ++dt) va[j][dt] = *(const bf16x8*)(vst + (size_t)jb * 4096 + ((j * 4 + dt) * 64 + lane) * 8);
                    const int jn = __builtin_amdgcn_readfirstlane(sel[qi * 16 + (k + 1 < ns ? k + 1 : k)]);
#pragma unroll
                    for (int t = 0; t < 4; ++t)
#pragma unroll
                        for (int kk = 0; kk < 2; ++kk) kn[t][kk] = *(const bf16x8*)(ksf + (size_t)jn * 4096 + ((t * 2 + kk) * 64 + lane) * 8);
                    f32x4 s[2];
#pragma unroll
                    for (int u = 0; u < 2; ++u) {
                        s[u] = (f32x4){0.f, 0.f, 0.f, 0.f};
#pragma unroll
                        for (int kk = 0; kk < 2; ++kk) { s[u] = MFMA16(ka[2 * u][kk], qlo[kk], s[u]); s[u] = MFMA16(ka[2 * u + 1][kk], qhi[kk], s[u]); }
                    }
                    if (qp - (jb * 64 + 63) >= 1513) {
                        const float cst = b31s - m;
#pragma unroll
                        for (int u = 0; u < 2; ++u)
#pragma unroll
                            for (int r = 0; r < 4; ++r) s[u][r] = s[u][r] * SC2 + cst;
                    } else {
#pragma unroll
                        for (int u = 0; u < 2; ++u)
#pragma unroll
                            for (int r = 0; r < 4; ++r) {
                                const int dist = qp - (jb * 64 + 16 * (2 * u + hs) + 4 * qd + r);
                                const float bb = bias_s[rel_bucket(dist < 0 ? 0 : dist)];
                                s[u][r] = dist >= 0 ? s[u][r] * SC2 + (bb - m) : NEGF;
                            }
                    }
                    float sum = 0.f;
#pragma unroll
                    for (int u = 0; u < 2; ++u)
#pragma unroll
                        for (int r = 0; r < 4; ++r) { const float p = ex2(s[u][r]); s[u][r] = p; sum += p; }
                    l += sum;
                    {
                        const bf16x8 p8 = pack8(s[0][0], s[0][1], s[0][2], s[0][3], s[1][0], s[1][1], s[1][2], s[1][3]);
                        const bf16x8 plo = lowc ? p8 : zero8, phi = lowc ? zero8 : p8;
#pragma unroll
                        for (int dt = 0; dt < 4; ++dt) { o[dt] = MFMA16(va[0][dt], plo, o[dt]); o[dt] = MFMA16(va[1][dt], phi, o[dt]); }
                    }
                    jb = jn;
#pragma unroll
                    for (int t = 0; t < 4; ++t)
#pragma unroll
                        for (int kk = 0; kk < 2; ++kk) ka[t][kk] = kn[t][kk];
                }
                float lt = l + __shfl_xor(l, 16); lt += __shfl_xor(lt, 32); lt += __shfl_xor(lt, 8);
#pragma unroll
                for (int dt = 0; dt < 4; ++dt)
#pragma unroll
                    for (int r = 0; r < 4; ++r) o[dt][r] += __shfl_xor(o[dt][r], 8);
                const float gt1 = sigmoidf_(bf2f(Pb[(size_t)qp * NP + C_GATE + (g * 8 + hd) * 3 + 1]));
                const float inv = lt > 0.f ? gt1 / lt : 0.f;
                if (hh < 8) {
#pragma unroll
                    for (int dt = 0; dt < 4; ++dt)
#pragma unroll
                        for (int r = 0; r < 4; ++r) olds[(qi * 8 + hh) * 65 + 16 * dt + 4 * qd + r] += o[dt][r] * inv;
                }
            }
        }
        LDS_WAIT();
        {
            int lw = lane; asm volatile("" : "+v"(lw));
            const int c = lw & 31, hi = lw >> 5, h = c & 7, qpos = q0 + (c >> 3);
            const size_t mrow = (size_t)(b * S + qpos);
            const bf16_t* prow = P + mrow * NP;
            const float gt2 = sigmoidf_(bf2f(prow[C_GATE + (g * 8 + h) * 3 + 2]));
            bf16x8 qfw[4];
#pragma unroll
            for (int kk = 0; kk < 4; ++kk) qfw[kk] = *(const bf16x8*)(prow + C_QA + (g * 8 + h) * 64 + kk * 16 + hi * 8);
            float qnW; { float qn2 = sumsq8(qfw[0]) + sumsq8(qfw[1]) + sumsq8(qfw[2]) + sumsq8(qfw[3]); qn2 += __shfl_xor(qn2, 32); qnW = sqrtf(qn2); }
            float m = qnW * knW + bmaxA, l = 0.f;
            f32x16 o0, o1;
#pragma unroll
            for (int r = 0; r < 16; ++r) { o0[r] = 0.f; o1[r] = 0.f; }
            window_branch<512>(kwf, vwt, lw, qfw, lutW + h * LUTW_STRIDE + 32, q0, qpos, c, hi, m, l, o0, o1);
            const float lt = l + __shfl_xor(l, 32), inv = lt > 0.f ? gt2 / lt : 0.f;
            bf16_t* orow = O + mrow * D + (g * 8 + h) * 64;
#pragma unroll
            for (int dt = 0; dt < 2; ++dt)
#pragma unroll
                for (int q4 = 0; q4 < 4; ++q4) {
                    const f32x16& oo = dt ? o1 : o0;
                    const int d0 = dt * 32 + 8 * q4 + 4 * hi;
                    const float e0 = oo[4 * q4] * inv + olds[c * 65 + d0], e1 = oo[4 * q4 + 1] * inv + olds[c * 65 + d0 + 1];
                    const float e2 = oo[4 * q4 + 2] * inv + olds[c * 65 + d0 + 2], e3 = oo[4 * q4 + 3] * inv + olds[c * 65 + d0 + 3];
                    u32x2 w; w.x = pk2(e0, e1); w.y = pk2(e2, e3);
                    *(u32x2*)(orow + d0) = w;
                }
        }
        LDS_WAIT();
    }
}

DI unsigned ordf(float f) { const unsigned u = __builtin_bit_cast(unsigned, f); return (u & 0x80000000u) ? ~u : (u | 0x80000000u); }
DI float unordf(unsigned k) { const unsigned u = (k & 0x80000000u) ? (k & 0x7fffffffu) : ~k; return __builtin_bit_cast(float, u); }

DI void peer_half_topk(const bf16_t* qrow  , const bf16_t* subk  , int hi, int lane, LAS unsigned* ltop) {
    unsigned keys[64];
    asm volatile("" : "+v"(subk));
#pragma unroll
    for (int rt = 0; rt < 4; ++rt) {
        f32x16 acc;
#pragma unroll
        for (int r = 0; r < 16; ++r) acc[r] = 0.f;
#pragma unroll
        for (int kk = 0; kk < 8; ++kk) {
            const bf16x8 af = *(const bf16x8*)(subk + (size_t)(rt * 32) * 128 + kk * 16);
            const bf16x8 bf = *(const bf16x8*)(qrow + kk * 16);
            acc = MFMA32(af, bf, acc);
        }
#pragma unroll
        for (int r = 0; r < 16; ++r) { const int n = rt * 32 + crow(r, hi); keys[rt * 16 + r] = (ordf(acc[r]) & ~0x7Fu) | (unsigned)(127 - n); }
    }
#pragma unroll 1
    for (int k = 0; k < 16; ++k) {
        unsigned mx = keys[0];
#pragma unroll
        for (int i = 1; i < 64; ++i) mx = mx > keys[i] ? mx : keys[i];
        const unsigned om = (unsigned)__shfl_xor((int)mx, 32);
        mx = mx > om ? mx : om;
        ltop[k * 64 + lane] = mx;
#pragma unroll
        for (int i = 0; i < 64; ++i) keys[i] = keys[i] == mx ? 0u : keys[i];
    }
}

DI void phase_peer_select(const Args& a, int layer, LAS unsigned char* lds) {
    const int tid = opaque_tid(), lane = tid & 63, wave = tid >> 6;
    const int gw = blockIdx.x * 8 + wave, NGW = gridDim.x * 8;
    unsigned char* ws = a.ws;
    const bf16_t* Q2 = (const bf16_t*)(ws + WS_Q2);
    const bf16_t* subk = (const bf16_t*)(ws + WS_SUBK) + (size_t)layer * 2 * 128 * 128;
    int* IDX = (int*)(ws + WS_IDX);
    float* GATE = (float*)(ws + WS_GATE);
    LAS unsigned* lt1 = (LAS unsigned*)(lds + wave * 8192);
    LAS unsigned* lt2 = lt1 + 1024;
    const int c = lane & 31, hi = lane >> 5, tl = c >> 3, h = c & 7;
#pragma unroll 1
    for (int unit = gw; unit < M / 4; unit += NGW) {
        const size_t m = (size_t)unit * 4 + tl;
        const bf16_t* qrow = Q2 + m * D + h * 256 + hi * 8;
        peer_half_topk(qrow, subk + (size_t)c * 128 + hi * 8, hi, lane, lt1);
        peer_half_topk(qrow + 128, subk + 128 * 128 + (size_t)c * 128 + hi * 8, hi, lane, lt2);
        LDS_WAIT();
        unsigned t1[16], t2[16];
#pragma unroll
        for (int i = 0; i < 16; ++i) { t1[i] = lt1[i * 64 + lane]; t2[i] = lt2[i * 64 + lane]; }
        unsigned ck[16][16];
#pragma unroll
        for (int x = 0; x < 16; ++x)
#pragma unroll
            for (int y = 0; y < 16; ++y)
                if ((x + 1) * (y + 1) <= 16) ck[x][y] = (ordf(unordf(t1[x] & ~0x7Fu) + unordf(t2[y] & ~0x7Fu)) & ~0xFFu) | (unsigned)(255 - (x * 16 + y));
        const float scmax = unordf(ck[0][0] & ~0xFFu);
        int* ip = IDX + m * 128 + h * 16; float* gp = GATE + m * 128 + h * 16;
        float sum = 0.f;
#pragma unroll 1
        for (int k = 0; k < 16; ++k) {
            unsigned mx = 0u;
#pragma unroll
            for (int x = 0; x < 16; ++x)
#pragma unroll
                for (int y = 0; y < 16; ++y)
                    if ((x + 1) * (y + 1) <= 16) mx = mx > ck[x][y] ? mx : ck[x][y];
#pragma unroll
            for (int x = 0; x < 16; ++x)
#pragma unroll
                for (int y = 0; y < 16; ++y)
                    if ((x + 1) * (y + 1) <= 16) ck[x][y] = ck[x][y] == mx ? 0u : ck[x][y];
            const int ci = 255 - (int)(mx & 0xFFu);
            const int e = (int)(127u - (lt1[(ci >> 4) * 64 + lane] & 0x7Fu)) * 128 + (int)(127u - (lt2[(ci & 15) * 64 + lane] & 0x7Fu));
            const float ek = __expf(unordf(mx & ~0xFFu) - scmax);
            sum += ek;
            if (hi == 0) { ip[k] = e; gp[k] = ek; }
        }
        if (hi == 0) ((float*)(ws + WS_GSUM))[m * 8 + h] = 1.f / sum;
        LDS_WAIT();
    }
}

#define FP8_LO(w) __builtin_amdgcn_cvt_pk_f32_fp8((int)(w), false)
#define FP8_HI(w) __builtin_amdgcn_cvt_pk_f32_fp8((int)(w), true)
DI float dot16(const float (&x)[32], int o, const u32x4 w) {
    const f32x2 a0 = FP8_LO(w.x), a1 = FP8_HI(w.x), a2 = FP8_LO(w.y), a3 = FP8_HI(w.y), a4 = FP8_LO(w.z), a5 = FP8_HI(w.z), a6 = FP8_LO(w.w), a7 = FP8_HI(w.w);
    return (x[o + 0] * a0.x + x[o + 1] * a0.y + x[o + 2] * a1.x + x[o + 3] * a1.y) + (x[o + 4] * a2.x + x[o + 5] * a2.y + x[o + 6] * a3.x + x[o + 7] * a3.y)
         + (x[o + 8] * a4.x + x[o + 9] * a4.y + x[o + 10] * a5.x + x[o + 11] * a5.y) + (x[o + 12] * a6.x + x[o + 13] * a6.y + x[o + 14] * a7.x + x[o + 15] * a7.y);
}
DI float dot16p(const u32x4 xa, const u32x4 xb, const u32x4 w) {
    const f32x2 a0 = FP8_LO(w.x), a1 = FP8_HI(w.x), a2 = FP8_LO(w.y), a3 = FP8_HI(w.y), a4 = FP8_LO(w.z), a5 = FP8_HI(w.z), a6 = FP8_LO(w.w), a7 = FP8_HI(w.w);
    return (bflo(xa.x) * a0.x + bfhi(xa.x) * a0.y + bflo(xa.y) * a1.x + bfhi(xa.y) * a1.y) + (bflo(xa.z) * a2.x + bfhi(xa.z) * a2.y + bflo(xa.w) * a3.x + bfhi(xa.w) * a3.y)
         + (bflo(xb.x) * a4.x + bfhi(xb.x) * a4.y + bflo(xb.y) * a5.x + bfhi(xb.y) * a5.y) + (bflo(xb.z) * a6.x + bfhi(xb.z) * a6.y + bflo(xb.w) * a7.x + bfhi(xb.w) * a7.y);
}
DI void axpy16(float (&acc)[32], int o, float g, const u32x4 w) {
    const f32x2 a0 = FP8_LO(w.x), a1 = FP8_HI(w.x), a2 = FP8_LO(w.y), a3 = FP8_HI(w.y), a4 = FP8_LO(w.z), a5 = FP8_HI(w.z), a6 = FP8_LO(w.w), a7 = FP8_HI(w.w);
    acc[o + 0] += g * a0.x; acc[o + 1] += g * a0.y; acc[o + 2] += g * a1.x; acc[o + 3] += g * a1.y; acc[o + 4] += g * a2.x; acc[o + 5] += g * a2.y; acc[o + 6] += g * a3.x; acc[o + 7] += g * a3.y;
    acc[o + 8] += g * a4.x; acc[o + 9] += g * a4.y; acc[o + 10] += g * a5.x; acc[o + 11] += g * a5.y; acc[o + 12] += g * a6.x; acc[o + 13] += g * a6.y; acc[o + 14] += g * a7.x; acc[o + 15] += g * a7.y;
}
DI void gat_load8(const unsigned char* base, int idlo, int idhi, int g4, unsigned lo16, u32x4 (&buf)[8]) {
    const int ids = g4 < 16 ? idlo : idhi, e0 = (g4 & 15) * 4;
#pragma unroll
    for (int j = 0; j < 4; ++j) { const unsigned of = (unsigned)__shfl(ids, e0 + j) * (unsigned)D + lo16; buf[2 * j] = *(const u32x4*)(base + of); buf[2 * j + 1] = *(const u32x4*)(base + of + 1024u); }
}
DI float dots4(const u32x4 (&xp)[4], const u32x4 b0, const u32x4 b1, const u32x4 b2, const u32x4 b3, const u32x4 b4, const u32x4 b5, const u32x4 b6, const u32x4 b7, int lane) {
    const float d0 = dot16p(xp[0], xp[1], b0) + dot16p(xp[2], xp[3], b1); __builtin_amdgcn_sched_barrier(0);
    const float d1 = dot16p(xp[0], xp[1], b2) + dot16p(xp[2], xp[3], b3); __builtin_amdgcn_sched_barrier(0);
    const float d2 = dot16p(xp[0], xp[1], b4) + dot16p(xp[2], xp[3], b5); __builtin_amdgcn_sched_barrier(0);
    const float d3 = dot16p(xp[0], xp[1], b6) + dot16p(xp[2], xp[3], b7); __builtin_amdgcn_sched_barrier(0);
    const bool p1 = lane & 1, p2 = lane & 2;
    const float b0s = (p1 ? d1 : d0) + __shfl_xor(p1 ? d0 : d1, 1);
    const float b1s = (p1 ? d3 : d2) + __shfl_xor(p1 ? d2 : d3, 1);
    float cs = (p2 ? b1s : b0s) + __shfl_xor(p2 ? b0s : b1s, 2);
    cs += __shfl_xor(cs, 4); cs += __shfl_xor(cs, 8); cs += __shfl_xor(cs, 16); cs += __shfl_xor(cs, 32);
    return cs;
}
DI void phase_peer_u(const Args& a, int layer) {
    const int tid = opaque_tid(), lane = tid & 63, wave = tid >> 6;
    const int gw = blockIdx.x * 8 + wave, NGW = gridDim.x * 8;
    unsigned char* ws = a.ws;
    const bf16_t* XN = (const bf16_t*)(ws + WS_XN);
    const unsigned char* U = ws + WS_U + (size_t)layer * NEXP * D;
    const unsigned lo16 = (unsigned)lane * 16u;
    const int* IDX = (const int*)(ws + WS_IDX);
    float* GATE = (float*)(ws + WS_GATE);
    const float* GSUM = (const float*)(ws + WS_GSUM);
    int m = gw;
    if (m < M) {
        int idA = IDX[(size_t)m * 128 + lane], idB = IDX[(size_t)m * 128 + 64 + lane];
        u32x4 xp[4];
#pragma unroll
        for (int q = 0; q < 4; ++q) xp[q] = *(const u32x4*)(XN + (size_t)m * D + (q >> 1) * 1024 + lane * 16 + (q & 1) * 8);
        u32x4 cur[8];
        gat_load8(U, idA, idB, 0, lo16, cur);
#pragma unroll 1
        for (; m < M; m += NGW) {
            const int mn = m + NGW < M ? m + NGW : m;
            const int idAn = IDX[(size_t)mn * 128 + lane], idBn = IDX[(size_t)mn * 128 + 64 + lane];
            u32x4 xpn[4];
#pragma unroll
            for (int q = 0; q < 4; ++q) xpn[q] = *(const u32x4*)(XN + (size_t)mn * D + (q >> 1) * 1024 + lane * 16 + (q & 1) * 8);
            const float glA = GATE[(size_t)m * 128 + lane] * GSUM[(size_t)m * 8 + (lane >> 4)] * (1.f / V_SCALE);
            const float glB = GATE[(size_t)m * 128 + 64 + lane] * GSUM[(size_t)m * 8 + 4 + (lane >> 4)] * (1.f / V_SCALE);
            float ghA = 0.f, ghB = 0.f;
            const float rstdu = __builtin_bit_cast(float, __builtin_amdgcn_readfirstlane(__builtin_bit_cast(int, rsqrtf(wave_sum(lane < 32 ? ((const float*)(ws + WS_RSS))[((size_t)layer * M + m) * 32 + lane] : 0.f) * (1.f / D) + 1e-6f) * (1.f / U_SCALE))));
#pragma unroll 1
            for (int g4 = 0; g4 < 32; ++g4) {
                u32x4 nxt[8];
                if (g4 < 31) gat_load8(U, idA, idB, g4 + 1, lo16, nxt); else gat_load8(U, idAn, idBn, 0, lo16, nxt);
                const float c0 = dots4(xp, cur[0], cur[1], cur[2], cur[3], cur[4], cur[5], cur[6], cur[7], lane);
                const float hv = gelu_tanh(c0 * rstdu);
                const bool mine = (lane >> 2) == (g4 & 15);
                if (g4 < 16) ghA = mine ? hv * glA : ghA; else ghB = mine ? hv * glB : ghB;
#pragma unroll
                for (int j = 0; j < 8; ++j) cur[j] = nxt[j];
            }
            GATE[(size_t)m * 128 + lane] = ghA; GATE[(size_t)m * 128 + 64 + lane] = ghB;
            idA = idAn; idB = idBn;
#pragma unroll
            for (int q = 0; q < 4; ++q) xp[q] = xpn[q];
        }
    }
}
DI void phase_peer_v(const Args& a, int layer) {
    const int tid = opaque_tid(), lane = tid & 63, wave = tid >> 6;
    const int gw = blockIdx.x * 8 + wave, NGW = gridDim.x * 8;
    unsigned char* ws = a.ws;
    const unsigned char* V = ws + WS_V + (size_t)layer * NEXP * D;
    const unsigned lo16 = (unsigned)lane * 16u;
    const int* IDX = (const int*)(ws + WS_IDX);
    const float* GH = (const float*)(ws + WS_GATE);
    int m = gw;
    if (m < M) {
        int idA = IDX[(size_t)m * 128 + lane], idB = IDX[(size_t)m * 128 + 64 + lane];
        u32x4 cur[8];
        gat_load8(V, idA, idB, 0, lo16, cur);
#pragma unroll 1
        for (; m < M; m += NGW) {
            const int mn = m + NGW < M ? m + NGW : m;
            const int idAn = IDX[(size_t)mn * 128 + lane], idBn = IDX[(size_t)mn * 128 + 64 + lane];
            const float ghA = GH[(size_t)m * 128 + lane], ghB = GH[(size_t)m * 128 + 64 + lane];
            float acc[32];
#pragma unroll
            for (int i = 0; i < 32; ++i) acc[i] = 0.f;
#pragma unroll 1
            for (int g4 = 0; g4 < 32; ++g4) {
                u32x4 nxt[8];
                if (g4 < 31) gat_load8(V, idA, idB, g4 + 1, lo16, nxt); else gat_load8(V, idAn, idBn, 0, lo16, nxt);
                const float ghs = g4 < 16 ? ghA : ghB;
#pragma unroll
                for (int j = 0; j < 4; ++j) { const float gv = __shfl(ghs, (g4 & 15) * 4 + j); axpy16(acc, 0, gv, cur[2 * j]); axpy16(acc, 16, gv, cur[2 * j + 1]); __builtin_amdgcn_sched_barrier(0); }
#pragma unroll
                for (int j = 0; j < 8; ++j) cur[j] = nxt[j];
            }
            idA = idAn; idB = idBn;
            float ss = 0.f;
#pragma unroll
            for (int q = 0; q < 4; ++q) {
                const f32x4* hp = (const f32x4*)(a.out + (size_t)m * D + (q >> 1) * 1024 + lane * 16 + (q & 1) * 8);
                const f32x4 h0 = hp[0], h1 = hp[1];
                acc[q * 8 + 0] += h0.x; acc[q * 8 + 1] += h0.y; acc[q * 8 + 2] += h0.z; acc[q * 8 + 3] += h0.w;
                acc[q * 8 + 4] += h1.x; acc[q * 8 + 5] += h1.y; acc[q * 8 + 6] += h1.z; acc[q * 8 + 7] += h1.w;
#pragma unroll
                for (int e = 0; e < 8; ++e) ss += acc[q * 8 + e] * acc[q * 8 + e];
                __builtin_amdgcn_sched_barrier(0);
            }
            const float rstd = rsqrtf(wave_sum(ss) * (1.f / D) + 1e-6f);
            const float* gn = layer + 1 < NLAYER ? a.attn_norm + (size_t)(layer + 1) * D : a.final_norm;
            asm volatile("" : "+s"(gn));
#pragma unroll
            for (int q = 0; q < 4; ++q) {
                const int col = (q >> 1) * 1024 + lane * 16 + (q & 1) * 8;
                const f32x4 g0 = *(const f32x4*)(gn + col), g1 = *(const f32x4*)(gn + col + 4);
                f32x4 h0, h1;
                h0.x = acc[q * 8 + 0]; h0.y = acc[q * 8 + 1]; h0.z = acc[q * 8 + 2]; h0.w = acc[q * 8 + 3];
                h1.x = acc[q * 8 + 4]; h1.y = acc[q * 8 + 5]; h1.z = acc[q * 8 + 6]; h1.w = acc[q * 8 + 7];
                const f32x4 y0 = h0 * rstd * g0, y1 = h1 * rstd * g1;
                f32x4* hp = (f32x4*)(a.out + (size_t)m * D + col);
                if (layer + 1 < NLAYER) {
                    hp[0] = h0; hp[1] = h1;
                    u32x4 w; w.x = pk2(y0.x, y0.y); w.y = pk2(y0.z, y0.w); w.z = pk2(y1.x, y1.y); w.w = pk2(y1.z, y1.w);
                    *(u32x4*)((bf16_t*)(ws + WS_XN) + (size_t)m * D + col) = w;
                } else { hp[0] = y0; hp[1] = y1; }
                __builtin_amdgcn_sched_barrier(0);
            }
        }
    }
}

constexpr size_t WS_BAR = 95 * MiB;
#define XB_TMO      128
#define XB_XCNT(j)  (256  + 64 * (j))
#define XB_XSUB(j)  (1280 + 64 * (j))
#define XB_XGEN(j)  (2304 + 64 * (j))
#define XB_TOP      3328
#define XB_TOPGEN   3392
#define XCD_BAR_WORDS 3456
#define XB_SPIN_CAP (1u << 18)

__device__ __forceinline__ unsigned xb_ld(unsigned* p)              { return __hip_atomic_load(p, __ATOMIC_RELAXED, __HIP_MEMORY_SCOPE_AGENT); }
__device__ __forceinline__ unsigned xb_add(unsigned* p, unsigned v) { return __hip_atomic_fetch_add(p, v, __ATOMIC_RELAXED, __HIP_MEMORY_SCOPE_AGENT); }
__device__ __forceinline__ unsigned xb_xcc_id() { return (unsigned)__builtin_amdgcn_s_getreg((3 << 11) | 20) & 0xFu; }
#define XB_SPIN(cond, bar) do { unsigned _sp = 0; while (cond) { __builtin_amdgcn_s_sleep(1); \
    if ((++_sp & 255u) == 0u) { if (xb_ld(&(bar)[XB_TMO])) break; if (_sp > XB_SPIN_CAP) { atomicAdd(&(bar)[XB_TMO], 1u); break; } } } } while (0)

struct XcdBarrier {
    unsigned* bar; unsigned x;
    volatile LAS unsigned* st;
};

__device__ __forceinline__ XcdBarrier xcd_barrier_post(unsigned* bar, volatile LAS unsigned* st) {
    XcdBarrier b; b.bar = bar; b.x = xb_xcc_id(); b.st = st;
    if (threadIdx.x == 0) (void)xb_add(&bar[XB_XCNT(b.x)], 1u);
    return b;
}
__device__ __forceinline__ void xcd_barrier_complete(unsigned* bar, unsigned x, unsigned& nloc, unsigned& nx) {
    const unsigned G = gridDim.x * gridDim.y * gridDim.z;
    unsigned sum, cnt, mine, sp = 0u;
    for (;;) {
        sum = 0u; cnt = 0u; mine = 0u;
#pragma unroll
        for (unsigned j = 0; j < 16; ++j) { const unsigned c = xb_ld(&bar[XB_XCNT(j)]); sum += c; cnt += (c > 0u) ? 1u : 0u; mine = (j == x) ? c : mine; }
        if (sum == G) break;
        __builtin_amdgcn_s_sleep(1);
        if ((++sp & 255u) == 0u) { if (xb_ld(&bar[XB_TMO])) break; if (sp > XB_SPIN_CAP) { atomicAdd(&bar[XB_TMO], 1u); break; } }
    }
    nloc = mine > 0u ? mine : 1u; nx = cnt > 0u ? cnt : 1u;
}

__device__ __forceinline__ void xcd_barrier(const XcdBarrier& b) {
    asm volatile("s_waitcnt vmcnt(0)" ::: "memory");
    __syncthreads();
    if (threadIdx.x == 0) {
        unsigned* bar = b.bar;
        __builtin_amdgcn_s_waitcnt(0);
        unsigned nloc = b.st[0], nx = b.st[1];
        if (nloc == 0u) { xcd_barrier_complete(bar, b.x, nloc, nx); b.st[0] = nloc; b.st[1] = nx; }
        const unsigned old = xb_add(&bar[XB_XSUB(b.x)], 1u);
        const unsigned gen = old / nloc;
        if (old + 1u == (gen + 1u) * nloc) {
            __builtin_amdgcn_fence(__ATOMIC_RELEASE, "agent");
            asm volatile("s_waitcnt vmcnt(0)" ::: "memory");
            const unsigned og = xb_add(&bar[XB_TOP], 1u);
            const unsigned tg = og / nx;
            if (og + 1u == (tg + 1u) * nx) xb_add(&bar[XB_TOPGEN], 1u);
            else XB_SPIN(xb_ld(&bar[XB_TOPGEN]) == tg, bar);
            __builtin_amdgcn_fence(__ATOMIC_ACQUIRE, "agent");
            xb_add(&bar[XB_XGEN(b.x)], 1u);
            asm volatile("s_waitcnt vmcnt(0)" ::: "memory");
        } else {
            XB_SPIN(xb_ld(&bar[XB_XGEN(b.x)]) == gen, bar);
            __builtin_amdgcn_fence(__ATOMIC_ACQUIRE, "agent");
            asm volatile("s_waitcnt vmcnt(0)" ::: "memory");
        }
    }
    __syncthreads();
}

constexpr int NPHASE = 22, PH_PER_LAYER = 10;
template <int KIND>
DI void run_phase(const Args& a, int layer, LAS unsigned char* lds) {
    unsigned char* ws = a.ws;
    if constexpr (KIND == 0) { phase_prologue(a, lds); phase_rms_bf16(a.x, a.attn_norm, (bf16_t*)(ws + WS_XN)); }
    if constexpr (KIND == 1) phase_rms_bf16(layer == 0 ? a.x : a.out, a.attn_norm + (size_t)layer * D, (bf16_t*)(ws + WS_XN));
    if constexpr (KIND == 2 || KIND == 7) {
        const bool inproj = KIND == 2;
        const int N = inproj ? C_GATE : D, ldw = inproj ? NP : D;
        pg8::Gemm g{(const bf16_t*)(ws + WS_XN), (const bf16_t*)(ws + (inproj ? WS_WIN : WS_WQ)) + (size_t)layer * ldw * D, M, N, D};
        pg8::StaticOrder So; So.init(M, N, (int)gridDim.x, (int)blockIdx.x);
        EpiBf16RS E{(bf16_t*)(ws + (inproj ? WS_P : WS_Q2)), ldw, inproj ? nullptr : (const float*)(ws + WS_RSS) + (size_t)layer * M * 32};
        pg8::gemm_phase<EpiBf16RS, pg8::StaticOrder, true, true>(lds, g, So, E);
    }
    if constexpr (KIND == 3) phase_prep(a, layer, lds);
    if constexpr (KIND == 4) phase_attn(a, layer, lds);
    if constexpr (KIND == 5) {
        pg8::Gemm g{(const bf16_t*)(ws + WS_O), (const bf16_t*)(ws + WS_WOUT) + (size_t)layer * D * D, M, D, D};
        pg8::StaticOrder So; So.init(M, D, (int)gridDim.x, (int)blockIdx.x);
        EpiResid E{layer == 0 ? a.x : a.out, a.out, D, (bf16_t*)(ws + WS_XN), (float*)(ws + WS_RSS) + (size_t)layer * M * 32};
        pg8::gemm_phase<EpiResid, pg8::StaticOrder, true, true>(lds, g, So, E);
    }
    if constexpr (KIND == 6) phase_rms_bf16(a.out, a.ffn_norm + (size_t)layer * D, (bf16_t*)(ws + WS_XN));
    if constexpr (KIND == 8) phase_peer_select(a, layer, lds);
    if constexpr (KIND == 9) phase_peer_u(a, layer);
    if constexpr (KIND == 14) phase_peer_v(a, layer);
    if constexpr (KIND == 10) phase_rms_final(a.out, a.final_norm);
}

#ifndef MK_PER_PHASE
#define MK_PER_PHASE 0
#endif

#if MK_PER_PHASE
template <int KIND>
__global__ void __launch_bounds__(NTHREADS, 2) k_phase(Args a, int layer) {
    extern __shared__ __attribute__((aligned(16))) unsigned char lds_raw[];
    run_phase<KIND>(a, layer, (LAS unsigned char*)lds_raw);
}
template <int KIND> static void launch_phase(const Args& a, int layer, int grid, hipStream_t stream) {
    static bool attr = false;
    if (!attr) { (void)hipFuncSetAttribute((const void*)k_phase<KIND>, hipFuncAttributeMaxDynamicSharedMemorySize, LDS_BYTES); attr = true; }
    hipLaunchKernelGGL(k_phase<KIND>, dim3(grid), dim3(NTHREADS), LDS_BYTES, stream, a, layer);
}
#else
__global__ void __launch_bounds__(NTHREADS, 2) hybrid_fwd(Args a) {
    extern __shared__ __attribute__((aligned(16))) unsigned char lds_raw[];
    LAS unsigned char* lds = (LAS unsigned char*)lds_raw;
    volatile LAS unsigned* bst = (volatile LAS unsigned*)(lds + LDS_BYTES - 16);
    if (threadIdx.x < 4) bst[threadIdx.x] = 0u;
    __syncthreads();
    const XcdBarrier xbar = xcd_barrier_post((unsigned*)(a.ws + WS_BAR), bst);
    bool first_seam = true;
#pragma unroll 1
    for (int ph = a.ph_lo; ph < a.ph_hi; ++ph) {
        if (ph == NPHASE - 1 || ph == 1 + PH_PER_LAYER || ph == 1 || ph == 6 || ph == 6 + PH_PER_LAYER) continue;
        if (ph == 0) run_phase<0>(a, 0, lds);
        else if (ph == NPHASE - 1) run_phase<10>(a, 0, lds);
        else {
            const int layer = (ph - 1) / PH_PER_LAYER, k = (ph - 1) % PH_PER_LAYER;
            if (k == 0) run_phase<1>(a, layer, lds);
            else if (k == 1) run_phase<2>(a, layer, lds);
            else if (k == 2) run_phase<3>(a, layer, lds);
            else if (k == 3) run_phase<4>(a, layer, lds);
            else if (k == 4) run_phase<5>(a, layer, lds);
            else if (k == 5) run_phase<6>(a, layer, lds);
            else if (k == 6) run_phase<7>(a, layer, lds);
            else if (k == 7) run_phase<8>(a, layer, lds);
            else if (k == 8) run_phase<9>(a, layer, lds);
            else run_phase<14>(a, layer, lds);
        }
        if (ph + 1 < a.ph_hi) { if (first_seam) { cg::this_grid().sync(); first_seam = false; } else xcd_barrier(xbar); }
    }
}
#endif

extern "C" void kernel_launch(void* const* d_in, const int* in_sizes, int n_in, void* d_out, int out_size, void* d_ws, size_t ws_size, hipStream_t stream) {
    static int grid = 0;
    if (grid == 0) {
        if (n_in != 18 || out_size != M * D || ws_size < WS_END) { fprintf(stderr, "kernel_launch: unexpected shapes (n_in %d, out %d, ws %zu)\n", n_in, out_size, ws_size); grid = -1; return; }
        int dev = 0, cus = 0;
        if (hipGetDevice(&dev) != hipSuccess || hipDeviceGetAttribute(&cus, hipDeviceAttributeMultiprocessorCount, dev) != hipSuccess) { grid = -1; return; }
#if !MK_PER_PHASE
        if (hipFuncSetAttribute((const void*)hybrid_fwd, hipFuncAttributeMaxDynamicSharedMemorySize, LDS_BYTES) != hipSuccess) { fprintf(stderr, "kernel_launch: hipFuncSetAttribute failed\n"); grid = -1; return; }
        int per_cu = 0;
        if (hipOccupancyMaxActiveBlocksPerMultiprocessor(&per_cu, (const void*)hybrid_fwd, NTHREADS, LDS_BYTES) != hipSuccess || per_cu < 1) fprintf(stderr, "kernel_launch: occupancy query says %d\n", per_cu);
        (void)hipGetLastError();
#endif
        grid = cus;
    }
    if (grid < 0) return;
    Args a{};
    a.x = (const float*)d_in[0]; a.attn_norm = (const float*)d_in[1]; a.w_in = (const float*)d_in[2]; a.cmp_pos_k = (const float*)d_in[3];
    a.cmp_w1_k = (const float*)d_in[4]; a.cmp_w2_k = (const float*)d_in[5]; a.cmp_pos_v = (const float*)d_in[6]; a.cmp_w1_v = (const float*)d_in[7];
    a.cmp_w2_v = (const float*)d_in[8]; a.sinks = (const float*)d_in[9]; a.w_out = (const float*)d_in[10]; a.ffn_norm = (const float*)d_in[11];
    a.peer_wq = (const float*)d_in[12]; a.peer_subkeys = (const float*)d_in[13]; a.peer_u = (const float*)d_in[14]; a.peer_v = (const float*)d_in[15];
    a.rel_bias = (const float*)d_in[16]; a.final_norm = (const float*)d_in[17];
    a.out = (float*)d_out; a.ws = (unsigned char*)d_ws;
    a.ph_lo = 0; a.ph_hi = NPHASE;
#if MK_PER_PHASE
    launch_phase<0>(a, 0, grid, stream);
    for (int l = 0; l < NLAYER; ++l) {
        launch_phase<2>(a, l, grid, stream); launch_phase<3>(a, l, grid, stream);
        launch_phase<4>(a, l, grid, stream); launch_phase<5>(a, l, grid, stream);
        launch_phase<7>(a, l, grid, stream); launch_phase<8>(a, l, grid, stream); launch_phase<9>(a, l, grid, stream); launch_phase<14>(a, l, grid, stream);
    }
#else
    (void)hipMemsetAsync((unsigned char*)d_ws + WS_BAR, 0, 16384, stream);
    void* args[] = {&a};
    const hipError_t e = hipLaunchCooperativeKernel((const void*)hybrid_fwd, dim3(grid), dim3(NTHREADS), args, LDS_BYTES, stream);
    if (e != hipSuccess) fprintf(stderr, "kernel_launch: cooperative launch failed: %s (grid %d)\n", hipGetErrorString(e), grid);
#endif
}
```

```cpp
#include <hip/hip_runtime.h>
#include <cstdio>
#include <cstdint>
__device__ __forceinline__ int opaque_tid() { int t = threadIdx.x; asm volatile("" : "+v"(t)); return t; }
namespace pg8 {
#define PG8_LAS __attribute__((address_space(3)))
typedef unsigned short bf16_t;
typedef short bf16x8 __attribute__((ext_vector_type(8)));
typedef float f32x4 __attribute__((ext_vector_type(4)));
typedef unsigned u32x4 __attribute__((ext_vector_type(4)));
constexpr int BM = 256, BK = 64, HALF = 128, HTB = HALF * BK * 2  , STAGE_BYTES = 8 * HTB, NXCD = 8, WGM = 8;

__host__ __device__ __forceinline__ int lds_byte(int r, int c) { const int st = (r >> 4) * 2 + (c >> 5), rr = r & 15, cc = c & 31, ob = rr * 64 + cc * 2; return st * 1024 + (ob ^ (((ob >> 9) & 1) << 5)); }
__host__ __device__ __forceinline__ void stage_rc(int b, int& R, int& C) { const int st = b / 1024, sb = b % 1024, swz = sb ^ (((sb >> 9) & 1) << 5); R = (st >> 1) * 16 + swz / 64; C = (st & 1) * 32 + (swz % 64) / 2; }
__host__ __device__ __forceinline__ int perm32(int rho) { const int n = rho >> 4, i = rho & 15; return 8 * (i >> 2) + 4 * n + (i & 3); }

struct Unit { int pm, pn; };
struct Gemm { const bf16_t* A; const bf16_t* Bt; int M, N, K; };

struct StaticOrder {
    int nM, nN, nwg, G, c;
    __host__ __device__ void init(int M, int N, int G_, int c_) { nM = M / BM; nN = N / BM; nwg = nM * nN; G = G_; c = c_; }
    __host__ __device__ bool next(int i, Unit& u) const {
        const long L = (long)i * G + c; if (L >= nwg) return false;
        int wgid = (int)L; { const int q = nwg / NXCD, r = nwg % NXCD, xcd = wgid % NXCD, off = wgid / NXCD; wgid = (xcd < r ? xcd * (q + 1) : r * (q + 1) + (xcd - r) * q) + off; }
        const int nig = WGM * nN, gid = wgid / nig, fm = gid * WGM, gsz = (nM - fm) < WGM ? (nM - fm) : WGM;
        u.pm = fm + ((wgid % nig) % gsz); u.pn = (wgid % nig) / gsz; return true;
    }
    __device__ __forceinline__ void a_ready(const Unit&) const {}
    __device__ __forceinline__ void done(const Unit&) const {}
};

__device__ __forceinline__ unsigned cvt_pk_bf16(float lo, float hi) { unsigned r; asm volatile("v_cvt_pk_bf16_f32 %0, %1, %2" : "=v"(r) : "v"(lo), "v"(hi)); return r; }
typedef float f32x2 __attribute__((ext_vector_type(2)));
__device__ __forceinline__ f32x2 gelu_pk(f32x2 v) {
    const f32x2 av = __builtin_elementwise_abs(v), d = av * 0.2316418882f + 1.0f;
    f32x2 t; t.x = __builtin_amdgcn_rcpf(d.x); t.y = __builtin_amdgcn_rcpf(d.y);
    f32x2 q = t * 0.5307027145f + (-0.7265760135f); q = q * t + 0.7107068705f; q = q * t + (-0.142248368f); q = q * t + 0.127414796f; q = q * t;
    const f32x2 s = (v * v) * (-0.72134752044f);
    f32x2 e; e.x = __builtin_amdgcn_exp2f(s.x); e.y = __builtin_amdgcn_exp2f(s.y);
    const f32x2 m = v * (q * e), r = v - m;
    f32x2 o; o.x = v.x < 0.f ? m.x : r.x; o.y = v.y < 0.f ? m.y : r.y; return o;
}

template <int ACT  > struct EpiBf16 {
    static constexpr bool PERM = true, AFTER_DRAIN = false; static_assert(ACT == 0 || ACT == 1, "EpiBf16: ACT is 0 (none) or 1 (gelu_pk)");
    bf16_t* O; int ldc; const float* bias; int split_cols; size_t split_stride; float scale0;
    __device__ __forceinline__ void operator()(const f32x4 (&acc)[2][2][4][2], const Unit& u, int wr, int wc, int fr, int fq) const {
        const int row0 = u.pm * BM + wr * 64 + fr; int colt = u.pn * BM; bf16_t* base = O;
        float sc = 1.f; if (split_cols) { const int t = colt / split_cols; base += (size_t)t * split_stride; colt -= t * split_cols; if (t == 0) sc = scale0; }
        const int col0 = colt + wc * 32 + 8 * fq, bcol0 = u.pn * BM + wc * 32 + 8 * fq;
        f32x4 bv[2][2];
#pragma unroll
        for (int bj = 0; bj < 2; ++bj)
#pragma unroll
            for (int n = 0; n < 2; ++n) bv[bj][n] = bias ? *(const f32x4*)(bias + bcol0 + bj * HALF + 4 * n) : (f32x4){0.f, 0.f, 0.f, 0.f};
#pragma unroll
        for (int ai = 0; ai < 2; ++ai)
#pragma unroll
            for (int m = 0; m < 4; ++m) { bf16_t* rowp = base + (size_t)(row0 + ai * HALF + m * 16) * ldc + col0;
#pragma unroll
                for (int bj = 0; bj < 2; ++bj) { f32x4 v0 = acc[ai][bj][m][0] + bv[bj][0], v1 = acc[ai][bj][m][1] + bv[bj][1];
                    if (ACT == 1) { f32x2 a = gelu_pk((f32x2){v0[0], v0[1]}), b = gelu_pk((f32x2){v0[2], v0[3]}), c = gelu_pk((f32x2){v1[0], v1[1]}), d = gelu_pk((f32x2){v1[2], v1[3]});
                        v0 = (f32x4){a.x, a.y, b.x, b.y}; v1 = (f32x4){c.x, c.y, d.x, d.y}; }
                    v0 = v0 * sc; v1 = v1 * sc; u32x4 w; w.x = cvt_pk_bf16(v0[0], v0[1]); w.y = cvt_pk_bf16(v0[2], v0[3]); w.z = cvt_pk_bf16(v1[0], v1[1]); w.w = cvt_pk_bf16(v1[2], v1[3]);
                    *(u32x4*)(rowp + bj * HALF) = w; } }
    }
};
template <class Epi, class Sched, bool ALIGN_EPI = false, bool SP2 = false>
__device__ __forceinline__ void gemm_phase(PG8_LAS unsigned char* lds, const Gemm g, const Sched& S, const Epi& E) {
    const int tid = opaque_tid(), wid = __builtin_amdgcn_readfirstlane(tid >> 6), lane = tid & 63, wr = wid >> 2, wc = wid & 3, fr = lane & 15, fq = lane >> 4;
    const int K = g.K, nt = K / BK;
    unsigned voffA[2], voffB[2];
#pragma unroll
    for (int i = 0; i < 2; ++i) { int R, C; stage_rc(tid * 16 + i * 8192, R, C); const int Rb = Epi::PERM ? ((R & ~31) + perm32(R & 31)) : R;
        voffA[i] = (unsigned)(R * K + C) * 2u; voffB[i] = (unsigned)(Rb * K + C) * 2u; }
    const size_t kstep = (size_t)(BK * 2);
    const size_t hstep = (size_t)HALF * K * 2;
    const size_t tstep = 2 * hstep;
    const unsigned ldsw = (unsigned)wid * 1024u;
    const int aoff = lds_byte(wr * 64 + fr, fq * 8), boff = lds_byte(wc * 32 + fr, fq * 8);
#define PG8_SA(b, h) (((b) * 2 + (h)) * HTB)
#define PG8_SB(b, h) ((4 + (b) * 2 + (h)) * HTB)
#define PG8_STAGE(bufoff, gbase, voff) do { _Pragma("unroll") for (int _i = 0; _i < 2; ++_i) \
        __builtin_amdgcn_global_load_lds((const unsigned*)((const char*)(gbase) + (voff)[_i]), (PG8_LAS unsigned*)(lds + (bufoff) + ldsw + _i * 8192), 16, 0, 0); } while (0)
#define PG8_LDA(dst, b, h) do { _Pragma("unroll") for (int m = 0; m < 4; ++m) _Pragma("unroll") for (int k = 0; k < 2; ++k) dst[m][k] = *(const PG8_LAS bf16x8*)(lds + PG8_SA(b, h) + aoff + m * 2048 + k * 1024); } while (0)
#define PG8_LDB(dst, b, h) do { _Pragma("unroll") for (int n = 0; n < 2; ++n) _Pragma("unroll") for (int k = 0; k < 2; ++k) dst[n][k] = *(const PG8_LAS bf16x8*)(lds + PG8_SB(b, h) + boff + n * 2048 + k * 1024); } while (0)
#define PG8_MMA(ai, bj, At, Bt) do { __builtin_amdgcn_s_setprio(1); _Pragma("unroll") for (int m = 0; m < 4; ++m) _Pragma("unroll") for (int n = 0; n < 2; ++n) _Pragma("unroll") for (int k = 0; k < 2; ++k) \
        acc[ai][bj][m][n] = __builtin_amdgcn_mfma_f32_16x16x32_bf16(Bt[n][k], At[m][k], acc[ai][bj][m][n], 0, 0, 0); __builtin_amdgcn_s_setprio(0); } while (0)
#define PG8_WAIT_V(n) asm volatile("s_waitcnt vmcnt(" #n ")" ::: "memory")
#define PG8_WAIT_L(n) asm volatile("s_waitcnt lgkmcnt(" #n ")" ::: "memory")
#define PG8_BAR __builtin_amdgcn_s_barrier()
#define PG8_SCHED __builtin_amdgcn_sched_barrier(0)
    Unit cur, nxt; int ui = 0;
    if (!S.next(0, cur)) return;
    f32x4 acc[2][2][4][2];
#pragma unroll
    for (int a = 0; a < 2; ++a)
#pragma unroll
        for (int b = 0; b < 2; ++b)
#pragma unroll
            for (int m = 0; m < 4; ++m)
#pragma unroll
                for (int n = 0; n < 2; ++n) acc[a][b][m][n] = (f32x4){0.f, 0.f, 0.f, 0.f};
    bf16x8 At[4][2], B0[2][2], B1[2][2];
    const char* cA = (const char*)g.A + (size_t)cur.pm * tstep; const char* cB = (const char*)g.Bt + (size_t)cur.pn * tstep;
    S.a_ready(cur);
    if constexpr (SP2) {
        PG8_STAGE(PG8_SB(0, 0), cB, voffB); PG8_STAGE(PG8_SB(0, 1), cB + hstep, voffB); PG8_STAGE(PG8_SA(0, 0), cA, voffA); PG8_STAGE(PG8_SA(0, 1), cA + hstep, voffA);
        if (wr == 1) PG8_BAR;
        PG8_WAIT_V(2); PG8_BAR;
        PG8_STAGE(PG8_SB(1, 0), cB + kstep, voffB); PG8_STAGE(PG8_SA(1, 0), cA + kstep, voffA); PG8_STAGE(PG8_SB(1, 1), cB + hstep + kstep, voffB);
        PG8_WAIT_V(6); PG8_BAR;
    } else {
        PG8_STAGE(PG8_SB(0, 0), cB, voffB); PG8_STAGE(PG8_SA(0, 0), cA, voffA); PG8_STAGE(PG8_SB(0, 1), cB + hstep, voffB); PG8_STAGE(PG8_SA(0, 1), cA + hstep, voffA);
        if (wr == 1) PG8_BAR;
        PG8_WAIT_V(4); PG8_BAR;
        PG8_STAGE(PG8_SB(1, 0), cB + kstep, voffB); PG8_STAGE(PG8_SA(1, 0), cA + kstep, voffA); PG8_STAGE(PG8_SB(1, 1), cB + hstep + kstep, voffB);
        PG8_WAIT_V(6); PG8_BAR;
    }
    for (;;) {
        const bool has_next = S.next(ui + 1, nxt);
        const char* nA = has_next ? (const char*)g.A + (size_t)nxt.pm * tstep : cA; const char* nB = has_next ? (const char*)g.Bt + (size_t)nxt.pn * tstep : cB;
        for (int t = 0; t < nt; t += 2) {
            const bool last = (t == nt - 2);
            const char* a1 = cA + (size_t)(t + 1) * kstep;
            const char* a2 = last ? nA : cA + (size_t)(t + 2) * kstep; const char* b2 = last ? nB : cB + (size_t)(t + 2) * kstep;
            const char* a3 = a2 + kstep; const char* b3 = b2 + kstep;
            if (last && has_next) S.a_ready(nxt);
            if constexpr (SP2) {
            PG8_LDB(B0, 0, 0); PG8_LDB(B1, 0, 1); PG8_SCHED; PG8_LDA(At, 0, 0); PG8_STAGE(PG8_SA(1, 1), a1 + hstep, voffA);
            PG8_WAIT_V(8); PG8_WAIT_L(0); PG8_BAR; PG8_MMA(0, 0, At, B0); PG8_MMA(0, 1, At, B1); PG8_BAR; PG8_SCHED;
            PG8_LDA(At, 0, 1); PG8_STAGE(PG8_SB(0, 0), b2, voffB); PG8_STAGE(PG8_SB(0, 1), b2 + hstep, voffB); PG8_STAGE(PG8_SA(0, 0), a2, voffA);
            PG8_WAIT_V(8); PG8_WAIT_L(0); PG8_BAR; PG8_MMA(1, 0, At, B0); PG8_MMA(1, 1, At, B1); PG8_BAR; PG8_SCHED;
            PG8_LDB(B0, 1, 0); PG8_LDB(B1, 1, 1); PG8_SCHED; PG8_LDA(At, 1, 0); PG8_STAGE(PG8_SA(0, 1), a2 + hstep, voffA);
            PG8_WAIT_V(8); PG8_WAIT_L(0); PG8_BAR; PG8_MMA(0, 0, At, B0); PG8_MMA(0, 1, At, B1); PG8_BAR; PG8_SCHED;
            PG8_LDA(At, 1, 1); PG8_STAGE(PG8_SB(1, 0), b3, voffB); PG8_STAGE(PG8_SB(1, 1), b3 + hstep, voffB); PG8_STAGE(PG8_SA(1, 0), a3, voffA);
            PG8_WAIT_V(8); PG8_WAIT_L(0); PG8_BAR; PG8_MMA(1, 0, At, B0); PG8_MMA(1, 1, At, B1); PG8_BAR; PG8_SCHED;
            } else {
            PG8_LDB(B0, 0, 0); PG8_SCHED; PG8_LDA(At, 0, 0); PG8_STAGE(PG8_SA(1, 1), a1 + hstep, voffA);
            PG8_WAIT_L(8); PG8_BAR; PG8_WAIT_L(0); PG8_MMA(0, 0, At, B0); PG8_BAR; PG8_SCHED;
            PG8_LDB(B1, 0, 1); PG8_STAGE(PG8_SB(0, 0), b2, voffB);
            PG8_BAR; PG8_WAIT_L(0); PG8_MMA(0, 1, At, B1); PG8_BAR;
            PG8_LDA(At, 0, 1); PG8_STAGE(PG8_SA(0, 0), a2, voffA);
            PG8_BAR; PG8_WAIT_L(0); PG8_MMA(1, 0, At, B0); PG8_BAR; PG8_SCHED;
            PG8_STAGE(PG8_SB(0, 1), b2 + hstep, voffB);
            PG8_WAIT_V(6); PG8_BAR; PG8_MMA(1, 1, At, B1); PG8_BAR;
            PG8_LDB(B0, 1, 0); PG8_SCHED; PG8_LDA(At, 1, 0); PG8_STAGE(PG8_SA(0, 1), a2 + hstep, voffA);
            PG8_WAIT_L(8); PG8_BAR; PG8_WAIT_L(0); PG8_MMA(0, 0, At, B0); PG8_BAR; PG8_SCHED;
            PG8_LDB(B1, 1, 1); PG8_STAGE(PG8_SB(1, 0), b3, voffB);
            PG8_BAR; PG8_WAIT_L(0); PG8_MMA(0, 1, At, B1); PG8_BAR;
            PG8_LDA(At, 1, 1); PG8_STAGE(PG8_SA(1, 0), a3, voffA);
            PG8_BAR; PG8_WAIT_L(0); PG8_MMA(1, 0, At, B0); PG8_BAR; PG8_SCHED;
            PG8_STAGE(PG8_SB(1, 1), b3 + hstep, voffB);
            PG8_WAIT_V(6); PG8_BAR; PG8_MMA(1, 1, At, B1); PG8_BAR;
            }
        }
        if constexpr (ALIGN_EPI) { if (wr == 0) PG8_BAR; }
        if constexpr (!Epi::AFTER_DRAIN) { E(acc, cur, wr, wc, fr, fq); S.done(cur); }
        if (!has_next) break;
#pragma unroll
        for (int a = 0; a < 2; ++a)
#pragma unroll
            for (int b = 0; b < 2; ++b)
#pragma unroll
                for (int m = 0; m < 4; ++m)
#pragma unroll
                    for (int n = 0; n < 2; ++n) acc[a][b][m][n] = (f32x4){0.f, 0.f, 0.f, 0.f};
        cur = nxt; cA = nA; cB = nB; ++ui;
        if constexpr (ALIGN_EPI) { if (wr == 1) PG8_BAR; }
    }
    PG8_WAIT_V(0);
    if constexpr (!ALIGN_EPI) { if (wr == 0) PG8_BAR; }
    PG8_BAR;
    if constexpr (Epi::AFTER_DRAIN) { E.fused(acc, cur, wr, wc, fr, fq, lds, wid, lane); S.done(cur); }
#undef PG8_SA
#undef PG8_SB
#undef PG8_STAGE
#undef PG8_LDA
#undef PG8_LDB
#undef PG8_MMA
#undef PG8_WAIT_V
#undef PG8_WAIT_L
#undef PG8_BAR
#undef PG8_SCHED
}
}

#include <hip/hip_cooperative_groups.h>
namespace cg = cooperative_groups;

#define DI __device__ __forceinline__
#define LAS __attribute__((address_space(3)))
typedef unsigned short bf16_t;
typedef short bf16x8 __attribute__((ext_vector_type(8)));
typedef float f32x4 __attribute__((ext_vector_type(4)));
typedef float f32x2 __attribute__((ext_vector_type(2)));
typedef float f32x16 __attribute__((ext_vector_type(16)));
typedef unsigned u32x4 __attribute__((ext_vector_type(4)));
typedef unsigned u32x2 __attribute__((ext_vector_type(2)));
typedef __bf16 bf16v2 __attribute__((ext_vector_type(2)));

#define MFMA32(a, b, c) __builtin_amdgcn_mfma_f32_32x32x16_bf16((a), (b), (c), 0, 0, 0)
#define MFMA16(a, b, c) __builtin_amdgcn_mfma_f32_16x16x32_bf16((a), (b), (c), 0, 0, 0)
#define LDS_WAIT() asm volatile("s_waitcnt lgkmcnt(0)" ::: "memory")

constexpr int NB = 2, S = 16384, D = 2048, M = NB * S, NLAYER = 2;
constexpr int NPROJ = 3120, NP = 3328;
constexpr int C_QA = 0, C_QB = 1024, C_KC = 2048, C_VC = 2176, C_KS = 2304, C_VS = 2432, C_KW = 2560, C_VW = 2688, C_KB = 2816, C_VB = 2944, C_GATE = 3072;
constexpr int NCP = 1024;
constexpr int NEXP = 16384;
constexpr float NEGF = -1e30f;

constexpr size_t MiB = 1u << 20;
constexpr size_t WS_WIN = 0;
constexpr size_t WS_WOUT = 28 * MiB;
constexpr size_t WS_WQ = 46 * MiB;
constexpr size_t WS_CW1 = 64 * MiB;
constexpr size_t WS_SUBK = 67 * MiB;
constexpr size_t WS_KC = 68 * MiB;
constexpr size_t WS_VCT = 69 * MiB;
constexpr size_t WS_VST = 70 * MiB;
constexpr size_t WS_VWT = 78 * MiB;
constexpr size_t WS_VBT = 86 * MiB;
constexpr size_t WS_IDX = 96 * MiB;
constexpr size_t WS_GATE = 112 * MiB;
constexpr size_t WS_GSUM = 94 * MiB;
constexpr size_t WS_U = 128 * MiB;
constexpr size_t WS_V = 256 * MiB;
constexpr size_t WS_KSF = 192 * MiB, WS_KWF = 200 * MiB, WS_KBF = 208 * MiB;
constexpr size_t WS_KMAX = 95 * MiB + 65536;
constexpr size_t WS_RSS = 192 * MiB + 24 * MiB;
constexpr size_t WS_XN = 384 * MiB;
constexpr size_t WS_O = 512 * MiB;
constexpr size_t WS_Q2 = 640 * MiB;
constexpr size_t WS_P = 768 * MiB;
constexpr size_t WS_END = 1000 * MiB;

constexpr int LDS_BYTES = 139264;
constexpr int NTHREADS = 512;

struct Args {
    const float* x; const float* attn_norm; const float* w_in; const float* cmp_pos_k; const float* cmp_w1_k; const float* cmp_w2_k;
    const float* cmp_pos_v; const float* cmp_w1_v; const float* cmp_w2_v; const float* sinks; const float* w_out; const float* ffn_norm;
    const float* peer_wq; const float* peer_subkeys; const float* peer_u; const float* peer_v; const float* rel_bias; const float* final_norm;
    float* out; unsigned char* ws; int ph_lo, ph_hi;
};

DI unsigned f2bf(float f) { unsigned u = __builtin_bit_cast(unsigned, f); return (u + 0x7fffu + ((u >> 16) & 1u)) >> 16; }
DI unsigned pk2(float lo, float hi) { const f32x2 v = {lo, hi}; return __builtin_bit_cast(unsigned, __builtin_convertvector(v, bf16v2)); }
DI float bflo(unsigned w) { return __builtin_bit_cast(float, w << 16); }
DI float bfhi(unsigned w) { return __builtin_bit_cast(float, w & 0xffff0000u); }
DI float bf2f(bf16_t v) { return __builtin_bit_cast(float, (unsigned)v << 16); }
DI float wave_sum(float v) {
#pragma unroll
    for (int o = 1; o < 64; o <<= 1) v += __shfl_xor(v, o);
    return v;
}
DI float gelu_tanh(float x) {
    const float y = 0.7978845608028654f * (x + 0.044715f * x * x * x);
    const float t = __expf(2.f * y);
    const float th = 1.f - 2.f / (t + 1.f);
    return 0.5f * x * (1.f + th);
}
DI float sigmoidf_(float x) { return 1.f / (1.f + __expf(-x)); }
DI int crow(int r, int hi) { return (r & 3) + 8 * (r >> 2) + 4 * hi; }
DI int rel_bucket(int d) {
    const float lf = __log2f((float)(d < 1 ? 1 : d));
    int b = 16 + (int)((lf - 4.0f) * (16.0f / 7.0f));
    b = b > 31 ? 31 : b;
    return d < 16 ? d : b;
}
DI bf16x8 pack8(float a0, float a1, float a2, float a3, float a4, float a5, float a6, float a7) {
    u32x4 p; p.x = pk2(a0, a1); p.y = pk2(a2, a3); p.z = pk2(a4, a5); p.w = pk2(a6, a7);
    return __builtin_bit_cast(bf16x8, p);
}

DI int win_srccol(int n) {
    if (n < 1024) return n;
    if (n < 2048) return 1840 + (n - 1024);
    if (n < 2816) return 1024 + (n - 2048);
    if (n < 3072) return 2864 + (n - 2816);
    if (n < 3120) return 1792 + (n - 3072);
    return -1;
}
template <bool WIN>
DI void transpose_item(const float* W, int K, int Nsrc, bf16_t* WT, int k0, int n0, LAS float* scr, int lane, const float* gk = nullptr) {
    const int nd = n0 + (lane & 31);
    const int ns = WIN ? win_srccol(nd) : nd;
#pragma unroll 8
    for (int i = 0; i < 32; ++i) { const int kk = 2 * i + (lane >> 5); scr[kk * 33 + (lane & 31)] = (ns >= 0 ? W[(size_t)(k0 + kk) * Nsrc + ns] : 0.f) * (gk ? gk[k0 + kk] : 1.f); }
    LDS_WAIT();
    const int c = lane & 7;
#pragma unroll
    for (int j = 0; j < 4; ++j) { const int n = (lane >> 3) + 8 * j; const LAS float* s = scr + (8 * c) * 33 + n;
        u32x4 o; o.x = pk2(s[0 * 33], s[1 * 33]); o.y = pk2(s[2 * 33], s[3 * 33]); o.z = pk2(s[4 * 33], s[5 * 33]); o.w = pk2(s[6 * 33], s[7 * 33]);
        *(u32x4*)(WT + (size_t)(n0 + n) * K + k0 + 8 * c) = o; }
    LDS_WAIT();
}
template <bool WIN>
DI void transpose_matrix(const float* W, int K, int Nsrc, int Ndst, bf16_t* WT, LAS float* scr, int lane, int gw, int NGW, const float* gk = nullptr) {
    const int nblk = Ndst / 32, nitems = (K / 64) * nblk;
    for (int it = gw; it < nitems; it += NGW) transpose_item<WIN>(W, K, Nsrc, WT, 64 * (it / nblk), 32 * (it % nblk), scr, lane, gk);
}
DI void convert_rows(const float* src, bf16_t* dst, size_t n8, size_t gt, size_t ngt) {
    for (size_t i = gt; i < n8; i += ngt) {
        const f32x4 a = ((const f32x4*)src)[2 * i], b = ((const f32x4*)src)[2 * i + 1];
        u32x4 o; o.x = pk2(a.x, a.y); o.y = pk2(a.z, a.w); o.z = pk2(b.x, b.y); o.w = pk2(b.z, b.w);
        ((u32x4*)dst)[i] = o;
    }
}
constexpr float U_SCALE = 512.f, V_SCALE = 64.f;
DI void convert_rows_fp8(const float* src, unsigned char* dst, size_t n16, float scale, size_t gt, size_t ngt, const float* gnorm = nullptr) {
    for (size_t i = gt; i < n16; i += ngt) {
        f32x4 a = ((const f32x4*)src)[4 * i] * scale, b = ((const f32x4*)src)[4 * i + 1] * scale, c = ((const f32x4*)src)[4 * i + 2] * scale, d = ((const f32x4*)src)[4 * i + 3] * scale;
        if (gnorm) { const f32x4* gp = (const f32x4*)(gnorm + ((16 * i) / ((size_t)NEXP * D)) * D + (16 * i) % D); a = a * gp[0]; b = b * gp[1]; c = c * gp[2]; d = d * gp[3]; }
        u32x4 o;
        o.x = (unsigned)__builtin_amdgcn_cvt_pk_fp8_f32(a.z, a.w, __builtin_amdgcn_cvt_pk_fp8_f32(a.x, a.y, 0, false), true);
        o.y = (unsigned)__builtin_amdgcn_cvt_pk_fp8_f32(b.z, b.w, __builtin_amdgcn_cvt_pk_fp8_f32(b.x, b.y, 0, false), true);
        o.z = (unsigned)__builtin_amdgcn_cvt_pk_fp8_f32(c.z, c.w, __builtin_amdgcn_cvt_pk_fp8_f32(c.x, c.y, 0, false), true);
        o.w = (unsigned)__builtin_amdgcn_cvt_pk_fp8_f32(d.z, d.w, __builtin_amdgcn_cvt_pk_fp8_f32(d.x, d.y, 0, false), true);
        ((u32x4*)dst)[i] = o;
    }
}
DI void phase_prologue(const Args& a, LAS unsigned char* lds) {
    const int tid = opaque_tid(), lane = tid & 63, wave = tid >> 6;
    if (blockIdx.x == 0 && tid < 32) ((unsigned*)(a.ws + WS_KMAX))[tid] = 0u;
    const int gw = blockIdx.x * 8 + wave, NGW = gridDim.x * 8;
    LAS float* scr = (LAS float*)(lds + wave * 8448);
    unsigned char* ws = a.ws;
    for (int l = 0; l < NLAYER; ++l) {
        transpose_matrix<true>(a.w_in + (size_t)l * D * NPROJ, D, NPROJ, NP, (bf16_t*)(ws + WS_WIN) + (size_t)l * NP * D, scr, lane, gw, NGW);
        transpose_matrix<false>(a.w_out + (size_t)l * D * D, D, D, D, (bf16_t*)(ws + WS_WOUT) + (size_t)l * D * D, scr, lane, gw, NGW);
        transpose_matrix<false>(a.peer_wq + (size_t)l * D * D, D, D, D, (bf16_t*)(ws + WS_WQ) + (size_t)l * D * D, scr, lane, gw, NGW, a.ffn_norm + (size_t)l * D);
        transpose_matrix<false>(a.cmp_w1_k + (size_t)l * 2048 * 128, 2048, 128, 128, (bf16_t*)(ws + WS_CW1) + (size_t)(l * 2 + 0) * 128 * 2048, scr, lane, gw, NGW);
        transpose_matrix<false>(a.cmp_w1_v + (size_t)l * 2048 * 128, 2048, 128, 128, (bf16_t*)(ws + WS_CW1) + (size_t)(l * 2 + 1) * 128 * 2048, scr, lane, gw, NGW);
    }
    const size_t gt = (size_t)blockIdx.x * NTHREADS + tid, ngt = (size_t)gridDim.x * NTHREADS;
    convert_rows_fp8(a.peer_u, ws + WS_U, (size_t)NLAYER * NEXP * D / 16, U_SCALE, gt, ngt, a.ffn_norm);
    convert_rows_fp8(a.peer_v, ws + WS_V, (size_t)NLAYER * NEXP * D / 16, V_SCALE, gt, ngt);
    convert_rows(a.peer_subkeys, (bf16_t*)(ws + WS_SUBK), (size_t)NLAYER * 2 * 128 * 128 / 8, gt, ngt);
}

DI void phase_rms_bf16(const float* X, const float* g, bf16_t* XN) {
    const int tid = opaque_tid(), lane = tid & 63, wave = tid >> 6;
    const int gw = blockIdx.x * 8 + wave, NGW = gridDim.x * 8;
    f32x4 gv[8];
#pragma unroll
    for (int j = 0; j < 8; ++j) gv[j] = ((const f32x4*)g)[lane + 64 * j];
    for (int m = gw; m < M; m += NGW) {
        const f32x4* xr = (const f32x4*)(X + (size_t)m * D);
        f32x4 v[8]; float s = 0.f;
#pragma unroll
        for (int j = 0; j < 8; ++j) { v[j] = xr[lane + 64 * j]; s += (v[j].x * v[j].x + v[j].y * v[j].y) + (v[j].z * v[j].z + v[j].w * v[j].w); }
        const float rstd = rsqrtf(wave_sum(s) * (1.f / D) + 1e-6f);
        u32x2* o8 = (u32x2*)(XN + (size_t)m * D);
#pragma unroll
        for (int j = 0; j < 8; ++j) { const f32x4 y = v[j] * rstd * gv[j]; u32x2 w; w.x = pk2(y.x, y.y); w.y = pk2(y.z, y.w); o8[lane + 64 * j] = w; }
    }
}
DI void phase_rms_final(float* X, const float* g) {
    const int tid = opaque_tid(), lane = tid & 63, wave = tid >> 6;
    const int gw = blockIdx.x * 8 + wave, NGW = gridDim.x * 8;
    f32x4 gv[8];
#pragma unroll
    for (int j = 0; j < 8; ++j) gv[j] = ((const f32x4*)g)[lane + 64 * j];
    for (int m = gw; m < M; m += NGW) {
        f32x4* xr = (f32x4*)(X + (size_t)m * D);
        f32x4 v[8]; float s = 0.f;
#pragma unroll
        for (int j = 0; j < 8; ++j) { v[j] = xr[lane + 64 * j]; s += (v[j].x * v[j].x + v[j].y * v[j].y) + (v[j].z * v[j].z + v[j].w * v[j].w); }
        const float rstd = rsqrtf(wave_sum(s) * (1.f / D) + 1e-6f);
#pragma unroll
        for (int j = 0; j < 8; ++j) xr[lane + 64 * j] = v[j] * rstd * gv[j];
    }
}

struct EpiResid {
    static constexpr bool PERM = false, AFTER_DRAIN = false;
    const float* base; float* out; int ldc; bf16_t* hb; float* rss;
    DI void operator()(const pg8::f32x4 (&acc)[2][2][4][2], const pg8::Unit& u, int wr, int wc, int fr, int fq) const {
        const int col0 = u.pn * pg8::BM + wc * 32 + 4 * fq;
#pragma unroll
        for (int ai = 0; ai < 2; ++ai)
#pragma unroll
            for (int m = 0; m < 4; ++m) {
                const int row = u.pm * pg8::BM + ai * pg8::HALF + wr * 64 + m * 16 + fr;
                const size_t off = (size_t)row * ldc + col0;
                float ssq = 0.f;
#pragma unroll
                for (int bj = 0; bj < 2; ++bj)
#pragma unroll
                    for (int n = 0; n < 2; ++n) { const size_t o = off + bj * pg8::HALF + n * 16; const pg8::f32x4 bs = *(const pg8::f32x4*)(base + o); const pg8::f32x4 v = bs + acc[ai][bj][m][n];
                        *(pg8::f32x4*)(out + o) = v; ssq += (v[0] * v[0] + v[1] * v[1]) + (v[2] * v[2] + v[3] * v[3]);
                        u32x2 w; w.x = pk2(v[0], v[1]); w.y = pk2(v[2], v[3]); *(u32x2*)(hb + o) = w; }
                ssq += __shfl_xor(ssq, 16); ssq += __shfl_xor(ssq, 32);
                if (fq == 0) rss[(size_t)row * 32 + u.pn * 4 + wc] = ssq;
                asm volatile("" ::: "memory");
            }
    }
};
struct EpiBf16RS {
    static constexpr bool PERM = true, AFTER_DRAIN = false;
    bf16_t* O; int ldc; const float* rss;
    DI void operator()(const pg8::f32x4 (&acc)[2][2][4][2], const pg8::Unit& u, int wr, int wc, int fr, int fq) const {
        const int row0 = u.pm * pg8::BM + wr * 64 + fr, col0 = u.pn * pg8::BM + wc * 32 + 8 * fq;
#pragma unroll
        for (int ai = 0; ai < 2; ++ai)
#pragma unroll
            for (int m = 0; m < 4; ++m) {
                const int row = row0 + ai * pg8::HALF + m * 16;
                float sc = 1.f;
                if (rss) { const pg8::f32x4* rp = (const pg8::f32x4*)(rss + (size_t)row * 32); pg8::f32x4 t = rp[0];
#pragma unroll
                    for (int j = 1; j < 8; ++j) t += rp[j];
                    sc = rsqrtf(((t[0] + t[1]) + (t[2] + t[3])) * (1.f / D) + 1e-6f); }
                bf16_t* rowp = O + (size_t)row * ldc + col0;
#pragma unroll
                for (int bj = 0; bj < 2; ++bj) { const pg8::f32x4 v0 = acc[ai][bj][m][0] * sc, v1 = acc[ai][bj][m][1] * sc;
                    u32x4 w; w.x = pk2(v0[0], v0[1]); w.y = pk2(v0[2], v0[3]); w.z = pk2(v1[0], v1[1]); w.w = pk2(v1[2], v1[3]);
                    *(u32x4*)(rowp + bj * pg8::HALF) = w; }
            }
    }
};

DI void phase_prep(const Args& a, int layer, LAS unsigned char* lds) {
    const int tid = opaque_tid(), lane = tid & 63, wave = tid >> 6;
    const int gw = blockIdx.x * 8 + wave, NGW = gridDim.x * 8;
    unsigned char* ws = a.ws;
    const bf16_t* P = (const bf16_t*)(ws + WS_P);
    {
        LAS bf16_t* scr = (LAS bf16_t*)(lds + wave * 9216);
        for (int it = gw; it < 6 * 4 * 256; it += NGW) {
            const int which = it / 1024, bg = (it / 256) & 3, st = it & 255, b = bg >> 1, g = bg & 1;
            if (which >= 3) {
                const int srccol = (which == 3 ? C_KS : which == 4 ? C_KW : C_KB) + g * 64;
                bf16_t* dst = (bf16_t*)(ws + (which == 3 ? WS_KSF : which == 4 ? WS_KWF : WS_KBF)) + (size_t)bg * 64 * S + (size_t)st * 4096;
                float rmax = 0.f;
#pragma unroll
                for (int i = 0; i < 8; ++i) { const int tok = i * 8 + (lane >> 3), q = lane & 7;
                    const u32x4 v = *(const u32x4*)(P + (size_t)(b * S + st * 64 + tok) * NP + srccol + q * 8);
                    const int pos = which == 3 ? (((tok >> 4) * 2 + (q >> 2)) * 64 + (q & 3) * 16 + (tok & 15))
                                               : ((tok >> 5) * 256 + (q >> 1) * 64 + (q & 1) * 32 + (tok & 31));
                    *(u32x4*)(dst + pos * 8) = v;
                    float ss = bflo(v.x) * bflo(v.x) + bfhi(v.x) * bfhi(v.x) + bflo(v.y) * bflo(v.y) + bfhi(v.y) * bfhi(v.y)
                             + bflo(v.z) * bflo(v.z) + bfhi(v.z) * bfhi(v.z) + bflo(v.w) * bflo(v.w) + bfhi(v.w) * bfhi(v.w);
                    ss += __shfl_xor(ss, 1); ss += __shfl_xor(ss, 2); ss += __shfl_xor(ss, 4);
                    rmax = fmaxf(rmax, ss); }
                rmax = fmaxf(rmax, __shfl_xor(rmax, 8)); rmax = fmaxf(rmax, __shfl_xor(rmax, 16)); rmax = fmaxf(rmax, __shfl_xor(rmax, 32));
                if (lane == 0) atomicMax((unsigned*)(ws + WS_KMAX) + (layer * 4 + (which - 3)) * 4 + bg, __builtin_bit_cast(unsigned, rmax));
                continue;
            }
            const int srccol = (which == 0 ? C_VS : which == 1 ? C_VW : C_VB) + g * 64;
            bf16_t* dst = (bf16_t*)(ws + (which == 0 ? WS_VST : which == 1 ? WS_VWT : WS_VBT)) + (size_t)bg * 64 * S + (size_t)st * 4096;
#pragma unroll
            for (int i = 0; i < 8; ++i) { const int tok = i * 8 + (lane >> 3), ch = lane & 7;
                const u32x4 v = *(const u32x4*)(P + (size_t)(b * S + st * 64 + tok) * NP + srccol + ch * 8);
                *(LAS u32x4*)(scr + tok * 72 + ch * 8) = v; }
            LDS_WAIT();
#pragma unroll
            for (int f = 0; f < 8; ++f) {
                int d, kb0, kstep;
                if (which == 0) { const int j = f >> 2, dt = f & 3, hh = lane & 15, qd = lane >> 4; d = 16 * dt + hh; kb0 = 16 * j + 4 * qd; kstep = 32; }
                else { const int tl = f >> 2, j = (f >> 1) & 1, dt = f & 1, c = lane & 31, hi = lane >> 5; d = dt * 32 + c; kb0 = tl * 32 + 16 * j + 4 * hi; kstep = 8; }
                unsigned e[8];
#pragma unroll
                for (int i = 0; i < 8; ++i) e[i] = scr[(kb0 + (i & 3) + kstep * (i >> 2)) * 72 + d];
                u32x4 o; o.x = e[0] | (e[1] << 16); o.y = e[2] | (e[3] << 16); o.z = e[4] | (e[5] << 16); o.w = e[6] | (e[7] << 16);
                *(u32x4*)(dst + (f * 64 + lane) * 8) = o;
            }
            LDS_WAIT();
        }
    }
    {
        const bf16_t* XN = (const bf16_t*)(ws + WS_XN);
        const bf16_t* wg = (const bf16_t*)(ws + WS_WIN) + (size_t)layer * NP * D + (size_t)C_GATE * D;
        bf16_t* Pw = (bf16_t*)(ws + WS_P);
        const int c = lane & 31, hi = lane >> 5;
        for (int it = NGW - 1 - gw; it < M / 32; it += NGW) {
            const bf16_t* ar = XN + (size_t)(it * 32 + c) * D + hi * 8;
            const bf16_t* b0 = wg + (size_t)c * D + hi * 8, *b1 = wg + (size_t)(32 + c) * D + hi * 8;
            f32x16 a0, a1;
#pragma unroll
            for (int r = 0; r < 16; ++r) { a0[r] = 0.f; a1[r] = 0.f; }
#pragma unroll 8
            for (int kk = 0; kk < 128; ++kk) {
                const bf16x8 af = *(const bf16x8*)(ar + kk * 16);
                a0 = MFMA32(af, *(const bf16x8*)(b0 + kk * 16), a0);
                a1 = MFMA32(af, *(const bf16x8*)(b1 + kk * 16), a1);
            }
#pragma unroll
            for (int r = 0; r < 16; ++r) {
                bf16_t* pr = Pw + (size_t)(it * 32 + crow(r, hi)) * NP + C_GATE;
                pr[c] = (bf16_t)f2bf(a0[r]);
                if (c < 16) pr[32 + c] = (bf16_t)f2bf(a1[r]);
            }
        }
    }
    __syncthreads();
    {
        LAS float* H = (LAS float*)lds;
        const int c = lane & 31, hi = lane >> 5, rg = wave >> 2, nt = wave & 3;
        for (int it = blockIdx.x; it < 128; it += gridDim.x) {
            const int kv = it >> 6, bg = (it >> 4) & 3, rt = it & 15, b = bg >> 1, g = bg & 1;
            const float* pos = (kv ? a.cmp_pos_v : a.cmp_pos_k) + (size_t)layer * 32 * 64;
            const bf16_t* w1t = (const bf16_t*)(ws + WS_CW1) + (size_t)(layer * 2 + kv) * 128 * 2048;
            const float* w2 = (kv ? a.cmp_w2_v : a.cmp_w2_k) + (size_t)layer * 128 * 64;
            int irow = rt * 64 + rg * 32 + c; irow = irow > 1022 ? 1022 : irow;
            const bf16_t* src = P + (size_t)(b * S + 16 * irow) * NP + (kv ? C_VC : C_KC) + g * 64;
            const bf16_t* bsrc = w1t + (size_t)(nt * 32 + c) * 2048 + hi * 8;
            f32x16 acc;
#pragma unroll
            for (int r = 0; r < 16; ++r) acc[r] = 0.f;
#pragma unroll 4
            for (int kk = 0; kk < 128; ++kk) {
                const int tok = kk >> 2, d = (kk & 3) * 16 + hi * 8;
                const u32x4 sv = *(const u32x4*)(src + (size_t)tok * NP + d);
                const f32x4 p0 = *(const f32x4*)(pos + tok * 64 + d), p1 = *(const f32x4*)(pos + tok * 64 + d + 4);
                const bf16x8 af = pack8(bflo(sv.x) + p0.x, bfhi(sv.x) + p0.y, bflo(sv.y) + p0.z, bfhi(sv.y) + p0.w,
                                        bflo(sv.z) + p1.x, bfhi(sv.z) + p1.y, bflo(sv.w) + p1.z, bfhi(sv.w) + p1.w);
                const bf16x8 bf = *(const bf16x8*)(bsrc + kk * 16);
                acc = MFMA32(af, bf, acc);
            }
#pragma unroll
            for (int r = 0; r < 16; ++r) H[(rg * 32 + crow(r, hi)) * 129 + nt * 32 + c] = gelu_tanh(acc[r]);
            __syncthreads();
            {
                const int i = tid >> 3, dc = (tid & 7) * 8;
                float o[8];
#pragma unroll
                for (int e = 0; e < 8; ++e) o[e] = 0.f;
                for (int n = 0; n < 128; ++n) {
                    const float hv = H[i * 129 + n];
                    const f32x4 wa = *(const f32x4*)(w2 + n * 64 + dc), wb = *(const f32x4*)(w2 + n * 64 + dc + 4);
                    o[0] += hv * wa.x; o[1] += hv * wa.y; o[2] += hv * wa.z; o[3] += hv * wa.w;
                    o[4] += hv * wb.x; o[5] += hv * wb.y; o[6] += hv * wb.z; o[7] += hv * wb.w;
                }
                const int ig = rt * 64 + i;
                if (ig > 1022) {
#pragma unroll
                    for (int e = 0; e < 8; ++e) o[e] = 0.f;
                }
                if (kv == 0) {
                    u32x4 w; w.x = pk2(o[0], o[1]); w.y = pk2(o[2], o[3]); w.z = pk2(o[4], o[5]); w.w = pk2(o[6], o[7]);
                    float ss = bflo(w.x) * bflo(w.x) + bfhi(w.x) * bfhi(w.x) + bflo(w.y) * bflo(w.y) + bfhi(w.y) * bfhi(w.y)
                             + bflo(w.z) * bflo(w.z) + bfhi(w.z) * bfhi(w.z) + bflo(w.w) * bflo(w.w) + bfhi(w.w) * bfhi(w.w);
                    ss += __shfl_xor(ss, 1); ss += __shfl_xor(ss, 2); ss += __shfl_xor(ss, 4);
                    ss = fmaxf(ss, __shfl_xor(ss, 8)); ss = fmaxf(ss, __shfl_xor(ss, 16)); ss = fmaxf(ss, __shfl_xor(ss, 32));
                    if (lane == 0) atomicMax((unsigned*)(ws + WS_KMAX) + (layer * 4 + 3) * 4 + bg, __builtin_bit_cast(unsigned, ss));
                    const int q = dc >> 3;
                    *(u32x4*)((bf16_t*)(ws + WS_KC) + (size_t)bg * NCP * 64 + (size_t)(ig >> 5) * 2048 + ((q >> 1) * 64 + (q & 1) * 32 + (ig & 31)) * 8) = w;
                } else {
                    const int kk5 = ig & 31, jj = kk5 >> 4, rem = kk5 & 15, hh1 = (rem >> 2) & 1, ii = (rem >> 3) * 4 + (rem & 3);
                    bf16_t* vt = (bf16_t*)(ws + WS_VCT) + (size_t)bg * 64 * NCP + (size_t)(ig >> 5) * 2048 + ii;
#pragma unroll
                    for (int e = 0; e < 8; ++e) { const int dd = dc + e; vt[((jj * 2 + (dd >> 5)) * 64 + hh1 * 32 + (dd & 31)) * 8] = (bf16_t)f2bf(o[e]); }
                }
            }
            __syncthreads();
        }
    }
}

constexpr float LOG2E = 1.4426950408889634f, SC2 = 0.125f * 1.4426950408889634f;
DI float ex2(float x) { return __builtin_amdgcn_exp2f(x); }
DI void loadK32(const bf16_t* kt, int lane, bf16x8 (&k)[4]) {
#pragma unroll
    for (int kk = 0; kk < 4; ++kk) k[kk] = *(const bf16x8*)(kt + (kk * 64 + lane) * 8);
}
DI f32x16 qk32r(const bf16x8 (&k)[4], const bf16x8 (&q)[4]) {
    f32x16 s;
#pragma unroll
    for (int r = 0; r < 16; ++r) s[r] = 0.f;
#pragma unroll
    for (int kk = 0; kk < 4; ++kk) s = MFMA32(k[kk], q[kk], s);
    return s;
}
DI void loadV32(const bf16_t* vt, int lane, bf16x8 (&v)[2][2]) {
#pragma unroll
    for (int j = 0; j < 2; ++j)
#pragma unroll
        for (int dt = 0; dt < 2; ++dt) v[j][dt] = *(const bf16x8*)(vt + ((j * 2 + dt) * 64 + lane) * 8);
}
DI void pv32r(const f32x16& p, const bf16x8 (&v)[2][2], f32x16& o0, f32x16& o1) {
#pragma unroll
    for (int j = 0; j < 2; ++j) {
        const bf16x8 pb = pack8(p[8 * j], p[8 * j + 1], p[8 * j + 2], p[8 * j + 3], p[8 * j + 4], p[8 * j + 5], p[8 * j + 6], p[8 * j + 7]);
        o0 = MFMA32(v[j][0], pb, o0);
        o1 = MFMA32(v[j][1], pb, o1);
    }
}
template <bool MASKED>
DI bool softmax32(f32x16& s, unsigned vm, float& m, float& l, float& alpha) {
    float sum = 0.f;
#pragma unroll
    for (int r = 0; r < 16; ++r) { float p = ex2(s[r] - m); if (MASKED) p = ((vm >> r) & 1u) ? p : 0.f; s[r] = p; sum += p; }
    l += sum; alpha = 1.f;
    return false;
}
#define DPPF(v, ctrl) __builtin_bit_cast(float, __builtin_amdgcn_update_dpp(0, __builtin_bit_cast(int, (v)), (ctrl), 0xF, 0xF, false))
#define DPPI(v, ctrl) __builtin_amdgcn_update_dpp(0, (v), (ctrl), 0xF, 0xF, false)
DI float sum8_dpp(float v) {
    v += __builtin_bit_cast(float, __builtin_amdgcn_update_dpp(0, __builtin_bit_cast(int, v), 0xB1, 0xF, 0xF, false));
    v += __builtin_bit_cast(float, __builtin_amdgcn_update_dpp(0, __builtin_bit_cast(int, v), 0x4E, 0xF, 0xF, false));
    v += __builtin_bit_cast(float, __builtin_amdgcn_update_dpp(0, __builtin_bit_cast(int, v), 0x141, 0xF, 0xF, false));
    return v;
}
DI float sumsq8(const bf16x8 v) { const u32x4 w = __builtin_bit_cast(u32x4, v);
    return bflo(w.x) * bflo(w.x) + bfhi(w.x) * bfhi(w.x) + bflo(w.y) * bflo(w.y) + bfhi(w.y) * bfhi(w.y) + bflo(w.z) * bflo(w.z) + bfhi(w.z) * bfhi(w.z) + bflo(w.w) * bflo(w.w) + bfhi(w.w) * bfhi(w.w); }
DI unsigned logits_cmp(f32x16& s, int key0, int qpos, int hi, const LAS float* bias_h) {
    unsigned vm = 0u;
#pragma unroll
    for (int r = 0; r < 16; ++r) {
        const int dist = qpos - (16 * (key0 + crow(r, hi)) + 31);
        const bool valid = dist >= 0;
        const float bb = bias_h[rel_bucket(dist < 0 ? 0 : dist)];
        s[r] = valid ? s[r] * SC2 + bb : NEGF;
        vm |= valid ? (1u << r) : 0u;
    }
    return vm;
}

constexpr int AW_IMP = 0, AW_OLDS = 4128, AW_SEL = 4128 + 8320, AW_NSEL = AW_SEL + 256, AW_BYTES = 12800;
constexpr int ATT_BIAS_OFF = 8 * AW_BYTES;
constexpr int LUTW_STRIDE = 612, LUTB_STRIDE = 228;
constexpr int ATT_LUTW_OFF = ATT_BIAS_OFF + 4096, ATT_LUTB_OFF = ATT_LUTW_OFF + 8 * LUTW_STRIDE * 4, ATT_LDS_END = ATT_LUTB_OFF + 8 * LUTB_STRIDE * 4;
static_assert(ATT_LDS_END <= LDS_BYTES, "attention LDS map");

template <int W>
DI void window_branch(const bf16_t* Kf  , const bf16_t* Vf  , int lane,
                      const bf16x8 (&qf)[4], const LAS float* lut_h  , int q0, int qpos, int c, int hi,
                      float& m, float& l, f32x16& o0, f32x16& o1) {
    const int kd = q0 & ~31;
    int kstart = q0 - (W - 1); kstart = kstart < 0 ? 0 : kstart; kstart &= ~31;
    bf16x8 kc[4];
    loadK32(Kf + (size_t)(kd >> 5) * 2048, lane, kc);
    const float sini = -m * (1.f / SC2);
#pragma unroll 1
    for (int key0 = kd; key0 >= kstart; key0 -= 32) {
        bf16x8 vf[2][2], kn[4];
        loadV32(Vf + (size_t)(key0 >> 5) * 2048, lane, vf);
        const int nk = key0 - 32 >= kstart ? key0 - 32 : key0;
        loadK32(Kf + (size_t)(nk >> 5) * 2048, lane, kn);
        f32x16 s;
#pragma unroll
        for (int r = 0; r < 16; ++r) s[r] = sini;
#pragma unroll
        for (int kk = 0; kk < 4; ++kk) s = MFMA32(kc[kk], qf[kk], s);
        const LAS float* pt = lut_h + (qpos - key0 - 4 * hi - 27);
        float sum = 0.f;
#pragma unroll
        for (int r = 0; r < 16; ++r) { const float p = ex2(s[r] * SC2 + pt[27 - ((r & 3) + 8 * (r >> 2))]); s[r] = p; sum += p; }
        l += sum;
        pv32r(s, vf, o0, o1);
#pragma unroll
        for (int kk = 0; kk < 4; ++kk) kc[kk] = kn[kk];
    }
}

DI void phase_attn(const Args& a, int layer, LAS unsigned char* lds) {
    const int tid = opaque_tid(), lane = tid & 63, wave = tid >> 6;
    unsigned char* ws = a.ws;
    const bf16_t* P = (const bf16_t*)(ws + WS_P);
    bf16_t* O = (bf16_t*)(ws + WS_O);
    const int bg = blockIdx.x & 3, b = bg >> 1, g = bg & 1, wq = blockIdx.x >> 2, nwq = gridDim.x >> 2;
    LAS float* bias = (LAS float*)(lds + ATT_BIAS_OFF);
    LAS float* lutW = (LAS float*)(lds + ATT_LUTW_OFF);
    LAS float* lutB = (LAS float*)(lds + ATT_LUTB_OFF);
    for (int i = tid; i < 1024; i += NTHREADS) bias[i] = a.rel_bias[(i & 31) * 32 + (i >> 5)] * LOG2E;
    for (int i = tid; i < 8 * LUTW_STRIDE; i += NTHREADS) { const int hh = i / LUTW_STRIDE, dist = i % LUTW_STRIDE - 32;
        lutW[i] = (dist >= 0 && dist < 512) ? a.rel_bias[rel_bucket(dist) * 32 + g * 8 + hh] * LOG2E : NEGF; }
    for (int i = tid; i < 8 * LUTB_STRIDE; i += NTHREADS) { const int hh = i / LUTB_STRIDE, dist = i % LUTB_STRIDE - 32;
        lutB[i] = (dist >= 0 && dist < 128) ? a.rel_bias[rel_bucket(dist) * 32 + 16 + g * 8 + hh] * LOG2E : NEGF; }
    __syncthreads();
    LAS unsigned char* wl = lds + wave * AW_BYTES;
    LAS float* imp = (LAS float*)(wl + AW_IMP);
    LAS float* olds = (LAS float*)(wl + AW_OLDS);
    LAS int* sel = (LAS int*)(wl + AW_SEL);
    LAS int* nsel = (LAS int*)(wl + AW_NSEL);
    const int c = lane & 31, hi = lane >> 5, ql = c >> 3, h = c & 7;
    const bf16_t* Pb = P + (size_t)b * S * NP;
    const bf16_t* kcb = (const bf16_t*)(ws + WS_KC) + (size_t)bg * NCP * 64;
    const bf16_t* vct = (const bf16_t*)(ws + WS_VCT) + (size_t)bg * 64 * NCP;
    const bf16_t* vst = (const bf16_t*)(ws + WS_VST) + (size_t)bg * 64 * S;
    const bf16_t* vwt = (const bf16_t*)(ws + WS_VWT) + (size_t)bg * 64 * S;
    const bf16_t* kwf = (const bf16_t*)(ws + WS_KWF) + (size_t)bg * 64 * S;
    const bf16_t* kbf = (const bf16_t*)(ws + WS_KBF) + (size_t)bg * 64 * S;
    const bf16_t* ksf = (const bf16_t*)(ws + WS_KSF) + (size_t)bg * 64 * S;
    const bf16_t* vbt = (const bf16_t*)(ws + WS_VBT) + (size_t)bg * 64 * S;
    const float sinkv = a.sinks[layer * 16 + g * 8 + h] * LOG2E;
    const LAS float* bias_a = bias + (g * 8 + h) * 32;
    const float b31 = bias_a[31];
    const unsigned* kmx = (const unsigned*)(ws + WS_KMAX) + layer * 16 + bg;
    const float knS = sqrtf(__builtin_bit_cast(float, kmx[0])) * SC2, knW = sqrtf(__builtin_bit_cast(float, kmx[4])) * SC2;
    const float knB = sqrtf(__builtin_bit_cast(float, kmx[8])) * SC2, knC = sqrtf(__builtin_bit_cast(float, kmx[12])) * SC2;
    float bmaxA = bias_a[0], bmaxB = bias[(16 + g * 8 + h) * 32];
    for (int k = 1; k < 32; ++k) { bmaxA = fmaxf(bmaxA, bias_a[k]); bmaxB = fmaxf(bmaxB, bias[(16 + g * 8 + h) * 32 + k]); }
    bmaxA += 0.01f; bmaxB += 0.01f;

#pragma unroll 1
    for (int qt0 = wq; qt0 < S / 32 && wq < nwq; qt0 += nwq) {
        const int rnd = qt0 / nwq, qt32 = ((rnd & 1) && (rnd + 1) * nwq <= S / 32) ? rnd * nwq + (nwq - 1 - wq) : qt0;
        const int q0 = qt32 * 32 + wave * 4;
        const int qpos = q0 + ql;
        const size_t mrow = (size_t)(b * S + qpos);
        const bf16_t* prow = P + mrow * NP;
        {
            bf16x8 qf[4];
#pragma unroll
            for (int kk = 0; kk < 4; ++kk) qf[kk] = *(const bf16x8*)(prow + C_QB + (g * 8 + h) * 64 + kk * 16 + hi * 8);
            float qn2 = sumsq8(qf[0]) + sumsq8(qf[1]) + sumsq8(qf[2]) + sumsq8(qf[3]); qn2 += __shfl_xor(qn2, 32);
            float m = sqrtf(qn2) * knB + bmaxB, l = hi == 0 ? ex2(sinkv - m) : 0.f;
            f32x16 o0, o1;
#pragma unroll
            for (int r = 0; r < 16; ++r) { o0[r] = 0.f; o1[r] = 0.f; }
            window_branch<128>(kbf, vbt, lane, qf, lutB + h * LUTB_STRIDE + 32, q0, qpos, c, hi, m, l, o0, o1);
            const float lt = l + __shfl_xor(l, 32), inv = 1.f / lt;
            bf16_t* orow = O + mrow * D + 1024 + (g * 8 + h) * 64;
#pragma unroll
            for (int dt = 0; dt < 2; ++dt)
#pragma unroll
                for (int q4 = 0; q4 < 4; ++q4) {
                    const f32x16& oo = dt ? o1 : o0;
                    u32x2 w; w.x = pk2(oo[4 * q4] * inv, oo[4 * q4 + 1] * inv); w.y = pk2(oo[4 * q4 + 2] * inv, oo[4 * q4 + 3] * inv);
                    *(u32x2*)(orow + dt * 32 + 8 * q4 + 4 * hi) = w;
                }
        }
        const float gt0 = sigmoidf_(bf2f(prow[C_GATE + (g * 8 + h) * 3 + 0]));
        bf16x8 qfa[4];
#pragma unroll
        for (int kk = 0; kk < 4; ++kk) qfa[kk] = *(const bf16x8*)(prow + C_QA + (g * 8 + h) * 64 + kk * 16 + hi * 8);
        float qnA; { float qn2 = sumsq8(qfa[0]) + sumsq8(qfa[1]) + sumsq8(qfa[2]) + sumsq8(qfa[3]); qn2 += __shfl_xor(qn2, 32); qnA = sqrtf(qn2); }
        for (int i = lane; i < 4 * 257; i += 64) imp[i] = 0.f;
        const int ntile = (q0 + 3) / 512 + 1;
        const int nfast = q0 >= 2040 ? (q0 - 2040) / 512 + 1 : 0;
        {
            float m = qnA * knC + bmaxA, l = 0.f;
            {
                bf16x8 kc[4];
                loadK32(kcb, lane, kc);
#pragma unroll 1
                for (int t = 0; t < ntile; ++t) {
                    bf16x8 kn[4];
                    const int tn = t + 1 < ntile ? t + 1 : t;
                    loadK32(kcb + (size_t)tn * 2048, lane, kn);
                    f32x16 s = qk32r(kc, qfa);
                    float alpha;
                    if (t < nfast) {
#pragma unroll
                        for (int r = 0; r < 16; ++r) s[r] = s[r] * SC2 + b31;
                        (void)softmax32<false>(s, 0u, m, l, alpha);
                    } else {
                        const unsigned vm = logits_cmp(s, t * 32, qpos, hi, bias_a);
                        (void)softmax32<true>(s, vm, m, l, alpha);
                    }
#pragma unroll
                    for (int kk = 0; kk < 4; ++kk) kc[kk] = kn[kk];
                }
            }
            const float lt = l + __shfl_xor(l, 32), inv = lt > 0.f ? 1.f / lt : 0.f;
            f32x16 o0, o1;
#pragma unroll
            for (int r = 0; r < 16; ++r) { o0[r] = 0.f; o1[r] = 0.f; }
            LDS_WAIT();
            bf16x8 kc[4];
            loadK32(kcb, lane, kc);
#pragma unroll 1
            for (int t = 0; t < ntile; ++t) {
                bf16x8 vf[2][2], kn[4];
                loadV32(vct + (size_t)t * 2048, lane, vf);
                const int tn = t + 1 < ntile ? t + 1 : t;
                loadK32(kcb + (size_t)tn * 2048, lane, kn);
                f32x16 s = qk32r(kc, qfa);
                if (t < nfast) {
#pragma unroll
                    for (int r = 0; r < 16; ++r) s[r] = ex2(s[r] * SC2 + (b31 - m)) * inv;
                } else {
                    const unsigned vm = logits_cmp(s, t * 32, qpos, hi, bias_a);
#pragma unroll
                    for (int r = 0; r < 16; ++r) s[r] = ((vm >> r) & 1u) ? ex2(s[r] - m) * inv : 0.f;
                }
#pragma unroll
                for (int grp = 0; grp < 4; ++grp) {
                    float wa = 2.f * (s[4 * grp] + s[4 * grp + 1] + s[4 * grp + 2]) + s[4 * grp + 3], wb = s[4 * grp + 3];
                    wa = sum8_dpp(wa); wb = sum8_dpp(wb);
                    const int j = t * 8 + 2 * grp + hi;
                    if (h == 0) {
                        (void)__hip_atomic_fetch_add(imp + ql * 257 + j, wa, __ATOMIC_RELAXED, __HIP_MEMORY_SCOPE_WORKGROUP);
                        (void)__hip_atomic_fetch_add(imp + ql * 257 + j + 1, wb, __ATOMIC_RELAXED, __HIP_MEMORY_SCOPE_WORKGROUP);
                    }
                }
                pv32r(s, vf, o0, o1);
#pragma unroll
                for (int kk = 0; kk < 4; ++kk) kc[kk] = kn[kk];
            }
#pragma unroll
            for (int r = 0; r < 16; ++r) { olds[c * 65 + crow(r, hi)] = gt0 * o0[r]; olds[c * 65 + 32 + crow(r, hi)] = gt0 * o1[r]; }
        }
        LDS_WAIT();
        {
            const int tq = lane >> 4, sub = lane & 15;
            const int qp = q0 + tq, cb = qp >> 6;
            float v[16];
#pragma unroll
            for (int i = 0; i < 16; ++i) { const int j = sub + 16 * i; v[i] = (j >= 1 && j <= cb - 2) ? imp[tq * 257 + j] : -1.f; }
            int n = (cb < 2 ? cb : 2) + 1;
            if (sub == 0) {
                sel[tq * 16 + 0] = 0;
                if (cb >= 1) sel[tq * 16 + n - 1] = cb;
                if (cb >= 2) sel[tq * 16 + 1] = cb - 1;
            }
#pragma unroll 1
            for (int k = 0; k < 13; ++k) {
                float bv = v[0]; int bj = sub;
#pragma unroll
                for (int i = 1; i < 16; ++i) { if (v[i] > bv) { bv = v[i]; bj = sub + 16 * i; } }
                { const float ov = DPPF(bv, 0xB1); const int oj = DPPI(bj, 0xB1); if (ov > bv || (ov == bv && oj < bj)) { bv = ov; bj = oj; } }
                { const float ov = DPPF(bv, 0x4E); const int oj = DPPI(bj, 0x4E); if (ov > bv || (ov == bv && oj < bj)) { bv = ov; bj = oj; } }
                { const float ov = DPPF(bv, 0x141); const int oj = DPPI(bj, 0x141); if (ov > bv || (ov == bv && oj < bj)) { bv = ov; bj = oj; } }
                { const float ov = DPPF(bv, 0x140); const int oj = DPPI(bj, 0x140); if (ov > bv || (ov == bv && oj < bj)) { bv = ov; bj = oj; } }
                if (bv >= 0.f) {
                    if (sub == 0) sel[tq * 16 + n] = bj;
                    n += 1;
#pragma unroll
                    for (int i = 0; i < 16; ++i) { if (bj == sub + 16 * i) v[i] = -1.f; }
                }
            }
            if (sub == 0) nsel[tq] = n;
        }
        LDS_WAIT();
        {
            const int hh = lane & 15, qd = lane >> 4, hd = hh & 7;
            const LAS float* bias_s = bias + (g * 8 + hd) * 32;
            const float b31s = bias_s[31];

#pragma unroll 1
            for (int qi = 0; qi < 4; ++qi) {
                const int qp = q0 + qi;
                const bf16_t* pr = Pb + (size_t)qp * NP;
                bf16x8 qf[2];
#pragma unroll
                for (int kk = 0; kk < 2; ++kk) qf[kk] = *(const bf16x8*)(pr + C_QA + (g * 8 + hd) * 64 + kk * 32 + qd * 8);
                float qs2 = sumsq8(qf[0]) + sumsq8(qf[1]); qs2 += __shfl_xor(qs2, 16); qs2 += __shfl_xor(qs2, 32);
                const float m = sqrtf(qs2) * knS + bmaxA; float l = 0.f;
                const bool lowc = hh < 8;
                const bf16x8 zero8 = {0, 0, 0, 0, 0, 0, 0, 0};
                bf16x8 qlo[2], qhi[2];
#pragma unroll
                for (int kk = 0; kk < 2; ++kk) { qlo[kk] = lowc ? qf[kk] : zero8; qhi[kk] = lowc ? zero8 : qf[kk]; }
                const int hs = hh >> 3;
                f32x4 o[4];
#pragma unroll
                for (int dt = 0; dt < 4; ++dt) o[dt] = (f32x4){0.f, 0.f, 0.f, 0.f};
                const int ns = __builtin_amdgcn_readfirstlane(nsel[qi]);
                int jb = __builtin_amdgcn_readfirstlane(sel[qi * 16]);
                bf16x8 ka[4][2];
#pragma unroll
                for (int t = 0; t < 4; ++t)
#pragma unroll
                    for (int kk = 0; kk < 2; ++kk) ka[t][kk] = *(const bf16x8*)(ksf + (size_t)jb * 4096 + ((t * 2 + kk) * 64 + lane) * 8);
#pragma unroll 1
                for (int k = 0; k < ns; ++k) {
                    bf16x8 va[2][4], kn[4][2];
#pragma unroll
                    for (int j = 0; j < 2; ++j)
#pragma unroll
                        for (int dt = 0; dt < 4; ++dt) va[j][dt] = *(const bf16x8*)(vst + (size_t)jb * 4096 + ((j * 4 + dt) * 64 + lane) * 8);
                    const int jn = __builtin_amdgcn_readfirstlane(sel[qi * 16 + (k + 1 < ns ? k + 1 : k)]);
#pragma unroll
                    for (int t = 0; t < 4; ++t)
#pragma unroll
                        for (int kk = 0; kk < 2; ++kk) kn[t][kk] = *(const bf16x8*)(ksf + (size_t)jn * 4096 + ((t * 2 + kk) * 64 + lane) * 8);
                    f32x4 s[2];
#pragma unroll
                    for (int u = 0; u < 2; ++u) {
                        s[u] = (f32x4){0.f, 0.f, 0.f, 0.f};
#pragma unroll
                        for (int kk = 0; kk < 2; ++kk) { s[u] = MFMA16(ka[2 * u][kk], qlo[kk], s[u]); s[u] = MFMA16(ka[2 * u + 1][kk], qhi[kk], s[u]); }
                    }
                    if (qp - (jb * 64 + 63) >= 1513) {
                        const float cst = b31s - m;
#pragma unroll
                        for (int u = 0; u < 2; ++u)
#pragma unroll
                            for (int r = 0; r < 4; ++r) s[u][r] = s[u][r] * SC2 + cst;
                    } else {
#pragma unroll
                        for (int u = 0; u < 2; ++u)
#pragma unroll
                            for (int r = 0; r < 4; ++r) {
                                const int dist = qp - (jb * 64 + 16 * (2 * u + hs) + 4 * qd + r);
                                const float bb = bias_s[rel_bucket(dist < 0 ? 0 : dist)];
                                s[u][r] = dist >= 0 ? s[u][r] * SC2 + (bb - m) : NEGF;
                            }
                    }
                    float sum = 0.f;
#pragma unroll
                    for (int u = 0; u < 2; ++u)
#pragma unroll
                        for (int r = 0; r < 4; ++r) { const float p = ex2(s[u][r]); s[u][r] = p; sum += p; }
                    l += sum;
                    {
                        const bf16x8 p8 = pack8(s[0][0], s[0][1], s[0][2], s[0][3], s[1][0], s[1][1], s[1][2], s[1][3]);
                        const bf16x8 plo = lowc ? p8 : zero8, phi = lowc ? zero8 : p8;
#pragma unroll
                        for (int dt = 0; dt < 4; ++dt) { o[dt] = MFMA16(va[0][dt], plo, o[dt]); o[dt] = MFMA16(va[1][dt], phi, o[dt]); }
                    }
                    jb = jn;
#pragma unroll
                    for (int t = 0; t < 4; ++t)
#pragma unroll
                        for (int kk = 0; kk < 2; ++kk) ka[t][kk] = kn[t][kk];
                }
                float lt = l + __shfl_xor(l, 16); lt += __shfl_xor(lt, 32); lt += __shfl_xor(lt, 8);
#pragma unroll
                for (int dt = 0; dt < 4; ++dt)
#pragma unroll
                    for (int r = 0; r < 4; ++r) o[dt][r] += __shfl_xor(o[dt][r], 8);
                const float gt1 = sigmoidf_(bf2f(Pb[(size_t)qp * NP + C_GATE + (g * 8 + hd) * 3 + 1]));
                const float inv = lt > 0.f ? gt1 / lt : 0.f;
                if (hh < 8) {
#pragma unroll
                    for (int dt = 0; dt < 4; ++dt)
#pragma unroll
                        for (int r = 0; r < 4; ++r) olds[(qi * 8 + hh) * 65 + 16 * dt + 4 * qd + r] += o[dt][r] * inv;
                }
            }
        }
        LDS_WAIT();
        {
            int lw = lane; asm volatile("" : "+v"(lw));
            const int c = lw & 31, hi = lw >> 5, h = c & 7, qpos = q0 + (c >> 3);
            const size_t mrow = (size_t)(b * S + qpos);
            const bf16_t* prow = P + mrow * NP;
            const float gt2 = sigmoidf_(bf2f(prow[C_GATE + (g * 8 + h) * 3 + 2]));
            bf16x8 qfw[4];
#pragma unroll
            for (int kk = 0; kk < 4; ++kk) qfw[kk] = *(const bf16x8*)(prow + C_QA + (g * 8 + h) * 64 + kk * 16 + hi * 8);
            float qnW; { float qn2 = sumsq8(qfw[0]) + sumsq8(qfw[1]) + sumsq8(qfw[2]) + sumsq8(qfw[3]); qn2 += __shfl_xor(qn2, 32); qnW = sqrtf(qn2); }
            float m = qnW * knW + bmaxA, l = 0.f;
            f32x16 o0, o1;
#pragma unroll
            for (int r = 0; r < 16; ++r) { o0[r] = 0.f; o1[r] = 0.f; }
            window_branch<512>(kwf, vwt, lw, qfw, lutW + h * LUTW_STRIDE + 32, q0, qpos, c, hi, m, l, o0, o1);
            const float lt = l + __shfl_xor(l, 32), inv = lt > 0.f ? gt2 / lt : 0.f;
            bf16_t* orow = O + mrow * D + (g * 8 + h) * 64;
#pragma unroll
            for (int dt = 0; dt < 2; ++dt)
#pragma unroll
                for (int q4 = 0; q4 < 4; ++q4) {
                    const f32x16& oo = dt ? o1 : o0;
                    const int d0 = dt * 32 + 8 * q4 + 4 * hi;
                    const float e0 = oo[4 * q4] * inv + olds[c * 65 + d0], e1 = oo[4 * q4 + 1] * inv + olds[c * 65 + d0 + 1];
                    const float e2 = oo[4 * q4 + 2] * inv + olds[c * 65 + d0 + 2], e3 = oo[4 * q4 + 3] * inv + olds[c * 65 + d0 + 3];
                    u32x2 w; w.x = pk2(e0, e1); w.y = pk2(e2, e3);
                    *(u32x2*)(orow + d0) = w;
                }
        }
        LDS_WAIT();
    }
}

DI unsigned ordf(float f) { const unsigned u = __builtin_bit_cast(unsigned, f); return (u & 0x80000000u) ? ~u : (u | 0x80000000u); }
DI float unordf(unsigned k) { const unsigned u = (k & 0x80000000u) ? (k & 0x7fffffffu) : ~k; return __builtin_bit_cast(float, u); }

DI void peer_half_topk(const bf16_t* qrow  , const bf16_t* subk  , int hi, int lane, LAS unsigned* ltop) {
    unsigned keys[64];
    asm volatile("" : "+v"(subk));
#pragma unroll
    for (int rt = 0; rt < 4; ++rt) {
        f32x16 acc;
#pragma unroll
        for (int r = 0; r < 16; ++r) acc[r] = 0.f;
#pragma unroll
        for (int kk = 0; kk < 8; ++kk) {
            const bf16x8 af = *(const bf16x8*)(subk + (size_t)(rt * 32) * 128 + kk * 16);
            const bf16x8 bf = *(const bf16x8*)(qrow + kk * 16);
            acc = MFMA32(af, bf, acc);
        }
#pragma unroll
        for (int r = 0; r < 16; ++r) { const int n = rt * 32 + crow(r, hi); keys[rt * 16 + r] = (ordf(acc[r]) & ~0x7Fu) | (unsigned)(127 - n); }
    }
#pragma unroll 1
    for (int k = 0; k < 16; ++k) {
        unsigned mx = keys[0];
#pragma unroll
        for (int i = 1; i < 64; ++i) mx = mx > keys[i] ? mx : keys[i];
        const unsigned om = (unsigned)__shfl_xor((int)mx, 32);
        mx = mx > om ? mx : om;
        ltop[k * 64 + lane] = mx;
#pragma unroll
        for (int i = 0; i < 64; ++i) keys[i] = keys[i] == mx ? 0u : keys[i];
    }
}

DI void phase_peer_select(const Args& a, int layer, LAS unsigned char* lds) {
    const int tid = opaque_tid(), lane = tid & 63, wave = tid >> 6;
    const int gw = blockIdx.x * 8 + wave, NGW = gridDim.x * 8;
    unsigned char* ws = a.ws;
    const bf16_t* Q2 = (const bf16_t*)(ws + WS_Q2);
    const bf16_t* subk = (const bf16_t*)(ws + WS_SUBK) + (size_t)layer * 2 * 128 * 128;
    int* IDX = (int*)(ws + WS_IDX);
    float* GATE = (float*)(ws + WS_GATE);
    LAS unsigned* lt1 = (LAS unsigned*)(lds + wave * 8192);
    LAS unsigned* lt2 = lt1 + 1024;
    const int c = lane & 31, hi = lane >> 5, tl = c >> 3, h = c & 7;
#pragma unroll 1
    for (int unit = gw; unit < M / 4; unit += NGW) {
        const size_t m = (size_t)unit * 4 + tl;
        const bf16_t* qrow = Q2 + m * D + h * 256 + hi * 8;
        peer_half_topk(qrow, subk + (size_t)c * 128 + hi * 8, hi, lane, lt1);
        peer_half_topk(qrow + 128, subk + 128 * 128 + (size_t)c * 128 + hi * 8, hi, lane, lt2);
        LDS_WAIT();
        unsigned t1[16], t2[16];
#pragma unroll
        for (int i = 0; i < 16; ++i) { t1[i] = lt1[i * 64 + lane]; t2[i] = lt2[i * 64 + lane]; }
        unsigned ck[16][16];
#pragma unroll
        for (int x = 0; x < 16; ++x)
#pragma unroll
            for (int y = 0; y < 16; ++y)
                if ((x + 1) * (y + 1) <= 16) ck[x][y] = (ordf(unordf(t1[x] & ~0x7Fu) + unordf(t2[y] & ~0x7Fu)) & ~0xFFu) | (unsigned)(255 - (x * 16 + y));
        const float scmax = unordf(ck[0][0] & ~0xFFu);
        int* ip = IDX + m * 128 + h * 16; float* gp = GATE + m * 128 + h * 16;
        float sum = 0.f;
#pragma unroll 1
        for (int k = 0; k < 16; ++k) {
            unsigned mx = 0u;
#pragma unroll
            for (int x = 0; x < 16; ++x)
#pragma unroll
                for (int y = 0; y < 16; ++y)
                    if ((x + 1) * (y + 1) <= 16) mx = mx > ck[x][y] ? mx : ck[x][y];
#pragma unroll
            for (int x = 0; x < 16; ++x)
#pragma unroll
                for (int y = 0; y < 16; ++y)
                    if ((x + 1) * (y + 1) <= 16) ck[x][y] = ck[x][y] == mx ? 0u : ck[x][y];
            const int ci = 255 - (int)(mx & 0xFFu);
            const int e = (int)(127u - (lt1[(ci >> 4) * 64 + lane] & 0x7Fu)) * 128 + (int)(127u - (lt2[(ci & 15) * 64 + lane] & 0x7Fu));
            const float ek = __expf(unordf(mx & ~0xFFu) - scmax);
            sum += ek;
            if (hi == 0) { ip[k] = e; gp[k] = ek; }
        }
        if (hi == 0) ((float*)(ws + WS_GSUM))[m * 8 + h] = 1.f / sum;
        LDS_WAIT();
    }
}

#define FP8_LO(w) __builtin_amdgcn_cvt_pk_f32_fp8((int)(w), false)
#define FP8_HI(w) __builtin_amdgcn_cvt_pk_f32_fp8((int)(w), true)
DI float dot16(const float (&x)[32], int o, const u32x4 w) {
    const f32x2 a0 = FP8_LO(w.x), a1 = FP8_HI(w.x), a2 = FP8_LO(w.y), a3 = FP8_HI(w.y), a4 = FP8_LO(w.z), a5 = FP8_HI(w.z), a6 = FP8_LO(w.w), a7 = FP8_HI(w.w);
    return (x[o + 0] * a0.x + x[o + 1] * a0.y + x[o + 2] * a1.x + x[o + 3] * a1.y) + (x[o + 4] * a2.x + x[o + 5] * a2.y + x[o + 6] * a3.x + x[o + 7] * a3.y)
         + (x[o + 8] * a4.x + x[o + 9] * a4.y + x[o + 10] * a5.x + x[o + 11] * a5.y) + (x[o + 12] * a6.x + x[o + 13] * a6.y + x[o + 14] * a7.x + x[o + 15] * a7.y);
}
DI float dot16p(const u32x4 xa, const u32x4 xb, const u32x4 w) {
    const f32x2 a0 = FP8_LO(w.x), a1 = FP8_HI(w.x), a2 = FP8_LO(w.y), a3 = FP8_HI(w.y), a4 = FP8_LO(w.z), a5 = FP8_HI(w.z), a6 = FP8_LO(w.w), a7 = FP8_HI(w.w);
    return (bflo(xa.x) * a0.x + bfhi(xa.x) * a0.y + bflo(xa.y) * a1.x + bfhi(xa.y) * a1.y) + (bflo(xa.z) * a2.x + bfhi(xa.z) * a2.y + bflo(xa.w) * a3.x + bfhi(xa.w) * a3.y)
         + (bflo(xb.x) * a4.x + bfhi(xb.x) * a4.y + bflo(xb.y) * a5.x + bfhi(xb.y) * a5.y) + (bflo(xb.z) * a6.x + bfhi(xb.z) * a6.y + bflo(xb.w) * a7.x + bfhi(xb.w) * a7.y);
}
DI void axpy16(float (&acc)[32], int o, float g, const u32x4 w) {
    const f32x2 a0 = FP8_LO(w.x), a1 = FP8_HI(w.x), a2 = FP8_LO(w.y), a3 = FP8_HI(w.y), a4 = FP8_LO(w.z), a5 = FP8_HI(w.z), a6 = FP8_LO(w.w), a7 = FP8_HI(w.w);
    acc[o + 0] += g * a0.x; acc[o + 1] += g * a0.y; acc[o + 2] += g * a1.x; acc[o + 3] += g * a1.y; acc[o + 4] += g * a2.x; acc[o + 5] += g * a2.y; acc[o + 6] += g * a3.x; acc[o + 7] += g * a3.y;
    acc[o + 8] += g * a4.x; acc[o + 9] += g * a4.y; acc[o + 10] += g * a5.x; acc[o + 11] += g * a5.y; acc[o + 12] += g * a6.x; acc[o + 13] += g * a6.y; acc[o + 14] += g * a7.x; acc[o + 15] += g * a7.y;
}
DI void gat_load8(const unsigned char* base, int idlo, int idhi, int g4, unsigned lo16, u32x4 (&buf)[8]) {
    const int ids = g4 < 16 ? idlo : idhi, e0 = (g4 & 15) * 4;
#pragma unroll
    for (int j = 0; j < 4; ++j) { const unsigned of = (unsigned)__shfl(ids, e0 + j) * (unsigned)D + lo16; buf[2 * j] = *(const u32x4*)(base + of); buf[2 * j + 1] = *(const u32x4*)(base + of + 1024u); }
}
DI float dots4(const u32x4 (&xp)[4], const u32x4 b0, const u32x4 b1, const u32x4 b2, const u32x4 b3, const u32x4 b4, const u32x4 b5, const u32x4 b6, const u32x4 b7, int lane) {
    const float d0 = dot16p(xp[0], xp[1], b0) + dot16p(xp[2], xp[3], b1); __builtin_amdgcn_sched_barrier(0);
    const float d1 = dot16p(xp[0], xp[1], b2) + dot16p(xp[2], xp[3], b3); __builtin_amdgcn_sched_barrier(0);
    const float d2 = dot16p(xp[0], xp[1], b4) + dot16p(xp[2], xp[3], b5); __builtin_amdgcn_sched_barrier(0);
    const float d3 = dot16p(xp[0], xp[1], b6) + dot16p(xp[2], xp[3], b7); __builtin_amdgcn_sched_barrier(0);
    const bool p1 = lane & 1, p2 = lane & 2;
    const float b0s = (p1 ? d1 : d0) + __shfl_xor(p1 ? d0 : d1, 1);
    const float b1s = (p1 ? d3 : d2) + __shfl_xor(p1 ? d2 : d3, 1);
    float cs = (p2 ? b1s : b0s) + __shfl_xor(p2 ? b0s : b1s, 2);
    cs += __shfl_xor(cs, 4); cs += __shfl_xor(cs, 8); cs += __shfl_xor(cs, 16); cs += __shfl_xor(cs, 32);
    return cs;
}
DI void phase_peer_u(const Args& a, int layer) {
    const int tid = opaque_tid(), lane = tid & 63, wave = tid >> 6;
    const int gw = blockIdx.x * 8 + wave, NGW = gridDim.x * 8;
    unsigned char* ws = a.ws;
    const bf16_t* XN = (const bf16_t*)(ws + WS_XN);
    const unsigned char* U = ws + WS_U + (size_t)layer * NEXP * D;
    const unsigned lo16 = (unsigned)lane * 16u;
    const int* IDX = (const int*)(ws + WS_IDX);
    float* GATE = (float*)(ws + WS_GATE);
    const float* GSUM = (const float*)(ws + WS_GSUM);
    int m = gw;
    if (m < M) {
        int idA = IDX[(size_t)m * 128 + lane], idB = IDX[(size_t)m * 128 + 64 + lane];
        u32x4 xp[4];
#pragma unroll
        for (int q = 0; q < 4; ++q) xp[q] = *(const u32x4*)(XN + (size_t)m * D + (q >> 1) * 1024 + lane * 16 + (q & 1) * 8);
        u32x4 cur[8];
        gat_load8(U, idA, idB, 0, lo16, cur);
#pragma unroll 1
        for (; m < M; m += NGW) {
            const int mn = m + NGW < M ? m + NGW : m;
            const int idAn = IDX[(size_t)mn * 128 + lane], idBn = IDX[(size_t)mn * 128 + 64 + lane];
            u32x4 xpn[4];
#pragma unroll
            for (int q = 0; q < 4; ++q) xpn[q] = *(const u32x4*)(XN + (size_t)mn * D + (q >> 1) * 1024 + lane * 16 + (q & 1) * 8);
            const float glA = GATE[(size_t)m * 128 + lane] * GSUM[(size_t)m * 8 + (lane >> 4)] * (1.f / V_SCALE);
            const float glB = GATE[(size_t)m * 128 + 64 + lane] * GSUM[(size_t)m * 8 + 4 + (lane >> 4)] * (1.f / V_SCALE);
            float ghA = 0.f, ghB = 0.f;
            const float rstdu = __builtin_bit_cast(float, __builtin_amdgcn_readfirstlane(__builtin_bit_cast(int, rsqrtf(wave_sum(lane < 32 ? ((const float*)(ws + WS_RSS))[((size_t)layer * M + m) * 32 + lane] : 0.f) * (1.f / D) + 1e-6f) * (1.f / U_SCALE))));
#pragma unroll 1
            for (int g4 = 0; g4 < 32; ++g4) {
                u32x4 nxt[8];
                if (g4 < 31) gat_load8(U, idA, idB, g4 + 1, lo16, nxt); else gat_load8(U, idAn, idBn, 0, lo16, nxt);
                const float c0 = dots4(xp, cur[0], cur[1], cur[2], cur[3], cur[4], cur[5], cur[6], cur[7], lane);
                const float hv = gelu_tanh(c0 * rstdu);
                const bool mine = (lane >> 2) == (g4 & 15);
                if (g4 < 16) ghA = mine ? hv * glA : ghA; else ghB = mine ? hv * glB : ghB;
#pragma unroll
                for (int j = 0; j < 8; ++j) cur[j] = nxt[j];
            }
            GATE[(size_t)m * 128 + lane] = ghA; GATE[(size_t)m * 128 + 64 + lane] = ghB;
            idA = idAn; idB = idBn;
#pragma unroll
            for (int q = 0; q < 4; ++q) xp[q] = xpn[q];
        }
    }
}
DI void gat_loadh(const unsigned char* base, int idlo, int idhi, int g8, unsigned lo16, u32x4 (&buf)[8]) {
    const int ids = g8 < 8 ? idlo : idhi, e0 = (g8 & 7) * 8;
#pragma unroll
    for (int j = 0; j < 8; ++j) buf[j] = *(const u32x4*)(base + ((unsigned)__shfl(ids, e0 + j) * (unsigned)D + lo16));
}
DI void axpy16h(float (&acc)[16], float g, const u32x4 w) {
    const f32x2 a0 = FP8_LO(w.x), a1 = FP8_HI(w.x), a2 = FP8_LO(w.y), a3 = FP8_HI(w.y), a4 = FP8_LO(w.z), a5 = FP8_HI(w.z), a6 = FP8_LO(w.w), a7 = FP8_HI(w.w);
    acc[0] += g * a0.x; acc[1] += g * a0.y; acc[2] += g * a1.x; acc[3] += g * a1.y; acc[4] += g * a2.x; acc[5] += g * a2.y; acc[6] += g * a3.x; acc[7] += g * a3.y;
    acc[8] += g * a4.x; acc[9] += g * a4.y; acc[10] += g * a5.x; acc[11] += g * a5.y; acc[12] += g * a6.x; acc[13] += g * a6.y; acc[14] += g * a7.x; acc[15] += g * a7.y;
}
DI void phase_peer_v(const Args& a, int layer, int ci) {
    const int tid = opaque_tid(), lane = tid & 63, wave = tid >> 6;
    const int gw = blockIdx.x * 8 + wave, NGW = gridDim.x * 8;
    unsigned char* ws = a.ws;
    const unsigned char* V = ws + WS_V + (size_t)layer * NEXP * D + ci * 1024;
    const unsigned lo16 = (unsigned)lane * 16u;
    const int* IDX = (const int*)(ws + WS_IDX);
    const float* GH = (const float*)(ws + WS_GATE);
    int m = gw;
    if (m < M) {
        int idA = IDX[(size_t)m * 128 + lane], idB = IDX[(size_t)m * 128 + 64 + lane];
        u32x4 cur[8];
        gat_loadh(V, idA, idB, 0, lo16, cur);
#pragma unroll 1
        for (; m < M; m += NGW) {
            const int mn = m + NGW < M ? m + NGW : m;
            const int idAn = IDX[(size_t)mn * 128 + lane], idBn = IDX[(size_t)mn * 128 + 64 + lane];
            const float ghA = GH[(size_t)m * 128 + lane], ghB = GH[(size_t)m * 128 + 64 + lane];
            float acc[16];
#pragma unroll
            for (int i = 0; i < 16; ++i) acc[i] = 0.f;
#pragma unroll 1
            for (int g8 = 0; g8 < 16; ++g8) {
                u32x4 nxt[8];
                if (g8 < 15) gat_loadh(V, idA, idB, g8 + 1, lo16, nxt); else gat_loadh(V, idAn, idBn, 0, lo16, nxt);
                const float ghs = g8 < 8 ? ghA : ghB;
#pragma unroll
                for (int j = 0; j < 8; ++j) { const float gv = __shfl(ghs, (g8 & 7) * 8 + j); axpy16h(acc, gv, cur[j]); if (j & 1) __builtin_amdgcn_sched_barrier(0); }
#pragma unroll
                for (int j = 0; j < 8; ++j) cur[j] = nxt[j];
            }
            idA = idAn; idB = idBn;
            float* hrow = a.out + (size_t)m * D;
            const int col = ci * 1024 + lane * 16;
            float ss = 0.f;
#pragma unroll
            for (int q = 0; q < 4; ++q) { const f32x4 h = *(const f32x4*)(hrow + col + 4 * q);
                acc[4 * q] += h.x; acc[4 * q + 1] += h.y; acc[4 * q + 2] += h.z; acc[4 * q + 3] += h.w; }
            if (ci == 0) {
#pragma unroll
                for (int q = 0; q < 4; ++q) { f32x4 h; h.x = acc[4 * q]; h.y = acc[4 * q + 1]; h.z = acc[4 * q + 2]; h.w = acc[4 * q + 3]; *(f32x4*)(hrow + col + 4 * q) = h; }
            } else {
                f32x4 ho[4];
#pragma unroll
                for (int q = 0; q < 4; ++q) { ho[q] = *(const f32x4*)(hrow + lane * 16 + 4 * q); ss += (ho[q].x * ho[q].x + ho[q].y * ho[q].y) + (ho[q].z * ho[q].z + ho[q].w * ho[q].w); }
#pragma unroll
                for (int i = 0; i < 16; ++i) ss += acc[i] * acc[i];
                const float rstd = rsqrtf(wave_sum(ss) * (1.f / D) + 1e-6f);
                const float* gn = layer + 1 < NLAYER ? a.attn_norm + (size_t)(layer + 1) * D : a.final_norm;
                asm volatile("" : "+s"(gn));
                bf16_t* xrow = (bf16_t*)(ws + WS_XN) + (size_t)m * D;
#pragma unroll
                for (int q = 0; q < 4; ++q) {
                    const f32x4 g0 = *(const f32x4*)(gn + lane * 16 + 4 * q), g1 = *(const f32x4*)(gn + col + 4 * q);
                    f32x4 h1; h1.x = acc[4 * q]; h1.y = acc[4 * q + 1]; h1.z = acc[4 * q + 2]; h1.w = acc[4 * q + 3];
                    const f32x4 y0 = ho[q] * rstd * g0, y1 = h1 * rstd * g1;
                    if (layer + 1 < NLAYER) {
                        *(f32x4*)(hrow + col + 4 * q) = h1;
                        u32x2 w0; w0.x = pk2(y0.x, y0.y); w0.y = pk2(y0.z, y0.w); *(u32x2*)(xrow + lane * 16 + 4 * q) = w0;
                        u32x2 w1; w1.x = pk2(y1.x, y1.y); w1.y = pk2(y1.z, y1.w); *(u32x2*)(xrow + col + 4 * q) = w1;
                    } else { *(f32x4*)(hrow + lane * 16 + 4 * q) = y0; *(f32x4*)(hrow + col + 4 * q) = y1; }
                }
            }
        }
    }
}

constexpr size_t WS_BAR = 95 * MiB;
#define XB_TMO      128
#define XB_XCNT(j)  (256  + 64 * (j))
#define XB_XSUB(j)  (1280 + 64 * (j))
#define XB_XGEN(j)  (2304 + 64 * (j))
#define XB_TOP      3328
#define XB_TOPGEN   3392
#define XCD_BAR_WORDS 3456
#define XB_SPIN_CAP (1u << 18)

__device__ __forceinline__ unsigned xb_ld(unsigned* p)              { return __hip_atomic_load(p, __ATOMIC_RELAXED, __HIP_MEMORY_SCOPE_AGENT); }
__device__ __forceinline__ unsigned xb_add(unsigned* p, unsigned v) { return __hip_atomic_fetch_add(p, v, __ATOMIC_RELAXED, __HIP_MEMORY_SCOPE_AGENT); }
__device__ __forceinline__ unsigned xb_xcc_id() { return (unsigned)__builtin_amdgcn_s_getreg((3 << 11) | 20) & 0xFu; }
#define XB_SPIN(cond, bar) do { unsigned _sp = 0; while (cond) { __builtin_amdgcn_s_sleep(1); \
    if ((++_sp & 255u) == 0u) { if (xb_ld(&(bar)[XB_TMO])) break; if (_sp > XB_SPIN_CAP) { atomicAdd(&(bar)[XB_TMO], 1u); break; } } } } while (0)

struct XcdBarrier {
    unsigned* bar; unsigned x;
    volatile LAS unsigned* st;
};

__device__ __forceinline__ XcdBarrier xcd_barrier_post(unsigned* bar, volatile LAS unsigned* st) {
    XcdBarrier b; b.bar = bar; b.x = xb_xcc_id(); b.st = st;
    if (threadIdx.x == 0) (void)xb_add(&bar[XB_XCNT(b.x)], 1u);
    return b;
}
__device__ __forceinline__ void xcd_barrier_complete(unsigned* bar, unsigned x, unsigned& nloc, unsigned& nx) {
    const unsigned G = gridDim.x * gridDim.y * gridDim.z;
    unsigned sum, cnt, mine, sp = 0u;
    for (;;) {
        sum = 0u; cnt = 0u; mine = 0u;
#pragma unroll
        for (unsigned j = 0; j < 16; ++j) { const unsigned c = xb_ld(&bar[XB_XCNT(j)]); sum += c; cnt += (c > 0u) ? 1u : 0u; mine = (j == x) ? c : mine; }
        if (sum == G) break;
        __builtin_amdgcn_s_sleep(1);
        if ((++sp & 255u) == 0u) { if (xb_ld(&bar[XB_TMO])) break; if (sp > XB_SPIN_CAP) { atomicAdd(&bar[XB_TMO], 1u); break; } }
    }
    nloc = mine > 0u ? mine : 1u; nx = cnt > 0u ? cnt : 1u;
}

__device__ __forceinline__ void xcd_barrier(const XcdBarrier& b) {
    asm volatile("s_waitcnt vmcnt(0)" ::: "memory");
    __syncthreads();
    if (threadIdx.x == 0) {
        unsigned* bar = b.bar;
        __builtin_amdgcn_s_waitcnt(0);
        unsigned nloc = b.st[0], nx = b.st[1];
        if (nloc == 0u) { xcd_barrier_complete(bar, b.x, nloc, nx); b.st[0] = nloc; b.st[1] = nx; }
        const unsigned old = xb_add(&bar[XB_XSUB(b.x)], 1u);
        const unsigned gen = old / nloc;
        if (old + 1u == (gen + 1u) * nloc) {
            __builtin_amdgcn_fence(__ATOMIC_RELEASE, "agent");
            asm volatile("s_waitcnt vmcnt(0)" ::: "memory");
            const unsigned og = xb_add(&bar[XB_TOP], 1u);
            const unsigned tg = og / nx;
            if (og + 1u == (tg + 1u) * nx) xb_add(&bar[XB_TOPGEN], 1u);
            else XB_SPIN(xb_ld(&bar[XB_TOPGEN]) == tg, bar);
            __builtin_amdgcn_fence(__ATOMIC_ACQUIRE, "agent");
            xb_add(&bar[XB_XGEN(b.x)], 1u);
            asm volatile("s_waitcnt vmcnt(0)" ::: "memory");
        } else {
            XB_SPIN(xb_ld(&bar[XB_XGEN(b.x)]) == gen, bar);
            __builtin_amdgcn_fence(__ATOMIC_ACQUIRE, "agent");
            asm volatile("s_waitcnt vmcnt(0)" ::: "memory");
        }
    }
    __syncthreads();
}

constexpr int NPHASE = 24, PH_PER_LAYER = 11;
template <int KIND>
DI void run_phase(const Args& a, int layer, LAS unsigned char* lds, int aux = 0) {
    unsigned char* ws = a.ws;
    if constexpr (KIND == 0) { phase_prologue(a, lds); phase_rms_bf16(a.x, a.attn_norm, (bf16_t*)(ws + WS_XN)); }
    if constexpr (KIND == 1) phase_rms_bf16(layer == 0 ? a.x : a.out, a.attn_norm + (size_t)layer * D, (bf16_t*)(ws + WS_XN));
    if constexpr (KIND == 2 || KIND == 7) {
        const bool inproj = KIND == 2;
        const int N = inproj ? C_GATE : D, ldw = inproj ? NP : D;
        pg8::Gemm g{(const bf16_t*)(ws + WS_XN), (const bf16_t*)(ws + (inproj ? WS_WIN : WS_WQ)) + (size_t)layer * ldw * D, M, N, D};
        pg8::StaticOrder So; So.init(M, N, (int)gridDim.x, (int)blockIdx.x);
        EpiBf16RS E{(bf16_t*)(ws + (inproj ? WS_P : WS_Q2)), ldw, inproj ? nullptr : (const float*)(ws + WS_RSS) + (size_t)layer * M * 32};
        pg8::gemm_phase<EpiBf16RS, pg8::StaticOrder, true, true>(lds, g, So, E);
    }
    if constexpr (KIND == 3) phase_prep(a, layer, lds);
    if constexpr (KIND == 4) phase_attn(a, layer, lds);
    if constexpr (KIND == 5) {
        pg8::Gemm g{(const bf16_t*)(ws + WS_O), (const bf16_t*)(ws + WS_WOUT) + (size_t)layer * D * D, M, D, D};
        pg8::StaticOrder So; So.init(M, D, (int)gridDim.x, (int)blockIdx.x);
        EpiResid E{layer == 0 ? a.x : a.out, a.out, D, (bf16_t*)(ws + WS_XN), (float*)(ws + WS_RSS) + (size_t)layer * M * 32};
        pg8::gemm_phase<EpiResid, pg8::StaticOrder, true, true>(lds, g, So, E);
    }
    if constexpr (KIND == 6) phase_rms_bf16(a.out, a.ffn_norm + (size_t)layer * D, (bf16_t*)(ws + WS_XN));
    if constexpr (KIND == 8) phase_peer_select(a, layer, lds);
    if constexpr (KIND == 9) phase_peer_u(a, layer);
    if constexpr (KIND == 14) phase_peer_v(a, layer, aux);
    if constexpr (KIND == 10) phase_rms_final(a.out, a.final_norm);
}

#ifndef MK_PER_PHASE
#define MK_PER_PHASE 0
#endif

#if MK_PER_PHASE
template <int KIND>
__global__ void __launch_bounds__(NTHREADS, 2) k_phase(Args a, int layer) {
    extern __shared__ __attribute__((aligned(16))) unsigned char lds_raw[];
    run_phase<KIND>(a, layer, (LAS unsigned char*)lds_raw);
}
template <int KIND> static void launch_phase(const Args& a, int layer, int grid, hipStream_t stream) {
    static bool attr = false;
    if (!attr) { (void)hipFuncSetAttribute((const void*)k_phase<KIND>, hipFuncAttributeMaxDynamicSharedMemorySize, LDS_BYTES); attr = true; }
    hipLaunchKernelGGL(k_phase<KIND>, dim3(grid), dim3(NTHREADS), LDS_BYTES, stream, a, layer);
}
#else
__global__ void __launch_bounds__(NTHREADS, 2) hybrid_fwd(Args a) {
    extern __shared__ __attribute__((aligned(16))) unsigned char lds_raw[];
    LAS unsigned char* lds = (LAS unsigned char*)lds_raw;
    volatile LAS unsigned* bst = (volatile LAS unsigned*)(lds + LDS_BYTES - 16);
    if (threadIdx.x < 4) bst[threadIdx.x] = 0u;
    __syncthreads();
    const XcdBarrier xbar = xcd_barrier_post((unsigned*)(a.ws + WS_BAR), bst);
    bool first_seam = true;
#pragma unroll 1
    for (int ph = a.ph_lo; ph < a.ph_hi; ++ph) {
        if (ph == NPHASE - 1 || ph == 1 + PH_PER_LAYER || ph == 1 || ph == 6 || ph == 6 + PH_PER_LAYER) continue;
        if (ph == 0) run_phase<0>(a, 0, lds);
        else if (ph == NPHASE - 1) run_phase<10>(a, 0, lds);
        else {
            const int layer = (ph - 1) / PH_PER_LAYER, k = (ph - 1) % PH_PER_LAYER;
            if (k == 0) run_phase<1>(a, layer, lds);
            else if (k == 1) run_phase<2>(a, layer, lds);
            else if (k == 2) run_phase<3>(a, layer, lds);
            else if (k == 3) run_phase<4>(a, layer, lds);
            else if (k == 4) run_phase<5>(a, layer, lds);
            else if (k == 5) run_phase<6>(a, layer, lds);
            else if (k == 6) run_phase<7>(a, layer, lds);
            else if (k == 7) run_phase<8>(a, layer, lds);
            else if (k == 8) run_phase<9>(a, layer, lds);
            else run_phase<14>(a, layer, lds, k - 9);
        }
        if (ph + 1 < a.ph_hi) { if (first_seam) { cg::this_grid().sync(); first_seam = false; } else xcd_barrier(xbar); }
    }
}
#endif

extern "C" void kernel_launch(void* const* d_in, const int* in_sizes, int n_in, void* d_out, int out_size, void* d_ws, size_t ws_size, hipStream_t stream) {
    static int grid = 0;
    if (grid == 0) {
        if (n_in != 18 || out_size != M * D || ws_size < WS_END) { fprintf(stderr, "kernel_launch: unexpected shapes (n_in %d, out %d, ws %zu)\n", n_in, out_size, ws_size); grid = -1; return; }
        int dev = 0, cus = 0;
        if (hipGetDevice(&dev) != hipSuccess || hipDeviceGetAttribute(&cus, hipDeviceAttributeMultiprocessorCount, dev) != hipSuccess) { grid = -1; return; }
#if !MK_PER_PHASE
        if (hipFuncSetAttribute((const void*)hybrid_fwd, hipFuncAttributeMaxDynamicSharedMemorySize, LDS_BYTES) != hipSuccess) { fprintf(stderr, "kernel_launch: hipFuncSetAttribute failed\n"); grid = -1; return; }
        int per_cu = 0;
        if (hipOccupancyMaxActiveBlocksPerMultiprocessor(&per_cu, (const void*)hybrid_fwd, NTHREADS, LDS_BYTES) != hipSuccess || per_cu < 1) fprintf(stderr, "kernel_launch: occupancy query says %d\n", per_cu);
        (void)hipGetLastError();
#endif
        grid = cus;
    }
    if (grid < 0) return;
    Args a{};
    a.x = (const float*)d_in[0]; a.attn_norm = (const float*)d_in[1]; a.w_in = (const float*)d_in[2]; a.cmp_pos_k = (const float*)d_in[3];
    a.cmp_w1_k = (const float*)d_in[4]; a.cmp_w2_k = (const float*)d_in[5]; a.cmp_pos_v = (const float*)d_in[6]; a.cmp_w1_v = (const float*)d_in[7];
    a.cmp_w2_v = (const float*)d_in[8]; a.sinks = (const float*)d_in[9]; a.w_out = (const float*)d_in[10]; a.ffn_norm = (const float*)d_in[11];
    a.peer_wq = (const float*)d_in[12]; a.peer_subkeys = (const float*)d_in[13]; a.peer_u = (const float*)d_in[14]; a.peer_v = (const float*)d_in[15];
    a.rel_bias = (const float*)d_in[16]; a.final_norm = (const float*)d_in[17];
    a.out = (float*)d_out; a.ws = (unsigned char*)d_ws;
    a.ph_lo = 0; a.ph_hi = NPHASE;
#if MK_PER_PHASE
    launch_phase<0>(a, 0, grid, stream);
    for (int l = 0; l < NLAYER; ++l) {
        launch_phase<2>(a, l, grid, stream); launch_phase<3>(a, l, grid, stream);
        launch_phase<4>(a, l, grid, stream); launch_phase<5>(a, l, grid, stream);
        launch_phase<7>(a, l, grid, stream); launch_phase<8>(a, l, grid, stream); launch_phase<9>(a, l, grid, stream); launch_phase<14>(a, l, grid, stream);
    }
#else
    (void)hipMemsetAsync((unsigned char*)d_ws + WS_BAR, 0, 16384, stream);
    void* args[] = {&a};
    const hipError_t e = hipLaunchCooperativeKernel((const void*)hybrid_fwd, dim3(grid), dim3(NTHREADS), args, LDS_BYTES, stream);
    if (e != hipSuccess) fprintf(stderr, "kernel_launch: cooperative launch failed: %s (grid %d)\n", hipGetErrorString(e), grid);
#endif
}
```

```cpp
#include <hip/hip_runtime.h>
#include <cstdio>
#include <cstdint>
__device__ __forceinline__ int opaque_tid() { int t = threadIdx.x; asm volatile("" : "+v"(t)); return t; }
namespace pg8 {
#define PG8_LAS __attribute__((address_space(3)))
typedef unsigned short bf16_t;
typedef short bf16x8 __attribute__((ext_vector_type(8)));
typedef float f32x4 __attribute__((ext_vector_type(4)));
typedef unsigned u32x4 __attribute__((ext_vector_type(4)));
constexpr int BM = 256, BK = 64, HALF = 128, HTB = HALF * BK * 2  , STAGE_BYTES = 8 * HTB, NXCD = 8, WGM = 8;

__host__ __device__ __forceinline__ int lds_byte(int r, int c) { const int st = (r >> 4) * 2 + (c >> 5), rr = r & 15, cc = c & 31, ob = rr * 64 + cc * 2; return st * 1024 + (ob ^ (((ob >> 9) & 1) << 5)); }
__host__ __device__ __forceinline__ void stage_rc(int b, int& R, int& C) { const int st = b / 1024, sb = b % 1024, swz = sb ^ (((sb >> 9) & 1) << 5); R = (st >> 1) * 16 + swz / 64; C = (st & 1) * 32 + (swz % 64) / 2; }
__host__ __device__ __forceinline__ int perm32(int rho) { const int n = rho >> 4, i = rho & 15; return 8 * (i >> 2) + 4 * n + (i & 3); }

struct Unit { int pm, pn; };
struct Gemm { const bf16_t* A; const bf16_t* Bt; int M, N, K; };

struct StaticOrder {
    int nM, nN, nwg, G, c;
    __host__ __device__ void init(int M, int N, int G_, int c_) { nM = M / BM; nN = N / BM; nwg = nM * nN; G = G_; c = c_; }
    __host__ __device__ bool next(int i, Unit& u) const {
        const long L = (long)i * G + c; if (L >= nwg) return false;
        int wgid = (int)L; { const int q = nwg / NXCD, r = nwg % NXCD, xcd = wgid % NXCD, off = wgid / NXCD; wgid = (xcd < r ? xcd * (q + 1) : r * (q + 1) + (xcd - r) * q) + off; }
        const int nig = WGM * nN, gid = wgid / nig, fm = gid * WGM, gsz = (nM - fm) < WGM ? (nM - fm) : WGM;
        u.pm = fm + ((wgid % nig) % gsz); u.pn = (wgid % nig) / gsz; return true;
    }
    __device__ __forceinline__ void a_ready(const Unit&) const {}
    __device__ __forceinline__ void done(const Unit&) const {}
};

__device__ __forceinline__ unsigned cvt_pk_bf16(float lo, float hi) { unsigned r; asm volatile("v_cvt_pk_bf16_f32 %0, %1, %2" : "=v"(r) : "v"(lo), "v"(hi)); return r; }
typedef float f32x2 __attribute__((ext_vector_type(2)));
__device__ __forceinline__ f32x2 gelu_pk(f32x2 v) {
    const f32x2 av = __builtin_elementwise_abs(v), d = av * 0.2316418882f + 1.0f;
    f32x2 t; t.x = __builtin_amdgcn_rcpf(d.x); t.y = __builtin_amdgcn_rcpf(d.y);
    f32x2 q = t * 0.5307027145f + (-0.7265760135f); q = q * t + 0.7107068705f; q = q * t + (-0.142248368f); q = q * t + 0.127414796f; q = q * t;
    const f32x2 s = (v * v) * (-0.72134752044f);
    f32x2 e; e.x = __builtin_amdgcn_exp2f(s.x); e.y = __builtin_amdgcn_exp2f(s.y);
    const f32x2 m = v * (q * e), r = v - m;
    f32x2 o; o.x = v.x < 0.f ? m.x : r.x; o.y = v.y < 0.f ? m.y : r.y; return o;
}

template <int ACT  > struct EpiBf16 {
    static constexpr bool PERM = true, AFTER_DRAIN = false; static_assert(ACT == 0 || ACT == 1, "EpiBf16: ACT is 0 (none) or 1 (gelu_pk)");
    bf16_t* O; int ldc; const float* bias; int split_cols; size_t split_stride; float scale0;
    __device__ __forceinline__ void operator()(const f32x4 (&acc)[2][2][4][2], const Unit& u, int wr, int wc, int fr, int fq) const {
        const int row0 = u.pm * BM + wr * 64 + fr; int colt = u.pn * BM; bf16_t* base = O;
        float sc = 1.f; if (split_cols) { const int t = colt / split_cols; base += (size_t)t * split_stride; colt -= t * split_cols; if (t == 0) sc = scale0; }
        const int col0 = colt + wc * 32 + 8 * fq, bcol0 = u.pn * BM + wc * 32 + 8 * fq;
        f32x4 bv[2][2];
#pragma unroll
        for (int bj = 0; bj < 2; ++bj)
#pragma unroll
            for (int n = 0; n < 2; ++n) bv[bj][n] = bias ? *(const f32x4*)(bias + bcol0 + bj * HALF + 4 * n) : (f32x4){0.f, 0.f, 0.f, 0.f};
#pragma unroll
        for (int ai = 0; ai < 2; ++ai)
#pragma unroll
            for (int m = 0; m < 4; ++m) { bf16_t* rowp = base + (size_t)(row0 + ai * HALF + m * 16) * ldc + col0;
#pragma unroll
                for (int bj = 0; bj < 2; ++bj) { f32x4 v0 = acc[ai][bj][m][0] + bv[bj][0], v1 = acc[ai][bj][m][1] + bv[bj][1];
                    if (ACT == 1) { f32x2 a = gelu_pk((f32x2){v0[0], v0[1]}), b = gelu_pk((f32x2){v0[2], v0[3]}), c = gelu_pk((f32x2){v1[0], v1[1]}), d = gelu_pk((f32x2){v1[2], v1[3]});
                        v0 = (f32x4){a.x, a.y, b.x, b.y}; v1 = (f32x4){c.x, c.y, d.x, d.y}; }
                    v0 = v0 * sc; v1 = v1 * sc; u32x4 w; w.x = cvt_pk_bf16(v0[0], v0[1]); w.y = cvt_pk_bf16(v0[2], v0[3]); w.z = cvt_pk_bf16(v1[0], v1[1]); w.w = cvt_pk_bf16(v1[2], v1[3]);
                    *(u32x4*)(rowp + bj * HALF) = w; } }
    }
};
template <class Epi, class Sched, bool ALIGN_EPI = false, bool SP2 = false>
__device__ __forceinline__ void gemm_phase(PG8_LAS unsigned char* lds, const Gemm g, const Sched& S, const Epi& E) {
    const int tid = opaque_tid(), wid = __builtin_amdgcn_readfirstlane(tid >> 6), lane = tid & 63, wr = wid >> 2, wc = wid & 3, fr = lane & 15, fq = lane >> 4;
    const int K = g.K, nt = K / BK;
    unsigned voffA[2], voffB[2];
#pragma unroll
    for (int i = 0; i < 2; ++i) { int R, C; stage_rc(tid * 16 + i * 8192, R, C); const int Rb = Epi::PERM ? ((R & ~31) + perm32(R & 31)) : R;
        voffA[i] = (unsigned)(R * K + C) * 2u; voffB[i] = (unsigned)(Rb * K + C) * 2u; }
    const size_t kstep = (size_t)(BK * 2);
    const size_t hstep = (size_t)HALF * K * 2;
    const size_t tstep = 2 * hstep;
    const unsigned ldsw = (unsigned)wid * 1024u;
    const int aoff = lds_byte(wr * 64 + fr, fq * 8), boff = lds_byte(wc * 32 + fr, fq * 8);
#define PG8_SA(b, h) (((b) * 2 + (h)) * HTB)
#define PG8_SB(b, h) ((4 + (b) * 2 + (h)) * HTB)
#define PG8_STAGE(bufoff, gbase, voff) do { _Pragma("unroll") for (int _i = 0; _i < 2; ++_i) \
        __builtin_amdgcn_global_load_lds((const unsigned*)((const char*)(gbase) + (voff)[_i]), (PG8_LAS unsigned*)(lds + (bufoff) + ldsw + _i * 8192), 16, 0, 0); } while (0)
#define PG8_LDA(dst, b, h) do { _Pragma("unroll") for (int m = 0; m < 4; ++m) _Pragma("unroll") for (int k = 0; k < 2; ++k) dst[m][k] = *(const PG8_LAS bf16x8*)(lds + PG8_SA(b, h) + aoff + m * 2048 + k * 1024); } while (0)
#define PG8_LDB(dst, b, h) do { _Pragma("unroll") for (int n = 0; n < 2; ++n) _Pragma("unroll") for (int k = 0; k < 2; ++k) dst[n][k] = *(const PG8_LAS bf16x8*)(lds + PG8_SB(b, h) + boff + n * 2048 + k * 1024); } while (0)
#define PG8_MMA(ai, bj, At, Bt) do { __builtin_amdgcn_s_setprio(1); _Pragma("unroll") for (int m = 0; m < 4; ++m) _Pragma("unroll") for (int n = 0; n < 2; ++n) _Pragma("unroll") for (int k = 0; k < 2; ++k) \
        acc[ai][bj][m][n] = __builtin_amdgcn_mfma_f32_16x16x32_bf16(Bt[n][k], At[m][k], acc[ai][bj][m][n], 0, 0, 0); __builtin_amdgcn_s_setprio(0); } while (0)
#define PG8_WAIT_V(n) asm volatile("s_waitcnt vmcnt(" #n ")" ::: "memory")
#define PG8_WAIT_L(n) asm volatile("s_waitcnt lgkmcnt(" #n ")" ::: "memory")
#define PG8_BAR __builtin_amdgcn_s_barrier()
#define PG8_SCHED __builtin_amdgcn_sched_barrier(0)
    Unit cur, nxt; int ui = 0;
    if (!S.next(0, cur)) return;
    f32x4 acc[2][2][4][2];
#pragma unroll
    for (int a = 0; a < 2; ++a)
#pragma unroll
        for (int b = 0; b < 2; ++b)
#pragma unroll
            for (int m = 0; m < 4; ++m)
#pragma unroll
                for (int n = 0; n < 2; ++n) acc[a][b][m][n] = (f32x4){0.f, 0.f, 0.f, 0.f};
    bf16x8 At[4][2], B0[2][2], B1[2][2];
    const char* cA = (const char*)g.A + (size_t)cur.pm * tstep; const char* cB = (const char*)g.Bt + (size_t)cur.pn * tstep;
    S.a_ready(cur);
    if constexpr (SP2) {
        PG8_STAGE(PG8_SB(0, 0), cB, voffB); PG8_STAGE(PG8_SB(0, 1), cB + hstep, voffB); PG8_STAGE(PG8_SA(0, 0), cA, voffA); PG8_STAGE(PG8_SA(0, 1), cA + hstep, voffA);
        if (wr == 1) PG8_BAR;
        PG8_WAIT_V(2); PG8_BAR;
        PG8_STAGE(PG8_SB(1, 0), cB + kstep, voffB); PG8_STAGE(PG8_SA(1, 0), cA + kstep, voffA); PG8_STAGE(PG8_SB(1, 1), cB + hstep + kstep, voffB);
        PG8_WAIT_V(6); PG8_BAR;
    } else {
        PG8_STAGE(PG8_SB(0, 0), cB, voffB); PG8_STAGE(PG8_SA(0, 0), cA, voffA); PG8_STAGE(PG8_SB(0, 1), cB + hstep, voffB); PG8_STAGE(PG8_SA(0, 1), cA + hstep, voffA);
        if (wr == 1) PG8_BAR;
        PG8_WAIT_V(4); PG8_BAR;
        PG8_STAGE(PG8_SB(1, 0), cB + kstep, voffB); PG8_STAGE(PG8_SA(1, 0), cA + kstep, voffA); PG8_STAGE(PG8_SB(1, 1), cB + hstep + kstep, voffB);
        PG8_WAIT_V(6); PG8_BAR;
    }
    for (;;) {
        const bool has_next = S.next(ui + 1, nxt);
        const char* nA = has_next ? (const char*)g.A + (size_t)nxt.pm * tstep : cA; const char* nB = has_next ? (const char*)g.Bt + (size_t)nxt.pn * tstep : cB;
        for (int t = 0; t < nt; t += 2) {
            const bool last = (t == nt - 2);
            const char* a1 = cA + (size_t)(t + 1) * kstep;
            const char* a2 = last ? nA : cA + (size_t)(t + 2) * kstep; const char* b2 = last ? nB : cB + (size_t)(t + 2) * kstep;
            const char* a3 = a2 + kstep; const char* b3 = b2 + kstep;
            if (last && has_next) S.a_ready(nxt);
            if constexpr (SP2) {
            PG8_LDB(B0, 0, 0); PG8_LDB(B1, 0, 1); PG8_SCHED; PG8_LDA(At, 0, 0); PG8_STAGE(PG8_SA(1, 1), a1 + hstep, voffA);
            PG8_WAIT_V(8); PG8_WAIT_L(0); PG8_BAR; PG8_MMA(0, 0, At, B0); PG8_MMA(0, 1, At, B1); PG8_BAR; PG8_SCHED;
            PG8_LDA(At, 0, 1); PG8_STAGE(PG8_SB(0, 0), b2, voffB); PG8_STAGE(PG8_SB(0, 1), b2 + hstep, voffB); PG8_STAGE(PG8_SA(0, 0), a2, voffA);
            PG8_WAIT_V(8); PG8_WAIT_L(0); PG8_BAR; PG8_MMA(1, 0, At, B0); PG8_MMA(1, 1, At, B1); PG8_BAR; PG8_SCHED;
            PG8_LDB(B0, 1, 0); PG8_LDB(B1, 1, 1); PG8_SCHED; PG8_LDA(At, 1, 0); PG8_STAGE(PG8_SA(0, 1), a2 + hstep, voffA);
            PG8_WAIT_V(8); PG8_WAIT_L(0); PG8_BAR; PG8_MMA(0, 0, At, B0); PG8_MMA(0, 1, At, B1); PG8_BAR; PG8_SCHED;
            PG8_LDA(At, 1, 1); PG8_STAGE(PG8_SB(1, 0), b3, voffB); PG8_STAGE(PG8_SB(1, 1), b3 + hstep, voffB); PG8_STAGE(PG8_SA(1, 0), a3, voffA);
            PG8_WAIT_V(8); PG8_WAIT_L(0); PG8_BAR; PG8_MMA(1, 0, At, B0); PG8_MMA(1, 1, At, B1); PG8_BAR; PG8_SCHED;
            } else {
            PG8_LDB(B0, 0, 0); PG8_SCHED; PG8_LDA(At, 0, 0); PG8_STAGE(PG8_SA(1, 1), a1 + hstep, voffA);
            PG8_WAIT_L(8); PG8_BAR; PG8_WAIT_L(0); PG8_MMA(0, 0, At, B0); PG8_BAR; PG8_SCHED;
            PG8_LDB(B1, 0, 1); PG8_STAGE(PG8_SB(0, 0), b2, voffB);
            PG8_BAR; PG8_WAIT_L(0); PG8_MMA(0, 1, At, B1); PG8_BAR;
            PG8_LDA(At, 0, 1); PG8_STAGE(PG8_SA(0, 0), a2, voffA);
            PG8_BAR; PG8_WAIT_L(0); PG8_MMA(1, 0, At, B0); PG8_BAR; PG8_SCHED;
            PG8_STAGE(PG8_SB(0, 1), b2 + hstep, voffB);
            PG8_WAIT_V(6); PG8_BAR; PG8_MMA(1, 1, At, B1); PG8_BAR;
            PG8_LDB(B0, 1, 0); PG8_SCHED; PG8_LDA(At, 1, 0); PG8_STAGE(PG8_SA(0, 1), a2 + hstep, voffA);
            PG8_WAIT_L(8); PG8_BAR; PG8_WAIT_L(0); PG8_MMA(0, 0, At, B0); PG8_BAR; PG8_SCHED;
            PG8_LDB(B1, 1, 1); PG8_STAGE(PG8_SB(1, 0), b3, voffB);
            PG8_BAR; PG8_WAIT_L(0); PG8_MMA(0, 1, At, B1); PG8_BAR;
            PG8_LDA(At, 1, 1); PG8_STAGE(PG8_SA(1, 0), a3, voffA);
            PG8_BAR; PG8_WAIT_L(0); PG8_MMA(1, 0, At, B0); PG8_BAR; PG8_SCHED;
            PG8_STAGE(PG8_SB(1, 1), b3 + hstep, voffB);
            PG8_WAIT_V(6); PG8_BAR; PG8_MMA(1, 1, At, B1); PG8_BAR;
            }
        }
        if constexpr (ALIGN_EPI) { if (wr == 0) PG8_BAR; }
        if constexpr (!Epi::AFTER_DRAIN) { E(acc, cur, wr, wc, fr, fq); S.done(cur); }
        if (!has_next) break;
#pragma unroll
        for (int a = 0; a < 2; ++a)
#pragma unroll
            for (int b = 0; b < 2; ++b)
#pragma unroll
                for (int m = 0; m < 4; ++m)
#pragma unroll
                    for (int n = 0; n < 2; ++n) acc[a][b][m][n] = (f32x4){0.f, 0.f, 0.f, 0.f};
        cur = nxt; cA = nA; cB = nB; ++ui;
        if constexpr (ALIGN_EPI) { if (wr == 1) PG8_BAR; }
    }
    PG8_WAIT_V(0);
    if constexpr (!ALIGN_EPI) { if (wr == 0) PG8_BAR; }
    PG8_BAR;
    if constexpr (Epi::AFTER_DRAIN) { E.fused(acc, cur, wr, wc, fr, fq, lds, wid, lane); S.done(cur); }
#undef PG8_SA
#undef PG8_SB
#undef PG8_STAGE
#undef PG8_LDA
#undef PG8_LDB
#undef PG8_MMA
#undef PG8_WAIT_V
#undef PG8_WAIT_L
#undef PG8_BAR
#undef PG8_SCHED
}
}

#include <hip/hip_cooperative_groups.h>
namespace cg = cooperative_groups;

#define DI __device__ __forceinline__
#define LAS __attribute__((address_space(3)))
typedef unsigned short bf16_t;
typedef short bf16x8 __attribute__((ext_vector_type(8)));
typedef float f32x4 __attribute__((ext_vector_type(4)));
typedef float f32x2 __attribute__((ext_vector_type(2)));
typedef float f32x16 __attribute__((ext_vector_type(16)));
typedef unsigned u32x4 __attribute__((ext_vector_type(4)));
typedef unsigned u32x2 __attribute__((ext_vector_type(2)));
typedef __bf16 bf16v2 __attribute__((ext_vector_type(2)));

#define MFMA32(a, b, c) __builtin_amdgcn_mfma_f32_32x32x16_bf16((a), (b), (c), 0, 0, 0)
#define MFMA16(a, b, c) __builtin_amdgcn_mfma_f32_16x16x32_bf16((a), (b), (c), 0, 0, 0)
#define LDS_WAIT() asm volatile("s_waitcnt lgkmcnt(0)" ::: "memory")

constexpr int NB = 2, S = 16384, D = 2048, M = NB * S, NLAYER = 2;
constexpr int NPROJ = 3120, NP = 3328;
constexpr int C_QA = 0, C_QB = 1024, C_KC = 2048, C_VC = 2176, C_KS = 2304, C_VS = 2432, C_KW = 2560, C_VW = 2688, C_KB = 2816, C_VB = 2944, C_GATE = 3072;
constexpr int NCP = 1024;
constexpr int NEXP = 16384;
constexpr float NEGF = -1e30f;

constexpr size_t MiB = 1u << 20;
constexpr size_t WS_WIN = 0;
constexpr size_t WS_WOUT = 28 * MiB;
constexpr size_t WS_WQ = 46 * MiB;
constexpr size_t WS_CW1 = 64 * MiB;
constexpr size_t WS_SUBK = 67 * MiB;
constexpr size_t WS_KC = 68 * MiB;
constexpr size_t WS_VCT = 69 * MiB;
constexpr size_t WS_VST = 70 * MiB;
constexpr size_t WS_VWT = 78 * MiB;
constexpr size_t WS_VBT = 86 * MiB;
constexpr size_t WS_IDX = 96 * MiB;
constexpr size_t WS_GATE = 112 * MiB;
constexpr size_t WS_GSUM = 94 * MiB;
constexpr size_t WS_U = 128 * MiB;
constexpr size_t WS_V = 256 * MiB;
constexpr size_t WS_KSF = 192 * MiB, WS_KWF = 200 * MiB, WS_KBF = 208 * MiB;
constexpr size_t WS_KMAX = 95 * MiB + 65536;
constexpr size_t WS_RSS = 192 * MiB + 24 * MiB;
constexpr size_t WS_XN = 384 * MiB;
constexpr size_t WS_O = 512 * MiB;
constexpr size_t WS_Q2 = 640 * MiB;
constexpr size_t WS_P = 768 * MiB;
constexpr size_t WS_END = 1000 * MiB;

constexpr int LDS_BYTES = 139264;
constexpr int NTHREADS = 512;

struct Args {
    const float* x; const float* attn_norm; const float* w_in; const float* cmp_pos_k; const float* cmp_w1_k; const float* cmp_w2_k;
    const float* cmp_pos_v; const float* cmp_w1_v; const float* cmp_w2_v; const float* sinks; const float* w_out; const float* ffn_norm;
    const float* peer_wq; const float* peer_subkeys; const float* peer_u; const float* peer_v; const float* rel_bias; const float* final_norm;
    float* out; unsigned char* ws; int ph_lo, ph_hi;
};

DI unsigned f2bf(float f) { unsigned u = __builtin_bit_cast(unsigned, f); return (u + 0x7fffu + ((u >> 16) & 1u)) >> 16; }
DI unsigned pk2(float lo, float hi) { const f32x2 v = {lo, hi}; return __builtin_bit_cast(unsigned, __builtin_convertvector(v, bf16v2)); }
DI float bflo(unsigned w) { return __builtin_bit_cast(float, w << 16); }
DI float bfhi(unsigned w) { return __builtin_bit_cast(float, w & 0xffff0000u); }
DI float bf2f(bf16_t v) { return __builtin_bit_cast(float, (unsigned)v << 16); }
DI float wave_sum(float v) {
#pragma unroll
    for (int o = 1; o < 64; o <<= 1) v += __shfl_xor(v, o);
    return v;
}
DI float gelu_tanh(float x) {
    const float y = 0.7978845608028654f * (x + 0.044715f * x * x * x);
    const float t = __expf(2.f * y);
    const float th = 1.f - 2.f / (t + 1.f);
    return 0.5f * x * (1.f + th);
}
DI float sigmoidf_(float x) { return 1.f / (1.f + __expf(-x)); }
DI int crow(int r, int hi) { return (r & 3) + 8 * (r >> 2) + 4 * hi; }
DI int rel_bucket(int d) {
    const float lf = __log2f((float)(d < 1 ? 1 : d));
    int b = 16 + (int)((lf - 4.0f) * (16.0f / 7.0f));
    b = b > 31 ? 31 : b;
    return d < 16 ? d : b;
}
DI bf16x8 pack8(float a0, float a1, float a2, float a3, float a4, float a5, float a6, float a7) {
    u32x4 p; p.x = pk2(a0, a1); p.y = pk2(a2, a3); p.z = pk2(a4, a5); p.w = pk2(a6, a7);
    return __builtin_bit_cast(bf16x8, p);
}

DI int win_srccol(int n) {
    if (n < 1024) return n;
    if (n < 2048) return 1840 + (n - 1024);
    if (n < 2816) return 1024 + (n - 2048);
    if (n < 3072) return 2864 + (n - 2816);
    if (n < 3120) return 1792 + (n - 3072);
    return -1;
}
template <bool WIN>
DI void transpose_item(const float* W, int K, int Nsrc, bf16_t* WT, int k0, int n0, LAS float* scr, int lane, const float* gk = nullptr) {
    const int nd = n0 + (lane & 31);
    const int ns = WIN ? win_srccol(nd) : nd;
#pragma unroll 8
    for (int i = 0; i < 32; ++i) { const int kk = 2 * i + (lane >> 5); scr[kk * 33 + (lane & 31)] = (ns >= 0 ? W[(size_t)(k0 + kk) * Nsrc + ns] : 0.f) * (gk ? gk[k0 + kk] : 1.f); }
    LDS_WAIT();
    const int c = lane & 7;
#pragma unroll
    for (int j = 0; j < 4; ++j) { const int n = (lane >> 3) + 8 * j; const LAS float* s = scr + (8 * c) * 33 + n;
        u32x4 o; o.x = pk2(s[0 * 33], s[1 * 33]); o.y = pk2(s[2 * 33], s[3 * 33]); o.z = pk2(s[4 * 33], s[5 * 33]); o.w = pk2(s[6 * 33], s[7 * 33]);
        *(u32x4*)(WT + (size_t)(n0 + n) * K + k0 + 8 * c) = o; }
    LDS_WAIT();
}
template <bool WIN>
DI void transpose_matrix(const float* W, int K, int Nsrc, int Ndst, bf16_t* WT, LAS float* scr, int lane, int gw, int NGW, const float* gk = nullptr) {
    const int nblk = Ndst / 32, nitems = (K / 64) * nblk;
    for (int it = gw; it < nitems; it += NGW) transpose_item<WIN>(W, K, Nsrc, WT, 64 * (it / nblk), 32 * (it % nblk), scr, lane, gk);
}
DI void convert_rows(const float* src, bf16_t* dst, size_t n8, size_t gt, size_t ngt) {
    for (size_t i = gt; i < n8; i += ngt) {
        const f32x4 a = ((const f32x4*)src)[2 * i], b = ((const f32x4*)src)[2 * i + 1];
        u32x4 o; o.x = pk2(a.x, a.y); o.y = pk2(a.z, a.w); o.z = pk2(b.x, b.y); o.w = pk2(b.z, b.w);
        ((u32x4*)dst)[i] = o;
    }
}
constexpr float U_SCALE = 512.f, V_SCALE = 64.f;
DI void convert_rows_fp8(const float* src, unsigned char* dst, size_t n16, float scale, size_t gt, size_t ngt, const float* gnorm = nullptr) {
    for (size_t i = gt; i < n16; i += ngt) {
        f32x4 a = ((const f32x4*)src)[4 * i] * scale, b = ((const f32x4*)src)[4 * i + 1] * scale, c = ((const f32x4*)src)[4 * i + 2] * scale, d = ((const f32x4*)src)[4 * i + 3] * scale;
        if (gnorm) { const f32x4* gp = (const f32x4*)(gnorm + ((16 * i) / ((size_t)NEXP * D)) * D + (16 * i) % D); a = a * gp[0]; b = b * gp[1]; c = c * gp[2]; d = d * gp[3]; }
        u32x4 o;
        o.x = (unsigned)__builtin_amdgcn_cvt_pk_fp8_f32(a.z, a.w, __builtin_amdgcn_cvt_pk_fp8_f32(a.x, a.y, 0, false), true);
        o.y = (unsigned)__builtin_amdgcn_cvt_pk_fp8_f32(b.z, b.w, __builtin_amdgcn_cvt_pk_fp8_f32(b.x, b.y, 0, false), true);
        o.z = (unsigned)__builtin_amdgcn_cvt_pk_fp8_f32(c.z, c.w, __builtin_amdgcn_cvt_pk_fp8_f32(c.x, c.y, 0, false), true);
        o.w = (unsigned)__builtin_amdgcn_cvt_pk_fp8_f32(d.z, d.w, __builtin_amdgcn_cvt_pk_fp8_f32(d.x, d.y, 0, false), true);
        ((u32x4*)dst)[i] = o;
    }
}
DI void phase_prologue(const Args& a, LAS unsigned char* lds) {
    const int tid = opaque_tid(), lane = tid & 63, wave = tid >> 6;
    if (blockIdx.x == 0 && tid < 32) ((unsigned*)(a.ws + WS_KMAX))[tid] = 0u;
    const int gw = blockIdx.x * 8 + wave, NGW = gridDim.x * 8;
    LAS float* scr = (LAS float*)(lds + wave * 8448);
    unsigned char* ws = a.ws;
    for (int l = 0; l < NLAYER; ++l) {
        transpose_matrix<true>(a.w_in + (size_t)l * D * NPROJ, D, NPROJ, NP, (bf16_t*)(ws + WS_WIN) + (size_t)l * NP * D, scr, lane, gw, NGW);
        transpose_matrix<false>(a.w_out + (size_t)l * D * D, D, D, D, (bf16_t*)(ws + WS_WOUT) + (size_t)l * D * D, scr, lane, gw, NGW);
        transpose_matrix<false>(a.peer_wq + (size_t)l * D * D, D, D, D, (bf16_t*)(ws + WS_WQ) + (size_t)l * D * D, scr, lane, gw, NGW, a.ffn_norm + (size_t)l * D);
        transpose_matrix<false>(a.cmp_w1_k + (size_t)l * 2048 * 128, 2048, 128, 128, (bf16_t*)(ws + WS_CW1) + (size_t)(l * 2 + 0) * 128 * 2048, scr, lane, gw, NGW);
        transpose_matrix<false>(a.cmp_w1_v + (size_t)l * 2048 * 128, 2048, 128, 128, (bf16_t*)(ws + WS_CW1) + (size_t)(l * 2 + 1) * 128 * 2048, scr, lane, gw, NGW);
    }
    const size_t gt = (size_t)blockIdx.x * NTHREADS + tid, ngt = (size_t)gridDim.x * NTHREADS;
    convert_rows_fp8(a.peer_u, ws + WS_U, (size_t)NLAYER * NEXP * D / 16, U_SCALE, gt, ngt, a.ffn_norm);
    convert_rows_fp8(a.peer_v, ws + WS_V, (size_t)NLAYER * NEXP * D / 16, V_SCALE, gt, ngt);
    convert_rows(a.peer_subkeys, (bf16_t*)(ws + WS_SUBK), (size_t)NLAYER * 2 * 128 * 128 / 8, gt, ngt);
}

DI void phase_rms_bf16(const float* X, const float* g, bf16_t* XN) {
    const int tid = opaque_tid(), lane = tid & 63, wave = tid >> 6;
    const int gw = blockIdx.x * 8 + wave, NGW = gridDim.x * 8;
    f32x4 gv[8];
#pragma unroll
    for (int j = 0; j < 8; ++j) gv[j] = ((const f32x4*)g)[lane + 64 * j];
    for (int m = gw; m < M; m += NGW) {
        const f32x4* xr = (const f32x4*)(X + (size_t)m * D);
        f32x4 v[8]; float s = 0.f;
#pragma unroll
        for (int j = 0; j < 8; ++j) { v[j] = xr[lane + 64 * j]; s += (v[j].x * v[j].x + v[j].y * v[j].y) + (v[j].z * v[j].z + v[j].w * v[j].w); }
        const float rstd = rsqrtf(wave_sum(s) * (1.f / D) + 1e-6f);
        u32x2* o8 = (u32x2*)(XN + (size_t)m * D);
#pragma unroll
        for (int j = 0; j < 8; ++j) { const f32x4 y = v[j] * rstd * gv[j]; u32x2 w; w.x = pk2(y.x, y.y); w.y = pk2(y.z, y.w); o8[lane + 64 * j] = w; }
    }
}
DI void phase_rms_final(float* X, const float* g) {
    const int tid = opaque_tid(), lane = tid & 63, wave = tid >> 6;
    const int gw = blockIdx.x * 8 + wave, NGW = gridDim.x * 8;
    f32x4 gv[8];
#pragma unroll
    for (int j = 0; j < 8; ++j) gv[j] = ((const f32x4*)g)[lane + 64 * j];
    for (int m = gw; m < M; m += NGW) {
        f32x4* xr = (f32x4*)(X + (size_t)m * D);
        f32x4 v[8]; float s = 0.f;
#pragma unroll
        for (int j = 0; j < 8; ++j) { v[j] = xr[lane + 64 * j]; s += (v[j].x * v[j].x + v[j].y * v[j].y) + (v[j].z * v[j].z + v[j].w * v[j].w); }
        const float rstd = rsqrtf(wave_sum(s) * (1.f / D) + 1e-6f);
#pragma unroll
        for (int j = 0; j < 8; ++j) xr[lane + 64 * j] = v[j] * rstd * gv[j];
    }
}

struct EpiResid {
    static constexpr bool PERM = false, AFTER_DRAIN = false;
    const float* base; float* out; int ldc; bf16_t* hb; float* rss;
    DI void operator()(const pg8::f32x4 (&acc)[2][2][4][2], const pg8::Unit& u, int wr, int wc, int fr, int fq) const {
        const int col0 = u.pn * pg8::BM + wc * 32 + 4 * fq;
#pragma unroll
        for (int ai = 0; ai < 2; ++ai)
#pragma unroll
            for (int m = 0; m < 4; ++m) {
                const int row = u.pm * pg8::BM + ai * pg8::HALF + wr * 64 + m * 16 + fr;
                const size_t off = (size_t)row * ldc + col0;
                float ssq = 0.f;
#pragma unroll
                for (int bj = 0; bj < 2; ++bj)
#pragma unroll
                    for (int n = 0; n < 2; ++n) { const size_t o = off + bj * pg8::HALF + n * 16; const pg8::f32x4 bs = *(const pg8::f32x4*)(base + o); const pg8::f32x4 v = bs + acc[ai][bj][m][n];
                        *(pg8::f32x4*)(out + o) = v; ssq += (v[0] * v[0] + v[1] * v[1]) + (v[2] * v[2] + v[3] * v[3]);
                        u32x2 w; w.x = pk2(v[0], v[1]); w.y = pk2(v[2], v[3]); *(u32x2*)(hb + o) = w; }
                ssq += __shfl_xor(ssq, 16); ssq += __shfl_xor(ssq, 32);
                if (fq == 0) rss[(size_t)row * 32 + u.pn * 4 + wc] = ssq;
                asm volatile("" ::: "memory");
            }
    }
};
struct EpiBf16RS {
    static constexpr bool PERM = true, AFTER_DRAIN = false;
    bf16_t* O; int ldc; const float* rss;
    DI void operator()(const pg8::f32x4 (&acc)[2][2][4][2], const pg8::Unit& u, int wr, int wc, int fr, int fq) const {
        const int row0 = u.pm * pg8::BM + wr * 64 + fr, col0 = u.pn * pg8::BM + wc * 32 + 8 * fq;
#pragma unroll
        for (int ai = 0; ai < 2; ++ai)
#pragma unroll
            for (int m = 0; m < 4; ++m) {
                const int row = row0 + ai * pg8::HALF + m * 16;
                float sc = 1.f;
                if (rss) { const pg8::f32x4* rp = (const pg8::f32x4*)(rss + (size_t)row * 32); pg8::f32x4 t = rp[0];
#pragma unroll
                    for (int j = 1; j < 8; ++j) t += rp[j];
                    sc = rsqrtf(((t[0] + t[1]) + (t[2] + t[3])) * (1.f / D) + 1e-6f); }
                bf16_t* rowp = O + (size_t)row * ldc + col0;
#pragma unroll
                for (int bj = 0; bj < 2; ++bj) { const pg8::f32x4 v0 = acc[ai][bj][m][0] * sc, v1 = acc[ai][bj][m][1] * sc;
                    u32x4 w; w.x = pk2(v0[0], v0[1]); w.y = pk2(v0[2], v0[3]); w.z = pk2(v1[0], v1[1]); w.w = pk2(v1[2], v1[3]);
                    *(u32x4*)(rowp + bj * pg8::HALF) = w; }
            }
    }
};

DI void phase_prep(const Args& a, int layer, LAS unsigned char* lds) {
    const int tid = opaque_tid(), lane = tid & 63, wave = tid >> 6;
    const int gw = blockIdx.x * 8 + wave, NGW = gridDim.x * 8;
    unsigned char* ws = a.ws;
    const bf16_t* P = (const bf16_t*)(ws + WS_P);
    {
        LAS bf16_t* scr = (LAS bf16_t*)(lds + wave * 9216);
        for (int it = gw; it < 6 * 4 * 256; it += NGW) {
            const int which = it / 1024, bg = (it / 256) & 3, st = it & 255, b = bg >> 1, g = bg & 1;
            if (which >= 3) {
                const int srccol = (which == 3 ? C_KS : which == 4 ? C_KW : C_KB) + g * 64;
                bf16_t* dst = (bf16_t*)(ws + (which == 3 ? WS_KSF : which == 4 ? WS_KWF : WS_KBF)) + (size_t)bg * 64 * S + (size_t)st * 4096;
                float rmax = 0.f;
#pragma unroll
                for (int i = 0; i < 8; ++i) { const int tok = i * 8 + (lane >> 3), q = lane & 7;
                    const u32x4 v = *(const u32x4*)(P + (size_t)(b * S + st * 64 + tok) * NP + srccol + q * 8);
                    const int pos = which == 3 ? (((tok >> 4) * 2 + (q >> 2)) * 64 + (q & 3) * 16 + (tok & 15))
                                               : ((tok >> 5) * 256 + (q >> 1) * 64 + (q & 1) * 32 + (tok & 31));
                    *(u32x4*)(dst + pos * 8) = v;
                    float ss = bflo(v.x) * bflo(v.x) + bfhi(v.x) * bfhi(v.x) + bflo(v.y) * bflo(v.y) + bfhi(v.y) * bfhi(v.y)
                             + bflo(v.z) * bflo(v.z) + bfhi(v.z) * bfhi(v.z) + bflo(v.w) * bflo(v.w) + bfhi(v.w) * bfhi(v.w);
                    ss += __shfl_xor(ss, 1); ss += __shfl_xor(ss, 2); ss += __shfl_xor(ss, 4);
                    rmax = fmaxf(rmax, ss); }
                rmax = fmaxf(rmax, __shfl_xor(rmax, 8)); rmax = fmaxf(rmax, __shfl_xor(rmax, 16)); rmax = fmaxf(rmax, __shfl_xor(rmax, 32));
                if (lane == 0) atomicMax((unsigned*)(ws + WS_KMAX) + (layer * 4 + (which - 3)) * 4 + bg, __builtin_bit_cast(unsigned, rmax));
                continue;
            }
            const int srccol = (which == 0 ? C_VS : which == 1 ? C_VW : C_VB) + g * 64;
            bf16_t* dst = (bf16_t*)(ws + (which == 0 ? WS_VST : which == 1 ? WS_VWT : WS_VBT)) + (size_t)bg * 64 * S + (size_t)st * 4096;
#pragma unroll
            for (int i = 0; i < 8; ++i) { const int tok = i * 8 + (lane >> 3), ch = lane & 7;
                const u32x4 v = *(const u32x4*)(P + (size_t)(b * S + st * 64 + tok) * NP + srccol + ch * 8);
                *(LAS u32x4*)(scr + tok * 72 + ch * 8) = v; }
            LDS_WAIT();
#pragma unroll
            for (int f = 0; f < 8; ++f) {
                int d, kb0, kstep;
                if (which == 0) { const int j = f >> 2, dt = f & 3, hh = lane & 15, qd = lane >> 4; d = 16 * dt + hh; kb0 = 16 * j + 4 * qd; kstep = 32; }
                else { const int tl = f >> 2, j = (f >> 1) & 1, dt = f & 1, c = lane & 31, hi = lane >> 5; d = dt * 32 + c; kb0 = tl * 32 + 16 * j + 4 * hi; kstep = 8; }
                unsigned e[8];
#pragma unroll
                for (int i = 0; i < 8; ++i) e[i] = scr[(kb0 + (i & 3) + kstep * (i >> 2)) * 72 + d];
                u32x4 o; o.x = e[0] | (e[1] << 16); o.y = e[2] | (e[3] << 16); o.z = e[4] | (e[5] << 16); o.w = e[6] | (e[7] << 16);
                *(u32x4*)(dst + (f * 64 + lane) * 8) = o;
            }
            LDS_WAIT();
        }
    }
    {
        const bf16_t* XN = (const bf16_t*)(ws + WS_XN);
        const bf16_t* wg = (const bf16_t*)(ws + WS_WIN) + (size_t)layer * NP * D + (size_t)C_GATE * D;
        bf16_t* Pw = (bf16_t*)(ws + WS_P);
        const int c = lane & 31, hi = lane >> 5;
        for (int it = NGW - 1 - gw; it < M / 32; it += NGW) {
            const bf16_t* ar = XN + (size_t)(it * 32 + c) * D + hi * 8;
            const bf16_t* b0 = wg + (size_t)c * D + hi * 8, *b1 = wg + (size_t)(32 + c) * D + hi * 8;
            f32x16 a0, a1;
#pragma unroll
            for (int r = 0; r < 16; ++r) { a0[r] = 0.f; a1[r] = 0.f; }
#pragma unroll 8
            for (int kk = 0; kk < 128; ++kk) {
                const bf16x8 af = *(const bf16x8*)(ar + kk * 16);
                a0 = MFMA32(af, *(const bf16x8*)(b0 + kk * 16), a0);
                a1 = MFMA32(af, *(const bf16x8*)(b1 + kk * 16), a1);
            }
#pragma unroll
            for (int r = 0; r < 16; ++r) {
                bf16_t* pr = Pw + (size_t)(it * 32 + crow(r, hi)) * NP + C_GATE;
                pr[c] = (bf16_t)f2bf(a0[r]);
                if (c < 16) pr[32 + c] = (bf16_t)f2bf(a1[r]);
            }
        }
    }
    __syncthreads();
    {
        LAS float* H = (LAS float*)lds;
        const int c = lane & 31, hi = lane >> 5, rg = wave >> 2, nt = wave & 3;
        for (int it = blockIdx.x; it < 128; it += gridDim.x) {
            const int kv = it >> 6, bg = (it >> 4) & 3, rt = it & 15, b = bg >> 1, g = bg & 1;
            const float* pos = (kv ? a.cmp_pos_v : a.cmp_pos_k) + (size_t)layer * 32 * 64;
            const bf16_t* w1t = (const bf16_t*)(ws + WS_CW1) + (size_t)(layer * 2 + kv) * 128 * 2048;
            const float* w2 = (kv ? a.cmp_w2_v : a.cmp_w2_k) + (size_t)layer * 128 * 64;
            int irow = rt * 64 + rg * 32 + c; irow = irow > 1022 ? 1022 : irow;
            const bf16_t* src = P + (size_t)(b * S + 16 * irow) * NP + (kv ? C_VC : C_KC) + g * 64;
            const bf16_t* bsrc = w1t + (size_t)(nt * 32 + c) * 2048 + hi * 8;
            f32x16 acc;
#pragma unroll
            for (int r = 0; r < 16; ++r) acc[r] = 0.f;
#pragma unroll 4
            for (int kk = 0; kk < 128; ++kk) {
                const int tok = kk >> 2, d = (kk & 3) * 16 + hi * 8;
                const u32x4 sv = *(const u32x4*)(src + (size_t)tok * NP + d);
                const f32x4 p0 = *(const f32x4*)(pos + tok * 64 + d), p1 = *(const f32x4*)(pos + tok * 64 + d + 4);
                const bf16x8 af = pack8(bflo(sv.x) + p0.x, bfhi(sv.x) + p0.y, bflo(sv.y) + p0.z, bfhi(sv.y) + p0.w,
                                        bflo(sv.z) + p1.x, bfhi(sv.z) + p1.y, bflo(sv.w) + p1.z, bfhi(sv.w) + p1.w);
                const bf16x8 bf = *(const bf16x8*)(bsrc + kk * 16);
                acc = MFMA32(af, bf, acc);
            }
#pragma unroll
            for (int r = 0; r < 16; ++r) H[(rg * 32 + crow(r, hi)) * 129 + nt * 32 + c] = gelu_tanh(acc[r]);
            __syncthreads();
            {
                const int i = tid >> 3, dc = (tid & 7) * 8;
                float o[8];
#pragma unroll
                for (int e = 0; e < 8; ++e) o[e] = 0.f;
                for (int n = 0; n < 128; ++n) {
                    const float hv = H[i * 129 + n];
                    const f32x4 wa = *(const f32x4*)(w2 + n * 64 + dc), wb = *(const f32x4*)(w2 + n * 64 + dc + 4);
                    o[0] += hv * wa.x; o[1] += hv * wa.y; o[2] += hv * wa.z; o[3] += hv * wa.w;
                    o[4] += hv * wb.x; o[5] += hv * wb.y; o[6] += hv * wb.z; o[7] += hv * wb.w;
                }
                const int ig = rt * 64 + i;
                if (ig > 1022) {
#pragma unroll
                    for (int e = 0; e < 8; ++e) o[e] = 0.f;
                }
                if (kv == 0) {
                    u32x4 w; w.x = pk2(o[0], o[1]); w.y = pk2(o[2], o[3]); w.z = pk2(o[4], o[5]); w.w = pk2(o[6], o[7]);
                    float ss = bflo(w.x) * bflo(w.x) + bfhi(w.x) * bfhi(w.x) + bflo(w.y) * bflo(w.y) + bfhi(w.y) * bfhi(w.y)
                             + bflo(w.z) * bflo(w.z) + bfhi(w.z) * bfhi(w.z) + bflo(w.w) * bflo(w.w) + bfhi(w.w) * bfhi(w.w);
                    ss += __shfl_xor(ss, 1); ss += __shfl_xor(ss, 2); ss += __shfl_xor(ss, 4);
                    ss = fmaxf(ss, __shfl_xor(ss, 8)); ss = fmaxf(ss, __shfl_xor(ss, 16)); ss = fmaxf(ss, __shfl_xor(ss, 32));
                    if (lane == 0) atomicMax((unsigned*)(ws + WS_KMAX) + (layer * 4 + 3) * 4 + bg, __builtin_bit_cast(unsigned, ss));
                    const int q = dc >> 3;
                    *(u32x4*)((bf16_t*)(ws + WS_KC) + (size_t)bg * NCP * 64 + (size_t)(ig >> 5) * 2048 + ((q >> 1) * 64 + (q & 1) * 32 + (ig & 31)) * 8) = w;
                } else {
                    const int kk5 = ig & 31, jj = kk5 >> 4, rem = kk5 & 15, hh1 = (rem >> 2) & 1, ii = (rem >> 3) * 4 + (rem & 3);
                    bf16_t* vt = (bf16_t*)(ws + WS_VCT) + (size_t)bg * 64 * NCP + (size_t)(ig >> 5) * 2048 + ii;
#pragma unroll
                    for (int e = 0; e < 8; ++e) { const int dd = dc + e; vt[((jj * 2 + (dd >> 5)) * 64 + hh1 * 32 + (dd & 31)) * 8] = (bf16_t)f2bf(o[e]); }
                }
            }
            __syncthreads();
        }
    }
}

constexpr float LOG2E = 1.4426950408889634f, SC2 = 0.125f * 1.4426950408889634f;
DI float ex2(float x) { return __builtin_amdgcn_exp2f(x); }
DI void loadK32(const bf16_t* kt, int lane, bf16x8 (&k)[4]) {
#pragma unroll
    for (int kk = 0; kk < 4; ++kk) k[kk] = *(const bf16x8*)(kt + (kk * 64 + lane) * 8);
}
DI f32x16 qk32r(const bf16x8 (&k)[4], const bf16x8 (&q)[4]) {
    f32x16 s;
#pragma unroll
    for (int r = 0; r < 16; ++r) s[r] = 0.f;
#pragma unroll
    for (int kk = 0; kk < 4; ++kk) s = MFMA32(k[kk], q[kk], s);
    return s;
}
DI void loadV32(const bf16_t* vt, int lane, bf16x8 (&v)[2][2]) {
#pragma unroll
    for (int j = 0; j < 2; ++j)
#pragma unroll
        for (int dt = 0; dt < 2; ++dt) v[j][dt] = *(const bf16x8*)(vt + ((j * 2 + dt) * 64 + lane) * 8);
}
DI void pv32r(const f32x16& p, const bf16x8 (&v)[2][2], f32x16& o0, f32x16& o1) {
#pragma unroll
    for (int j = 0; j < 2; ++j) {
        const bf16x8 pb = pack8(p[8 * j], p[8 * j + 1], p[8 * j + 2], p[8 * j + 3], p[8 * j + 4], p[8 * j + 5], p[8 * j + 6], p[8 * j + 7]);
        o0 = MFMA32(v[j][0], pb, o0);
        o1 = MFMA32(v[j][1], pb, o1);
    }
}
template <bool MASKED>
DI bool softmax32(f32x16& s, unsigned vm, float& m, float& l, float& alpha) {
    float sum = 0.f;
#pragma unroll
    for (int r = 0; r < 16; ++r) { float p = ex2(s[r] - m); if (MASKED) p = ((vm >> r) & 1u) ? p : 0.f; s[r] = p; sum += p; }
    l += sum; alpha = 1.f;
    return false;
}
#define DPPF(v, ctrl) __builtin_bit_cast(float, __builtin_amdgcn_update_dpp(0, __builtin_bit_cast(int, (v)), (ctrl), 0xF, 0xF, false))
#define DPPI(v, ctrl) __builtin_amdgcn_update_dpp(0, (v), (ctrl), 0xF, 0xF, false)
DI float sum8_dpp(float v) {
    v += __builtin_bit_cast(float, __builtin_amdgcn_update_dpp(0, __builtin_bit_cast(int, v), 0xB1, 0xF, 0xF, false));
    v += __builtin_bit_cast(float, __builtin_amdgcn_update_dpp(0, __builtin_bit_cast(int, v), 0x4E, 0xF, 0xF, false));
    v += __builtin_bit_cast(float, __builtin_amdgcn_update_dpp(0, __builtin_bit_cast(int, v), 0x141, 0xF, 0xF, false));
    return v;
}
DI float sumsq8(const bf16x8 v) { const u32x4 w = __builtin_bit_cast(u32x4, v);
    return bflo(w.x) * bflo(w.x) + bfhi(w.x) * bfhi(w.x) + bflo(w.y) * bflo(w.y) + bfhi(w.y) * bfhi(w.y) + bflo(w.z) * bflo(w.z) + bfhi(w.z) * bfhi(w.z) + bflo(w.w) * bflo(w.w) + bfhi(w.w) * bfhi(w.w); }
DI unsigned logits_cmp(f32x16& s, int key0, int qpos, int hi, const LAS float* bias_h) {
    unsigned vm = 0u;
#pragma unroll
    for (int r = 0; r < 16; ++r) {
        const int dist = qpos - (16 * (key0 + crow(r, hi)) + 31);
        const bool valid = dist >= 0;
        const float bb = bias_h[rel_bucket(dist < 0 ? 0 : dist)];
        s[r] = valid ? s[r] * SC2 + bb : NEGF;
        vm |= valid ? (1u << r) : 0u;
    }
    return vm;
}

constexpr int AW_IMP = 0, AW_OLDS = 4128, AW_SEL = 4128 + 8320, AW_NSEL = AW_SEL + 256, AW_BYTES = 12800;
constexpr int ATT_BIAS_OFF = 8 * AW_BYTES;
constexpr int LUTW_STRIDE = 612, LUTB_STRIDE = 228;
constexpr int ATT_LUTW_OFF = ATT_BIAS_OFF + 4096, ATT_LUTB_OFF = ATT_LUTW_OFF + 8 * LUTW_STRIDE * 4, ATT_LDS_END = ATT_LUTB_OFF + 8 * LUTB_STRIDE * 4;
static_assert(ATT_LDS_END <= LDS_BYTES, "attention LDS map");

template <int W>
DI void window_branch(const bf16_t* Kf  , const bf16_t* Vf  , int lane,
                      const bf16x8 (&qf)[4], const LAS float* lut_h  , int q0, int qpos, int c, int hi,
                      float& m, float& l, f32x16& o0, f32x16& o1) {
    const int kd = q0 & ~31;
    int kstart = q0 - (W - 1); kstart = kstart < 0 ? 0 : kstart; kstart &= ~31;
    bf16x8 kc[4];
    loadK32(Kf + (size_t)(kd >> 5) * 2048, lane, kc);
    const float sini = -m * (1.f / SC2);
#pragma unroll 1
    for (int key0 = kd; key0 >= kstart; key0 -= 32) {
        bf16x8 vf[2][2], kn[4];
        loadV32(Vf + (size_t)(key0 >> 5) * 2048, lane, vf);
        const int nk = key0 - 32 >= kstart ? key0 - 32 : key0;
        loadK32(Kf + (size_t)(nk >> 5) * 2048, lane, kn);
        f32x16 s;
#pragma unroll
        for (int r = 0; r < 16; ++r) s[r] = sini;
#pragma unroll
        for (int kk = 0; kk < 4; ++kk) s = MFMA32(kc[kk], qf[kk], s);
        const LAS float* pt = lut_h + (qpos - key0 - 4 * hi - 27);
        float sum = 0.f;
#pragma unroll
        for (int r = 0; r < 16; ++r) { const float p = ex2(s[r] * SC2 + pt[27 - ((r & 3) + 8 * (r >> 2))]); s[r] = p; sum += p; }
        l += sum;
        pv32r(s, vf, o0, o1);
#pragma unroll
        for (int kk = 0; kk < 4; ++kk) kc[kk] = kn[kk];
    }
}

DI void phase_attn(const Args& a, int layer, LAS unsigned char* lds) {
    const int tid = opaque_tid(), lane = tid & 63, wave = tid >> 6;
    unsigned char* ws = a.ws;
    const bf16_t* P = (const bf16_t*)(ws + WS_P);
    bf16_t* O = (bf16_t*)(ws + WS_O);
    const int bg = blockIdx.x & 3, b = bg >> 1, g = bg & 1, wq = blockIdx.x >> 2, nwq = gridDim.x >> 2;
    LAS float* bias = (LAS float*)(lds + ATT_BIAS_OFF);
    LAS float* lutW = (LAS float*)(lds + ATT_LUTW_OFF);
    LAS float* lutB = (LAS float*)(lds + ATT_LUTB_OFF);
    for (int i = tid; i < 1024; i += NTHREADS) bias[i] = a.rel_bias[(i & 31) * 32 + (i >> 5)] * LOG2E;
    for (int i = tid; i < 8 * LUTW_STRIDE; i += NTHREADS) { const int hh = i / LUTW_STRIDE, dist = i % LUTW_STRIDE - 32;
        lutW[i] = (dist >= 0 && dist < 512) ? a.rel_bias[rel_bucket(dist) * 32 + g * 8 + hh] * LOG2E : NEGF; }
    for (int i = tid; i < 8 * LUTB_STRIDE; i += NTHREADS) { const int hh = i / LUTB_STRIDE, dist = i % LUTB_STRIDE - 32;
        lutB[i] = (dist >= 0 && dist < 128) ? a.rel_bias[rel_bucket(dist) * 32 + 16 + g * 8 + hh] * LOG2E : NEGF; }
    __syncthreads();
    LAS unsigned char* wl = lds + wave * AW_BYTES;
    LAS float* imp = (LAS float*)(wl + AW_IMP);
    LAS float* olds = (LAS float*)(wl + AW_OLDS);
    LAS int* sel = (LAS int*)(wl + AW_SEL);
    LAS int* nsel = (LAS int*)(wl + AW_NSEL);
    const int c = lane & 31, hi = lane >> 5, ql = c >> 3, h = c & 7;
    const bf16_t* Pb = P + (size_t)b * S * NP;
    const bf16_t* kcb = (const bf16_t*)(ws + WS_KC) + (size_t)bg * NCP * 64;
    const bf16_t* vct = (const bf16_t*)(ws + WS_VCT) + (size_t)bg * 64 * NCP;
    const bf16_t* vst = (const bf16_t*)(ws + WS_VST) + (size_t)bg * 64 * S;
    const bf16_t* vwt = (const bf16_t*)(ws + WS_VWT) + (size_t)bg * 64 * S;
    const bf16_t* kwf = (const bf16_t*)(ws + WS_KWF) + (size_t)bg * 64 * S;
    const bf16_t* kbf = (const bf16_t*)(ws + WS_KBF) + (size_t)bg * 64 * S;
    const bf16_t* ksf = (const bf16_t*)(ws + WS_KSF) + (size_t)bg * 64 * S;
    const bf16_t* vbt = (const bf16_t*)(ws + WS_VBT) + (size_t)bg * 64 * S;
    const float sinkv = a.sinks[layer * 16 + g * 8 + h] * LOG2E;
    const LAS float* bias_a = bias + (g * 8 + h) * 32;
    const float b31 = bias_a[31];
    const unsigned* kmx = (const unsigned*)(ws + WS_KMAX) + layer * 16 + bg;
    const float knS = sqrtf(__builtin_bit_cast(float, kmx[0])) * SC2, knW = sqrtf(__builtin_bit_cast(float, kmx[4])) * SC2;
    const float knB = sqrtf(__builtin_bit_cast(float, kmx[8])) * SC2, knC = sqrtf(__builtin_bit_cast(float, kmx[12])) * SC2;
    float bmaxA = bias_a[0], bmaxB = bias[(16 + g * 8 + h) * 32];
    for (int k = 1; k < 32; ++k) { bmaxA = fmaxf(bmaxA, bias_a[k]); bmaxB = fmaxf(bmaxB, bias[(16 + g * 8 + h) * 32 + k]); }
    bmaxA += 0.01f; bmaxB += 0.01f;

#pragma unroll 1
    for (int qt0 = wq; qt0 < S / 32 && wq < nwq; qt0 += nwq) {
        const int rnd = qt0 / nwq, qt32 = ((rnd & 1) && (rnd + 1) * nwq <= S / 32) ? rnd * nwq + (nwq - 1 - wq) : qt0;
        const int q0 = qt32 * 32 + wave * 4;
        const int qpos = q0 + ql;
        const size_t mrow = (size_t)(b * S + qpos);
        const bf16_t* prow = P + mrow * NP;
        {
            bf16x8 qf[4];
#pragma unroll
            for (int kk = 0; kk < 4; ++kk) qf[kk] = *(const bf16x8*)(prow + C_QB + (g * 8 + h) * 64 + kk * 16 + hi * 8);
            float qn2 = sumsq8(qf[0]) + sumsq8(qf[1]) + sumsq8(qf[2]) + sumsq8(qf[3]); qn2 += __shfl_xor(qn2, 32);
            float m = sqrtf(qn2) * knB + bmaxB, l = hi == 0 ? ex2(sinkv - m) : 0.f;
            f32x16 o0, o1;
#pragma unroll
            for (int r = 0; r < 16; ++r) { o0[r] = 0.f; o1[r] = 0.f; }
            window_branch<128>(kbf, vbt, lane, qf, lutB + h * LUTB_STRIDE + 32, q0, qpos, c, hi, m, l, o0, o1);
            const float lt = l + __shfl_xor(l, 32), inv = 1.f / lt;
            bf16_t* orow = O + mrow * D + 1024 + (g * 8 + h) * 64;
#pragma unroll
            for (int dt = 0; dt < 2; ++dt)
#pragma unroll
                for (int q4 = 0; q4 < 4; ++q4) {
                    const f32x16& oo = dt ? o1 : o0;
                    u32x2 w; w.x = pk2(oo[4 * q4] * inv, oo[4 * q4 + 1] * inv); w.y = pk2(oo[4 * q4 + 2] * inv, oo[4 * q4 + 3] * inv);
                    *(u32x2*)(orow + dt * 32 + 8 * q4 + 4 * hi) = w;
                }
        }
        const float gt0 = sigmoidf_(bf2f(prow[C_GATE + (g * 8 + h) * 3 + 0]));
        bf16x8 qfa[4];
#pragma unroll
        for (int kk = 0; kk < 4; ++kk) qfa[kk] = *(const bf16x8*)(prow + C_QA + (g * 8 + h) * 64 + kk * 16 + hi * 8);
        float qnA; { float qn2 = sumsq8(qfa[0]) + sumsq8(qfa[1]) + sumsq8(qfa[2]) + sumsq8(qfa[3]); qn2 += __shfl_xor(qn2, 32); qnA = sqrtf(qn2); }
        for (int i = lane; i < 4 * 257; i += 64) imp[i] = 0.f;
        const int ntile = (q0 + 3) / 512 + 1;
        const int nfast = q0 >= 2040 ? (q0 - 2040) / 512 + 1 : 0;
        {
            float m = qnA * knC + bmaxA, l = 0.f;
            {
                bf16x8 kc[4];
                loadK32(kcb, lane, kc);
#pragma unroll 1
                for (int t = 0; t < ntile; ++t) {
                    bf16x8 kn[4];
                    const int tn = t + 1 < ntile ? t + 1 : t;
                    loadK32(kcb + (size_t)tn * 2048, lane, kn);
                    f32x16 s = qk32r(kc, qfa);
                    float alpha;
                    if (t < nfast) {
#pragma unroll
                        for (int r = 0; r < 16; ++r) s[r] = s[r] * SC2 + b31;
                        (void)softmax32<false>(s, 0u, m, l, alpha);
                    } else {
                        const unsigned vm = logits_cmp(s, t * 32, qpos, hi, bias_a);
                        (void)softmax32<true>(s, vm, m, l, alpha);
                    }
#pragma unroll
                    for (int kk = 0; kk < 4; ++kk) kc[kk] = kn[kk];
                }
            }
            const float lt = l + __shfl_xor(l, 32), inv = lt > 0.f ? 1.f / lt : 0.f;
            f32x16 o0, o1;
#pragma unroll
            for (int r = 0; r < 16; ++r) { o0[r] = 0.f; o1[r] = 0.f; }
            LDS_WAIT();
            bf16x8 kc[4];
            loadK32(kcb, lane, kc);
#pragma unroll 1
            for (int t = 0; t < ntile; ++t) {
                bf16x8 vf[2][2], kn[4];
                loadV32(vct + (size_t)t * 2048, lane, vf);
                const int tn = t + 1 < ntile ? t + 1 : t;
                loadK32(kcb + (size_t)tn * 2048, lane, kn);
                f32x16 s = qk32r(kc, qfa);
                if (t < nfast) {
#pragma unroll
                    for (int r = 0; r < 16; ++r) s[r] = ex2(s[r] * SC2 + (b31 - m)) * inv;
                } else {
                    const unsigned vm = logits_cmp(s, t * 32, qpos, hi, bias_a);
#pragma unroll
                    for (int r = 0; r < 16; ++r) s[r] = ((vm >> r) & 1u) ? ex2(s[r] - m) * inv : 0.f;
                }
#pragma unroll
                for (int grp = 0; grp < 4; ++grp) {
                    float wa = 2.f * (s[4 * grp] + s[4 * grp + 1] + s[4 * grp + 2]) + s[4 * grp + 3], wb = s[4 * grp + 3];
                    wa = sum8_dpp(wa); wb = sum8_dpp(wb);
                    const int j = t * 8 + 2 * grp + hi;
                    if (h == 0) {
                        (void)__hip_atomic_fetch_add(imp + ql * 257 + j, wa, __ATOMIC_RELAXED, __HIP_MEMORY_SCOPE_WORKGROUP);
                        (void)__hip_atomic_fetch_add(imp + ql * 257 + j + 1, wb, __ATOMIC_RELAXED, __HIP_MEMORY_SCOPE_WORKGROUP);
                    }
                }
                pv32r(s, vf, o0, o1);
#pragma unroll
                for (int kk = 0; kk < 4; ++kk) kc[kk] = kn[kk];
            }
#pragma unroll
            for (int r = 0; r < 16; ++r) { olds[c * 65 + crow(r, hi)] = gt0 * o0[r]; olds[c * 65 + 32 + crow(r, hi)] = gt0 * o1[r]; }
        }
        LDS_WAIT();
        {
            const int tq = lane >> 4, sub = lane & 15;
            const int qp = q0 + tq, cb = qp >> 6;
            float v[16];
#pragma unroll
            for (int i = 0; i < 16; ++i) { const int j = sub + 16 * i; v[i] = (j >= 1 && j <= cb - 2) ? imp[tq * 257 + j] : -1.f; }
            int n = (cb < 2 ? cb : 2) + 1;
            if (sub == 0) {
                sel[tq * 16 + 0] = 0;
                if (cb >= 1) sel[tq * 16 + n - 1] = cb;
                if (cb >= 2) sel[tq * 16 + 1] = cb - 1;
            }
#pragma unroll 1
            for (int k = 0; k < 13; ++k) {
                float bv = v[0]; int bj = sub;
#pragma unroll
                for (int i = 1; i < 16; ++i) { if (v[i] > bv) { bv = v[i]; bj = sub + 16 * i; } }
                { const float ov = DPPF(bv, 0xB1); const int oj = DPPI(bj, 0xB1); if (ov > bv || (ov == bv && oj < bj)) { bv = ov; bj = oj; } }
                { const float ov = DPPF(bv, 0x4E); const int oj = DPPI(bj, 0x4E); if (ov > bv || (ov == bv && oj < bj)) { bv = ov; bj = oj; } }
                { const float ov = DPPF(bv, 0x141); const int oj = DPPI(bj, 0x141); if (ov > bv || (ov == bv && oj < bj)) { bv = ov; bj = oj; } }
                { const float ov = DPPF(bv, 0x140); const int oj = DPPI(bj, 0x140); if (ov > bv || (ov == bv && oj < bj)) { bv = ov; bj = oj; } }
                if (bv >= 0.f) {
                    if (sub == 0) sel[tq * 16 + n] = bj;
                    n += 1;
#pragma unroll
                    for (int i = 0; i < 16; ++i) { if (bj == sub + 16 * i) v[i] = -1.f; }
                }
            }
            if (sub == 0) nsel[tq] = n;
        }
        LDS_WAIT();
        {
            const int hh = lane & 15, qd = lane >> 4, hd = hh & 7;
            const LAS float* bias_s = bias + (g * 8 + hd) * 32;
            const float b31s = bias_s[31];

#pragma unroll 1
            for (int qi = 0; qi < 4; ++qi) {
                const int qp = q0 + qi;
                const bf16_t* pr = Pb + (size_t)qp * NP;
                bf16x8 qf[2];
#pragma unroll
                for (int kk = 0; kk < 2; ++kk) qf[kk] = *(const bf16x8*)(pr + C_QA + (g * 8 + hd) * 64 + kk * 32 + qd * 8);
                float qs2 = sumsq8(qf[0]) + sumsq8(qf[1]); qs2 += __shfl_xor(qs2, 16); qs2 += __shfl_xor(qs2, 32);
                const float m = sqrtf(qs2) * knS + bmaxA; float l = 0.f;
                const bool lowc = hh < 8;
                const bf16x8 zero8 = {0, 0, 0, 0, 0, 0, 0, 0};
                bf16x8 qlo[2], qhi[2];
#pragma unroll
                for (int kk = 0; kk < 2; ++kk) { qlo[kk] = lowc ? qf[kk] : zero8; qhi[kk] = lowc ? zero8 : qf[kk]; }
                const int hs = hh >> 3;
                f32x4 o[4];
#pragma unroll
                for (int dt = 0; dt < 4; ++dt) o[dt] = (f32x4){0.f, 0.f, 0.f, 0.f};
                const int ns = __builtin_amdgcn_readfirstlane(nsel[qi]);
                int jb = __builtin_amdgcn_readfirstlane(sel[qi * 16]);
                bf16x8 ka[4][2];
#pragma unroll
                for (int t = 0; t < 4; ++t)
#pragma unroll
                    for (int kk = 0; kk < 2; ++kk) ka[t][kk] = *(const bf16x8*)(ksf + (size_t)jb * 4096 + ((t * 2 + kk) * 64 + lane) * 8);
#pragma unroll 1
                for (int k = 0; k < ns; ++k) {
                    bf16x8 va[2][4], kn[4][2];
#pragma unroll
                    for (int j = 0; j < 2; ++j)
#pragma unroll
                        for (int dt = 0; dt < 4; ++dt) va[j][dt] = *(const bf16x8*)(vst + (size_t)jb * 4096 + ((j * 4 + dt) * 64 + lane) * 8);
                    const int jn = __builtin_amdgcn_readfirstlane(sel[qi * 16 + (k + 1 < ns ? k + 1 : k)]);
#pragma unroll
                    for (int t = 0; t < 4; ++t)
#pragma unroll
                        for (int kk = 0; kk < 2; ++kk) kn[t][kk] = *(const bf16x8*)(ksf + (size_t)jn * 4096 + ((t * 2 + kk) * 64 + lane) * 8);
                    f32x4 s[2];
#pragma unroll
                    for (int u = 0; u < 2; ++u) {
                        s[u] = (f32x4){0.f, 0.f, 0.f, 0.f};
#pragma unroll
                        for (int kk = 0; kk < 2; ++kk) { s[u] = MFMA16(ka[2 * u][kk], qlo[kk], s[u]); s[u] = MFMA16(ka[2 * u + 1][kk], qhi[kk], s[u]); }
                    }
                    if (qp - (jb * 64 + 63) >= 1513) {
                        const float cst = b31s - m;
#pragma unroll
                        for (int u = 0; u < 2; ++u)
#pragma unroll
                            for (int r = 0; r < 4; ++r) s[u][r] = s[u][r] * SC2 + cst;
                    } else {
#pragma unroll
                        for (int u = 0; u < 2; ++u)
#pragma unroll
                            for (int r = 0; r < 4; ++r) {
                                const int dist = qp - (jb * 64 + 16 * (2 * u + hs) + 4 * qd + r);
                                const float bb = bias_s[rel_bucket(dist < 0 ? 0 : dist)];
                                s[u][r] = dist >= 0 ? s[u][r] * SC2 + (bb - m) : NEGF;
                            }
                    }
                    float sum = 0.f;
#pragma unroll
                    for (int u = 0; u < 2; ++u)
#pragma unroll
                        for (int r = 0; r < 4; ++r) { const float p = ex2(s[u][r]); s[u][r] = p; sum += p; }
                    l += sum;
                    {
                        const bf16x8 p8 = pack8(s[0][0], s[0][1], s[0][2], s[0][3], s[1][0], s[1][1], s[1][2], s[1][3]);
                        const bf16x8 plo = lowc ? p8 : zero8, phi = lowc ? zero8 : p8;
#pragma unroll
                        for (int dt = 0; dt < 4; ++dt) { o[dt] = MFMA16(va[0][dt], plo, o[dt]); o[dt] = MFMA16(va[1][dt], phi, o[dt]); }
                    }
                    jb = jn;
#pragma unroll
                    for (int t = 0; t < 4; ++t)
#pragma unroll
                        for (int kk = 0; kk < 2; ++kk) ka[t][kk] = kn[t][kk];
                }
                float lt = l + __shfl_xor(l, 16); lt += __shfl_xor(lt, 32); lt += __shfl_xor(lt, 8);
#pragma unroll
                for (int dt = 0; dt < 4; ++dt)
#pragma unroll
                    for (int r = 0; r < 4; ++r) o[dt][r] += __shfl_xor(o[dt][r], 8);
                const float gt1 = sigmoidf_(bf2f(Pb[(size_t)qp * NP + C_GATE + (g * 8 + hd) * 3 + 1]));
                const float inv = lt > 0.f ? gt1 / lt : 0.f;
                if (hh < 8) {
#pragma unroll
                    for (int dt = 0; dt < 4; ++dt)
#pragma unroll
                        for (int r = 0; r < 4; ++r) olds[(qi * 8 + hh) * 65 + 16 * dt + 4 * qd + r] += o[dt][r] * inv;
                }
            }
        }
        LDS_WAIT();
        {
            int lw = lane; asm volatile("" : "+v"(lw));
            const int c = lw & 31, hi = lw >> 5, h = c & 7, qpos = q0 + (c >> 3);
            const size_t mrow = (size_t)(b * S + qpos);
            const bf16_t* prow = P + mrow * NP;
            const float gt2 = sigmoidf_(bf2f(prow[C_GATE + (g * 8 + h) * 3 + 2]));
            bf16x8 qfw[4];
#pragma unroll
            for (int kk = 0; kk < 4; ++kk) qfw[kk] = *(const bf16x8*)(prow + C_QA + (g * 8 + h) * 64 + kk * 16 + hi * 8);
            float qnW; { float qn2 = sumsq8(qfw[0]) + sumsq8(qfw[1]) + sumsq8(qfw[2]) + sumsq8(qfw[3]); qn2 += __shfl_xor(qn2, 32); qnW = sqrtf(qn2); }
            float m = qnW * knW + bmaxA, l = 0.f;
            f32x16 o0, o1;
#pragma unroll
            for (int r = 0; r < 16; ++r) { o0[r] = 0.f; o1[r] = 0.f; }
            window_branch<512>(kwf, vwt, lw, qfw, lutW + h * LUTW_STRIDE + 32, q0, qpos, c, hi, m, l, o0, o1);
            const float lt = l + __shfl_xor(l, 32), inv = lt > 0.f ? gt2 / lt : 0.f;
            bf16_t* orow = O + mrow * D + (g * 8 + h) * 64;
#pragma unroll
            for (int dt = 0; dt < 2; ++dt)
#pragma unroll
                for (int q4 = 0; q4 < 4; ++q4) {
                    const f32x16& oo = dt ? o1 : o0;
                    const int d0 = dt * 32 + 8 * q4 + 4 * hi;
                    const float e0 = oo[4 * q4] * inv + olds[c * 65 + d0], e1 = oo[4 * q4 + 1] * inv + olds[c * 65 + d0 + 1];
                    const float e2 = oo[4 * q4 + 2] * inv + olds[c * 65 + d0 + 2], e3 = oo[4 * q4 + 3] * inv + olds[c * 65 + d0 + 3];
                    u32x2 w; w.x = pk2(e0, e1); w.y = pk2(e2, e3);
                    *(u32x2*)(orow + d0) = w;
                }
        }
        LDS_WAIT();
    }
}

DI unsigned ordf(float f) { const unsigned u = __builtin_bit_cast(unsigned, f); return (u & 0x80000000u) ? ~u : (u | 0x80000000u); }
DI float unordf(unsigned k) { const unsigned u = (k & 0x80000000u) ? (k & 0x7fffffffu) : ~k; return __builtin_bit_cast(float, u); }

DI void peer_half_topk(const bf16_t* qrow  , const bf16_t* subk  , int hi, int lane, LAS unsigned* ltop) {
    unsigned keys[64];
    asm volatile("" : "+v"(subk));
#pragma unroll
    for (int rt = 0; rt < 4; ++rt) {
        f32x16 acc;
#pragma unroll
        for (int r = 0; r < 16; ++r) acc[r] = 0.f;
#pragma unroll
        for (int kk = 0; kk < 8; ++kk) {
            const bf16x8 af = *(const bf16x8*)(subk + (size_t)(rt * 32) * 128 + kk * 16);
            const bf16x8 bf = *(const bf16x8*)(qrow + kk * 16);
            acc = MFMA32(af, bf, acc);
        }
#pragma unroll
        for (int r = 0; r < 16; ++r) { const int n = rt * 32 + crow(r, hi); keys[rt * 16 + r] = (ordf(acc[r]) & ~0x7Fu) | (unsigned)(127 - n); }
    }
#pragma unroll 1
    for (int k = 0; k < 16; ++k) {
        unsigned mx = keys[0];
#pragma unroll
        for (int i = 1; i < 64; ++i) mx = mx > keys[i] ? mx : keys[i];
        const unsigned om = (unsigned)__shfl_xor((int)mx, 32);
        mx = mx > om ? mx : om;
        ltop[k * 64 + lane] = mx;
#pragma unroll
        for (int i = 0; i < 64; ++i) keys[i] = keys[i] == mx ? 0u : keys[i];
    }
}

DI void phase_peer_select(const Args& a, int layer, LAS unsigned char* lds) {
    const int tid = opaque_tid(), lane = tid & 63, wave = tid >> 6;
    const int gw = blockIdx.x * 8 + wave, NGW = gridDim.x * 8;
    unsigned char* ws = a.ws;
    const bf16_t* Q2 = (const bf16_t*)(ws + WS_Q2);
    const bf16_t* subk = (const bf16_t*)(ws + WS_SUBK) + (size_t)layer * 2 * 128 * 128;
    int* IDX = (int*)(ws + WS_IDX);
    float* GATE = (float*)(ws + WS_GATE);
    LAS unsigned* lt1 = (LAS unsigned*)(lds + wave * 8192);
    LAS unsigned* lt2 = lt1 + 1024;
    const int c = lane & 31, hi = lane >> 5, tl = c >> 3, h = c & 7;
#pragma unroll 1
    for (int unit = gw; unit < M / 4; unit += NGW) {
        const size_t m = (size_t)unit * 4 + tl;
        const bf16_t* qrow = Q2 + m * D + h * 256 + hi * 8;
        peer_half_topk(qrow, subk + (size_t)c * 128 + hi * 8, hi, lane, lt1);
        peer_half_topk(qrow + 128, subk + 128 * 128 + (size_t)c * 128 + hi * 8, hi, lane, lt2);
        LDS_WAIT();
        unsigned t1[16], t2[16];
#pragma unroll
        for (int i = 0; i < 16; ++i) { t1[i] = lt1[i * 64 + lane]; t2[i] = lt2[i * 64 + lane]; }
        unsigned ck[16][16];
#pragma unroll
        for (int x = 0; x < 16; ++x)
#pragma unroll
            for (int y = 0; y < 16; ++y)
                if ((x + 1) * (y + 1) <= 16) ck[x][y] = (ordf(unordf(t1[x] & ~0x7Fu) + unordf(t2[y] & ~0x7Fu)) & ~0xFFu) | (unsigned)(255 - (x * 16 + y));
        const float scmax = unordf(ck[0][0] & ~0xFFu);
        int* ip = IDX + m * 128 + h * 16; float* gp = GATE + m * 128 + h * 16;
        float sum = 0.f;
#pragma unroll 1
        for (int k = 0; k < 16; ++k) {
            unsigned mx = 0u;
#pragma unroll
            for (int x = 0; x < 16; ++x)
#pragma unroll
                for (int y = 0; y < 16; ++y)
                    if ((x + 1) * (y + 1) <= 16) mx = mx > ck[x][y] ? mx : ck[x][y];
#pragma unroll
            for (int x = 0; x < 16; ++x)
#pragma unroll
                for (int y = 0; y < 16; ++y)
                    if ((x + 1) * (y + 1) <= 16) ck[x][y] = ck[x][y] == mx ? 0u : ck[x][y];
            const int ci = 255 - (int)(mx & 0xFFu);
            const int e = (int)(127u - (lt1[(ci >> 4) * 64 + lane] & 0x7Fu)) * 128 + (int)(127u - (lt2[(ci & 15) * 64 + lane] & 0x7Fu));
            const float ek = __expf(unordf(mx & ~0xFFu) - scmax);
            sum += ek;
            if (hi == 0) { ip[k] = e; gp[k] = ek; }
        }
        if (hi == 0) ((float*)(ws + WS_GSUM))[m * 8 + h] = 1.f / sum;
        LDS_WAIT();
    }
}

#define FP8_LO(w) __builtin_amdgcn_cvt_pk_f32_fp8((int)(w), false)
#define FP8_HI(w) __builtin_amdgcn_cvt_pk_f32_fp8((int)(w), true)
DI float dot16(const float (&x)[32], int o, const u32x4 w) {
    const f32x2 a0 = FP8_LO(w.x), a1 = FP8_HI(w.x), a2 = FP8_LO(w.y), a3 = FP8_HI(w.y), a4 = FP8_LO(w.z), a5 = FP8_HI(w.z), a6 = FP8_LO(w.w), a7 = FP8_HI(w.w);
    return (x[o + 0] * a0.x + x[o + 1] * a0.y + x[o + 2] * a1.x + x[o + 3] * a1.y) + (x[o + 4] * a2.x + x[o + 5] * a2.y + x[o + 6] * a3.x + x[o + 7] * a3.y)
         + (x[o + 8] * a4.x + x[o + 9] * a4.y + x[o + 10] * a5.x + x[o + 11] * a5.y) + (x[o + 12] * a6.x + x[o + 13] * a6.y + x[o + 14] * a7.x + x[o + 15] * a7.y);
}
DI float dot16p(const u32x4 xa, const u32x4 xb, const u32x4 w) {
    const f32x2 a0 = FP8_LO(w.x), a1 = FP8_HI(w.x), a2 = FP8_LO(w.y), a3 = FP8_HI(w.y), a4 = FP8_LO(w.z), a5 = FP8_HI(w.z), a6 = FP8_LO(w.w), a7 = FP8_HI(w.w);
    return (bflo(xa.x) * a0.x + bfhi(xa.x) * a0.y + bflo(xa.y) * a1.x + bfhi(xa.y) * a1.y) + (bflo(xa.z) * a2.x + bfhi(xa.z) * a2.y + bflo(xa.w) * a3.x + bfhi(xa.w) * a3.y)
         + (bflo(xb.x) * a4.x + bfhi(xb.x) * a4.y + bflo(xb.y) * a5.x + bfhi(xb.y) * a5.y) + (bflo(xb.z) * a6.x + bfhi(xb.z) * a6.y + bflo(xb.w) * a7.x + bfhi(xb.w) * a7.y);
}
DI void axpy16(float (&acc)[32], int o, float g, const u32x4 w) {
    const f32x2 a0 = FP8_LO(w.x), a1 = FP8_HI(w.x), a2 = FP8_LO(w.y), a3 = FP8_HI(w.y), a4 = FP8_LO(w.z), a5 = FP8_HI(w.z), a6 = FP8_LO(w.w), a7 = FP8_HI(w.w);
    acc[o + 0] += g * a0.x; acc[o + 1] += g * a0.y; acc[o + 2] += g * a1.x; acc[o + 3] += g * a1.y; acc[o + 4] += g * a2.x; acc[o + 5] += g * a2.y; acc[o + 6] += g * a3.x; acc[o + 7] += g * a3.y;
    acc[o + 8] += g * a4.x; acc[o + 9] += g * a4.y; acc[o + 10] += g * a5.x; acc[o + 11] += g * a5.y; acc[o + 12] += g * a6.x; acc[o + 13] += g * a6.y; acc[o + 14] += g * a7.x; acc[o + 15] += g * a7.y;
}
DI void gat_load8(const unsigned char* base, int idlo, int idhi, int g4, unsigned lo16, u32x4 (&buf)[8]) {
    const int ids = g4 < 16 ? idlo : idhi, e0 = (g4 & 15) * 4;
#pragma unroll
    for (int j = 0; j < 4; ++j) { const unsigned of = (unsigned)__shfl(ids, e0 + j) * (unsigned)D + lo16; buf[2 * j] = *(const u32x4*)(base + of); buf[2 * j + 1] = *(const u32x4*)(base + of + 1024u); }
}
DI float dots4(const u32x4 (&xp)[4], const u32x4 b0, const u32x4 b1, const u32x4 b2, const u32x4 b3, const u32x4 b4, const u32x4 b5, const u32x4 b6, const u32x4 b7, int lane) {
    const float d0 = dot16p(xp[0], xp[1], b0) + dot16p(xp[2], xp[3], b1); __builtin_amdgcn_sched_barrier(0);
    const float d1 = dot16p(xp[0], xp[1], b2) + dot16p(xp[2], xp[3], b3); __builtin_amdgcn_sched_barrier(0);
    const float d2 = dot16p(xp[0], xp[1], b4) + dot16p(xp[2], xp[3], b5); __builtin_amdgcn_sched_barrier(0);
    const float d3 = dot16p(xp[0], xp[1], b6) + dot16p(xp[2], xp[3], b7); __builtin_amdgcn_sched_barrier(0);
    const bool p1 = lane & 1, p2 = lane & 2;
    const float b0s = (p1 ? d1 : d0) + __shfl_xor(p1 ? d0 : d1, 1);
    const float b1s = (p1 ? d3 : d2) + __shfl_xor(p1 ? d2 : d3, 1);
    float cs = (p2 ? b1s : b0s) + __shfl_xor(p2 ? b0s : b1s, 2);
    cs += __shfl_xor(cs, 4); cs += __shfl_xor(cs, 8); cs += __shfl_xor(cs, 16); cs += __shfl_xor(cs, 32);
    return cs;
}
constexpr size_t WS_PD = 224 * MiB;
DI void gat_loadhu(const unsigned char* base, int idlo, int idhi, int g8, unsigned lo16, u32x4 (&buf)[8]) {
    const int ids = g8 < 8 ? idlo : idhi, e0 = (g8 & 7) * 8;
#pragma unroll
    for (int j = 0; j < 8; ++j) buf[j] = *(const u32x4*)(base + ((unsigned)__shfl(ids, e0 + j) * (unsigned)D + lo16));
}
DI float dots4h(const u32x4 xa, const u32x4 xb, const u32x4 b0, const u32x4 b1, const u32x4 b2, const u32x4 b3, int lane) {
    const float d0 = dot16p(xa, xb, b0), d1 = dot16p(xa, xb, b1); __builtin_amdgcn_sched_barrier(0);
    const float d2 = dot16p(xa, xb, b2), d3 = dot16p(xa, xb, b3); __builtin_amdgcn_sched_barrier(0);
    const bool p1 = lane & 1, p2 = lane & 2;
    const float b0s = (p1 ? d1 : d0) + __shfl_xor(p1 ? d0 : d1, 1);
    const float b1s = (p1 ? d3 : d2) + __shfl_xor(p1 ? d2 : d3, 1);
    float cs = (p2 ? b1s : b0s) + __shfl_xor(p2 ? b0s : b1s, 2);
    cs += __shfl_xor(cs, 4); cs += __shfl_xor(cs, 8); cs += __shfl_xor(cs, 16); cs += __shfl_xor(cs, 32);
    return cs;
}
DI void phase_peer_u(const Args& a, int layer, int ci) {
    const int tid = opaque_tid(), lane = tid & 63, wave = tid >> 6;
    const int gw = blockIdx.x * 8 + wave, NGW = gridDim.x * 8;
    unsigned char* ws = a.ws;
    const bf16_t* XN = (const bf16_t*)(ws + WS_XN) + ci * 1024 + lane * 16;
    const unsigned char* U = ws + WS_U + (size_t)layer * NEXP * D + ci * 1024;
    const unsigned lo16 = (unsigned)lane * 16u;
    const int* IDX = (const int*)(ws + WS_IDX);
    float* GATE = (float*)(ws + WS_GATE);
    float* PD = (float*)(ws + WS_PD);
    const float* GSUM = (const float*)(ws + WS_GSUM);
    int m = gw;
    if (m < M) {
        int idA = IDX[(size_t)m * 128 + lane], idB = IDX[(size_t)m * 128 + 64 + lane];
        u32x4 xa = *(const u32x4*)(XN + (size_t)m * D), xb = *(const u32x4*)(XN + (size_t)m * D + 8);
        u32x4 cur[8];
        gat_loadhu(U, idA, idB, 0, lo16, cur);
#pragma unroll 1
        for (; m < M; m += NGW) {
            const int mn = m + NGW < M ? m + NGW : m;
            const int idAn = IDX[(size_t)mn * 128 + lane], idBn = IDX[(size_t)mn * 128 + 64 + lane];
            const u32x4 xan = *(const u32x4*)(XN + (size_t)mn * D), xbn = *(const u32x4*)(XN + (size_t)mn * D + 8);
            float glA = 0.f, glB = 0.f, pdA = 0.f, pdB = 0.f, rstdu = 0.f;
            if (ci == 1) {
                glA = GATE[(size_t)m * 128 + lane] * GSUM[(size_t)m * 8 + (lane >> 4)] * (1.f / V_SCALE);
                glB = GATE[(size_t)m * 128 + 64 + lane] * GSUM[(size_t)m * 8 + 4 + (lane >> 4)] * (1.f / V_SCALE);
                pdA = PD[(size_t)m * 128 + lane]; pdB = PD[(size_t)m * 128 + 64 + lane];
                rstdu = __builtin_bit_cast(float, __builtin_amdgcn_readfirstlane(__builtin_bit_cast(int, rsqrtf(wave_sum(lane < 32 ? ((const float*)(ws + WS_RSS))[((size_t)layer * M + m) * 32 + lane] : 0.f) * (1.f / D) + 1e-6f) * (1.f / U_SCALE))));
            }
            float rA = 0.f, rB = 0.f;
#pragma unroll 1
            for (int g8 = 0; g8 < 16; ++g8) {
                u32x4 nxt[8];
                if (g8 < 15) gat_loadhu(U, idA, idB, g8 + 1, lo16, nxt); else gat_loadhu(U, idAn, idBn, 0, lo16, nxt);
                const float c0 = dots4h(xa, xb, cur[0], cur[1], cur[2], cur[3], lane);
                const float c1 = dots4h(xa, xb, cur[4], cur[5], cur[6], cur[7], lane);
                const int q4 = (g8 & 7) * 2;
                const float cv = (lane >> 2) == q4 ? c0 : c1;
                const bool mine = (lane >> 3) == (g8 & 7);
                if (ci == 0) { if (g8 < 8) rA = mine ? cv : rA; else rB = mine ? cv : rB; }
                else { if (g8 < 8) rA = mine ? gelu_tanh((cv + pdA) * rstdu) * glA : rA; else rB = mine ? gelu_tanh((cv + pdB) * rstdu) * glB : rB; }
#pragma unroll
                for (int j = 0; j < 8; ++j) cur[j] = nxt[j];
            }
            if (ci == 0) { PD[(size_t)m * 128 + lane] = rA; PD[(size_t)m * 128 + 64 + lane] = rB; }
            else { GATE[(size_t)m * 128 + lane] = rA; GATE[(size_t)m * 128 + 64 + lane] = rB; }
            idA = idAn; idB = idBn; xa = xan; xb = xbn;
        }
    }
}
DI void gat_loadh(const unsigned char* base, int idlo, int idhi, int g8, unsigned lo16, u32x4 (&buf)[8]) {
    const int ids = g8 < 8 ? idlo : idhi, e0 = (g8 & 7) * 8;
#pragma unroll
    for (int j = 0; j < 8; ++j) buf[j] = *(const u32x4*)(base + ((unsigned)__shfl(ids, e0 + j) * (unsigned)D + lo16));
}
DI void axpy16h(float (&acc)[16], float g, const u32x4 w) {
    const f32x2 a0 = FP8_LO(w.x), a1 = FP8_HI(w.x), a2 = FP8_LO(w.y), a3 = FP8_HI(w.y), a4 = FP8_LO(w.z), a5 = FP8_HI(w.z), a6 = FP8_LO(w.w), a7 = FP8_HI(w.w);
    acc[0] += g * a0.x; acc[1] += g * a0.y; acc[2] += g * a1.x; acc[3] += g * a1.y; acc[4] += g * a2.x; acc[5] += g * a2.y; acc[6] += g * a3.x; acc[7] += g * a3.y;
    acc[8] += g * a4.x; acc[9] += g * a4.y; acc[10] += g * a5.x; acc[11] += g * a5.y; acc[12] += g * a6.x; acc[13] += g * a6.y; acc[14] += g * a7.x; acc[15] += g * a7.y;
}
DI void phase_peer_v(const Args& a, int layer, int ci) {
    const int tid = opaque_tid(), lane = tid & 63, wave = tid >> 6;
    const int gw = blockIdx.x * 8 + wave, NGW = gridDim.x * 8;
    unsigned char* ws = a.ws;
    const unsigned char* V = ws + WS_V + (size_t)layer * NEXP * D + ci * 1024;
    const unsigned lo16 = (unsigned)lane * 16u;
    const int* IDX = (const int*)(ws + WS_IDX);
    const float* GH = (const float*)(ws + WS_GATE);
    int m = gw;
    if (m < M) {
        int idA = IDX[(size_t)m * 128 + lane], idB = IDX[(size_t)m * 128 + 64 + lane];
        u32x4 cur[8];
        gat_loadh(V, idA, idB, 0, lo16, cur);
#pragma unroll 1
        for (; m < M; m += NGW) {
            const int mn = m + NGW < M ? m + NGW : m;
            const int idAn = IDX[(size_t)mn * 128 + lane], idBn = IDX[(size_t)mn * 128 + 64 + lane];
            const float ghA = GH[(size_t)m * 128 + lane], ghB = GH[(size_t)m * 128 + 64 + lane];
            float acc[16];
#pragma unroll
            for (int i = 0; i < 16; ++i) acc[i] = 0.f;
#pragma unroll 1
            for (int g8 = 0; g8 < 16; ++g8) {
                u32x4 nxt[8];
                if (g8 < 15) gat_loadh(V, idA, idB, g8 + 1, lo16, nxt); else gat_loadh(V, idAn, idBn, 0, lo16, nxt);
                const float ghs = g8 < 8 ? ghA : ghB;
#pragma unroll
                for (int j = 0; j < 8; ++j) { const float gv = __shfl(ghs, (g8 & 7) * 8 + j); axpy16h(acc, gv, cur[j]); if (j & 1) __builtin_amdgcn_sched_barrier(0); }
#pragma unroll
                for (int j = 0; j < 8; ++j) cur[j] = nxt[j];
            }
            idA = idAn; idB = idBn;
            float* hrow = a.out + (size_t)m * D;
            const int col = ci * 1024 + lane * 16;
            float ss = 0.f;
#pragma unroll
            for (int q = 0; q < 4; ++q) { const f32x4 h = *(const f32x4*)(hrow + col + 4 * q);
                acc[4 * q] += h.x; acc[4 * q + 1] += h.y; acc[4 * q + 2] += h.z; acc[4 * q + 3] += h.w; }
            if (ci == 0) {
#pragma unroll
                for (int q = 0; q < 4; ++q) { f32x4 h; h.x = acc[4 * q]; h.y = acc[4 * q + 1]; h.z = acc[4 * q + 2]; h.w = acc[4 * q + 3]; *(f32x4*)(hrow + col + 4 * q) = h; }
            } else {
                f32x4 ho[4];
#pragma unroll
                for (int q = 0; q < 4; ++q) { ho[q] = *(const f32x4*)(hrow + lane * 16 + 4 * q); ss += (ho[q].x * ho[q].x + ho[q].y * ho[q].y) + (ho[q].z * ho[q].z + ho[q].w * ho[q].w); }
#pragma unroll
                for (int i = 0; i < 16; ++i) ss += acc[i] * acc[i];
                const float rstd = rsqrtf(wave_sum(ss) * (1.f / D) + 1e-6f);
                const float* gn = layer + 1 < NLAYER ? a.attn_norm + (size_t)(layer + 1) * D : a.final_norm;
                asm volatile("" : "+s"(gn));
                bf16_t* xrow = (bf16_t*)(ws + WS_XN) + (size_t)m * D;
#pragma unroll
                for (int q = 0; q < 4; ++q) {
                    const f32x4 g0 = *(const f32x4*)(gn + lane * 16 + 4 * q), g1 = *(const f32x4*)(gn + col + 4 * q);
                    f32x4 h1; h1.x = acc[4 * q]; h1.y = acc[4 * q + 1]; h1.z = acc[4 * q + 2]; h1.w = acc[4 * q + 3];
                    const f32x4 y0 = ho[q] * rstd * g0, y1 = h1 * rstd * g1;
                    if (layer + 1 < NLAYER) {
                        *(f32x4*)(hrow + col + 4 * q) = h1;
                        u32x2 w0; w0.x = pk2(y0.x, y0.y); w0.y = pk2(y0.z, y0.w); *(u32x2*)(xrow + lane * 16 + 4 * q) = w0;
                        u32x2 w1; w1.x = pk2(y1.x, y1.y); w1.y = pk2(y1.z, y1.w); *(u32x2*)(xrow + col + 4 * q) = w1;
                    } else { *(f32x4*)(hrow + lane * 16 + 4 * q) = y0; *(f32x4*)(hrow + col + 4 * q) = y1; }
                }
            }
        }
    }
}

constexpr size_t WS_BAR = 95 * MiB;
#define XB_TMO      128
#define XB_XCNT(j)  (256  + 64 * (j))
#define XB_XSUB(j)  (1280 + 64 * (j))
#define XB_XGEN(j)  (2304 + 64 * (j))
#define XB_TOP      3328
#define XB_TOPGEN   3392
#define XCD_BAR_WORDS 3456
#define XB_SPIN_CAP (1u << 18)

__device__ __forceinline__ unsigned xb_ld(unsigned* p)              { return __hip_atomic_load(p, __ATOMIC_RELAXED, __HIP_MEMORY_SCOPE_AGENT); }
__device__ __forceinline__ unsigned xb_add(unsigned* p, unsigned v) { return __hip_atomic_fetch_add(p, v, __ATOMIC_RELAXED, __HIP_MEMORY_SCOPE_AGENT); }
__device__ __forceinline__ unsigned xb_xcc_id() { return (unsigned)__builtin_amdgcn_s_getreg((3 << 11) | 20) & 0xFu; }
#define XB_SPIN(cond, bar) do { unsigned _sp = 0; while (cond) { __builtin_amdgcn_s_sleep(1); \
    if ((++_sp & 255u) == 0u) { if (xb_ld(&(bar)[XB_TMO])) break; if (_sp > XB_SPIN_CAP) { atomicAdd(&(bar)[XB_TMO], 1u); break; } } } } while (0)

struct XcdBarrier {
    unsigned* bar; unsigned x;
    volatile LAS unsigned* st;
};

__device__ __forceinline__ XcdBarrier xcd_barrier_post(unsigned* bar, volatile LAS unsigned* st) {
    XcdBarrier b; b.bar = bar; b.x = xb_xcc_id(); b.st = st;
    if (threadIdx.x == 0) (void)xb_add(&bar[XB_XCNT(b.x)], 1u);
    return b;
}
__device__ __forceinline__ void xcd_barrier_complete(unsigned* bar, unsigned x, unsigned& nloc, unsigned& nx) {
    const unsigned G = gridDim.x * gridDim.y * gridDim.z;
    unsigned sum, cnt, mine, sp = 0u;
    for (;;) {
        sum = 0u; cnt = 0u; mine = 0u;
#pragma unroll
        for (unsigned j = 0; j < 16; ++j) { const unsigned c = xb_ld(&bar[XB_XCNT(j)]); sum += c; cnt += (c > 0u) ? 1u : 0u; mine = (j == x) ? c : mine; }
        if (sum == G) break;
        __builtin_amdgcn_s_sleep(1);
        if ((++sp & 255u) == 0u) { if (xb_ld(&bar[XB_TMO])) break; if (sp > XB_SPIN_CAP) { atomicAdd(&bar[XB_TMO], 1u); break; } }
    }
    nloc = mine > 0u ? mine : 1u; nx = cnt > 0u ? cnt : 1u;
}

__device__ __forceinline__ void xcd_barrier(const XcdBarrier& b) {
    asm volatile("s_waitcnt vmcnt(0)" ::: "memory");
    __syncthreads();
    if (threadIdx.x == 0) {
        unsigned* bar = b.bar;
        __builtin_amdgcn_s_waitcnt(0);
        unsigned nloc = b.st[0], nx = b.st[1];
        if (nloc == 0u) { xcd_barrier_complete(bar, b.x, nloc, nx); b.st[0] = nloc; b.st[1] = nx; }
        const unsigned old = xb_add(&bar[XB_XSUB(b.x)], 1u);
        const unsigned gen = old / nloc;
        if (old + 1u == (gen + 1u) * nloc) {
            __builtin_amdgcn_fence(__ATOMIC_RELEASE, "agent");
            asm volatile("s_waitcnt vmcnt(0)" ::: "memory");
            const unsigned og = xb_add(&bar[XB_TOP], 1u);
            const unsigned tg = og / nx;
            if (og + 1u == (tg + 1u) * nx) xb_add(&bar[XB_TOPGEN], 1u);
            else XB_SPIN(xb_ld(&bar[XB_TOPGEN]) == tg, bar);
            __builtin_amdgcn_fence(__ATOMIC_ACQUIRE, "agent");
            xb_add(&bar[XB_XGEN(b.x)], 1u);
            asm volatile("s_waitcnt vmcnt(0)" ::: "memory");
        } else {
            XB_SPIN(xb_ld(&bar[XB_XGEN(b.x)]) == gen, bar);
            __builtin_amdgcn_fence(__ATOMIC_ACQUIRE, "agent");
            asm volatile("s_waitcnt vmcnt(0)" ::: "memory");
        }
    }
    __syncthreads();
}

constexpr int NPHASE = 26, PH_PER_LAYER = 12;
template <int KIND>
DI void run_phase(const Args& a, int layer, LAS unsigned char* lds, int aux = 0) {
    unsigned char* ws = a.ws;
    if constexpr (KIND == 0) { phase_prologue(a, lds); phase_rms_bf16(a.x, a.attn_norm, (bf16_t*)(ws + WS_XN)); }
    if constexpr (KIND == 1) phase_rms_bf16(layer == 0 ? a.x : a.out, a.attn_norm + (size_t)layer * D, (bf16_t*)(ws + WS_XN));
    if constexpr (KIND == 2 || KIND == 7) {
        const bool inproj = KIND == 2;
        const int N = inproj ? C_GATE : D, ldw = inproj ? NP : D;
        pg8::Gemm g{(const bf16_t*)(ws + WS_XN), (const bf16_t*)(ws + (inproj ? WS_WIN : WS_WQ)) + (size_t)layer * ldw * D, M, N, D};
        pg8::StaticOrder So; So.init(M, N, (int)gridDim.x, (int)blockIdx.x);
        EpiBf16RS E{(bf16_t*)(ws + (inproj ? WS_P : WS_Q2)), ldw, inproj ? nullptr : (const float*)(ws + WS_RSS) + (size_t)layer * M * 32};
        pg8::gemm_phase<EpiBf16RS, pg8::StaticOrder, true, true>(lds, g, So, E);
    }
    if constexpr (KIND == 3) phase_prep(a, layer, lds);
    if constexpr (KIND == 4) phase_attn(a, layer, lds);
    if constexpr (KIND == 5) {
        pg8::Gemm g{(const bf16_t*)(ws + WS_O), (const bf16_t*)(ws + WS_WOUT) + (size_t)layer * D * D, M, D, D};
        pg8::StaticOrder So; So.init(M, D, (int)gridDim.x, (int)blockIdx.x);
        EpiResid E{layer == 0 ? a.x : a.out, a.out, D, (bf16_t*)(ws + WS_XN), (float*)(ws + WS_RSS) + (size_t)layer * M * 32};
        pg8::gemm_phase<EpiResid, pg8::StaticOrder, true, true>(lds, g, So, E);
    }
    if constexpr (KIND == 6) phase_rms_bf16(a.out, a.ffn_norm + (size_t)layer * D, (bf16_t*)(ws + WS_XN));
    if constexpr (KIND == 8) phase_peer_select(a, layer, lds);
    if constexpr (KIND == 9) phase_peer_u(a, layer, aux);
    if constexpr (KIND == 14) phase_peer_v(a, layer, aux);
    if constexpr (KIND == 10) phase_rms_final(a.out, a.final_norm);
}

#ifndef MK_PER_PHASE
#define MK_PER_PHASE 0
#endif

#if MK_PER_PHASE
template <int KIND>
__global__ void __launch_bounds__(NTHREADS, 2) k_phase(Args a, int layer) {
    extern __shared__ __attribute__((aligned(16))) unsigned char lds_raw[];
    run_phase<KIND>(a, layer, (LAS unsigned char*)lds_raw);
}
template <int KIND> static void launch_phase(const Args& a, int layer, int grid, hipStream_t stream) {
    static bool attr = false;
    if (!attr) { (void)hipFuncSetAttribute((const void*)k_phase<KIND>, hipFuncAttributeMaxDynamicSharedMemorySize, LDS_BYTES); attr = true; }
    hipLaunchKernelGGL(k_phase<KIND>, dim3(grid), dim3(NTHREADS), LDS_BYTES, stream, a, layer);
}
#else
__global__ void __launch_bounds__(NTHREADS, 2) hybrid_fwd(Args a) {
    extern __shared__ __attribute__((aligned(16))) unsigned char lds_raw[];
    LAS unsigned char* lds = (LAS unsigned char*)lds_raw;
    volatile LAS unsigned* bst = (volatile LAS unsigned*)(lds + LDS_BYTES - 16);
    if (threadIdx.x < 4) bst[threadIdx.x] = 0u;
    __syncthreads();
    const XcdBarrier xbar = xcd_barrier_post((unsigned*)(a.ws + WS_BAR), bst);
    bool first_seam = true;
#pragma unroll 1
    for (int ph = a.ph_lo; ph < a.ph_hi; ++ph) {
        if (ph == NPHASE - 1 || ph == 1 + PH_PER_LAYER || ph == 1 || ph == 6 || ph == 6 + PH_PER_LAYER) continue;
        if (ph == 0) run_phase<0>(a, 0, lds);
        else if (ph == NPHASE - 1) run_phase<10>(a, 0, lds);
        else {
            const int layer = (ph - 1) / PH_PER_LAYER, k = (ph - 1) % PH_PER_LAYER;
            if (k == 0) run_phase<1>(a, layer, lds);
            else if (k == 1) run_phase<2>(a, layer, lds);
            else if (k == 2) run_phase<3>(a, layer, lds);
            else if (k == 3) run_phase<4>(a, layer, lds);
            else if (k == 4) run_phase<5>(a, layer, lds);
            else if (k == 5) run_phase<6>(a, layer, lds);
            else if (k == 6) run_phase<7>(a, layer, lds);
            else if (k == 7) run_phase<8>(a, layer, lds);
            else if (k < 10) run_phase<9>(a, layer, lds, k - 8);
            else run_phase<14>(a, layer, lds, k - 10);
        }
        if (ph + 1 < a.ph_hi) { if (first_seam) { cg::this_grid().sync(); first_seam = false; } else xcd_barrier(xbar); }
    }
}
#endif

extern "C" void kernel_launch(void* const* d_in, const int* in_sizes, int n_in, void* d_out, int out_size, void* d_ws, size_t ws_size, hipStream_t stream) {
    static int grid = 0;
    if (grid == 0) {
        if (n_in != 18 || out_size != M * D || ws_size < WS_END) { fprintf(stderr, "kernel_launch: unexpected shapes (n_in %d, out %d, ws %zu)\n", n_in, out_size, ws_size); grid = -1; return; }
        int dev = 0, cus = 0;
        if (hipGetDevice(&dev) != hipSuccess || hipDeviceGetAttribute(&cus, hipDeviceAttributeMultiprocessorCount, dev) != hipSuccess) { grid = -1; return; }
#if !MK_PER_PHASE
        if (hipFuncSetAttribute((const void*)hybrid_fwd, hipFuncAttributeMaxDynamicSharedMemorySize, LDS_BYTES) != hipSuccess) { fprintf(stderr, "kernel_launch: hipFuncSetAttribute failed\n"); grid = -1; return; }
        int per_cu = 0;
        if (hipOccupancyMaxActiveBlocksPerMultiprocessor(&per_cu, (const void*)hybrid_fwd, NTHREADS, LDS_BYTES) != hipSuccess || per_cu < 1) fprintf(stderr, "kernel_launch: occupancy query says %d\n", per_cu);
        (void)hipGetLastError();
#endif
        grid = cus;
    }
    if (grid < 0) return;
    Args a{};
    a.x = (const float*)d_in[0]; a.attn_norm = (const float*)d_in[1]; a.w_in = (const float*)d_in[2]; a.cmp_pos_k = (const float*)d_in[3];
    a.cmp_w1_k = (const float*)d_in[4]; a.cmp_w2_k = (const float*)d_in[5]; a.cmp_pos_v = (const float*)d_in[6]; a.cmp_w1_v = (const float*)d_in[7];
    a.cmp_w2_v = (const float*)d_in[8]; a.sinks = (const float*)d_in[9]; a.w_out = (const float*)d_in[10]; a.ffn_norm = (const float*)d_in[11];
    a.peer_wq = (const float*)d_in[12]; a.peer_subkeys = (const float*)d_in[13]; a.peer_u = (const float*)d_in[14]; a.peer_v = (const float*)d_in[15];
    a.rel_bias = (const float*)d_in[16]; a.final_norm = (const float*)d_in[17];
    a.out = (float*)d_out; a.ws = (unsigned char*)d_ws;
    a.ph_lo = 0; a.ph_hi = NPHASE;
#if MK_PER_PHASE
    launch_phase<0>(a, 0, grid, stream);
    for (int l = 0; l < NLAYER; ++l) {
        launch_phase<2>(a, l, grid, stream); launch_phase<3>(a, l, grid, stream);
        launch_phase<4>(a, l, grid, stream); launch_phase<5>(a, l, grid, stream);
        launch_phase<7>(a, l, grid, stream); launch_phase<8>(a, l, grid, stream); launch_phase<9>(a, l, grid, stream); launch_phase<14>(a, l, grid, stream);
    }
#else
    (void)hipMemsetAsync((unsigned char*)d_ws + WS_BAR, 0, 16384, stream);
    void* args[] = {&a};
    const hipError_t e = hipLaunchCooperativeKernel((const void*)hybrid_fwd, dim3(grid), dim3(NTHREADS), args, LDS_BYTES, stream);
    if (e != hipSuccess) fprintf(stderr, "kernel_launch: cooperative launch failed: %s (grid %d)\n", hipGetErrorString(e), grid);
#endif
}
```
